# Optimizing an MI355X kernel written in HIP

```python
import math
import jax, jax.numpy as jnp
from jax import lax
import numpy as np

D_MODEL = 1024
BATCH = 8
SEQ = 4096
DEPTH = 1

PLE_DIM = 256
ROPE_THETA = 10000.0
RMS_EPS = 1e-6
Q_BLOCK = 128

D_MIX = D_MODEL
DIFF_WIDTH = D_MIX // 2
DIFF_HEADS = 4
DIFF_HD = DIFF_WIDTH // (2 * DIFF_HEADS)
MLA_WIDTH = D_MIX - DIFF_WIDTH
MLA_HEADS = 8
MLA_NOPE = 64
MLA_ROPE = 32
MLA_V = MLA_WIDTH // MLA_HEADS
MLA_Q_LORA = 384
MLA_KV_LORA = 128
SPLIT_SIZES = (DIFF_WIDTH, DIFF_WIDTH, DIFF_WIDTH, DIFF_WIDTH,
               MLA_Q_LORA, MLA_KV_LORA, MLA_ROPE, MLA_WIDTH)
D_IN = sum(SPLIT_SIZES)

kernel_name = "hymba_diffattn_mla_parallel_heads"


def rms_norm(x, g):
    xf = x.astype(jnp.float32)
    y = xf * lax.rsqrt(jnp.mean(xf * xf, axis=-1, keepdims=True) + RMS_EPS)
    return (y * g.astype(jnp.float32)).astype(x.dtype)


def rope(x, pos):
    d = x.shape[-1]
    inv = ROPE_THETA ** (-jnp.arange(0, d, 2, dtype=jnp.float32) / d)
    ang = pos.astype(jnp.float32)[..., None] * inv
    cos = jnp.cos(ang)[:, :, None, :]
    sin = jnp.sin(ang)[:, :, None, :]
    xf = x.astype(jnp.float32)
    x1, x2 = xf[..., : d // 2], xf[..., d // 2:]
    return jnp.concatenate([x1 * cos - x2 * sin, x2 * cos + x1 * sin], axis=-1).astype(x.dtype)


def to_blocks(t):
    b, s = t.shape[:2]
    return t.reshape(b, s // Q_BLOCK, Q_BLOCK, *t.shape[2:]).swapaxes(0, 1)


def from_blocks(t):
    nb, b, blk = t.shape[:3]
    return t.swapaxes(0, 1).reshape(b, nb * blk, *t.shape[3:])


def causal_probs(scores, start, seq):
    q_idx = start + jnp.arange(Q_BLOCK)
    k_idx = jnp.arange(seq)
    mask = k_idx[None, :] <= q_idx[:, None]
    return jax.nn.softmax(jnp.where(mask, scores, -jnp.inf), axis=-1)


def diff_attention(q, k, v, lam, pos):
    b, s, h, _, d = q.shape
    q = rope(q.reshape(b, s, 2 * h, d), pos).reshape(b, s, h, 2, d)
    k = rope(k.reshape(b, s, 2 * h, d), pos).reshape(b, s, h, 2, d)
    scale = d ** -0.5

    def block(args):
        qb, start = args
        sc = jnp.einsum('bqhmd,bkhmd->mbhqk', qb, k).astype(jnp.float32) * scale
        pr = causal_probs(sc, start, s)
        a = pr[0] - lam * pr[1]
        return jnp.einsum('bhqk,bkhe->bqhe', a.astype(v.dtype), v)

    starts = jnp.arange(s // Q_BLOCK) * Q_BLOCK
    return from_blocks(lax.map(block, (to_blocks(q), starts)))


def mla_attention(q_nope, q_rope, k_nope, k_rope, v):
    s = q_nope.shape[1]
    scale = (MLA_NOPE + MLA_ROPE) ** -0.5

    def block(args):
        qn, qr, start = args
        sc = (jnp.einsum('bqhd,bkhd->bhqk', qn, k_nope)
              + jnp.einsum('bqhr,bkr->bhqk', qr, k_rope)).astype(jnp.float32) * scale
        pr = causal_probs(sc, start, s)
        return jnp.einsum('bhqk,bkhd->bqhd', pr.astype(v.dtype), v)

    starts = jnp.arange(s // Q_BLOCK) * Q_BLOCK
    return from_blocks(lax.map(block, (to_blocks(q_nope), to_blocks(q_rope), starts)))


def setup_inputs(seed: int = 0) -> dict:
    key = jax.random.key(seed)
    ks = jax.random.split(key, 16)
    nrm = jax.random.normal
    f32 = jnp.float32
    x = nrm(ks[0], (BATCH, SEQ, D_MODEL), f32)
    p = nrm(ks[1], (DEPTH, BATCH, SEQ, PLE_DIM), f32)
    offset = jax.random.randint(ks[2], (BATCH, 1), 0, 1024, dtype=jnp.int32)
    positions = (offset + jnp.arange(SEQ, dtype=jnp.int32)[None, :]).astype(jnp.int32)
    norm_g = 1.0 + 0.02 * nrm(ks[3], (DEPTH, D_MODEL), f32)
    w_in = nrm(ks[4], (DEPTH, D_MODEL, D_IN), f32) * D_MODEL ** -0.5
    diff_lambda = 0.1 * nrm(ks[5], (DEPTH, 4, DIFF_HD), f32)
    diff_subln_g = 1.0 + 0.02 * nrm(ks[6], (DEPTH, 2 * DIFF_HD), f32)
    mla_q_norm_g = 1.0 + 0.02 * nrm(ks[7], (DEPTH, MLA_Q_LORA), f32)
    w_uq = nrm(ks[8], (DEPTH, MLA_Q_LORA, MLA_HEADS * (MLA_NOPE + MLA_ROPE)), f32) * MLA_Q_LORA ** -0.5
    mla_kv_norm_g = 1.0 + 0.02 * nrm(ks[9], (DEPTH, MLA_KV_LORA), f32)
    w_ukv = nrm(ks[10], (DEPTH, MLA_KV_LORA, MLA_HEADS * (MLA_NOPE + MLA_V)), f32) * MLA_KV_LORA ** -0.5
    w_out = nrm(ks[11], (DEPTH, D_MIX, D_MODEL), f32) * D_MIX ** -0.5
    w_ple = nrm(ks[12], (DEPTH, PLE_DIM, D_MODEL), f32) * PLE_DIM ** -0.5
    w_ple_gate = nrm(ks[13], (DEPTH, D_MODEL, D_MODEL), f32) * D_MODEL ** -0.5
    final_norm_g = 1.0 + 0.02 * nrm(ks[14], (D_MODEL,), f32)
    return {"x": x, "p": p, "positions": positions, "norm_g": norm_g, "w_in": w_in,
            "diff_lambda": diff_lambda, "diff_subln_g": diff_subln_g,
            "mla_q_norm_g": mla_q_norm_g, "w_uq": w_uq, "mla_kv_norm_g": mla_kv_norm_g,
            "w_ukv": w_ukv, "w_out": w_out, "w_ple": w_ple, "w_ple_gate": w_ple_gate,
            "final_norm_g": final_norm_g}


def reference(x, p, positions, norm_g, w_in, diff_lambda, diff_subln_g, mla_q_norm_g, w_uq,
              mla_kv_norm_g, w_ukv, w_out, w_ple, w_ple_gate, final_norm_g):
    b, s, _ = x.shape
    offsets = [int(o) for o in np.cumsum(SPLIT_SIZES)[:-1]]
    h = x
    for i in range(DEPTH):
        n = rms_norm(h, norm_g[i])
        proj = n @ w_in[i]
        dq, dk, dv, dgate, cq, ckv, kr, mgate = jnp.split(proj, offsets, axis=-1)

        lq1, lk1, lq2, lk2 = diff_lambda[i].astype(jnp.float32)
        lam_init = 0.8 - 0.6 * math.exp(-0.3 * i)
        lam = jnp.exp(jnp.sum(lq1 * lk1)) - jnp.exp(jnp.sum(lq2 * lk2)) + lam_init
        od = diff_attention(dq.reshape(b, s, DIFF_HEADS, 2, DIFF_HD),
                            dk.reshape(b, s, DIFF_HEADS, 2, DIFF_HD),
                            dv.reshape(b, s, DIFF_HEADS, 2 * DIFF_HD), lam, positions)
        od = rms_norm(od, diff_subln_g[i]) * (1.0 - lam_init)
        od = od.reshape(b, s, DIFF_WIDTH) * jax.nn.silu(dgate)

        q = (rms_norm(cq, mla_q_norm_g[i]) @ w_uq[i]).reshape(b, s, MLA_HEADS, MLA_NOPE + MLA_ROPE)
        q_nope = q[..., :MLA_NOPE]
        q_rope = rope(q[..., MLA_NOPE:], positions)
        kv = (rms_norm(ckv, mla_kv_norm_g[i]) @ w_ukv[i]).reshape(b, s, MLA_HEADS, MLA_NOPE + MLA_V)
        k_nope, v = kv[..., :MLA_NOPE], kv[..., MLA_NOPE:]
        k_rope = rope(kr[:, :, None, :], positions)[:, :, 0, :]
        om = mla_attention(q_nope, q_rope, k_nope, k_rope, v).reshape(b, s, MLA_WIDTH)
        om = om * jax.nn.silu(mgate)

        h = h + jnp.concatenate([od, om], axis=-1) @ w_out[i]

        h = h + (p[i] @ w_ple[i]) * jax.nn.sigmoid(h @ w_ple_gate[i])
    return rms_norm(h, final_norm_g)
```

```cpp
#include <hip/hip_runtime.h>
#include <cstdio>
#include <cstdint>

typedef unsigned short bf16_t;

constexpr int BATCH = 8, SEQ = 4096, T = BATCH * SEQ, DM = 1024, DIN = 3104, PLE_DIM = 256;
constexpr int OFF_DQ = 0, OFF_DK = 512, OFF_DV = 1024, OFF_DG = 1536, OFF_CQ = 2048, OFF_CKV = 2432, OFF_KR = 2560, OFF_MG = 2592;
constexpr int QLORA = 384, KVLORA = 128;
constexpr float RMS_EPS = 1e-6f;
constexpr float LOG2E = 1.4426950408889634f;
constexpr float C2D = 0.125f * LOG2E;
constexpr float C2M = 0.10206207261596575f * LOG2E;
constexpr float LAM_INIT = 0.2f;
constexpr int NT = 512;

constexpr size_t MiB = 1u << 20;
constexpr size_t WS_CTL = 0;
constexpr size_t WS_MISC = 1 * MiB;
constexpr size_t WS_SSQQ = 1 * MiB + 65536, WS_SSQKV = WS_SSQQ + 131072, WS_SSQF = WS_SSQKV + 131072;
constexpr size_t WS_CSA = 2 * MiB, WS_CSB = 10 * MiB;
constexpr size_t WS_WIN = 14 * MiB, WS_WPLE = 21 * MiB, WS_WUQ = 22 * MiB, WS_WUKV = 23 * MiB, WS_WOUT = 24 * MiB, WS_WG = 26 * MiB;
constexpr size_t WS_PB = 28 * MiB, WS_CQ = 44 * MiB, WS_CKV = 68 * MiB, WS_XN = 76 * MiB, WS_OD = WS_XN;
constexpr size_t WS_QD = 140 * MiB, WS_KD = 172 * MiB, WS_PLE = WS_QD, WS_VD = 204 * MiB, WS_G = 236 * MiB, WS_HB = WS_G;
constexpr size_t WS_QM = 300 * MiB, WS_KM = 348 * MiB, WS_VM = 396 * MiB, WS_YCAT = 428 * MiB, WS_END = 492 * MiB;

struct Params {
    const float* x; const float* p; const int* pos; const float* norm_g; const float* w_in; const float* diff_lambda;
    const float* subln_g; const float* qn_g; const float* w_uq; const float* kvn_g; const float* w_ukv; const float* w_out;
    const float* w_ple; const float* w_gate; const float* final_g; float* out; unsigned char* ws;
};

__device__ __forceinline__ unsigned f2bf(float f) { unsigned u = __float_as_uint(f); return (u + 0x7fffu + ((u >> 16) & 1u)) >> 16; }
__device__ __forceinline__ float bf2f(bf16_t h) { return __uint_as_float(((unsigned)h) << 16); }
__device__ __forceinline__ float wave_sum(float v) {
#pragma unroll
    for (int o = 1; o < 64; o <<= 1) v += __shfl_xor(v, o);
    return v;
}
__device__ __forceinline__ float silu_f(float v) { return v / (1.f + __expf(-v)); }
__device__ __forceinline__ float sigmoid_f(float v) { return 1.f / (1.f + __expf(-v)); }

__device__ __forceinline__ void phase0(const Params& P, int bid, int nb) {
    const int tid = threadIdx.x, lane = tid & 63, wave = tid >> 6;
    const int gw = bid * (NT / 64) + wave, ngw = nb * (NT / 64);
    const int gt = bid * NT + tid, ngt = nb * NT;
    bf16_t* XN = (bf16_t*)(P.ws + WS_XN);
    for (int t = gw; t < T; t += ngw) {
        const float4* xr = (const float4*)(P.x + (size_t)t * DM);
        float4 v[4]; float s = 0.f;
#pragma unroll
        for (int j = 0; j < 4; ++j) { v[j] = xr[lane + 64 * j]; s += v[j].x * v[j].x + v[j].y * v[j].y + v[j].z * v[j].z + v[j].w * v[j].w; }
        s = wave_sum(s);
        const float rstd = 1.0f / sqrtf(s * (1.f / DM) + RMS_EPS);
#pragma unroll
        for (int j = 0; j < 4; ++j) {
            const float4 g = ((const float4*)P.norm_g)[lane + 64 * j];
            uint2 o; o.x = f2bf(v[j].x * rstd * g.x) | (f2bf(v[j].y * rstd * g.y) << 16); o.y = f2bf(v[j].z * rstd * g.z) | (f2bf(v[j].w * rstd * g.w) << 16);
            ((uint2*)(XN + (size_t)t * DM))[lane + 64 * j] = o;
        }
    }
    bf16_t* PB = (bf16_t*)(P.ws + WS_PB);
    for (int i = gt; i < T * PLE_DIM / 4; i += ngt) {
        const float4 v = ((const float4*)P.p)[i];
        uint2 o; o.x = f2bf(v.x) | (f2bf(v.y) << 16); o.y = f2bf(v.z) | (f2bf(v.w) << 16);
        ((uint2*)PB)[i] = o;
    }
    float2* CSA = (float2*)(P.ws + WS_CSA); float2* CSB = (float2*)(P.ws + WS_CSB);
    for (int i = gt; i < T * 32; i += ngt) {
        const int t = i >> 5, k = i & 31;
        const double inv = pow(10000.0, -(double)k / 32.0);
        const double ang = (double)P.pos[t] * inv;
        double sn, cs; sincos(ang, &sn, &cs);
        CSA[i] = make_float2((float)cs, (float)sn);
    }
    for (int i = gt; i < T * 16; i += ngt) {
        const int t = i >> 4, k = i & 15;
        const double inv = pow(10000.0, -(double)k / 16.0);
        const double ang = (double)P.pos[t] * inv;
        double sn, cs; sincos(ang, &sn, &cs);
        CSB[i] = make_float2((float)cs, (float)sn);
    }
    float* ssq = (float*)(P.ws + WS_SSQQ);
    for (int i = gt; i < 3 * T; i += ngt) ssq[i] = 0.f;
    if (bid == 0 && tid == 0) {
        float s1 = 0.f, s2 = 0.f;
        for (int i = 0; i < 64; ++i) { s1 += P.diff_lambda[i] * P.diff_lambda[64 + i]; s2 += P.diff_lambda[128 + i] * P.diff_lambda[192 + i]; }
        ((float*)(P.ws + WS_MISC))[0] = expf(s1) - expf(s2) + LAM_INIT;
    }
}

constexpr int NG_SMEM_FLOATS = 16 * 129 + 16 * 65 + 128 * 65;
__device__ __forceinline__ void ngemm_tile(const bf16_t* A, int lda, int row0, const float* W, int ldw, int col0, int ncol, int K, const float* kscale, float* smem) {
    float* As = smem; float* Bs = smem + 16 * 129; float* Cs = Bs + 16 * 65;
    const int tid = threadIdx.x, ty = tid >> 4, tx = tid & 15;
    float acc[4][4];
#pragma unroll
    for (int i = 0; i < 4; ++i)
#pragma unroll
        for (int j = 0; j < 4; ++j) acc[i][j] = 0.f;
#pragma unroll 1
    for (int k0 = 0; k0 < K; k0 += 16) {
        __syncthreads();
#pragma unroll
        for (int i = 0; i < 4; ++i) { const int idx = tid + i * NT, r = idx >> 4, kk = idx & 15; As[kk * 129 + r] = bf2f(A[(size_t)(row0 + r) * lda + k0 + kk]); }
#pragma unroll
        for (int i = 0; i < 2; ++i) { const int idx = tid + i * NT, kk = idx >> 6, c = idx & 63;
            float w = 0.f; if (c < ncol) { w = W[(size_t)(k0 + kk) * ldw + col0 + c]; if (kscale) w *= kscale[k0 + kk]; }
            Bs[kk * 65 + c] = w; }
        __syncthreads();
#pragma unroll
        for (int kk = 0; kk < 16; ++kk) {
            float a[4], b[4];
#pragma unroll
            for (int i = 0; i < 4; ++i) a[i] = As[kk * 129 + ty * 4 + i];
#pragma unroll
            for (int j = 0; j < 4; ++j) b[j] = Bs[kk * 65 + tx * 4 + j];
#pragma unroll
            for (int i = 0; i < 4; ++i)
#pragma unroll
                for (int j = 0; j < 4; ++j) acc[i][j] += a[i] * b[j];
        }
    }
    __syncthreads();
#pragma unroll
    for (int i = 0; i < 4; ++i)
#pragma unroll
        for (int j = 0; j < 4; ++j) Cs[(ty * 4 + i) * 65 + tx * 4 + j] = acc[i][j];
    __syncthreads();
}

__device__ __forceinline__ void phase1_naive(const Params& P, int bid, int nb, float* smem) {
    const int tid = threadIdx.x;
    const bf16_t* XN = (const bf16_t*)(P.ws + WS_XN);
    bf16_t* QD = (bf16_t*)(P.ws + WS_QD); bf16_t* KD = (bf16_t*)(P.ws + WS_KD); bf16_t* VD = (bf16_t*)(P.ws + WS_VD); bf16_t* G = (bf16_t*)(P.ws + WS_G);
    bf16_t* CQ = (bf16_t*)(P.ws + WS_CQ); bf16_t* CKV = (bf16_t*)(P.ws + WS_CKV); bf16_t* KM = (bf16_t*)(P.ws + WS_KM);
    float* SSQQ = (float*)(P.ws + WS_SSQQ); float* SSQKV = (float*)(P.ws + WS_SSQKV);
    const float2* CSA = (const float2*)(P.ws + WS_CSA); const float2* CSB = (const float2*)(P.ws + WS_CSB);
    float* Cs = smem + 16 * 129 + 16 * 65;
    constexpr int NCT = 49, NRT = T / 128;
    for (int item = bid; item < NCT * NRT; item += nb) {
        const int ct = item % NCT, rt = item / NCT, row0 = rt * 128;
        int col0, ncol = 64;
        if (ct < 40) col0 = ct * 64; else if (ct == 40) { col0 = OFF_KR; ncol = 32; } else col0 = OFF_MG + (ct - 41) * 64;
        ngemm_tile(XN, DM, row0, P.w_in, DIN, col0, ncol, DM, nullptr, smem);
        _Pragma("unroll 1") for (int e = tid; e < 128 * 64; e += NT) {
            const int r = e >> 6, c = e & 63, t = row0 + r, b = t / SEQ, s = t % SEQ;
            const float v = Cs[r * 65 + c];
            if (col0 < OFF_DV) {
                const int i = c & 31; const float x1 = Cs[r * 65 + i], x2 = Cs[r * 65 + i + 32]; const float2 cs = CSA[(size_t)t * 32 + i];
                const float o = (c < 32) ? (x1 * cs.x - x2 * cs.y) : (x2 * cs.x + x1 * cs.y);
                if (col0 < OFF_DK) { const int mh = col0 / 64; QD[((size_t)(b * 8 + mh) * SEQ + s) * 64 + c] = (bf16_t)f2bf(o * C2D); }
                else { const int mh = (col0 - OFF_DK) / 64; KD[((size_t)(b * 8 + mh) * SEQ + s) * 64 + c] = (bf16_t)f2bf(o); }
            } else if (col0 < OFF_DG) { const int col = col0 - OFF_DV + c, h = col >> 7, d = col & 127; VD[((size_t)(b * 4 + h) * SEQ + s) * 128 + d] = (bf16_t)f2bf(v); }
            else if (col0 < OFF_CQ) { const int col = col0 - OFF_DG + c; G[(size_t)t * 1024 + col] = (bf16_t)f2bf(silu_f(v)); }
            else if (col0 < OFF_CKV) { const int col = col0 - OFF_CQ + c; CQ[(size_t)t * QLORA + col] = (bf16_t)f2bf(v); }
            else if (col0 < OFF_KR) { const int col = col0 - OFF_CKV + c; CKV[(size_t)t * KVLORA + col] = (bf16_t)f2bf(v); }
            else if (col0 == OFF_KR) { if (c < 32) { const int i = c & 15; const float x1 = Cs[r * 65 + i], x2 = Cs[r * 65 + i + 16]; const float2 cs = CSB[(size_t)t * 16 + i];
                    const float o = (c < 16) ? (x1 * cs.x - x2 * cs.y) : (x2 * cs.x + x1 * cs.y);
                    for (int h = 0; h < 8; ++h) KM[((size_t)(b * 8 + h) * SEQ + s) * 96 + 64 + c] = (bf16_t)f2bf(o); } }
            else { const int col = col0 - OFF_MG + c; G[(size_t)t * 1024 + 512 + col] = (bf16_t)f2bf(silu_f(v)); }
        }
        if (col0 >= OFF_CQ && col0 < OFF_KR && tid < 128) {
            float s = 0.f; _Pragma("unroll 4") for (int c = 0; c < 64; ++c) { const float v = Cs[tid * 65 + c]; s += v * v; }
            atomicAdd((col0 < OFF_CKV ? SSQQ : SSQKV) + row0 + tid, s);
        }
    }
}

__device__ __forceinline__ void phase15_naive(const Params& P, int bid, int nb, float* smem) {
    const int tid = threadIdx.x;
    const bf16_t* CQ = (const bf16_t*)(P.ws + WS_CQ); const bf16_t* CKV = (const bf16_t*)(P.ws + WS_CKV);
    bf16_t* QM = (bf16_t*)(P.ws + WS_QM); bf16_t* KM = (bf16_t*)(P.ws + WS_KM); bf16_t* VM = (bf16_t*)(P.ws + WS_VM);
    const float* SSQQ = (const float*)(P.ws + WS_SSQQ); const float* SSQKV = (const float*)(P.ws + WS_SSQKV);
    const float2* CSB = (const float2*)(P.ws + WS_CSB);
    float* Cs = smem + 16 * 129 + 16 * 65;
    constexpr int NCT = 12 + 16, NRT = T / 128;
    for (int item = bid; item < NCT * NRT; item += nb) {
        const int ct = item % NCT, rt = item / NCT, row0 = rt * 128;
        if (ct < 12) {
            const int col0 = ct * 64;
            ngemm_tile(CQ, QLORA, row0, P.w_uq, 768, col0, 64, QLORA, P.qn_g, smem);
            _Pragma("unroll 1") for (int e = tid; e < 128 * 64; e += NT) {
                const int r = e >> 6, c = e & 63, t = row0 + r, b = t / SEQ, s = t % SEQ, col = col0 + c, h = col / 96, j = col % 96;
                const float rstd = 1.0f / sqrtf(SSQQ[t] * (1.f / QLORA) + RMS_EPS);
                float o;
                if (j < 64) o = Cs[r * 65 + c];
                else { const int jj = j - 64, i = jj & 15, cb = c - jj; const float x1 = Cs[r * 65 + cb + i], x2 = Cs[r * 65 + cb + i + 16]; const float2 cs = CSB[(size_t)t * 16 + i];
                    o = (jj < 16) ? (x1 * cs.x - x2 * cs.y) : (x2 * cs.x + x1 * cs.y); }
                QM[((size_t)(b * 8 + h) * SEQ + s) * 96 + j] = (bf16_t)f2bf(o * rstd * C2M);
            }
        } else {
            const int col0 = (ct - 12) * 64;
            ngemm_tile(CKV, KVLORA, row0, P.w_ukv, 1024, col0, 64, KVLORA, P.kvn_g, smem);
            _Pragma("unroll 1") for (int e = tid; e < 128 * 64; e += NT) {
                const int r = e >> 6, c = e & 63, t = row0 + r, b = t / SEQ, s = t % SEQ, col = col0 + c, h = col >> 7, j = col & 127;
                const float rstd = 1.0f / sqrtf(SSQKV[t] * (1.f / KVLORA) + RMS_EPS);
                const float o = Cs[r * 65 + c] * rstd;
                if (j < 64) KM[((size_t)(b * 8 + h) * SEQ + s) * 96 + j] = (bf16_t)f2bf(o);
                else VM[((size_t)(b * 8 + h) * SEQ + s) * 64 + j - 64] = (bf16_t)f2bf(o);
            }
        }
    }
}

template <int DQK, int DV>
__device__ __forceinline__ void nattn_rows(const bf16_t* Qh, const bf16_t* Kh, const bf16_t* Vh, int q0, float* o, float& l_out) {
    const int i = q0 + threadIdx.x;
    unsigned q2[DQK / 2];
#pragma unroll
    for (int d = 0; d < DQK / 2; ++d) q2[d] = ((const unsigned*)(Qh + (size_t)i * DQK))[d];
#pragma unroll
    for (int d = 0; d < DV; ++d) o[d] = 0.f;
    float m = -1e30f, l = 0.f;
    const int jend = q0 + NT;
#pragma unroll 1
    for (int j0 = 0; j0 < jend; j0 += 4) {
        float sc[4];
#pragma unroll
        for (int k = 0; k < 4; ++k) {
            const unsigned* kr = (const unsigned*)(Kh + (size_t)(j0 + k) * DQK); float s = 0.f;
#pragma unroll
            for (int d = 0; d < DQK / 2; ++d) { const unsigned kk = kr[d], qq = q2[d];
                s += __uint_as_float(qq << 16) * __uint_as_float(kk << 16); s += __uint_as_float(qq & 0xffff0000u) * __uint_as_float(kk & 0xffff0000u); }
            sc[k] = (j0 + k <= i) ? s : -1e30f;
        }
        const float mn = fmaxf(fmaxf(fmaxf(sc[0], sc[1]), fmaxf(sc[2], sc[3])), m);
        const float alpha = exp2f(m - mn);
        float pr[4];
#pragma unroll
        for (int k = 0; k < 4; ++k) pr[k] = (j0 + k <= i) ? exp2f(sc[k] - mn) : 0.f;
        l = l * alpha + (pr[0] + pr[1]) + (pr[2] + pr[3]); m = mn;
#pragma unroll
        for (int d = 0; d < DV; ++d) o[d] *= alpha;
#pragma unroll
        for (int k = 0; k < 4; ++k) { const unsigned* vr = (const unsigned*)(Vh + (size_t)(j0 + k) * DV);
#pragma unroll
            for (int d = 0; d < DV / 2; ++d) { const unsigned vv = vr[d]; o[2 * d] += pr[k] * __uint_as_float(vv << 16); o[2 * d + 1] += pr[k] * __uint_as_float(vv & 0xffff0000u); } }
    }
    l_out = l;
}
__device__ __forceinline__ void phase2_naive(const Params& P, int bid, int nb) {
    const bf16_t* QD = (const bf16_t*)(P.ws + WS_QD); const bf16_t* KD = (const bf16_t*)(P.ws + WS_KD); const bf16_t* VD = (const bf16_t*)(P.ws + WS_VD);
    const bf16_t* QM = (const bf16_t*)(P.ws + WS_QM); const bf16_t* KM = (const bf16_t*)(P.ws + WS_KM); const bf16_t* VM = (const bf16_t*)(P.ws + WS_VM);
    const bf16_t* G = (const bf16_t*)(P.ws + WS_G); bf16_t* OD = (bf16_t*)(P.ws + WS_OD); bf16_t* YC = (bf16_t*)(P.ws + WS_YCAT);
    constexpr int NCH = SEQ / NT;
    for (int item = bid; item < 2 * 64 * NCH; item += nb) {
        const int kind = item / (64 * NCH), rem = item % (64 * NCH), bh = rem / NCH, ch = NCH - 1 - rem % NCH, q0 = ch * NT, b = bh >> 3, hh = bh & 7;
        const int i = q0 + threadIdx.x;
        if (kind == 0) {
            float o[128], l;
            nattn_rows<64, 128>(QD + (size_t)bh * SEQ * 64, KD + (size_t)bh * SEQ * 64, VD + (size_t)(b * 4 + (hh >> 1)) * SEQ * 128, q0, o, l);
            const float rl = 1.f / l;
#pragma unroll
            for (int d = 0; d < 128; ++d) OD[((size_t)bh * SEQ + i) * 128 + d] = (bf16_t)f2bf(o[d] * rl);
        } else {
            float o[64], l;
            nattn_rows<96, 64>(QM + (size_t)bh * SEQ * 96, KM + (size_t)bh * SEQ * 96, VM + (size_t)bh * SEQ * 64, q0, o, l);
            const float rl = 1.f / l; const size_t t = (size_t)b * SEQ + i;
#pragma unroll
            for (int d = 0; d < 64; ++d) { const size_t idx = t * 1024 + 512 + hh * 64 + d; YC[idx] = (bf16_t)f2bf(o[d] * rl * bf2f(G[idx])); }
        }
    }
}

__device__ __forceinline__ void phase25_naive(const Params& P, int bid, int nb) {
    const bf16_t* OD = (const bf16_t*)(P.ws + WS_OD); const bf16_t* G = (const bf16_t*)(P.ws + WS_G); bf16_t* YC = (bf16_t*)(P.ws + WS_YCAT);
    const float lam = ((const float*)(P.ws + WS_MISC))[0];
    const int lane = threadIdx.x & 63, wave = threadIdx.x >> 6;
    const int gw = bid * (NT / 64) + wave, ngw = nb * (NT / 64);
    for (int it = gw; it < T * 4; it += ngw) {
        const int t = it >> 2, h = it & 3, b = t / SEQ, s = t % SEQ;
        const bf16_t* o0 = OD + ((size_t)(b * 8 + 2 * h) * SEQ + s) * 128; const bf16_t* o1 = OD + ((size_t)(b * 8 + 2 * h + 1) * SEQ + s) * 128;
        const float d0 = bf2f(o0[lane]) - lam * bf2f(o1[lane]), d1 = bf2f(o0[lane + 64]) - lam * bf2f(o1[lane + 64]);
        const float ss = wave_sum(d0 * d0 + d1 * d1);
        const float rstd = 1.0f / sqrtf(ss * (1.f / 128.f) + RMS_EPS);
        const size_t base = (size_t)t * 1024 + h * 128;
        YC[base + lane] = (bf16_t)f2bf(d0 * rstd * P.subln_g[lane] * (1.f - LAM_INIT) * bf2f(G[base + lane]));
        YC[base + lane + 64] = (bf16_t)f2bf(d1 * rstd * P.subln_g[lane + 64] * (1.f - LAM_INIT) * bf2f(G[base + lane + 64]));
    }
}

__device__ __forceinline__ void phase3_naive(const Params& P, int bid, int nb, float* smem) {
    const int tid = threadIdx.x;
    const bf16_t* YC = (const bf16_t*)(P.ws + WS_YCAT); const bf16_t* PB = (const bf16_t*)(P.ws + WS_PB);
    bf16_t* HB = (bf16_t*)(P.ws + WS_HB); bf16_t* PLE = (bf16_t*)(P.ws + WS_PLE);
    float* Cs = smem + 16 * 129 + 16 * 65;
    constexpr int NRT = T / 128;
    for (int item = bid; item < 32 * NRT; item += nb) {
        const int ct = item % 32, rt = item / 32, row0 = rt * 128, col0 = (ct & 15) * 64;
        if (ct < 16) {
            ngemm_tile(YC, DM, row0, P.w_out, DM, col0, 64, DM, nullptr, smem);
            _Pragma("unroll 1") for (int e = tid; e < 128 * 64; e += NT) { const int r = e >> 6, c = e & 63; const size_t idx = (size_t)(row0 + r) * DM + col0 + c;
                const float h = P.x[idx] + Cs[r * 65 + c]; P.out[idx] = h; HB[idx] = (bf16_t)f2bf(h); }
        } else {
            ngemm_tile(PB, PLE_DIM, row0, P.w_ple, DM, col0, 64, PLE_DIM, nullptr, smem);
            _Pragma("unroll 1") for (int e = tid; e < 128 * 64; e += NT) { const int r = e >> 6, c = e & 63; const size_t idx = (size_t)(row0 + r) * DM + col0 + c; PLE[idx] = (bf16_t)f2bf(Cs[r * 65 + c]); }
        }
    }
}
__device__ __forceinline__ void phase4_naive(const Params& P, int bid, int nb, float* smem) {
    const int tid = threadIdx.x;
    const bf16_t* HB = (const bf16_t*)(P.ws + WS_HB); const bf16_t* PLE = (const bf16_t*)(P.ws + WS_PLE); float* SSQF = (float*)(P.ws + WS_SSQF);
    float* Cs = smem + 16 * 129 + 16 * 65;
    constexpr int NRT = T / 128;
    for (int item = bid; item < 16 * NRT; item += nb) {
        const int ct = item % 16, rt = item / 16, row0 = rt * 128, col0 = ct * 64;
        ngemm_tile(HB, DM, row0, P.w_gate, DM, col0, 64, DM, nullptr, smem);
        _Pragma("unroll 1") for (int e = tid; e < 128 * 64; e += NT) { const int r = e >> 6, c = e & 63; const size_t idx = (size_t)(row0 + r) * DM + col0 + c;
            const float h2 = P.out[idx] + bf2f(PLE[idx]) * sigmoid_f(Cs[r * 65 + c]); P.out[idx] = h2; Cs[r * 65 + c] = h2; }
        __syncthreads();
        if (tid < 128) { float s = 0.f; _Pragma("unroll 4") for (int c = 0; c < 64; ++c) { const float v = Cs[tid * 65 + c]; s += v * v; } atomicAdd(SSQF + row0 + tid, s); }
    }
}
__device__ __forceinline__ void phase5(const Params& P, int bid, int nb) {
    const float* SSQF = (const float*)(P.ws + WS_SSQF);
    const int lane = threadIdx.x & 63, wave = threadIdx.x >> 6;
    const int gw = bid * (NT / 64) + wave, ngw = nb * (NT / 64);
    for (int t = gw; t < T; t += ngw) {
        const float rstd = 1.0f / sqrtf(SSQF[t] * (1.f / DM) + RMS_EPS);
        float4* o = (float4*)(P.out + (size_t)t * DM);
#pragma unroll
        for (int j = 0; j < 4; ++j) { float4 v = o[lane + 64 * j]; const float4 g = ((const float4*)P.final_g)[lane + 64 * j];
            v.x *= rstd * g.x; v.y *= rstd * g.y; v.z *= rstd * g.z; v.w *= rstd * g.w; o[lane + 64 * j] = v; }
    }
}

__global__ void __launch_bounds__(NT) k_p0(Params P) { phase0(P, blockIdx.x, gridDim.x); }
__global__ void __launch_bounds__(NT) k_p1(Params P) { __shared__ float smem[NG_SMEM_FLOATS]; phase1_naive(P, blockIdx.x, gridDim.x, smem); }
__global__ void __launch_bounds__(NT) k_p15(Params P) { __shared__ float smem[NG_SMEM_FLOATS]; phase15_naive(P, blockIdx.x, gridDim.x, smem); }
__global__ void __launch_bounds__(NT) k_p2(Params P) { phase2_naive(P, blockIdx.x, gridDim.x); }
__global__ void __launch_bounds__(NT) k_p25(Params P) { phase25_naive(P, blockIdx.x, gridDim.x); }
__global__ void __launch_bounds__(NT) k_p3(Params P) { __shared__ float smem[NG_SMEM_FLOATS]; phase3_naive(P, blockIdx.x, gridDim.x, smem); }
__global__ void __launch_bounds__(NT) k_p4(Params P) { __shared__ float smem[NG_SMEM_FLOATS]; phase4_naive(P, blockIdx.x, gridDim.x, smem); }
__global__ void __launch_bounds__(NT) k_p5(Params P) { phase5(P, blockIdx.x, gridDim.x); }

extern "C" void kernel_launch(void* const* d_in, const int* in_sizes, int n_in, void* d_out, int out_size, void* d_ws, size_t ws_size, hipStream_t stream) {
    if (n_in != 15 || out_size != T * DM || ws_size < WS_END) { fprintf(stderr, "kernel_launch: unexpected shapes (n_in %d out %d ws %zu)\n", n_in, out_size, ws_size); return; }
    Params P{};
    P.x = (const float*)d_in[0]; P.p = (const float*)d_in[1]; P.pos = (const int*)d_in[2]; P.norm_g = (const float*)d_in[3]; P.w_in = (const float*)d_in[4];
    P.diff_lambda = (const float*)d_in[5]; P.subln_g = (const float*)d_in[6]; P.qn_g = (const float*)d_in[7]; P.w_uq = (const float*)d_in[8]; P.kvn_g = (const float*)d_in[9];
    P.w_ukv = (const float*)d_in[10]; P.w_out = (const float*)d_in[11]; P.w_ple = (const float*)d_in[12]; P.w_gate = (const float*)d_in[13]; P.final_g = (const float*)d_in[14];
    P.out = (float*)d_out; P.ws = (unsigned char*)d_ws;
    const int G = 1024;
    hipLaunchKernelGGL(k_p0, dim3(G), dim3(NT), 0, stream, P);
    hipLaunchKernelGGL(k_p1, dim3(2048), dim3(NT), 0, stream, P);
    hipLaunchKernelGGL(k_p15, dim3(2048), dim3(NT), 0, stream, P);
    hipLaunchKernelGGL(k_p2, dim3(1024), dim3(NT), 0, stream, P);
    hipLaunchKernelGGL(k_p25, dim3(G), dim3(NT), 0, stream, P);
    hipLaunchKernelGGL(k_p3, dim3(2048), dim3(NT), 0, stream, P);
    hipLaunchKernelGGL(k_p4, dim3(2048), dim3(NT), 0, stream, P);
    hipLaunchKernelGGL(k_p5, dim3(G), dim3(NT), 0, stream, P);
}
```

```cpp
#include <hip/hip_runtime.h>
#include <hip/hip_cooperative_groups.h>
#include <cstdio>
#include <cstdint>

namespace cg = cooperative_groups;
typedef unsigned short bf16_t;

constexpr int BATCH = 8, SEQ = 4096, T = BATCH * SEQ, DM = 1024, DIN = 3104, PLE_DIM = 256;
constexpr int OFF_DQ = 0, OFF_DK = 512, OFF_DV = 1024, OFF_DG = 1536, OFF_CQ = 2048, OFF_CKV = 2432, OFF_KR = 2560, OFF_MG = 2592;
constexpr int QLORA = 384, KVLORA = 128;
constexpr float RMS_EPS = 1e-6f;
constexpr float LOG2E = 1.4426950408889634f;
constexpr float C2D = 0.125f * LOG2E;
constexpr float C2M = 0.10206207261596575f * LOG2E;
constexpr float LAM_INIT = 0.2f;
constexpr int NT = 512;

constexpr size_t MiB = 1u << 20;
constexpr size_t WS_CTL = 0;
constexpr size_t WS_MISC = 1 * MiB;
constexpr size_t WS_SSQQ = 1 * MiB + 65536, WS_SSQKV = WS_SSQQ + 131072, WS_SSQF = WS_SSQKV + 131072;
constexpr size_t WS_CSA = 2 * MiB, WS_CSB = 10 * MiB;
constexpr size_t WS_WIN = 14 * MiB, WS_WPLE = 21 * MiB, WS_WUQ = 22 * MiB, WS_WUKV = 23 * MiB, WS_WOUT = 24 * MiB, WS_WG = 26 * MiB;
constexpr size_t WS_PB = 28 * MiB, WS_CQ = 44 * MiB, WS_CKV = 68 * MiB, WS_XN = 76 * MiB, WS_OD = WS_XN;
constexpr size_t WS_QD = 140 * MiB, WS_KD = 172 * MiB, WS_PLE = WS_QD, WS_VD = 204 * MiB, WS_G = 236 * MiB, WS_HB = WS_G;
constexpr size_t WS_QM = 300 * MiB, WS_KM = 348 * MiB, WS_VM = 396 * MiB, WS_YCAT = 428 * MiB, WS_END = 492 * MiB;

struct Params {
    const float* x; const float* p; const int* pos; const float* norm_g; const float* w_in; const float* diff_lambda;
    const float* subln_g; const float* qn_g; const float* w_uq; const float* kvn_g; const float* w_ukv; const float* w_out;
    const float* w_ple; const float* w_gate; const float* final_g; float* out; unsigned char* ws;
};

__device__ __forceinline__ unsigned f2bf(float f) { unsigned u = __float_as_uint(f); return (u + 0x7fffu + ((u >> 16) & 1u)) >> 16; }
__device__ __forceinline__ float bf2f(bf16_t h) { return __uint_as_float(((unsigned)h) << 16); }
__device__ __forceinline__ float wave_sum(float v) {
#pragma unroll
    for (int o = 1; o < 64; o <<= 1) v += __shfl_xor(v, o);
    return v;
}
__device__ __forceinline__ int tid_op() { int t = threadIdx.x; asm volatile("" : "+v"(t)); return t; }
__device__ __forceinline__ int sgpr_op(int v) { asm volatile("" : "+s"(v)); return v; }
__device__ __forceinline__ float silu_f(float v) { return v / (1.f + __expf(-v)); }
__device__ __forceinline__ float sigmoid_f(float v) { return 1.f / (1.f + __expf(-v)); }

__device__ __forceinline__ void phase0(const Params& P, int bid, int nb) {
    bid = sgpr_op(bid); nb = sgpr_op(nb);
    const int tid = tid_op(), lane = tid & 63, wave = tid >> 6;
    const int gw = bid * (NT / 64) + wave, ngw = nb * (NT / 64);
    const int gt = bid * NT + tid, ngt = nb * NT;
    bf16_t* XN = (bf16_t*)(P.ws + WS_XN);
    for (int t = gw; t < T; t += ngw) {
        const float4* xr = (const float4*)(P.x + (size_t)t * DM);
        float4 v[4]; float s = 0.f;
#pragma unroll
        for (int j = 0; j < 4; ++j) { v[j] = xr[lane + 64 * j]; s += v[j].x * v[j].x + v[j].y * v[j].y + v[j].z * v[j].z + v[j].w * v[j].w; }
        s = wave_sum(s);
        const float rstd = 1.0f / sqrtf(s * (1.f / DM) + RMS_EPS);
#pragma unroll
        for (int j = 0; j < 4; ++j) {
            const float4 g = ((const float4*)P.norm_g)[lane + 64 * j];
            uint2 o; o.x = f2bf(v[j].x * rstd * g.x) | (f2bf(v[j].y * rstd * g.y) << 16); o.y = f2bf(v[j].z * rstd * g.z) | (f2bf(v[j].w * rstd * g.w) << 16);
            ((uint2*)(XN + (size_t)t * DM))[lane + 64 * j] = o;
        }
    }
    bf16_t* PB = (bf16_t*)(P.ws + WS_PB);
    for (int i = gt; i < T * PLE_DIM / 4; i += ngt) {
        const float4 v = ((const float4*)P.p)[i];
        uint2 o; o.x = f2bf(v.x) | (f2bf(v.y) << 16); o.y = f2bf(v.z) | (f2bf(v.w) << 16);
        ((uint2*)PB)[i] = o;
    }
    float2* CSA = (float2*)(P.ws + WS_CSA); float2* CSB = (float2*)(P.ws + WS_CSB);
    for (int i = gt; i < T * 32; i += ngt) {
        const int t = i >> 5, k = i & 31;
        const double inv = pow(10000.0, -(double)k / 32.0);
        const double ang = (double)P.pos[t] * inv;
        double sn, cs; sincos(ang, &sn, &cs);
        CSA[i] = make_float2((float)cs, (float)sn);
    }
    for (int i = gt; i < T * 16; i += ngt) {
        const int t = i >> 4, k = i & 15;
        const double inv = pow(10000.0, -(double)k / 16.0);
        const double ang = (double)P.pos[t] * inv;
        double sn, cs; sincos(ang, &sn, &cs);
        CSB[i] = make_float2((float)cs, (float)sn);
    }
    float* ssq = (float*)(P.ws + WS_SSQQ);
    for (int i = gt; i < 3 * T; i += ngt) ssq[i] = 0.f;
    if (bid == 0 && tid == 0) {
        float s1 = 0.f, s2 = 0.f;
        for (int i = 0; i < 64; ++i) { s1 += P.diff_lambda[i] * P.diff_lambda[64 + i]; s2 += P.diff_lambda[128 + i] * P.diff_lambda[192 + i]; }
        ((float*)(P.ws + WS_MISC))[0] = expf(s1) - expf(s2) + LAM_INIT;
    }
}

constexpr int NG_SMEM_FLOATS = 16 * 129 + 16 * 65 + 128 * 65;
__device__ __forceinline__ void ngemm_tile(const bf16_t* A, int lda, int row0, const float* W, int ldw, int col0, int ncol, int K, const float* kscale, float* smem) {
    float* As = smem; float* Bs = smem + 16 * 129; float* Cs = Bs + 16 * 65;
    const int tid = tid_op(), ty = tid >> 4, tx = tid & 15;
    float acc[4][4];
#pragma unroll
    for (int i = 0; i < 4; ++i)
#pragma unroll
        for (int j = 0; j < 4; ++j) acc[i][j] = 0.f;
#pragma unroll 1
    for (int k0 = 0; k0 < K; k0 += 16) {
        __syncthreads();
#pragma unroll
        for (int i = 0; i < 4; ++i) { const int idx = tid + i * NT, r = idx >> 4, kk = idx & 15; As[kk * 129 + r] = bf2f(A[(size_t)(row0 + r) * lda + k0 + kk]); }
#pragma unroll
        for (int i = 0; i < 2; ++i) { const int idx = tid + i * NT, kk = idx >> 6, c = idx & 63;
            float w = 0.f; if (c < ncol) { w = W[(size_t)(k0 + kk) * ldw + col0 + c]; if (kscale) w *= kscale[k0 + kk]; }
            Bs[kk * 65 + c] = w; }
        __syncthreads();
#pragma unroll
        for (int kk = 0; kk < 16; ++kk) {
            float a[4], b[4];
#pragma unroll
            for (int i = 0; i < 4; ++i) a[i] = As[kk * 129 + ty * 4 + i];
#pragma unroll
            for (int j = 0; j < 4; ++j) b[j] = Bs[kk * 65 + tx * 4 + j];
#pragma unroll
            for (int i = 0; i < 4; ++i)
#pragma unroll
                for (int j = 0; j < 4; ++j) acc[i][j] += a[i] * b[j];
        }
    }
    __syncthreads();
#pragma unroll
    for (int i = 0; i < 4; ++i)
#pragma unroll
        for (int j = 0; j < 4; ++j) Cs[(ty * 4 + i) * 65 + tx * 4 + j] = acc[i][j];
    __syncthreads();
}

__device__ __forceinline__ void phase1_naive(const Params& P, int bid, int nb, float* smem) {
    bid = sgpr_op(bid); nb = sgpr_op(nb);
    const int tid = tid_op();
    const bf16_t* XN = (const bf16_t*)(P.ws + WS_XN);
    bf16_t* QD = (bf16_t*)(P.ws + WS_QD); bf16_t* KD = (bf16_t*)(P.ws + WS_KD); bf16_t* VD = (bf16_t*)(P.ws + WS_VD); bf16_t* G = (bf16_t*)(P.ws + WS_G);
    bf16_t* CQ = (bf16_t*)(P.ws + WS_CQ); bf16_t* CKV = (bf16_t*)(P.ws + WS_CKV); bf16_t* KM = (bf16_t*)(P.ws + WS_KM);
    float* SSQQ = (float*)(P.ws + WS_SSQQ); float* SSQKV = (float*)(P.ws + WS_SSQKV);
    const float2* CSA = (const float2*)(P.ws + WS_CSA); const float2* CSB = (const float2*)(P.ws + WS_CSB);
    float* Cs = smem + 16 * 129 + 16 * 65;
    constexpr int NCT = 49, NRT = T / 128;
    for (int item = bid; item < NCT * NRT; item += nb) {
        const int ct = item % NCT, rt = item / NCT, row0 = rt * 128;
        int col0, ncol = 64;
        if (ct < 40) col0 = ct * 64; else if (ct == 40) { col0 = OFF_KR; ncol = 32; } else col0 = OFF_MG + (ct - 41) * 64;
        ngemm_tile(XN, DM, row0, P.w_in, DIN, col0, ncol, DM, nullptr, smem);
        _Pragma("unroll 1") for (int e = tid; e < 128 * 64; e += NT) {
            const int r = e >> 6, c = e & 63, t = row0 + r, b = t / SEQ, s = t % SEQ;
            const float v = Cs[r * 65 + c];
            if (col0 < OFF_DV) {
                const int i = c & 31; const float x1 = Cs[r * 65 + i], x2 = Cs[r * 65 + i + 32]; const float2 cs = CSA[(size_t)t * 32 + i];
                const float o = (c < 32) ? (x1 * cs.x - x2 * cs.y) : (x2 * cs.x + x1 * cs.y);
                if (col0 < OFF_DK) { const int mh = col0 / 64; QD[((size_t)(b * 8 + mh) * SEQ + s) * 64 + c] = (bf16_t)f2bf(o * C2D); }
                else { const int mh = (col0 - OFF_DK) / 64; KD[((size_t)(b * 8 + mh) * SEQ + s) * 64 + c] = (bf16_t)f2bf(o); }
            } else if (col0 < OFF_DG) { const int col = col0 - OFF_DV + c, h = col >> 7, d = col & 127; VD[((size_t)(b * 4 + h) * SEQ + s) * 128 + d] = (bf16_t)f2bf(v); }
            else if (col0 < OFF_CQ) { const int col = col0 - OFF_DG + c; G[(size_t)t * 1024 + col] = (bf16_t)f2bf(silu_f(v)); }
            else if (col0 < OFF_CKV) { const int col = col0 - OFF_CQ + c; CQ[(size_t)t * QLORA + col] = (bf16_t)f2bf(v); }
            else if (col0 < OFF_KR) { const int col = col0 - OFF_CKV + c; CKV[(size_t)t * KVLORA + col] = (bf16_t)f2bf(v); }
            else if (col0 == OFF_KR) { if (c < 32) { const int i = c & 15; const float x1 = Cs[r * 65 + i], x2 = Cs[r * 65 + i + 16]; const float2 cs = CSB[(size_t)t * 16 + i];
                    const float o = (c < 16) ? (x1 * cs.x - x2 * cs.y) : (x2 * cs.x + x1 * cs.y);
                    for (int h = 0; h < 8; ++h) KM[((size_t)(b * 8 + h) * SEQ + s) * 96 + 64 + c] = (bf16_t)f2bf(o); } }
            else { const int col = col0 - OFF_MG + c; G[(size_t)t * 1024 + 512 + col] = (bf16_t)f2bf(silu_f(v)); }
        }
        if (col0 >= OFF_CQ && col0 < OFF_KR && tid < 128) {
            float s = 0.f; _Pragma("unroll 4") for (int c = 0; c < 64; ++c) { const float v = Cs[tid * 65 + c]; s += v * v; }
            atomicAdd((col0 < OFF_CKV ? SSQQ : SSQKV) + row0 + tid, s);
        }
    }
}

__device__ __forceinline__ void phase15_naive(const Params& P, int bid, int nb, float* smem) {
    bid = sgpr_op(bid); nb = sgpr_op(nb);
    const int tid = tid_op();
    const bf16_t* CQ = (const bf16_t*)(P.ws + WS_CQ); const bf16_t* CKV = (const bf16_t*)(P.ws + WS_CKV);
    bf16_t* QM = (bf16_t*)(P.ws + WS_QM); bf16_t* KM = (bf16_t*)(P.ws + WS_KM); bf16_t* VM = (bf16_t*)(P.ws + WS_VM);
    const float* SSQQ = (const float*)(P.ws + WS_SSQQ); const float* SSQKV = (const float*)(P.ws + WS_SSQKV);
    const float2* CSB = (const float2*)(P.ws + WS_CSB);
    float* Cs = smem + 16 * 129 + 16 * 65;
    constexpr int NCT = 12 + 16, NRT = T / 128;
    for (int item = bid; item < NCT * NRT; item += nb) {
        const int ct = item % NCT, rt = item / NCT, row0 = rt * 128;
        if (ct < 12) {
            const int col0 = ct * 64;
            ngemm_tile(CQ, QLORA, row0, P.w_uq, 768, col0, 64, QLORA, P.qn_g, smem);
            _Pragma("unroll 1") for (int e = tid; e < 128 * 64; e += NT) {
                const int r = e >> 6, c = e & 63, t = row0 + r, b = t / SEQ, s = t % SEQ, col = col0 + c, h = col / 96, j = col % 96;
                const float rstd = 1.0f / sqrtf(SSQQ[t] * (1.f / QLORA) + RMS_EPS);
                float o;
                if (j < 64) o = Cs[r * 65 + c];
                else { const int jj = j - 64, i = jj & 15, cb = c - jj; const float x1 = Cs[r * 65 + cb + i], x2 = Cs[r * 65 + cb + i + 16]; const float2 cs = CSB[(size_t)t * 16 + i];
                    o = (jj < 16) ? (x1 * cs.x - x2 * cs.y) : (x2 * cs.x + x1 * cs.y); }
                QM[((size_t)(b * 8 + h) * SEQ + s) * 96 + j] = (bf16_t)f2bf(o * rstd * C2M);
            }
        } else {
            const int col0 = (ct - 12) * 64;
            ngemm_tile(CKV, KVLORA, row0, P.w_ukv, 1024, col0, 64, KVLORA, P.kvn_g, smem);
            _Pragma("unroll 1") for (int e = tid; e < 128 * 64; e += NT) {
                const int r = e >> 6, c = e & 63, t = row0 + r, b = t / SEQ, s = t % SEQ, col = col0 + c, h = col >> 7, j = col & 127;
                const float rstd = 1.0f / sqrtf(SSQKV[t] * (1.f / KVLORA) + RMS_EPS);
                const float o = Cs[r * 65 + c] * rstd;
                if (j < 64) KM[((size_t)(b * 8 + h) * SEQ + s) * 96 + j] = (bf16_t)f2bf(o);
                else VM[((size_t)(b * 8 + h) * SEQ + s) * 64 + j - 64] = (bf16_t)f2bf(o);
            }
        }
    }
}

template <int DQK, int DV, int DVS>
__device__ __forceinline__ void nattn_rows(const bf16_t* Qh, const bf16_t* Kh, const bf16_t* Vh, int q0, float* o, float& l_out, unsigned* smem) {
    const int tid = tid_op(), i = q0 + tid;
    unsigned* Ks = smem; unsigned* Vs = smem + 32 * (DQK / 2);
    unsigned q2[DQK / 2];
#pragma unroll
    for (int d = 0; d < DQK / 2; ++d) q2[d] = ((const unsigned*)(Qh + (size_t)i * DQK))[d];
#pragma unroll
    for (int d = 0; d < DV; ++d) o[d] = 0.f;
    float m = -1e30f, l = 0.f;
    const int jend = q0 + NT;
#pragma unroll 1
    for (int j0 = 0; j0 < jend; j0 += 32) {
        __syncthreads();
        for (int idx = tid; idx < 32 * (DQK / 2); idx += NT) Ks[idx] = ((const unsigned*)(Kh + (size_t)j0 * DQK))[idx];
        for (int idx = tid; idx < 32 * (DV / 2); idx += NT) { const int r = idx / (DV / 2), c = idx % (DV / 2); Vs[idx] = ((const unsigned*)(Vh + (size_t)(j0 + r) * DVS))[c]; }
        __syncthreads();
#pragma unroll 1
        for (int jj = 0; jj < 32; jj += 2) {
            float sc[2];
#pragma unroll
            for (int k = 0; k < 2; ++k) {
                const unsigned* kr = Ks + (jj + k) * (DQK / 2); float s = 0.f;
#pragma unroll
                for (int d = 0; d < DQK / 2; ++d) { const unsigned kk = kr[d]; unsigned qq = q2[d]; asm volatile("" : "+v"(qq));
                    s += __uint_as_float(qq << 16) * __uint_as_float(kk << 16); s += __uint_as_float(qq & 0xffff0000u) * __uint_as_float(kk & 0xffff0000u); }
                sc[k] = (j0 + jj + k <= i) ? s : -1e30f;
                asm volatile("" : "+v"(sc[k]));
            }
            const float mn = fmaxf(fmaxf(sc[0], sc[1]), m);
            const float alpha = exp2f(m - mn);
            float pr[2];
#pragma unroll
            for (int k = 0; k < 2; ++k) pr[k] = (j0 + jj + k <= i) ? exp2f(sc[k] - mn) : 0.f;
            l = l * alpha + (pr[0] + pr[1]); m = mn;
#pragma unroll
            for (int d = 0; d < DV; ++d) o[d] *= alpha;
#pragma unroll
            for (int k = 0; k < 2; ++k) { const unsigned* vr = Vs + (jj + k) * (DV / 2);
#pragma unroll
                for (int d = 0; d < DV / 2; ++d) { const unsigned vv = vr[d]; o[2 * d] += pr[k] * __uint_as_float(vv << 16); o[2 * d + 1] += pr[k] * __uint_as_float(vv & 0xffff0000u); } }
        }
    }
    l_out = l;
}
__device__ __forceinline__ void phase2_naive(const Params& P, int bid, int nb, float* smemf) {
    bid = sgpr_op(bid); nb = sgpr_op(nb);
    unsigned* smem = (unsigned*)smemf;
    const bf16_t* QD = (const bf16_t*)(P.ws + WS_QD); const bf16_t* KD = (const bf16_t*)(P.ws + WS_KD); const bf16_t* VD = (const bf16_t*)(P.ws + WS_VD);
    const bf16_t* QM = (const bf16_t*)(P.ws + WS_QM); const bf16_t* KM = (const bf16_t*)(P.ws + WS_KM); const bf16_t* VM = (const bf16_t*)(P.ws + WS_VM);
    const bf16_t* G = (const bf16_t*)(P.ws + WS_G); bf16_t* OD = (bf16_t*)(P.ws + WS_OD); bf16_t* YC = (bf16_t*)(P.ws + WS_YCAT);
    constexpr int NCH = SEQ / NT;
    for (int item = bid; item < 2 * 64 * NCH; item += nb) {
        const int kind = item / (64 * NCH), rem = item % (64 * NCH), bh = rem / NCH, ch = NCH - 1 - rem % NCH, q0 = ch * NT, b = bh >> 3, hh = bh & 7;
        const int i = q0 + tid_op();
        if (kind == 0) {
#pragma unroll 1
            for (int half = 0; half < 2; ++half) {
                float o[64], l;
                nattn_rows<64, 64, 128>(QD + (size_t)bh * SEQ * 64, KD + (size_t)bh * SEQ * 64, VD + (size_t)(b * 4 + (hh >> 1)) * SEQ * 128 + half * 64, q0, o, l, smem);
                const float rl = 1.f / l;
#pragma unroll
                for (int d = 0; d < 64; ++d) OD[((size_t)bh * SEQ + i) * 128 + half * 64 + d] = (bf16_t)f2bf(o[d] * rl);
            }
        } else {
            float o[64], l;
            nattn_rows<96, 64, 64>(QM + (size_t)bh * SEQ * 96, KM + (size_t)bh * SEQ * 96, VM + (size_t)bh * SEQ * 64, q0, o, l, smem);
            const float rl = 1.f / l; const size_t t = (size_t)b * SEQ + i;
#pragma unroll
            for (int d = 0; d < 64; ++d) { const size_t idx = t * 1024 + 512 + hh * 64 + d; YC[idx] = (bf16_t)f2bf(o[d] * rl * bf2f(G[idx])); }
        }
    }
}

__device__ __forceinline__ void phase25_naive(const Params& P, int bid, int nb) {
    bid = sgpr_op(bid); nb = sgpr_op(nb);
    const bf16_t* OD = (const bf16_t*)(P.ws + WS_OD); const bf16_t* G = (const bf16_t*)(P.ws + WS_G); bf16_t* YC = (bf16_t*)(P.ws + WS_YCAT);
    const float lam = ((const float*)(P.ws + WS_MISC))[0];
    const int tid = tid_op(), lane = tid & 63, wave = tid >> 6;
    const int gw = bid * (NT / 64) + wave, ngw = nb * (NT / 64);
    for (int it = gw; it < T * 4; it += ngw) {
        const int t = it >> 2, h = it & 3, b = t / SEQ, s = t % SEQ;
        const bf16_t* o0 = OD + ((size_t)(b * 8 + 2 * h) * SEQ + s) * 128; const bf16_t* o1 = OD + ((size_t)(b * 8 + 2 * h + 1) * SEQ + s) * 128;
        const float d0 = bf2f(o0[lane]) - lam * bf2f(o1[lane]), d1 = bf2f(o0[lane + 64]) - lam * bf2f(o1[lane + 64]);
        const float ss = wave_sum(d0 * d0 + d1 * d1);
        const float rstd = 1.0f / sqrtf(ss * (1.f / 128.f) + RMS_EPS);
        const size_t base = (size_t)t * 1024 + h * 128;
        YC[base + lane] = (bf16_t)f2bf(d0 * rstd * P.subln_g[lane] * (1.f - LAM_INIT) * bf2f(G[base + lane]));
        YC[base + lane + 64] = (bf16_t)f2bf(d1 * rstd * P.subln_g[lane + 64] * (1.f - LAM_INIT) * bf2f(G[base + lane + 64]));
    }
}

__device__ __forceinline__ void phase3_naive(const Params& P, int bid, int nb, float* smem) {
    bid = sgpr_op(bid); nb = sgpr_op(nb);
    const int tid = tid_op();
    const bf16_t* YC = (const bf16_t*)(P.ws + WS_YCAT); const bf16_t* PB = (const bf16_t*)(P.ws + WS_PB);
    bf16_t* HB = (bf16_t*)(P.ws + WS_HB); bf16_t* PLE = (bf16_t*)(P.ws + WS_PLE);
    float* Cs = smem + 16 * 129 + 16 * 65;
    constexpr int NRT = T / 128;
    for (int item = bid; item < 32 * NRT; item += nb) {
        const int ct = item % 32, rt = item / 32, row0 = rt * 128, col0 = (ct & 15) * 64;
        if (ct < 16) {
            ngemm_tile(YC, DM, row0, P.w_out, DM, col0, 64, DM, nullptr, smem);
            _Pragma("unroll 1") for (int e = tid; e < 128 * 64; e += NT) { const int r = e >> 6, c = e & 63; const size_t idx = (size_t)(row0 + r) * DM + col0 + c;
                const float h = P.x[idx] + Cs[r * 65 + c]; P.out[idx] = h; HB[idx] = (bf16_t)f2bf(h); }
        } else {
            ngemm_tile(PB, PLE_DIM, row0, P.w_ple, DM, col0, 64, PLE_DIM, nullptr, smem);
            _Pragma("unroll 1") for (int e = tid; e < 128 * 64; e += NT) { const int r = e >> 6, c = e & 63; const size_t idx = (size_t)(row0 + r) * DM + col0 + c; PLE[idx] = (bf16_t)f2bf(Cs[r * 65 + c]); }
        }
    }
}
__device__ __forceinline__ void phase4_naive(const Params& P, int bid, int nb, float* smem) {
    bid = sgpr_op(bid); nb = sgpr_op(nb);
    const int tid = tid_op();
    const bf16_t* HB = (const bf16_t*)(P.ws + WS_HB); const bf16_t* PLE = (const bf16_t*)(P.ws + WS_PLE); float* SSQF = (float*)(P.ws + WS_SSQF);
    float* Cs = smem + 16 * 129 + 16 * 65;
    constexpr int NRT = T / 128;
    for (int item = bid; item < 16 * NRT; item += nb) {
        const int ct = item % 16, rt = item / 16, row0 = rt * 128, col0 = ct * 64;
        ngemm_tile(HB, DM, row0, P.w_gate, DM, col0, 64, DM, nullptr, smem);
        _Pragma("unroll 1") for (int e = tid; e < 128 * 64; e += NT) { const int r = e >> 6, c = e & 63; const size_t idx = (size_t)(row0 + r) * DM + col0 + c;
            const float h2 = P.out[idx] + bf2f(PLE[idx]) * sigmoid_f(Cs[r * 65 + c]); P.out[idx] = h2; Cs[r * 65 + c] = h2; }
        __syncthreads();
        if (tid < 128) { float s = 0.f; _Pragma("unroll 4") for (int c = 0; c < 64; ++c) { const float v = Cs[tid * 65 + c]; s += v * v; } atomicAdd(SSQF + row0 + tid, s); }
    }
}
__device__ __forceinline__ void phase5(const Params& P, int bid, int nb) {
    bid = sgpr_op(bid); nb = sgpr_op(nb);
    const float* SSQF = (const float*)(P.ws + WS_SSQF);
    const int tid = tid_op(), lane = tid & 63, wave = tid >> 6;
    const int gw = bid * (NT / 64) + wave, ngw = nb * (NT / 64);
    for (int t = gw; t < T; t += ngw) {
        const float rstd = 1.0f / sqrtf(SSQF[t] * (1.f / DM) + RMS_EPS);
        float4* o = (float4*)(P.out + (size_t)t * DM);
#pragma unroll
        for (int j = 0; j < 4; ++j) { float4 v = o[lane + 64 * j]; const float4 g = ((const float4*)P.final_g)[lane + 64 * j];
            v.x *= rstd * g.x; v.y *= rstd * g.y; v.z *= rstd * g.z; v.w *= rstd * g.w; o[lane + 64 * j] = v; }
    }
}

__global__ void __launch_bounds__(NT) fwd_megakernel(Params P) {
    __shared__ float smem[NG_SMEM_FLOATS];
    cg::grid_group grid = cg::this_grid();
    const int bid = blockIdx.x, nb = gridDim.x;
    phase0(P, bid, nb);
    grid.sync();
    phase1_naive(P, bid, nb, smem);
    grid.sync();
    phase15_naive(P, bid, nb, smem);
    grid.sync();
    phase2_naive(P, bid, nb, smem);
    grid.sync();
    phase25_naive(P, bid, nb);
    grid.sync();
    phase3_naive(P, bid, nb, smem);
    grid.sync();
    phase4_naive(P, bid, nb, smem);
    grid.sync();
    phase5(P, bid, nb);
}

extern "C" void kernel_launch(void* const* d_in, const int* in_sizes, int n_in, void* d_out, int out_size, void* d_ws, size_t ws_size, hipStream_t stream) {
    if (n_in != 15 || out_size != T * DM || ws_size < WS_END) { fprintf(stderr, "kernel_launch: unexpected shapes (n_in %d out %d ws %zu)\n", n_in, out_size, ws_size); return; }
    static int grid_blocks = 0;
    if (!grid_blocks) {
        int dev = 0, cus = 0, per_cu = 0;
        hipGetDevice(&dev);
        hipDeviceGetAttribute(&cus, hipDeviceAttributeMultiprocessorCount, dev);
        hipOccupancyMaxActiveBlocksPerMultiprocessor(&per_cu, fwd_megakernel, NT, 0);
        if (per_cu < 1) { fprintf(stderr, "kernel_launch: occupancy query says %d blocks/CU\n", per_cu); per_cu = 1; }
        if (per_cu > 1) per_cu = 1;
        grid_blocks = cus * per_cu;
    }
    Params P{};
    P.x = (const float*)d_in[0]; P.p = (const float*)d_in[1]; P.pos = (const int*)d_in[2]; P.norm_g = (const float*)d_in[3]; P.w_in = (const float*)d_in[4];
    P.diff_lambda = (const float*)d_in[5]; P.subln_g = (const float*)d_in[6]; P.qn_g = (const float*)d_in[7]; P.w_uq = (const float*)d_in[8]; P.kvn_g = (const float*)d_in[9];
    P.w_ukv = (const float*)d_in[10]; P.w_out = (const float*)d_in[11]; P.w_ple = (const float*)d_in[12]; P.w_gate = (const float*)d_in[13]; P.final_g = (const float*)d_in[14];
    P.out = (float*)d_out; P.ws = (unsigned char*)d_ws;
    void* args[] = {&P};
    hipError_t e = hipLaunchCooperativeKernel((void*)fwd_megakernel, dim3(grid_blocks), dim3(NT), args, 0, stream);
    if (e != hipSuccess) fprintf(stderr, "cooperative launch failed: %s (grid %d)\n", hipGetErrorString(e), grid_blocks);
}
```

```cpp
#include <hip/hip_runtime.h>
#include <hip/hip_cooperative_groups.h>
#include <cstdio>
#include <cstdint>

namespace cg = cooperative_groups;
typedef unsigned short bf16_t;

constexpr int BATCH = 8, SEQ = 4096, T = BATCH * SEQ, DM = 1024, DIN = 3104, PLE_DIM = 256;
constexpr int OFF_DQ = 0, OFF_DK = 512, OFF_DV = 1024, OFF_DG = 1536, OFF_CQ = 2048, OFF_CKV = 2432, OFF_KR = 2560, OFF_MG = 2592;
constexpr int QLORA = 384, KVLORA = 128, CQP = 512;
constexpr float RMS_EPS = 1e-6f;
constexpr float LOG2E = 1.4426950408889634f;
constexpr float C2D = 0.125f * LOG2E;
constexpr float C2M = 0.10206207261596575f * LOG2E;
constexpr float LAM_INIT = 0.2f;
constexpr int NT = 512;

constexpr size_t MiB = 1u << 20;
constexpr size_t WS_CTL = 0;
constexpr size_t WS_MISC = 1 * MiB;
constexpr size_t WS_SSQQ = 1 * MiB + 65536, WS_SSQKV = WS_SSQQ + 131072, WS_SSQF = WS_SSQKV + 131072;
constexpr size_t WS_CSA = 2 * MiB, WS_CSB = 10 * MiB;
constexpr size_t WS_WIN = 14 * MiB, WS_WPLE = 21 * MiB, WS_WUQ = 22 * MiB, WS_WUKV = 23 * MiB, WS_WOUT = 24 * MiB, WS_WG = 26 * MiB;
constexpr size_t WS_PB = 28 * MiB, WS_CQ = 44 * MiB  , WS_XN = 76 * MiB, WS_OD = WS_XN;
constexpr size_t WS_QD = 140 * MiB, WS_KD = 172 * MiB, WS_PLE = WS_QD, WS_VD = 204 * MiB, WS_G = 236 * MiB, WS_HB = WS_G;
constexpr size_t WS_QM = 300 * MiB, WS_KM = 348 * MiB, WS_VM = 396 * MiB, WS_YCAT = 428 * MiB, WS_END = 492 * MiB;

struct Params {
    const float* x; const float* p; const int* pos; const float* norm_g; const float* w_in; const float* diff_lambda;
    const float* subln_g; const float* qn_g; const float* w_uq; const float* kvn_g; const float* w_ukv; const float* w_out;
    const float* w_ple; const float* w_gate; const float* final_g; float* out; unsigned char* ws;
};

__device__ __forceinline__ unsigned f2bf(float f) { unsigned u = __float_as_uint(f); return (u + 0x7fffu + ((u >> 16) & 1u)) >> 16; }
__device__ __forceinline__ float bf2f(bf16_t h) { return __uint_as_float(((unsigned)h) << 16); }
__device__ __forceinline__ float wave_sum(float v) {
#pragma unroll
    for (int o = 1; o < 64; o <<= 1) v += __shfl_xor(v, o);
    return v;
}
__device__ __forceinline__ int tid_op() { int t = threadIdx.x; asm volatile("" : "+v"(t)); return t; }
__device__ __forceinline__ int sgpr_op(int v) { asm volatile("" : "+s"(v)); return v; }
__device__ __forceinline__ float silu_f(float v) { return v / (1.f + __expf(-v)); }
__device__ __forceinline__ float sigmoid_f(float v) { return 1.f / (1.f + __expf(-v)); }

__device__ __forceinline__ void phase0(const Params& P, int bid, int nb) {
    bid = sgpr_op(bid); nb = sgpr_op(nb);
    const int tid = tid_op(), lane = tid & 63, wave = tid >> 6;
    const int gw = bid * (NT / 64) + wave, ngw = nb * (NT / 64);
    const int gt = bid * NT + tid, ngt = nb * NT;
    bf16_t* XN = (bf16_t*)(P.ws + WS_XN);
    for (int t = gw; t < T; t += ngw) {
        const float4* xr = (const float4*)(P.x + (size_t)t * DM);
        float4 v[4]; float s = 0.f;
#pragma unroll
        for (int j = 0; j < 4; ++j) { v[j] = xr[lane + 64 * j]; s += v[j].x * v[j].x + v[j].y * v[j].y + v[j].z * v[j].z + v[j].w * v[j].w; }
        s = wave_sum(s);
        const float rstd = 1.0f / sqrtf(s * (1.f / DM) + RMS_EPS);
#pragma unroll
        for (int j = 0; j < 4; ++j) {
            const float4 g = ((const float4*)P.norm_g)[lane + 64 * j];
            uint2 o; o.x = f2bf(v[j].x * rstd * g.x) | (f2bf(v[j].y * rstd * g.y) << 16); o.y = f2bf(v[j].z * rstd * g.z) | (f2bf(v[j].w * rstd * g.w) << 16);
            ((uint2*)(XN + (size_t)t * DM))[lane + 64 * j] = o;
        }
    }
    bf16_t* PB = (bf16_t*)(P.ws + WS_PB);
    for (int i = gt; i < T * PLE_DIM / 4; i += ngt) {
        const float4 v = ((const float4*)P.p)[i];
        uint2 o; o.x = f2bf(v.x) | (f2bf(v.y) << 16); o.y = f2bf(v.z) | (f2bf(v.w) << 16);
        ((uint2*)PB)[i] = o;
    }
    float2* CSA = (float2*)(P.ws + WS_CSA); float2* CSB = (float2*)(P.ws + WS_CSB);
    for (int i = gt; i < T * 32; i += ngt) {
        const int t = i >> 5, k = i & 31;
        const double inv = pow(10000.0, -(double)k / 32.0);
        const double ang = (double)P.pos[t] * inv;
        double sn, cs; sincos(ang, &sn, &cs);
        CSA[i] = make_float2((float)cs, (float)sn);
    }
    for (int i = gt; i < T * 16; i += ngt) {
        const int t = i >> 4, k = i & 15;
        const double inv = pow(10000.0, -(double)k / 16.0);
        const double ang = (double)P.pos[t] * inv;
        double sn, cs; sincos(ang, &sn, &cs);
        CSB[i] = make_float2((float)cs, (float)sn);
    }
    float* ssq = (float*)(P.ws + WS_SSQQ);
    for (int i = gt; i < 3 * T; i += ngt) ssq[i] = 0.f;
    if (bid == 0 && tid == 0) {
        float s1 = 0.f, s2 = 0.f;
        for (int i = 0; i < 64; ++i) { s1 += P.diff_lambda[i] * P.diff_lambda[64 + i]; s2 += P.diff_lambda[128 + i] * P.diff_lambda[192 + i]; }
        ((float*)(P.ws + WS_MISC))[0] = expf(s1) - expf(s2) + LAM_INIT;
    }
}

constexpr int NG_SMEM_FLOATS = 16 * 129 + 16 * 65 + 128 * 65;
__device__ __forceinline__ void ngemm_tile(const bf16_t* A, int lda, int row0, const float* W, int ldw, int col0, int ncol, int K, const float* kscale, float* smem) {
    float* As = smem; float* Bs = smem + 16 * 129; float* Cs = Bs + 16 * 65;
    const int tid = tid_op(), ty = tid >> 4, tx = tid & 15;
    float acc[4][4];
#pragma unroll
    for (int i = 0; i < 4; ++i)
#pragma unroll
        for (int j = 0; j < 4; ++j) acc[i][j] = 0.f;
#pragma unroll 1
    for (int k0 = 0; k0 < K; k0 += 16) {
        __syncthreads();
#pragma unroll
        for (int i = 0; i < 4; ++i) { const int idx = tid + i * NT, r = idx >> 4, kk = idx & 15; As[kk * 129 + r] = bf2f(A[(size_t)(row0 + r) * lda + k0 + kk]); }
#pragma unroll
        for (int i = 0; i < 2; ++i) { const int idx = tid + i * NT, kk = idx >> 6, c = idx & 63;
            float w = 0.f; if (c < ncol) { w = W[(size_t)(k0 + kk) * ldw + col0 + c]; if (kscale) w *= kscale[k0 + kk]; }
            Bs[kk * 65 + c] = w; }
        __syncthreads();
#pragma unroll
        for (int kk = 0; kk < 16; ++kk) {
            float a[4], b[4];
#pragma unroll
            for (int i = 0; i < 4; ++i) a[i] = As[kk * 129 + ty * 4 + i];
#pragma unroll
            for (int j = 0; j < 4; ++j) b[j] = Bs[kk * 65 + tx * 4 + j];
#pragma unroll
            for (int i = 0; i < 4; ++i)
#pragma unroll
                for (int j = 0; j < 4; ++j) acc[i][j] += a[i] * b[j];
        }
    }
    __syncthreads();
#pragma unroll
    for (int i = 0; i < 4; ++i)
#pragma unroll
        for (int j = 0; j < 4; ++j) Cs[(ty * 4 + i) * 65 + tx * 4 + j] = acc[i][j];
    __syncthreads();
}

__device__ __forceinline__ void phase1_naive(const Params& P, int bid, int nb, float* smem) {
    bid = sgpr_op(bid); nb = sgpr_op(nb);
    const int tid = tid_op();
    const bf16_t* XN = (const bf16_t*)(P.ws + WS_XN);
    bf16_t* QD = (bf16_t*)(P.ws + WS_QD); bf16_t* KD = (bf16_t*)(P.ws + WS_KD); bf16_t* VD = (bf16_t*)(P.ws + WS_VD); bf16_t* G = (bf16_t*)(P.ws + WS_G);
    bf16_t* CQ = (bf16_t*)(P.ws + WS_CQ); bf16_t* KM = (bf16_t*)(P.ws + WS_KM);
    float* SSQQ = (float*)(P.ws + WS_SSQQ); float* SSQKV = (float*)(P.ws + WS_SSQKV);
    const float2* CSA = (const float2*)(P.ws + WS_CSA); const float2* CSB = (const float2*)(P.ws + WS_CSB);
    float* Cs = smem + 16 * 129 + 16 * 65;
    constexpr int NCT = 49, NRT = T / 128;
    for (int item = bid; item < NCT * NRT; item += nb) {
        const int ct = item % NCT, rt = item / NCT, row0 = rt * 128;
        int col0, ncol = 64;
        if (ct < 40) col0 = ct * 64; else if (ct == 40) { col0 = OFF_KR; ncol = 32; } else col0 = OFF_MG + (ct - 41) * 64;
        ngemm_tile(XN, DM, row0, P.w_in, DIN, col0, ncol, DM, nullptr, smem);
        _Pragma("unroll 1") for (int e = tid; e < 128 * 64; e += NT) {
            const int r = e >> 6, c = e & 63, t = row0 + r, b = t / SEQ, s = t % SEQ;
            const float v = Cs[r * 65 + c];
            if (col0 < OFF_DV) {
                const int i = c & 31; const float x1 = Cs[r * 65 + i], x2 = Cs[r * 65 + i + 32]; const float2 cs = CSA[(size_t)t * 32 + i];
                const float o = (c < 32) ? (x1 * cs.x - x2 * cs.y) : (x2 * cs.x + x1 * cs.y);
                if (col0 < OFF_DK) { const int mh = col0 / 64; QD[((size_t)(b * 8 + mh) * SEQ + s) * 64 + c] = (bf16_t)f2bf(o * C2D); }
                else { const int mh = (col0 - OFF_DK) / 64; KD[((size_t)(b * 8 + mh) * SEQ + s) * 64 + c] = (bf16_t)f2bf(o); }
            } else if (col0 < OFF_DG) { const int col = col0 - OFF_DV + c, h = col >> 7, d = col & 127; VD[((size_t)(b * 4 + h) * SEQ + s) * 128 + d] = (bf16_t)f2bf(v); }
            else if (col0 < OFF_CQ) { const int col = col0 - OFF_DG + c; G[(size_t)t * 1024 + col] = (bf16_t)f2bf(silu_f(v)); }
            else if (col0 < OFF_CKV) { const int col = col0 - OFF_CQ + c; CQ[(size_t)t * CQP + col] = (bf16_t)f2bf(v); }
            else if (col0 < OFF_KR) { const int col = col0 - OFF_CKV + c; CQ[(size_t)t * CQP + QLORA + col] = (bf16_t)f2bf(v); }
            else if (col0 == OFF_KR) { if (c < 32) { const int i = c & 15; const float x1 = Cs[r * 65 + i], x2 = Cs[r * 65 + i + 16]; const float2 cs = CSB[(size_t)t * 16 + i];
                    const float o = (c < 16) ? (x1 * cs.x - x2 * cs.y) : (x2 * cs.x + x1 * cs.y);
                    for (int h = 0; h < 8; ++h) KM[((size_t)(b * 8 + h) * SEQ + s) * 96 + 64 + c] = (bf16_t)f2bf(o); } }
            else { const int col = col0 - OFF_MG + c; G[(size_t)t * 1024 + 512 + col] = (bf16_t)f2bf(silu_f(v)); }
        }
        if (col0 >= OFF_CQ && col0 < OFF_KR && tid < 128) {
            float s = 0.f; _Pragma("unroll 4") for (int c = 0; c < 64; ++c) { const float v = Cs[tid * 65 + c]; s += v * v; }
            atomicAdd((col0 < OFF_CKV ? SSQQ : SSQKV) + row0 + tid, s);
        }
    }
}

__device__ __forceinline__ void phase15_naive(const Params& P, int bid, int nb, float* smem) {
    bid = sgpr_op(bid); nb = sgpr_op(nb);
    const int tid = tid_op();
    const bf16_t* CQ = (const bf16_t*)(P.ws + WS_CQ); const bf16_t* CKV = CQ + QLORA;
    bf16_t* QM = (bf16_t*)(P.ws + WS_QM); bf16_t* KM = (bf16_t*)(P.ws + WS_KM); bf16_t* VM = (bf16_t*)(P.ws + WS_VM);
    const float* SSQQ = (const float*)(P.ws + WS_SSQQ); const float* SSQKV = (const float*)(P.ws + WS_SSQKV);
    const float2* CSB = (const float2*)(P.ws + WS_CSB);
    float* Cs = smem + 16 * 129 + 16 * 65;
    constexpr int NCT = 12 + 16, NRT = T / 128;
    for (int item = bid; item < NCT * NRT; item += nb) {
        const int ct = item % NCT, rt = item / NCT, row0 = rt * 128;
        if (ct < 12) {
            const int col0 = ct * 64;
            ngemm_tile(CQ, CQP, row0, P.w_uq, 768, col0, 64, QLORA, P.qn_g, smem);
            _Pragma("unroll 1") for (int e = tid; e < 128 * 64; e += NT) {
                const int r = e >> 6, c = e & 63, t = row0 + r, b = t / SEQ, s = t % SEQ, col = col0 + c, h = col / 96, j = col % 96;
                const float rstd = 1.0f / sqrtf(SSQQ[t] * (1.f / QLORA) + RMS_EPS);
                float o;
                if (j < 64) o = Cs[r * 65 + c];
                else { const int jj = j - 64, i = jj & 15, cb = c - jj; const float x1 = Cs[r * 65 + cb + i], x2 = Cs[r * 65 + cb + i + 16]; const float2 cs = CSB[(size_t)t * 16 + i];
                    o = (jj < 16) ? (x1 * cs.x - x2 * cs.y) : (x2 * cs.x + x1 * cs.y); }
                QM[((size_t)(b * 8 + h) * SEQ + s) * 96 + j] = (bf16_t)f2bf(o * rstd * C2M);
            }
        } else {
            const int col0 = (ct - 12) * 64;
            ngemm_tile(CKV, CQP, row0, P.w_ukv, 1024, col0, 64, KVLORA, P.kvn_g, smem);
            _Pragma("unroll 1") for (int e = tid; e < 128 * 64; e += NT) {
                const int r = e >> 6, c = e & 63, t = row0 + r, b = t / SEQ, s = t % SEQ, col = col0 + c, h = col >> 7, j = col & 127;
                const float rstd = 1.0f / sqrtf(SSQKV[t] * (1.f / KVLORA) + RMS_EPS);
                const float o = Cs[r * 65 + c] * rstd;
                if (j < 64) KM[((size_t)(b * 8 + h) * SEQ + s) * 96 + j] = (bf16_t)f2bf(o);
                else VM[((size_t)(b * 8 + h) * SEQ + s) * 64 + j - 64] = (bf16_t)f2bf(o);
            }
        }
    }
}

template <int DQK, int DV, int DVS>
__device__ __forceinline__ void nattn_rows(const bf16_t* Qh, const bf16_t* Kh, const bf16_t* Vh, int q0, float* o, float& l_out, unsigned* smem) {
    const int tid = tid_op(), i = q0 + tid;
    unsigned* Ks = smem; unsigned* Vs = smem + 32 * (DQK / 2);
    unsigned q2[DQK / 2];
#pragma unroll
    for (int d = 0; d < DQK / 2; ++d) q2[d] = ((const unsigned*)(Qh + (size_t)i * DQK))[d];
#pragma unroll
    for (int d = 0; d < DV; ++d) o[d] = 0.f;
    float m = -1e30f, l = 0.f;
    const int jend = q0 + NT;
#pragma unroll 1
    for (int j0 = 0; j0 < jend; j0 += 32) {
        __syncthreads();
        for (int idx = tid; idx < 32 * (DQK / 2); idx += NT) Ks[idx] = ((const unsigned*)(Kh + (size_t)j0 * DQK))[idx];
        for (int idx = tid; idx < 32 * (DV / 2); idx += NT) { const int r = idx / (DV / 2), c = idx % (DV / 2); Vs[idx] = ((const unsigned*)(Vh + (size_t)(j0 + r) * DVS))[c]; }
        __syncthreads();
#pragma unroll 1
        for (int jj = 0; jj < 32; jj += 2) {
            float sc[2];
#pragma unroll
            for (int k = 0; k < 2; ++k) {
                const unsigned* kr = Ks + (jj + k) * (DQK / 2); float s = 0.f;
#pragma unroll
                for (int d = 0; d < DQK / 2; ++d) { const unsigned kk = kr[d]; unsigned qq = q2[d]; asm volatile("" : "+v"(qq));
                    s += __uint_as_float(qq << 16) * __uint_as_float(kk << 16); s += __uint_as_float(qq & 0xffff0000u) * __uint_as_float(kk & 0xffff0000u); }
                sc[k] = (j0 + jj + k <= i) ? s : -1e30f;
                asm volatile("" : "+v"(sc[k]));
            }
            const float mn = fmaxf(fmaxf(sc[0], sc[1]), m);
            const float alpha = exp2f(m - mn);
            float pr[2];
#pragma unroll
            for (int k = 0; k < 2; ++k) pr[k] = (j0 + jj + k <= i) ? exp2f(sc[k] - mn) : 0.f;
            l = l * alpha + (pr[0] + pr[1]); m = mn;
#pragma unroll
            for (int d = 0; d < DV; ++d) o[d] *= alpha;
#pragma unroll
            for (int k = 0; k < 2; ++k) { const unsigned* vr = Vs + (jj + k) * (DV / 2);
#pragma unroll
                for (int d = 0; d < DV / 2; ++d) { const unsigned vv = vr[d]; o[2 * d] += pr[k] * __uint_as_float(vv << 16); o[2 * d + 1] += pr[k] * __uint_as_float(vv & 0xffff0000u); } }
        }
    }
    l_out = l;
}
__device__ __forceinline__ void phase2_naive(const Params& P, int bid, int nb, float* smemf) {
    bid = sgpr_op(bid); nb = sgpr_op(nb);
    unsigned* smem = (unsigned*)smemf;
    const bf16_t* QD = (const bf16_t*)(P.ws + WS_QD); const bf16_t* KD = (const bf16_t*)(P.ws + WS_KD); const bf16_t* VD = (const bf16_t*)(P.ws + WS_VD);
    const bf16_t* QM = (const bf16_t*)(P.ws + WS_QM); const bf16_t* KM = (const bf16_t*)(P.ws + WS_KM); const bf16_t* VM = (const bf16_t*)(P.ws + WS_VM);
    const bf16_t* G = (const bf16_t*)(P.ws + WS_G); bf16_t* OD = (bf16_t*)(P.ws + WS_OD); bf16_t* YC = (bf16_t*)(P.ws + WS_YCAT);
    constexpr int NCH = SEQ / NT;
    for (int item = bid; item < 2 * 64 * NCH; item += nb) {
        const int kind = item / (64 * NCH), rem = item % (64 * NCH), bh = rem / NCH, ch = NCH - 1 - rem % NCH, q0 = ch * NT, b = bh >> 3, hh = bh & 7;
        const int i = q0 + tid_op();
        if (kind == 0) {
#pragma unroll 1
            for (int half = 0; half < 2; ++half) {
                float o[64], l;
                nattn_rows<64, 64, 128>(QD + (size_t)bh * SEQ * 64, KD + (size_t)bh * SEQ * 64, VD + (size_t)(b * 4 + (hh >> 1)) * SEQ * 128 + half * 64, q0, o, l, smem);
                const float rl = 1.f / l;
#pragma unroll
                for (int d = 0; d < 64; ++d) OD[((size_t)bh * SEQ + i) * 128 + half * 64 + d] = (bf16_t)f2bf(o[d] * rl);
            }
        } else {
            float o[64], l;
            nattn_rows<96, 64, 64>(QM + (size_t)bh * SEQ * 96, KM + (size_t)bh * SEQ * 96, VM + (size_t)bh * SEQ * 64, q0, o, l, smem);
            const float rl = 1.f / l; const size_t t = (size_t)b * SEQ + i;
#pragma unroll
            for (int d = 0; d < 64; ++d) { const size_t idx = t * 1024 + 512 + hh * 64 + d; YC[idx] = (bf16_t)f2bf(o[d] * rl * bf2f(G[idx])); }
        }
    }
}

__device__ __forceinline__ void phase25_naive(const Params& P, int bid, int nb) {
    bid = sgpr_op(bid); nb = sgpr_op(nb);
    const bf16_t* OD = (const bf16_t*)(P.ws + WS_OD); const bf16_t* G = (const bf16_t*)(P.ws + WS_G); bf16_t* YC = (bf16_t*)(P.ws + WS_YCAT);
    const float lam = ((const float*)(P.ws + WS_MISC))[0];
    const int tid = tid_op(), lane = tid & 63, wave = tid >> 6;
    const int gw = bid * (NT / 64) + wave, ngw = nb * (NT / 64);
    for (int it = gw; it < T * 4; it += ngw) {
        const int t = it >> 2, h = it & 3, b = t / SEQ, s = t % SEQ;
        const bf16_t* o0 = OD + ((size_t)(b * 8 + 2 * h) * SEQ + s) * 128; const bf16_t* o1 = OD + ((size_t)(b * 8 + 2 * h + 1) * SEQ + s) * 128;
        const float d0 = bf2f(o0[lane]) - lam * bf2f(o1[lane]), d1 = bf2f(o0[lane + 64]) - lam * bf2f(o1[lane + 64]);
        const float ss = wave_sum(d0 * d0 + d1 * d1);
        const float rstd = 1.0f / sqrtf(ss * (1.f / 128.f) + RMS_EPS);
        const size_t base = (size_t)t * 1024 + h * 128;
        YC[base + lane] = (bf16_t)f2bf(d0 * rstd * P.subln_g[lane] * (1.f - LAM_INIT) * bf2f(G[base + lane]));
        YC[base + lane + 64] = (bf16_t)f2bf(d1 * rstd * P.subln_g[lane + 64] * (1.f - LAM_INIT) * bf2f(G[base + lane + 64]));
    }
}

__device__ __forceinline__ void phase3_naive(const Params& P, int bid, int nb, float* smem) {
    bid = sgpr_op(bid); nb = sgpr_op(nb);
    const int tid = tid_op();
    const bf16_t* YC = (const bf16_t*)(P.ws + WS_YCAT); const bf16_t* PB = (const bf16_t*)(P.ws + WS_PB);
    bf16_t* HB = (bf16_t*)(P.ws + WS_HB); bf16_t* PLE = (bf16_t*)(P.ws + WS_PLE);
    float* Cs = smem + 16 * 129 + 16 * 65;
    constexpr int NRT = T / 128;
    for (int item = bid; item < 32 * NRT; item += nb) {
        const int ct = item % 32, rt = item / 32, row0 = rt * 128, col0 = (ct & 15) * 64;
        if (ct < 16) {
            ngemm_tile(YC, DM, row0, P.w_out, DM, col0, 64, DM, nullptr, smem);
            _Pragma("unroll 1") for (int e = tid; e < 128 * 64; e += NT) { const int r = e >> 6, c = e & 63; const size_t idx = (size_t)(row0 + r) * DM + col0 + c;
                const float h = P.x[idx] + Cs[r * 65 + c]; P.out[idx] = h; HB[idx] = (bf16_t)f2bf(h); }
        } else {
            ngemm_tile(PB, PLE_DIM, row0, P.w_ple, DM, col0, 64, PLE_DIM, nullptr, smem);
            _Pragma("unroll 1") for (int e = tid; e < 128 * 64; e += NT) { const int r = e >> 6, c = e & 63; const size_t idx = (size_t)(row0 + r) * DM + col0 + c; PLE[idx] = (bf16_t)f2bf(Cs[r * 65 + c]); }
        }
    }
}
__device__ __forceinline__ void phase4_naive(const Params& P, int bid, int nb, float* smem) {
    bid = sgpr_op(bid); nb = sgpr_op(nb);
    const int tid = tid_op();
    const bf16_t* HB = (const bf16_t*)(P.ws + WS_HB); const bf16_t* PLE = (const bf16_t*)(P.ws + WS_PLE); float* SSQF = (float*)(P.ws + WS_SSQF);
    float* Cs = smem + 16 * 129 + 16 * 65;
    constexpr int NRT = T / 128;
    for (int item = bid; item < 16 * NRT; item += nb) {
        const int ct = item % 16, rt = item / 16, row0 = rt * 128, col0 = ct * 64;
        ngemm_tile(HB, DM, row0, P.w_gate, DM, col0, 64, DM, nullptr, smem);
        _Pragma("unroll 1") for (int e = tid; e < 128 * 64; e += NT) { const int r = e >> 6, c = e & 63; const size_t idx = (size_t)(row0 + r) * DM + col0 + c;
            const float h2 = P.out[idx] + bf2f(PLE[idx]) * sigmoid_f(Cs[r * 65 + c]); P.out[idx] = h2; Cs[r * 65 + c] = h2; }
        __syncthreads();
        if (tid < 128) { float s = 0.f; _Pragma("unroll 4") for (int c = 0; c < 64; ++c) { const float v = Cs[tid * 65 + c]; s += v * v; } atomicAdd(SSQF + row0 + tid, s); }
    }
}
__device__ __forceinline__ void phase5(const Params& P, int bid, int nb) {
    bid = sgpr_op(bid); nb = sgpr_op(nb);
    const float* SSQF = (const float*)(P.ws + WS_SSQF);
    const int tid = tid_op(), lane = tid & 63, wave = tid >> 6;
    const int gw = bid * (NT / 64) + wave, ngw = nb * (NT / 64);
    for (int t = gw; t < T; t += ngw) {
        const float rstd = 1.0f / sqrtf(SSQF[t] * (1.f / DM) + RMS_EPS);
        float4* o = (float4*)(P.out + (size_t)t * DM);
#pragma unroll
        for (int j = 0; j < 4; ++j) { float4 v = o[lane + 64 * j]; const float4 g = ((const float4*)P.final_g)[lane + 64 * j];
            v.x *= rstd * g.x; v.y *= rstd * g.y; v.z *= rstd * g.z; v.w *= rstd * g.w; o[lane + 64 * j] = v; }
    }
}

namespace pg8 {
#define PG8_LAS __attribute__((address_space(3)))
typedef unsigned short bf16_t;
typedef short bf16x8 __attribute__((ext_vector_type(8)));
typedef float f32x4 __attribute__((ext_vector_type(4)));
typedef unsigned u32x4 __attribute__((ext_vector_type(4)));
constexpr int BM = 256, BK = 64, HALF = 128, HTB = HALF * BK * 2  , STAGE_BYTES = 8 * HTB, NXCD = 8, WGM = 8;

__host__ __device__ __forceinline__ int lds_byte(int r, int c) { const int st = (r >> 4) * 2 + (c >> 5), rr = r & 15, cc = c & 31, ob = rr * 64 + cc * 2; return st * 1024 + (ob ^ (((ob >> 9) & 1) << 5)); }
__host__ __device__ __forceinline__ void stage_rc(int b, int& R, int& C) { const int st = b / 1024, sb = b % 1024, swz = sb ^ (((sb >> 9) & 1) << 5); R = (st >> 1) * 16 + swz / 64; C = (st & 1) * 32 + (swz % 64) / 2; }
__host__ __device__ __forceinline__ int perm32(int rho) { const int n = rho >> 4, i = rho & 15; return 8 * (i >> 2) + 4 * n + (i & 3); }

struct Unit { int pm, pn; };
struct Gemm { const bf16_t* A; const bf16_t* Bt; int M, N, K, lda; };

struct StaticOrder {
    int nM, nN, nwg, G, c;
    __host__ __device__ void init(int M, int N, int G_, int c_) { nM = M / BM; nN = N / BM; nwg = nM * nN; G = G_; c = c_; }
    __host__ __device__ bool next(int i, Unit& u) const {
        const long L = (long)i * G + c; if (L >= nwg) return false;
        int wgid = (int)L; { const int q = nwg / NXCD, r = nwg % NXCD, xcd = wgid % NXCD, off = wgid / NXCD; wgid = (xcd < r ? xcd * (q + 1) : r * (q + 1) + (xcd - r) * q) + off; }
        const int nig = WGM * nN, gid = wgid / nig, fm = gid * WGM, gsz = (nM - fm) < WGM ? (nM - fm) : WGM;
        u.pm = fm + ((wgid % nig) % gsz); u.pn = (wgid % nig) / gsz; return true;
    }
    __device__ __forceinline__ void a_ready(const Unit&) const {}
    __device__ __forceinline__ void done(const Unit&) const {}
};

__device__ __forceinline__ unsigned cvt_pk_bf16(float lo, float hi) { unsigned r; asm volatile("v_cvt_pk_bf16_f32 %0, %1, %2" : "=v"(r) : "v"(lo), "v"(hi)); return r; }
template <class Epi, class Sched, bool ALIGN_EPI = false, bool SP2 = false>
__device__ __forceinline__ void gemm_phase(PG8_LAS unsigned char* lds, const Gemm g, const Sched& S, const Epi& E) {
    const int tid = tid_op(), wid = __builtin_amdgcn_readfirstlane(tid >> 6), lane = tid & 63, wr = wid >> 2, wc = wid & 3, fr = lane & 15, fq = lane >> 4;
    const int K = g.K, nt = K / BK;
    unsigned voffA[2], voffB[2];
#pragma unroll
    for (int i = 0; i < 2; ++i) { int R, C; stage_rc(tid * 16 + i * 8192, R, C); const int Rb = Epi::PERM ? ((R & ~31) + perm32(R & 31)) : R;
        voffA[i] = (unsigned)(R * g.lda + C) * 2u; voffB[i] = (unsigned)(Rb * K + C) * 2u; }
    const size_t kstep = (size_t)(BK * 2);
    const size_t hstepA = (size_t)HALF * g.lda * 2, hstepB = (size_t)HALF * K * 2;
    const size_t tstepA = 2 * hstepA, tstepB = 2 * hstepB;
    const unsigned ldsw = (unsigned)wid * 1024u;
    const int aoff = lds_byte(wr * 64 + fr, fq * 8), boff = lds_byte(wc * 32 + fr, fq * 8);
#define PG8_SA(b, h) (((b) * 2 + (h)) * HTB)
#define PG8_SB(b, h) ((4 + (b) * 2 + (h)) * HTB)
#define PG8_STAGE(bufoff, gbase, voff) do { _Pragma("unroll") for (int _i = 0; _i < 2; ++_i) \
        __builtin_amdgcn_global_load_lds((const unsigned*)((const char*)(gbase) + (voff)[_i]), (PG8_LAS unsigned*)(lds + (bufoff) + ldsw + _i * 8192), 16, 0, 0); } while (0)
#define PG8_LDA(dst, b, h) do { _Pragma("unroll") for (int m = 0; m < 4; ++m) _Pragma("unroll") for (int k = 0; k < 2; ++k) dst[m][k] = *(const PG8_LAS bf16x8*)(lds + PG8_SA(b, h) + aoff + m * 2048 + k * 1024); } while (0)
#define PG8_LDB(dst, b, h) do { _Pragma("unroll") for (int n = 0; n < 2; ++n) _Pragma("unroll") for (int k = 0; k < 2; ++k) dst[n][k] = *(const PG8_LAS bf16x8*)(lds + PG8_SB(b, h) + boff + n * 2048 + k * 1024); } while (0)
#define PG8_MMA(ai, bj, At, Bt) do { __builtin_amdgcn_s_setprio(1); _Pragma("unroll") for (int m = 0; m < 4; ++m) _Pragma("unroll") for (int n = 0; n < 2; ++n) _Pragma("unroll") for (int k = 0; k < 2; ++k) \
        acc[ai][bj][m][n] = __builtin_amdgcn_mfma_f32_16x16x32_bf16(Bt[n][k], At[m][k], acc[ai][bj][m][n], 0, 0, 0); __builtin_amdgcn_s_setprio(0); } while (0)
#define PG8_WAIT_V(n) asm volatile("s_waitcnt vmcnt(" #n ")" ::: "memory")
#define PG8_WAIT_L(n) asm volatile("s_waitcnt lgkmcnt(" #n ")" ::: "memory")
#define PG8_BAR __builtin_amdgcn_s_barrier()
#define PG8_SCHED __builtin_amdgcn_sched_barrier(0)
    Unit cur, nxt; int ui = 0;
    if (!S.next(0, cur)) return;
    f32x4 acc[2][2][4][2];
#pragma unroll
    for (int a = 0; a < 2; ++a)
#pragma unroll
        for (int b = 0; b < 2; ++b)
#pragma unroll
            for (int m = 0; m < 4; ++m)
#pragma unroll
                for (int n = 0; n < 2; ++n) acc[a][b][m][n] = (f32x4){0.f, 0.f, 0.f, 0.f};
    bf16x8 At[4][2], B0[2][2], B1[2][2];
    const char* cA = (const char*)g.A + (size_t)cur.pm * tstepA; const char* cB = (const char*)g.Bt + (size_t)cur.pn * tstepB;
    S.a_ready(cur);
    if constexpr (SP2) {
        PG8_STAGE(PG8_SB(0, 0), cB, voffB); PG8_STAGE(PG8_SB(0, 1), cB + hstepB, voffB); PG8_STAGE(PG8_SA(0, 0), cA, voffA); PG8_STAGE(PG8_SA(0, 1), cA + hstepA, voffA);
        if (wr == 1) PG8_BAR;
        PG8_WAIT_V(2); PG8_BAR;
        PG8_STAGE(PG8_SB(1, 0), cB + kstep, voffB); PG8_STAGE(PG8_SA(1, 0), cA + kstep, voffA); PG8_STAGE(PG8_SB(1, 1), cB + hstepB + kstep, voffB);
        PG8_WAIT_V(6); PG8_BAR;
    } else {
        PG8_STAGE(PG8_SB(0, 0), cB, voffB); PG8_STAGE(PG8_SA(0, 0), cA, voffA); PG8_STAGE(PG8_SB(0, 1), cB + hstepB, voffB); PG8_STAGE(PG8_SA(0, 1), cA + hstepA, voffA);
        if (wr == 1) PG8_BAR;
        PG8_WAIT_V(4); PG8_BAR;
        PG8_STAGE(PG8_SB(1, 0), cB + kstep, voffB); PG8_STAGE(PG8_SA(1, 0), cA + kstep, voffA); PG8_STAGE(PG8_SB(1, 1), cB + hstepB + kstep, voffB);
        PG8_WAIT_V(6); PG8_BAR;
    }
    for (;;) {
        const bool has_next = S.next(ui + 1, nxt);
        const char* nA = has_next ? (const char*)g.A + (size_t)nxt.pm * tstepA : cA; const char* nB = has_next ? (const char*)g.Bt + (size_t)nxt.pn * tstepB : cB;
#pragma unroll 1
        for (int t = 0; t < nt; t += 2) {
            const bool last = (t == nt - 2);
            const char* a1 = cA + (size_t)(t + 1) * kstep;
            const char* a2 = last ? nA : cA + (size_t)(t + 2) * kstep; const char* b2 = last ? nB : cB + (size_t)(t + 2) * kstep;
            const char* a3 = a2 + kstep; const char* b3 = b2 + kstep;
            if (last && has_next) S.a_ready(nxt);
            if constexpr (SP2) {
            PG8_LDB(B0, 0, 0); PG8_LDB(B1, 0, 1); PG8_SCHED; PG8_LDA(At, 0, 0); PG8_STAGE(PG8_SA(1, 1), a1 + hstepA, voffA);
            PG8_WAIT_V(8); PG8_WAIT_L(0); PG8_BAR; PG8_MMA(0, 0, At, B0); PG8_MMA(0, 1, At, B1); PG8_BAR; PG8_SCHED;
            PG8_LDA(At, 0, 1); PG8_STAGE(PG8_SB(0, 0), b2, voffB); PG8_STAGE(PG8_SB(0, 1), b2 + hstepB, voffB); PG8_STAGE(PG8_SA(0, 0), a2, voffA);
            PG8_WAIT_V(8); PG8_WAIT_L(0); PG8_BAR; PG8_MMA(1, 0, At, B0); PG8_MMA(1, 1, At, B1); PG8_BAR; PG8_SCHED;
            PG8_LDB(B0, 1, 0); PG8_LDB(B1, 1, 1); PG8_SCHED; PG8_LDA(At, 1, 0); PG8_STAGE(PG8_SA(0, 1), a2 + hstepA, voffA);
            PG8_WAIT_V(8); PG8_WAIT_L(0); PG8_BAR; PG8_MMA(0, 0, At, B0); PG8_MMA(0, 1, At, B1); PG8_BAR; PG8_SCHED;
            PG8_LDA(At, 1, 1); PG8_STAGE(PG8_SB(1, 0), b3, voffB); PG8_STAGE(PG8_SB(1, 1), b3 + hstepB, voffB); PG8_STAGE(PG8_SA(1, 0), a3, voffA);
            PG8_WAIT_V(8); PG8_WAIT_L(0); PG8_BAR; PG8_MMA(1, 0, At, B0); PG8_MMA(1, 1, At, B1); PG8_BAR; PG8_SCHED;
            } else {
            PG8_LDB(B0, 0, 0); PG8_SCHED; PG8_LDA(At, 0, 0); PG8_STAGE(PG8_SA(1, 1), a1 + hstepA, voffA);
            PG8_WAIT_L(8); PG8_BAR; PG8_WAIT_L(0); PG8_MMA(0, 0, At, B0); PG8_BAR; PG8_SCHED;
            PG8_LDB(B1, 0, 1); PG8_STAGE(PG8_SB(0, 0), b2, voffB);
            PG8_BAR; PG8_WAIT_L(0); PG8_MMA(0, 1, At, B1); PG8_BAR;
            PG8_LDA(At, 0, 1); PG8_STAGE(PG8_SA(0, 0), a2, voffA);
            PG8_BAR; PG8_WAIT_L(0); PG8_MMA(1, 0, At, B0); PG8_BAR; PG8_SCHED;
            PG8_STAGE(PG8_SB(0, 1), b2 + hstepB, voffB);
            PG8_WAIT_V(6); PG8_BAR; PG8_MMA(1, 1, At, B1); PG8_BAR;
            PG8_LDB(B0, 1, 0); PG8_SCHED; PG8_LDA(At, 1, 0); PG8_STAGE(PG8_SA(0, 1), a2 + hstepA, voffA);
            PG8_WAIT_L(8); PG8_BAR; PG8_WAIT_L(0); PG8_MMA(0, 0, At, B0); PG8_BAR; PG8_SCHED;
            PG8_LDB(B1, 1, 1); PG8_STAGE(PG8_SB(1, 0), b3, voffB);
            PG8_BAR; PG8_WAIT_L(0); PG8_MMA(0, 1, At, B1); PG8_BAR;
            PG8_LDA(At, 1, 1); PG8_STAGE(PG8_SA(1, 0), a3, voffA);
            PG8_BAR; PG8_WAIT_L(0); PG8_MMA(1, 0, At, B0); PG8_BAR; PG8_SCHED;
            PG8_STAGE(PG8_SB(1, 1), b3 + hstepB, voffB);
            PG8_WAIT_V(6); PG8_BAR; PG8_MMA(1, 1, At, B1); PG8_BAR;
            }
        }
        if constexpr (ALIGN_EPI) { if (wr == 0) PG8_BAR; }
        if constexpr (!Epi::AFTER_DRAIN) { E(acc, cur, wr, wc, fr, fq); S.done(cur); }
        if (!has_next) break;
#pragma unroll
        for (int a = 0; a < 2; ++a)
#pragma unroll
            for (int b = 0; b < 2; ++b)
#pragma unroll
                for (int m = 0; m < 4; ++m)
#pragma unroll
                    for (int n = 0; n < 2; ++n) acc[a][b][m][n] = (f32x4){0.f, 0.f, 0.f, 0.f};
        cur = nxt; cA = nA; cB = nB; ++ui;
        if constexpr (ALIGN_EPI) { if (wr == 1) PG8_BAR; }
    }
    PG8_WAIT_V(0);
    if constexpr (!ALIGN_EPI) { if (wr == 0) PG8_BAR; }
    PG8_BAR;
    if constexpr (Epi::AFTER_DRAIN) { E.fused(acc, cur, wr, wc, fr, fq, lds, wid, lane); S.done(cur); }
#undef PG8_SA
#undef PG8_SB
#undef PG8_STAGE
#undef PG8_LDA
#undef PG8_LDB
#undef PG8_MMA
#undef PG8_WAIT_V
#undef PG8_WAIT_L
#undef PG8_BAR
#undef PG8_SCHED
}
}

#define LAS __attribute__((address_space(3)))
typedef float f32x4 __attribute__((ext_vector_type(4)));
typedef unsigned u32x4 __attribute__((ext_vector_type(4)));
using pg8::cvt_pk_bf16;
__device__ __forceinline__ u32x4 pack8(const f32x4 a, const f32x4 b) { u32x4 w; w.x = cvt_pk_bf16(a[0], a[1]); w.y = cvt_pk_bf16(a[2], a[3]); w.z = cvt_pk_bf16(b[0], b[1]); w.w = cvt_pk_bf16(b[2], b[3]); return w; }

struct MapIn {
    __device__ __forceinline__ int operator()(int g) const { const int pn = g >> 8, cc = g & 255, bj = cc >> 7, w = cc & 127;
        if (pn < 2) return OFF_DQ + (4 * pn + (w >> 5)) * 64 + bj * 32 + (w & 31);
        if (pn < 4) return OFF_DK + (4 * (pn - 2) + (w >> 5)) * 64 + bj * 32 + (w & 31);
        if (pn < 6) return OFF_DV + (pn - 4) * 256 + cc;
        if (pn < 8) return OFF_DG + (pn - 6) * 256 + cc;
        if (pn == 8) return OFF_CQ + cc;
        if (pn == 9) return bj == 0 ? OFF_CQ + 256 + w : OFF_CKV + w;
        if (pn < 12) return OFF_MG + (pn - 10) * 256 + cc;
        return w < 16 ? OFF_KR + bj * 16 + w : -1; } };
struct MapUq {
    __device__ __forceinline__ int operator()(int g) const { const int pn = g >> 8, cc = g & 255;
        if (pn == 0) { const int bj = cc >> 7, w = cc & 127; return (w >> 4) * 96 + 64 + bj * 16 + (w & 15); }
        const int gp = g - 256; return (gp >> 6) * 96 + (gp & 63); } };
struct MapId { __device__ __forceinline__ int operator()(int g) const { return g; } };
template <class Map>
__device__ __forceinline__ void wconv(const float* W, int K, int ldw, const float* kscale, bf16_t* Wt, int ldwt, int kdst_off, int Ng, Map map, LAS float* scr, int gw, int ngw, int lane) {
    const int nblk = Ng / 32, items = (K / 64) * nblk;
    for (int it = gw; it < items; it += ngw) {
        const int kb = it / nblk, nbk = it % nblk, k0 = 64 * kb, n0 = 32 * nbk;
        const int src = map(n0 + (lane & 31));
#pragma unroll 8
        for (int i = 0; i < 32; ++i) { const int kk = 2 * i + (lane >> 5);
            float v = 0.f; if (src >= 0) { v = W[(size_t)(k0 + kk) * ldw + src]; if (kscale) v *= kscale[k0 + kk]; }
            scr[kk * 33 + (lane & 31)] = v; }
        asm volatile("s_waitcnt lgkmcnt(0)" ::: "memory");
        const int c = lane & 7;
#pragma unroll
        for (int j = 0; j < 4; ++j) { const int n = (lane >> 3) + 8 * j; const LAS float* sp = scr + (8 * c) * 33 + n;
            u32x4 o; o.x = f2bf(sp[0]) | (f2bf(sp[33]) << 16); o.y = f2bf(sp[2 * 33]) | (f2bf(sp[3 * 33]) << 16); o.z = f2bf(sp[4 * 33]) | (f2bf(sp[5 * 33]) << 16); o.w = f2bf(sp[6 * 33]) | (f2bf(sp[7 * 33]) << 16);
            *(u32x4*)(Wt + (size_t)(n0 + n) * ldwt + kdst_off + k0 + 8 * c) = o; }
        asm volatile("s_waitcnt lgkmcnt(0)" ::: "memory");
    }
}
constexpr int NIN = 13 * 256;
__device__ __forceinline__ void phase0_weights(const Params& P, int bid, int nb, LAS unsigned char* lds) {
    const int tid = tid_op(), lane = tid & 63, wave = tid >> 6;
    const int gw = bid * (NT / 64) + wave, ngw = nb * (NT / 64);
    LAS float* scr = (LAS float*)(lds + wave * 16384);
    wconv(P.w_in, DM, DIN, nullptr, (bf16_t*)(P.ws + WS_WIN), DM, 0, NIN, MapIn(), scr, gw, ngw, lane);
    wconv(P.w_ple, PLE_DIM, DM, nullptr, (bf16_t*)(P.ws + WS_WPLE), PLE_DIM, 0, DM, MapId(), scr, gw, ngw, lane);
    wconv(P.w_uq, QLORA, 768, P.qn_g, (bf16_t*)(P.ws + WS_WUQ), QLORA, 0, 768, MapUq(), scr, gw, ngw, lane);
    wconv(P.w_ukv, KVLORA, 1024, P.kvn_g, (bf16_t*)(P.ws + WS_WUKV), 256, 128, 1024, MapId(), scr, gw, ngw, lane);
    wconv(P.w_out, DM, DM, nullptr, (bf16_t*)(P.ws + WS_WOUT), DM, 0, DM, MapId(), scr, gw, ngw, lane);
    wconv(P.w_gate, DM, DM, nullptr, (bf16_t*)(P.ws + WS_WG), DM, 0, DM, MapId(), scr, gw, ngw, lane);
    u32x4* z = (u32x4*)(P.ws + WS_WUKV);
    for (int i = bid * NT + tid; i < 1024 * 16; i += nb * NT) { const int g = i >> 4, c = i & 15; z[g * 32 + c] = (u32x4){0u, 0u, 0u, 0u}; }
}

struct Epi1 {
    static constexpr bool PERM = true, AFTER_DRAIN = false;
    bf16_t *QD, *KD, *VD, *G, *CQ, *KM; float *SSQQ, *SSQKV; const float2 *CSA, *CSB;
    __device__ __forceinline__ void operator()(const f32x4 (&acc)[2][2][4][2], const pg8::Unit& u, int wr, int wc, int fr, int fq) const {
        const int pn = u.pn, b = u.pm >> 4, s0 = (u.pm & 15) * 256 + wr * 64 + fr, t0 = u.pm * 256 + wr * 64 + fr;
        if (pn < 4) {
            bf16_t* dst = pn < 2 ? QD : KD; const float sc = pn < 2 ? C2D : 1.f; const int mh = 4 * (pn & 1) + wc;
#pragma unroll
            for (int ai = 0; ai < 2; ++ai)
#pragma unroll
                for (int m = 0; m < 4; ++m) { const int ro = ai * 128 + m * 16; const f32x4* cs = (const f32x4*)(CSA + (size_t)(t0 + ro) * 32 + 8 * fq);
                    f32x4 o1[2], o2[2];
#pragma unroll
                    for (int n = 0; n < 2; ++n) { const f32x4 ca = cs[2 * n], cb = cs[2 * n + 1]; const f32x4 x1 = acc[ai][0][m][n], x2 = acc[ai][1][m][n];
                        o1[n] = (f32x4){x1[0] * ca[0] - x2[0] * ca[1], x1[1] * ca[2] - x2[1] * ca[3], x1[2] * cb[0] - x2[2] * cb[1], x1[3] * cb[2] - x2[3] * cb[3]} * sc;
                        o2[n] = (f32x4){x2[0] * ca[0] + x1[0] * ca[1], x2[1] * ca[2] + x1[1] * ca[3], x2[2] * cb[0] + x1[2] * cb[1], x2[3] * cb[2] + x1[3] * cb[3]} * sc; }
                    bf16_t* rp = dst + ((size_t)(b * 8 + mh) * SEQ + s0 + ro) * 64 + 8 * fq;
                    *(u32x4*)rp = pack8(o1[0], o1[1]); *(u32x4*)(rp + 32) = pack8(o2[0], o2[1]); asm volatile("" ::: "memory"); }
        } else if (pn < 6) {
#pragma unroll
            for (int ai = 0; ai < 2; ++ai)
#pragma unroll
                for (int m = 0; m < 4; ++m)
#pragma unroll
                    for (int bj = 0; bj < 2; ++bj) { const int ro = ai * 128 + m * 16, h = 2 * (pn - 4) + bj;
                        *(u32x4*)(VD + ((size_t)(b * 4 + h) * SEQ + s0 + ro) * 128 + 32 * wc + 8 * fq) = pack8(acc[ai][bj][m][0], acc[ai][bj][m][1]); }
        } else if (pn < 8 || pn == 10 || pn == 11) {
            const int cb = (pn < 8 ? (pn - 6) * 256 : 512 + (pn - 10) * 256) + 32 * wc + 8 * fq;
#pragma unroll
            for (int ai = 0; ai < 2; ++ai)
#pragma unroll
                for (int m = 0; m < 4; ++m)
#pragma unroll
                    for (int bj = 0; bj < 2; ++bj) { const int ro = ai * 128 + m * 16; f32x4 a = acc[ai][bj][m][0], c = acc[ai][bj][m][1];
#pragma unroll
                        for (int j = 0; j < 4; ++j) { a[j] = silu_f(a[j]); c[j] = silu_f(c[j]); }
                        *(u32x4*)(G + (size_t)(t0 + ro) * 1024 + cb + 128 * bj) = pack8(a, c); }
        } else if (pn < 10) {
#pragma unroll
            for (int ai = 0; ai < 2; ++ai)
#pragma unroll
                for (int m = 0; m < 4; ++m) { const int ro = ai * 128 + m * 16; float ss[2];
#pragma unroll
                    for (int bj = 0; bj < 2; ++bj) { const f32x4 a = acc[ai][bj][m][0], c = acc[ai][bj][m][1];
                        *(u32x4*)(CQ + (size_t)(t0 + ro) * CQP + (pn - 8) * 256 + 128 * bj + 32 * wc + 8 * fq) = pack8(a, c);
                        float q = (a[0] * a[0] + a[1] * a[1]) + (a[2] * a[2] + a[3] * a[3]) + (c[0] * c[0] + c[1] * c[1]) + (c[2] * c[2] + c[3] * c[3]);
                        q += __shfl_xor(q, 16); q += __shfl_xor(q, 32); ss[bj] = q; }
                    if (fq == 0) { if (pn == 8) atomicAdd(SSQQ + t0 + ro, ss[0] + ss[1]); else { atomicAdd(SSQQ + t0 + ro, ss[0]); atomicAdd(SSQKV + t0 + ro, ss[1]); } } }
        } else {
            if (wc == 0 && fq < 2) {
#pragma unroll
                for (int ai = 0; ai < 2; ++ai)
#pragma unroll
                    for (int m = 0; m < 4; ++m) { const int ro = ai * 128 + m * 16; const f32x4* cs = (const f32x4*)(CSB + (size_t)(t0 + ro) * 16 + 8 * fq);
                        f32x4 o1[2], o2[2];
#pragma unroll
                        for (int n = 0; n < 2; ++n) { const f32x4 ca = cs[2 * n], cb = cs[2 * n + 1]; const f32x4 x1 = acc[ai][0][m][n], x2 = acc[ai][1][m][n];
                            o1[n] = (f32x4){x1[0] * ca[0] - x2[0] * ca[1], x1[1] * ca[2] - x2[1] * ca[3], x1[2] * cb[0] - x2[2] * cb[1], x1[3] * cb[2] - x2[3] * cb[3]};
                            o2[n] = (f32x4){x2[0] * ca[0] + x1[0] * ca[1], x2[1] * ca[2] + x1[1] * ca[3], x2[2] * cb[0] + x1[2] * cb[1], x2[3] * cb[2] + x1[3] * cb[3]}; }
                        const u32x4 w1 = pack8(o1[0], o1[1]), w2 = pack8(o2[0], o2[1]);
#pragma unroll
                        for (int h = 0; h < 8; ++h) { bf16_t* rp = KM + ((size_t)(b * 8 + h) * SEQ + s0 + ro) * 96 + 64 + 8 * fq; *(u32x4*)rp = w1; *(u32x4*)(rp + 16) = w2; } }
            }
        }
    }
};
struct EpiStore {
    static constexpr bool PERM = true, AFTER_DRAIN = false;
    bf16_t* O; int ldc;
    __device__ __forceinline__ void operator()(const f32x4 (&acc)[2][2][4][2], const pg8::Unit& u, int wr, int wc, int fr, int fq) const {
        const int t0 = u.pm * 256 + wr * 64 + fr, c0 = u.pn * 256 + 32 * wc + 8 * fq;
#pragma unroll
        for (int ai = 0; ai < 2; ++ai)
#pragma unroll
            for (int m = 0; m < 4; ++m)
#pragma unroll
                for (int bj = 0; bj < 2; ++bj) *(u32x4*)(O + (size_t)(t0 + ai * 128 + m * 16) * ldc + c0 + 128 * bj) = pack8(acc[ai][bj][m][0], acc[ai][bj][m][1]);
    }
};
struct EpiQ {
    static constexpr bool PERM = true, AFTER_DRAIN = false;
    bf16_t* QM; const float* SSQQ; const float2* CSB;
    __device__ __forceinline__ void operator()(const f32x4 (&acc)[2][2][4][2], const pg8::Unit& u, int wr, int wc, int fr, int fq) const {
        const int pn = u.pn, b = u.pm >> 4, s0 = (u.pm & 15) * 256 + wr * 64 + fr, t0 = u.pm * 256 + wr * 64 + fr;
#pragma unroll
        for (int ai = 0; ai < 2; ++ai)
#pragma unroll
            for (int m = 0; m < 4; ++m) { const int ro = ai * 128 + m * 16; const float sc = C2M * __builtin_amdgcn_rsqf(SSQQ[t0 + ro] * (1.f / QLORA) + RMS_EPS);
                if (pn == 0) { const int h = 2 * wc + (fq >> 1), i0 = 8 * (fq & 1); const f32x4* cs = (const f32x4*)(CSB + (size_t)(t0 + ro) * 16 + i0);
                    f32x4 o1[2], o2[2];
#pragma unroll
                    for (int n = 0; n < 2; ++n) { const f32x4 ca = cs[2 * n], cb = cs[2 * n + 1]; const f32x4 x1 = acc[ai][0][m][n], x2 = acc[ai][1][m][n];
                        o1[n] = (f32x4){x1[0] * ca[0] - x2[0] * ca[1], x1[1] * ca[2] - x2[1] * ca[3], x1[2] * cb[0] - x2[2] * cb[1], x1[3] * cb[2] - x2[3] * cb[3]} * sc;
                        o2[n] = (f32x4){x2[0] * ca[0] + x1[0] * ca[1], x2[1] * ca[2] + x1[1] * ca[3], x2[2] * cb[0] + x1[2] * cb[1], x2[3] * cb[2] + x1[3] * cb[3]} * sc; }
                    bf16_t* rp = QM + ((size_t)(b * 8 + h) * SEQ + s0 + ro) * 96 + 64 + i0;
                    *(u32x4*)rp = pack8(o1[0], o1[1]); *(u32x4*)(rp + 16) = pack8(o2[0], o2[1]);
                } else {
#pragma unroll
                    for (int bj = 0; bj < 2; ++bj) { const int h = 4 * (pn - 1) + 2 * bj + (wc >> 1), d = 32 * (wc & 1) + 8 * fq;
                        *(u32x4*)(QM + ((size_t)(b * 8 + h) * SEQ + s0 + ro) * 96 + d) = pack8(acc[ai][bj][m][0] * sc, acc[ai][bj][m][1] * sc); } }
                asm volatile("" ::: "memory");
            }
    }
};
struct EpiKV {
    static constexpr bool PERM = true, AFTER_DRAIN = false;
    bf16_t *KM, *VM; const float* SSQKV;
    __device__ __forceinline__ void operator()(const f32x4 (&acc)[2][2][4][2], const pg8::Unit& u, int wr, int wc, int fr, int fq) const {
        const int pn = u.pn, b = u.pm >> 4, s0 = (u.pm & 15) * 256 + wr * 64 + fr, t0 = u.pm * 256 + wr * 64 + fr;
#pragma unroll
        for (int ai = 0; ai < 2; ++ai)
#pragma unroll
            for (int m = 0; m < 4; ++m) { const int ro = ai * 128 + m * 16; const float sc = __builtin_amdgcn_rsqf(SSQKV[t0 + ro] * (1.f / KVLORA) + RMS_EPS);
#pragma unroll
                for (int bj = 0; bj < 2; ++bj) { const int h = 2 * pn + bj; const size_t rowi = (size_t)(b * 8 + h) * SEQ + s0 + ro;
                    bf16_t* rp = (wc < 2) ? KM + rowi * 96 + 32 * wc + 8 * fq : VM + rowi * 64 + 32 * (wc - 2) + 8 * fq;
                    *(u32x4*)rp = pack8(acc[ai][bj][m][0] * sc, acc[ai][bj][m][1] * sc); }
                asm volatile("" ::: "memory"); }
    }
};
struct Epi3 {
    static constexpr bool PERM = true, AFTER_DRAIN = false;
    const float* x; float* out; bf16_t* HB;
    __device__ __forceinline__ void operator()(const f32x4 (&acc)[2][2][4][2], const pg8::Unit& u, int wr, int wc, int fr, int fq) const {
        const int t0 = u.pm * 256 + wr * 64 + fr, c0 = u.pn * 256 + 32 * wc + 8 * fq;
#pragma unroll
        for (int ai = 0; ai < 2; ++ai)
#pragma unroll
            for (int m = 0; m < 4; ++m) {
#pragma unroll
                for (int bj = 0; bj < 2; ++bj) { const size_t idx = (size_t)(t0 + ai * 128 + m * 16) * DM + c0 + 128 * bj;
                    const f32x4 h0 = *(const f32x4*)(x + idx) + acc[ai][bj][m][0], h1 = *(const f32x4*)(x + idx + 4) + acc[ai][bj][m][1];
                    *(f32x4*)(out + idx) = h0; *(f32x4*)(out + idx + 4) = h1; *(u32x4*)(HB + idx) = pack8(h0, h1); }
                asm volatile("" ::: "memory"); }
    }
};
struct Epi4 {
    static constexpr bool PERM = true, AFTER_DRAIN = false;
    float* out; const bf16_t* PLE; float* SSQF;
    __device__ __forceinline__ void operator()(const f32x4 (&acc)[2][2][4][2], const pg8::Unit& u, int wr, int wc, int fr, int fq) const {
        const int t0 = u.pm * 256 + wr * 64 + fr, c0 = u.pn * 256 + 32 * wc + 8 * fq;
#pragma unroll
        for (int ai = 0; ai < 2; ++ai)
#pragma unroll
            for (int m = 0; m < 4; ++m) { float q = 0.f;
#pragma unroll
                for (int bj = 0; bj < 2; ++bj) { const size_t idx = (size_t)(t0 + ai * 128 + m * 16) * DM + c0 + 128 * bj;
                    const u32x4 pw = *(const u32x4*)(PLE + idx); f32x4 h0 = *(const f32x4*)(out + idx), h1 = *(const f32x4*)(out + idx + 4);
                    const f32x4 a = acc[ai][bj][m][0], c = acc[ai][bj][m][1];
                    h0[0] += __uint_as_float(pw.x << 16) * sigmoid_f(a[0]); h0[1] += __uint_as_float(pw.x & 0xffff0000u) * sigmoid_f(a[1]);
                    h0[2] += __uint_as_float(pw.y << 16) * sigmoid_f(a[2]); h0[3] += __uint_as_float(pw.y & 0xffff0000u) * sigmoid_f(a[3]);
                    h1[0] += __uint_as_float(pw.z << 16) * sigmoid_f(c[0]); h1[1] += __uint_as_float(pw.z & 0xffff0000u) * sigmoid_f(c[1]);
                    h1[2] += __uint_as_float(pw.w << 16) * sigmoid_f(c[2]); h1[3] += __uint_as_float(pw.w & 0xffff0000u) * sigmoid_f(c[3]);
                    *(f32x4*)(out + idx) = h0; *(f32x4*)(out + idx + 4) = h1;
                    q += (h0[0] * h0[0] + h0[1] * h0[1]) + (h0[2] * h0[2] + h0[3] * h0[3]) + (h1[0] * h1[0] + h1[1] * h1[1]) + (h1[2] * h1[2] + h1[3] * h1[3]); }
                q += __shfl_xor(q, 16); q += __shfl_xor(q, 32);
                if (fq == 0) atomicAdd(SSQF + t0 + ai * 128 + m * 16, q);
                asm volatile("" ::: "memory"); }
    }
};

#ifndef PG8_SP2
#define PG8_SP2 true
#endif
#ifndef PG8_ALIGN
#define PG8_ALIGN true
#endif
__device__ __forceinline__ void phase1_gemm(const Params& P, LAS unsigned char* lds) {
    pg8::Gemm g{(const bf16_t*)(P.ws + WS_XN), (const bf16_t*)(P.ws + WS_WIN), T, NIN, DM, DM}; pg8::StaticOrder S; S.init(T, NIN, (int)gridDim.x, (int)blockIdx.x);
    Epi1 E{(bf16_t*)(P.ws + WS_QD), (bf16_t*)(P.ws + WS_KD), (bf16_t*)(P.ws + WS_VD), (bf16_t*)(P.ws + WS_G), (bf16_t*)(P.ws + WS_CQ), (bf16_t*)(P.ws + WS_KM),
           (float*)(P.ws + WS_SSQQ), (float*)(P.ws + WS_SSQKV), (const float2*)(P.ws + WS_CSA), (const float2*)(P.ws + WS_CSB)};
    pg8::gemm_phase<Epi1, pg8::StaticOrder, PG8_ALIGN, PG8_SP2>(lds, g, S, E);
}
__device__ __forceinline__ void phase15_gemm(const Params& P, LAS unsigned char* lds) {
    { pg8::Gemm g{(const bf16_t*)(P.ws + WS_CQ), (const bf16_t*)(P.ws + WS_WUQ), T, 768, QLORA, CQP}; pg8::StaticOrder S; S.init(T, 768, (int)gridDim.x, (int)blockIdx.x);
      EpiQ E{(bf16_t*)(P.ws + WS_QM), (const float*)(P.ws + WS_SSQQ), (const float2*)(P.ws + WS_CSB)};
      pg8::gemm_phase<EpiQ, pg8::StaticOrder, PG8_ALIGN, PG8_SP2>(lds, g, S, E); }
    { pg8::Gemm g{(const bf16_t*)(P.ws + WS_CQ) + 256, (const bf16_t*)(P.ws + WS_WUKV), T, 1024, 256, CQP}; pg8::StaticOrder S; S.init(T, 1024, (int)gridDim.x, (int)blockIdx.x);
      EpiKV E{(bf16_t*)(P.ws + WS_KM), (bf16_t*)(P.ws + WS_VM), (const float*)(P.ws + WS_SSQKV)};
      pg8::gemm_phase<EpiKV, pg8::StaticOrder, PG8_ALIGN, PG8_SP2>(lds, g, S, E); }
}
__device__ __forceinline__ void phase3_gemm(const Params& P, LAS unsigned char* lds) {
    { pg8::Gemm g{(const bf16_t*)(P.ws + WS_YCAT), (const bf16_t*)(P.ws + WS_WOUT), T, DM, DM, DM}; pg8::StaticOrder S; S.init(T, DM, (int)gridDim.x, (int)blockIdx.x);
      Epi3 E{P.x, P.out, (bf16_t*)(P.ws + WS_HB)};
      pg8::gemm_phase<Epi3, pg8::StaticOrder, PG8_ALIGN, PG8_SP2>(lds, g, S, E); }
    { pg8::Gemm g{(const bf16_t*)(P.ws + WS_PB), (const bf16_t*)(P.ws + WS_WPLE), T, DM, PLE_DIM, PLE_DIM}; pg8::StaticOrder S; S.init(T, DM, (int)gridDim.x, (int)blockIdx.x);
      EpiStore E{(bf16_t*)(P.ws + WS_PLE), DM};
      pg8::gemm_phase<EpiStore, pg8::StaticOrder, PG8_ALIGN, PG8_SP2>(lds, g, S, E); }
}
__device__ __forceinline__ void phase4_gemm(const Params& P, LAS unsigned char* lds) {
    pg8::Gemm g{(const bf16_t*)(P.ws + WS_HB), (const bf16_t*)(P.ws + WS_WG), T, DM, DM, DM}; pg8::StaticOrder S; S.init(T, DM, (int)gridDim.x, (int)blockIdx.x);
    Epi4 E{P.out, (const bf16_t*)(P.ws + WS_PLE), (float*)(P.ws + WS_SSQF)};
    pg8::gemm_phase<Epi4, pg8::StaticOrder, PG8_ALIGN, PG8_SP2>(lds, g, S, E);
}

#ifndef OPT_P1
#define OPT_P1 1
#endif
#ifndef OPT_P15
#define OPT_P15 1
#endif
#ifndef OPT_P3
#define OPT_P3 1
#endif
#ifndef OPT_P4
#define OPT_P4 1
#endif
constexpr int LDS_BYTES = 147456;
__global__ void __launch_bounds__(NT, 2) fwd_megakernel(Params P) {
    extern __shared__ __attribute__((aligned(16))) unsigned char lds_raw[];
    LAS unsigned char* lds = (LAS unsigned char*)lds_raw;
    float* smem = (float*)lds_raw;
    cg::grid_group grid = cg::this_grid();
    const int bid = blockIdx.x, nb = gridDim.x;
    phase0(P, bid, nb);
    phase0_weights(P, bid, nb, lds);
    grid.sync();
#if OPT_P1
    phase1_gemm(P, lds);
#else
    phase1_naive(P, bid, nb, smem);
#endif
    grid.sync();
#if OPT_P15
    phase15_gemm(P, lds);
#else
    phase15_naive(P, bid, nb, smem);
#endif
    grid.sync();
    phase2_naive(P, bid, nb, smem);
    grid.sync();
    phase25_naive(P, bid, nb);
    grid.sync();
#if OPT_P3
    phase3_gemm(P, lds);
#else
    phase3_naive(P, bid, nb, smem);
#endif
    grid.sync();
#if OPT_P4
    phase4_gemm(P, lds);
#else
    phase4_naive(P, bid, nb, smem);
#endif
    grid.sync();
    phase5(P, bid, nb);
}

extern "C" void kernel_launch(void* const* d_in, const int* in_sizes, int n_in, void* d_out, int out_size, void* d_ws, size_t ws_size, hipStream_t stream) {
    if (n_in != 15 || out_size != T * DM || ws_size < WS_END) { fprintf(stderr, "kernel_launch: unexpected shapes (n_in %d out %d ws %zu)\n", n_in, out_size, ws_size); return; }
    static int grid_blocks = 0;
    if (!grid_blocks) {
        int dev = 0, cus = 0, per_cu = 0;
        (void)hipGetDevice(&dev);
        (void)hipDeviceGetAttribute(&cus, hipDeviceAttributeMultiprocessorCount, dev);
        if (hipFuncSetAttribute((const void*)fwd_megakernel, hipFuncAttributeMaxDynamicSharedMemorySize, LDS_BYTES) != hipSuccess) { fprintf(stderr, "kernel_launch: hipFuncSetAttribute failed\n"); return; }
        if (hipOccupancyMaxActiveBlocksPerMultiprocessor(&per_cu, (const void*)fwd_megakernel, NT, LDS_BYTES) != hipSuccess || per_cu < 1) { fprintf(stderr, "kernel_launch: occupancy query says %d blocks/CU\n", per_cu); return; }
        grid_blocks = cus;
    }
    Params P{};
    P.x = (const float*)d_in[0]; P.p = (const float*)d_in[1]; P.pos = (const int*)d_in[2]; P.norm_g = (const float*)d_in[3]; P.w_in = (const float*)d_in[4];
    P.diff_lambda = (const float*)d_in[5]; P.subln_g = (const float*)d_in[6]; P.qn_g = (const float*)d_in[7]; P.w_uq = (const float*)d_in[8]; P.kvn_g = (const float*)d_in[9];
    P.w_ukv = (const float*)d_in[10]; P.w_out = (const float*)d_in[11]; P.w_ple = (const float*)d_in[12]; P.w_gate = (const float*)d_in[13]; P.final_g = (const float*)d_in[14];
    P.out = (float*)d_out; P.ws = (unsigned char*)d_ws;
    void* args[] = {&P};
    hipError_t e = hipLaunchCooperativeKernel((void*)fwd_megakernel, dim3(grid_blocks), dim3(NT), args, LDS_BYTES, stream);
    if (e != hipSuccess) fprintf(stderr, "cooperative launch failed: %s (grid %d)\n", hipGetErrorString(e), grid_blocks);
}
```

```cpp
#include <hip/hip_runtime.h>
#include <hip/hip_cooperative_groups.h>
#include <cstdio>
#include <cstdint>

namespace cg = cooperative_groups;
typedef unsigned short bf16_t;

constexpr int BATCH = 8, SEQ = 4096, T = BATCH * SEQ, DM = 1024, DIN = 3104, PLE_DIM = 256;
constexpr int OFF_DQ = 0, OFF_DK = 512, OFF_DV = 1024, OFF_DG = 1536, OFF_CQ = 2048, OFF_CKV = 2432, OFF_KR = 2560, OFF_MG = 2592;
constexpr int QLORA = 384, KVLORA = 128, CQP = 512;
constexpr float RMS_EPS = 1e-6f;
constexpr float LOG2E = 1.4426950408889634f;
constexpr float C2D = 0.125f * LOG2E;
constexpr float C2M = 0.10206207261596575f * LOG2E;
constexpr float LAM_INIT = 0.2f;
constexpr int NT = 512;

constexpr size_t MiB = 1u << 20;
constexpr size_t WS_CTL = 0;
constexpr size_t WS_MISC = 1 * MiB;
constexpr size_t WS_SSQQ = 1 * MiB + 65536, WS_SSQKV = WS_SSQQ + 131072, WS_SSQF = WS_SSQKV + 131072;
constexpr size_t WS_CSA = 2 * MiB, WS_CSB = 10 * MiB;
constexpr size_t WS_WIN = 14 * MiB, WS_WPLE = 21 * MiB, WS_WUQ = 22 * MiB, WS_WUKV = 23 * MiB, WS_WOUT = 24 * MiB, WS_WG = 26 * MiB;
constexpr size_t WS_PB = 28 * MiB, WS_CQ = 44 * MiB  , WS_XN = 76 * MiB, WS_OD = WS_XN;
constexpr size_t WS_QD = 140 * MiB, WS_KD = 172 * MiB, WS_PLE = WS_QD, WS_VD = 204 * MiB, WS_G = 236 * MiB, WS_HB = WS_G;
constexpr size_t WS_QM = 300 * MiB, WS_KM = 348 * MiB, WS_VM = 396 * MiB, WS_YCAT = 428 * MiB, WS_END = 492 * MiB;

struct Params {
    const float* x; const float* p; const int* pos; const float* norm_g; const float* w_in; const float* diff_lambda;
    const float* subln_g; const float* qn_g; const float* w_uq; const float* kvn_g; const float* w_ukv; const float* w_out;
    const float* w_ple; const float* w_gate; const float* final_g; float* out; unsigned char* ws;
};

__device__ __forceinline__ unsigned f2bf(float f) { unsigned u = __float_as_uint(f); return (u + 0x7fffu + ((u >> 16) & 1u)) >> 16; }
__device__ __forceinline__ float bf2f(bf16_t h) { return __uint_as_float(((unsigned)h) << 16); }
__device__ __forceinline__ float wave_sum(float v) {
#pragma unroll
    for (int o = 1; o < 64; o <<= 1) v += __shfl_xor(v, o);
    return v;
}
__device__ __forceinline__ int tid_op() { int t = threadIdx.x; asm volatile("" : "+v"(t)); return t; }
__device__ __forceinline__ int sgpr_op(int v) { asm volatile("" : "+s"(v)); return v; }
__device__ __forceinline__ float silu_f(float v) { return v / (1.f + __expf(-v)); }
__device__ __forceinline__ float sigmoid_f(float v) { return 1.f / (1.f + __expf(-v)); }

__device__ __forceinline__ void phase0(const Params& P, int bid, int nb) {
    bid = sgpr_op(bid); nb = sgpr_op(nb);
    const int tid = tid_op(), lane = tid & 63, wave = tid >> 6;
    const int gw = bid * (NT / 64) + wave, ngw = nb * (NT / 64);
    const int gt = bid * NT + tid, ngt = nb * NT;
    bf16_t* XN = (bf16_t*)(P.ws + WS_XN);
    for (int t = gw; t < T; t += ngw) {
        const float4* xr = (const float4*)(P.x + (size_t)t * DM);
        float4 v[4]; float s = 0.f;
#pragma unroll
        for (int j = 0; j < 4; ++j) { v[j] = xr[lane + 64 * j]; s += v[j].x * v[j].x + v[j].y * v[j].y + v[j].z * v[j].z + v[j].w * v[j].w; }
        s = wave_sum(s);
        const float rstd = 1.0f / sqrtf(s * (1.f / DM) + RMS_EPS);
#pragma unroll
        for (int j = 0; j < 4; ++j) {
            const float4 g = ((const float4*)P.norm_g)[lane + 64 * j];
            uint2 o; o.x = f2bf(v[j].x * rstd * g.x) | (f2bf(v[j].y * rstd * g.y) << 16); o.y = f2bf(v[j].z * rstd * g.z) | (f2bf(v[j].w * rstd * g.w) << 16);
            ((uint2*)(XN + (size_t)t * DM))[lane + 64 * j] = o;
        }
    }
    bf16_t* PB = (bf16_t*)(P.ws + WS_PB);
    for (int i = gt; i < T * PLE_DIM / 4; i += ngt) {
        const float4 v = ((const float4*)P.p)[i];
        uint2 o; o.x = f2bf(v.x) | (f2bf(v.y) << 16); o.y = f2bf(v.z) | (f2bf(v.w) << 16);
        ((uint2*)PB)[i] = o;
    }
    float2* CSA = (float2*)(P.ws + WS_CSA); float2* CSB = (float2*)(P.ws + WS_CSB);
    for (int i = gt; i < T * 32; i += ngt) {
        const int t = i >> 5, k = i & 31;
        const double inv = pow(10000.0, -(double)k / 32.0);
        const double ang = (double)P.pos[t] * inv;
        double sn, cs; sincos(ang, &sn, &cs);
        CSA[i] = make_float2((float)cs, (float)sn);
    }
    for (int i = gt; i < T * 16; i += ngt) {
        const int t = i >> 4, k = i & 15;
        const double inv = pow(10000.0, -(double)k / 16.0);
        const double ang = (double)P.pos[t] * inv;
        double sn, cs; sincos(ang, &sn, &cs);
        CSB[i] = make_float2((float)cs, (float)sn);
    }
    float* ssq = (float*)(P.ws + WS_SSQQ);
    for (int i = gt; i < 3 * T; i += ngt) ssq[i] = 0.f;
    if (bid == 0 && tid == 0) {
        float s1 = 0.f, s2 = 0.f;
        for (int i = 0; i < 64; ++i) { s1 += P.diff_lambda[i] * P.diff_lambda[64 + i]; s2 += P.diff_lambda[128 + i] * P.diff_lambda[192 + i]; }
        ((float*)(P.ws + WS_MISC))[0] = expf(s1) - expf(s2) + LAM_INIT;
    }
}

constexpr int NG_SMEM_FLOATS = 16 * 129 + 16 * 65 + 128 * 65;
__device__ __forceinline__ void ngemm_tile(const bf16_t* A, int lda, int row0, const float* W, int ldw, int col0, int ncol, int K, const float* kscale, float* smem) {
    float* As = smem; float* Bs = smem + 16 * 129; float* Cs = Bs + 16 * 65;
    const int tid = tid_op(), ty = tid >> 4, tx = tid & 15;
    float acc[4][4];
#pragma unroll
    for (int i = 0; i < 4; ++i)
#pragma unroll
        for (int j = 0; j < 4; ++j) acc[i][j] = 0.f;
#pragma unroll 1
    for (int k0 = 0; k0 < K; k0 += 16) {
        __syncthreads();
#pragma unroll
        for (int i = 0; i < 4; ++i) { const int idx = tid + i * NT, r = idx >> 4, kk = idx & 15; As[kk * 129 + r] = bf2f(A[(size_t)(row0 + r) * lda + k0 + kk]); }
#pragma unroll
        for (int i = 0; i < 2; ++i) { const int idx = tid + i * NT, kk = idx >> 6, c = idx & 63;
            float w = 0.f; if (c < ncol) { w = W[(size_t)(k0 + kk) * ldw + col0 + c]; if (kscale) w *= kscale[k0 + kk]; }
            Bs[kk * 65 + c] = w; }
        __syncthreads();
#pragma unroll
        for (int kk = 0; kk < 16; ++kk) {
            float a[4], b[4];
#pragma unroll
            for (int i = 0; i < 4; ++i) a[i] = As[kk * 129 + ty * 4 + i];
#pragma unroll
            for (int j = 0; j < 4; ++j) b[j] = Bs[kk * 65 + tx * 4 + j];
#pragma unroll
            for (int i = 0; i < 4; ++i)
#pragma unroll
                for (int j = 0; j < 4; ++j) acc[i][j] += a[i] * b[j];
        }
    }
    __syncthreads();
#pragma unroll
    for (int i = 0; i < 4; ++i)
#pragma unroll
        for (int j = 0; j < 4; ++j) Cs[(ty * 4 + i) * 65 + tx * 4 + j] = acc[i][j];
    __syncthreads();
}

__device__ __forceinline__ void phase1_naive(const Params& P, int bid, int nb, float* smem) {
    bid = sgpr_op(bid); nb = sgpr_op(nb);
    const int tid = tid_op();
    const bf16_t* XN = (const bf16_t*)(P.ws + WS_XN);
    bf16_t* QD = (bf16_t*)(P.ws + WS_QD); bf16_t* KD = (bf16_t*)(P.ws + WS_KD); bf16_t* VD = (bf16_t*)(P.ws + WS_VD); bf16_t* G = (bf16_t*)(P.ws + WS_G);
    bf16_t* CQ = (bf16_t*)(P.ws + WS_CQ); bf16_t* KM = (bf16_t*)(P.ws + WS_KM);
    float* SSQQ = (float*)(P.ws + WS_SSQQ); float* SSQKV = (float*)(P.ws + WS_SSQKV);
    const float2* CSA = (const float2*)(P.ws + WS_CSA); const float2* CSB = (const float2*)(P.ws + WS_CSB);
    float* Cs = smem + 16 * 129 + 16 * 65;
    constexpr int NCT = 49, NRT = T / 128;
    for (int item = bid; item < NCT * NRT; item += nb) {
        const int ct = item % NCT, rt = item / NCT, row0 = rt * 128;
        int col0, ncol = 64;
        if (ct < 40) col0 = ct * 64; else if (ct == 40) { col0 = OFF_KR; ncol = 32; } else col0 = OFF_MG + (ct - 41) * 64;
        ngemm_tile(XN, DM, row0, P.w_in, DIN, col0, ncol, DM, nullptr, smem);
        _Pragma("unroll 1") for (int e = tid; e < 128 * 64; e += NT) {
            const int r = e >> 6, c = e & 63, t = row0 + r, b = t / SEQ, s = t % SEQ;
            const float v = Cs[r * 65 + c];
            if (col0 < OFF_DV) {
                const int i = c & 31; const float x1 = Cs[r * 65 + i], x2 = Cs[r * 65 + i + 32]; const float2 cs = CSA[(size_t)t * 32 + i];
                const float o = (c < 32) ? (x1 * cs.x - x2 * cs.y) : (x2 * cs.x + x1 * cs.y);
                if (col0 < OFF_DK) { const int mh = col0 / 64; QD[((size_t)(b * 8 + mh) * SEQ + s) * 64 + c] = (bf16_t)f2bf(o * C2D); }
                else { const int mh = (col0 - OFF_DK) / 64; KD[((size_t)(b * 8 + mh) * SEQ + s) * 64 + c] = (bf16_t)f2bf(o); }
            } else if (col0 < OFF_DG) { const int col = col0 - OFF_DV + c, h = col >> 7, d = col & 127; VD[((size_t)(b * 4 + h) * SEQ + s) * 128 + d] = (bf16_t)f2bf(v); }
            else if (col0 < OFF_CQ) { const int col = col0 - OFF_DG + c; G[(size_t)t * 1024 + col] = (bf16_t)f2bf(silu_f(v)); }
            else if (col0 < OFF_CKV) { const int col = col0 - OFF_CQ + c; CQ[(size_t)t * CQP + col] = (bf16_t)f2bf(v); }
            else if (col0 < OFF_KR) { const int col = col0 - OFF_CKV + c; CQ[(size_t)t * CQP + QLORA + col] = (bf16_t)f2bf(v); }
            else if (col0 == OFF_KR) { if (c < 32) { const int i = c & 15; const float x1 = Cs[r * 65 + i], x2 = Cs[r * 65 + i + 16]; const float2 cs = CSB[(size_t)t * 16 + i];
                    const float o = (c < 16) ? (x1 * cs.x - x2 * cs.y) : (x2 * cs.x + x1 * cs.y);
                    for (int h = 0; h < 8; ++h) KM[((size_t)(b * 8 + h) * SEQ + s) * 96 + 64 + c] = (bf16_t)f2bf(o); } }
            else { const int col = col0 - OFF_MG + c; G[(size_t)t * 1024 + 512 + col] = (bf16_t)f2bf(silu_f(v)); }
        }
        if (col0 >= OFF_CQ && col0 < OFF_KR && tid < 128) {
            float s = 0.f; _Pragma("unroll 4") for (int c = 0; c < 64; ++c) { const float v = Cs[tid * 65 + c]; s += v * v; }
            atomicAdd((col0 < OFF_CKV ? SSQQ : SSQKV) + row0 + tid, s);
        }
    }
}

__device__ __forceinline__ void phase15_naive(const Params& P, int bid, int nb, float* smem) {
    bid = sgpr_op(bid); nb = sgpr_op(nb);
    const int tid = tid_op();
    const bf16_t* CQ = (const bf16_t*)(P.ws + WS_CQ); const bf16_t* CKV = CQ + QLORA;
    bf16_t* QM = (bf16_t*)(P.ws + WS_QM); bf16_t* KM = (bf16_t*)(P.ws + WS_KM); bf16_t* VM = (bf16_t*)(P.ws + WS_VM);
    const float* SSQQ = (const float*)(P.ws + WS_SSQQ); const float* SSQKV = (const float*)(P.ws + WS_SSQKV);
    const float2* CSB = (const float2*)(P.ws + WS_CSB);
    float* Cs = smem + 16 * 129 + 16 * 65;
    constexpr int NCT = 12 + 16, NRT = T / 128;
    for (int item = bid; item < NCT * NRT; item += nb) {
        const int ct = item % NCT, rt = item / NCT, row0 = rt * 128;
        if (ct < 12) {
            const int col0 = ct * 64;
            ngemm_tile(CQ, CQP, row0, P.w_uq, 768, col0, 64, QLORA, P.qn_g, smem);
            _Pragma("unroll 1") for (int e = tid; e < 128 * 64; e += NT) {
                const int r = e >> 6, c = e & 63, t = row0 + r, b = t / SEQ, s = t % SEQ, col = col0 + c, h = col / 96, j = col % 96;
                const float rstd = 1.0f / sqrtf(SSQQ[t] * (1.f / QLORA) + RMS_EPS);
                float o;
                if (j < 64) o = Cs[r * 65 + c];
                else { const int jj = j - 64, i = jj & 15, cb = c - jj; const float x1 = Cs[r * 65 + cb + i], x2 = Cs[r * 65 + cb + i + 16]; const float2 cs = CSB[(size_t)t * 16 + i];
                    o = (jj < 16) ? (x1 * cs.x - x2 * cs.y) : (x2 * cs.x + x1 * cs.y); }
                QM[((size_t)(b * 8 + h) * SEQ + s) * 96 + j] = (bf16_t)f2bf(o * rstd * C2M);
            }
        } else {
            const int col0 = (ct - 12) * 64;
            ngemm_tile(CKV, CQP, row0, P.w_ukv, 1024, col0, 64, KVLORA, P.kvn_g, smem);
            _Pragma("unroll 1") for (int e = tid; e < 128 * 64; e += NT) {
                const int r = e >> 6, c = e & 63, t = row0 + r, b = t / SEQ, s = t % SEQ, col = col0 + c, h = col >> 7, j = col & 127;
                const float rstd = 1.0f / sqrtf(SSQKV[t] * (1.f / KVLORA) + RMS_EPS);
                const float o = Cs[r * 65 + c] * rstd;
                if (j < 64) KM[((size_t)(b * 8 + h) * SEQ + s) * 96 + j] = (bf16_t)f2bf(o);
                else VM[((size_t)(b * 8 + h) * SEQ + s) * 64 + j - 64] = (bf16_t)f2bf(o);
            }
        }
    }
}

template <int DQK, int DV, int DVS>
__device__ __forceinline__ void nattn_rows(const bf16_t* Qh, const bf16_t* Kh, const bf16_t* Vh, int q0, float* o, float& l_out, unsigned* smem) {
    const int tid = tid_op(), i = q0 + tid;
    unsigned* Ks = smem; unsigned* Vs = smem + 32 * (DQK / 2);
    unsigned q2[DQK / 2];
#pragma unroll
    for (int d = 0; d < DQK / 2; ++d) q2[d] = ((const unsigned*)(Qh + (size_t)i * DQK))[d];
#pragma unroll
    for (int d = 0; d < DV; ++d) o[d] = 0.f;
    float m = -1e30f, l = 0.f;
    const int jend = q0 + NT;
#pragma unroll 1
    for (int j0 = 0; j0 < jend; j0 += 32) {
        __syncthreads();
        for (int idx = tid; idx < 32 * (DQK / 2); idx += NT) Ks[idx] = ((const unsigned*)(Kh + (size_t)j0 * DQK))[idx];
        for (int idx = tid; idx < 32 * (DV / 2); idx += NT) { const int r = idx / (DV / 2), c = idx % (DV / 2); Vs[idx] = ((const unsigned*)(Vh + (size_t)(j0 + r) * DVS))[c]; }
        __syncthreads();
#pragma unroll 1
        for (int jj = 0; jj < 32; jj += 2) {
            float sc[2];
#pragma unroll
            for (int k = 0; k < 2; ++k) {
                const unsigned* kr = Ks + (jj + k) * (DQK / 2); float s = 0.f;
#pragma unroll
                for (int d = 0; d < DQK / 2; ++d) { const unsigned kk = kr[d]; unsigned qq = q2[d]; asm volatile("" : "+v"(qq));
                    s += __uint_as_float(qq << 16) * __uint_as_float(kk << 16); s += __uint_as_float(qq & 0xffff0000u) * __uint_as_float(kk & 0xffff0000u); }
                sc[k] = (j0 + jj + k <= i) ? s : -1e30f;
                asm volatile("" : "+v"(sc[k]));
            }
            const float mn = fmaxf(fmaxf(sc[0], sc[1]), m);
            const float alpha = exp2f(m - mn);
            float pr[2];
#pragma unroll
            for (int k = 0; k < 2; ++k) pr[k] = (j0 + jj + k <= i) ? exp2f(sc[k] - mn) : 0.f;
            l = l * alpha + (pr[0] + pr[1]); m = mn;
#pragma unroll
            for (int d = 0; d < DV; ++d) o[d] *= alpha;
#pragma unroll
            for (int k = 0; k < 2; ++k) { const unsigned* vr = Vs + (jj + k) * (DV / 2);
#pragma unroll
                for (int d = 0; d < DV / 2; ++d) { const unsigned vv = vr[d]; o[2 * d] += pr[k] * __uint_as_float(vv << 16); o[2 * d + 1] += pr[k] * __uint_as_float(vv & 0xffff0000u); } }
        }
    }
    l_out = l;
}
__device__ __forceinline__ void phase2_naive(const Params& P, int bid, int nb, float* smemf) {
    bid = sgpr_op(bid); nb = sgpr_op(nb);
    unsigned* smem = (unsigned*)smemf;
    const bf16_t* QD = (const bf16_t*)(P.ws + WS_QD); const bf16_t* KD = (const bf16_t*)(P.ws + WS_KD); const bf16_t* VD = (const bf16_t*)(P.ws + WS_VD);
    const bf16_t* QM = (const bf16_t*)(P.ws + WS_QM); const bf16_t* KM = (const bf16_t*)(P.ws + WS_KM); const bf16_t* VM = (const bf16_t*)(P.ws + WS_VM);
    const bf16_t* G = (const bf16_t*)(P.ws + WS_G); bf16_t* OD = (bf16_t*)(P.ws + WS_OD); bf16_t* YC = (bf16_t*)(P.ws + WS_YCAT);
    constexpr int NCH = SEQ / NT;
    for (int item = bid; item < 2 * 64 * NCH; item += nb) {
        const int kind = item / (64 * NCH), rem = item % (64 * NCH), bh = rem / NCH, ch = NCH - 1 - rem % NCH, q0 = ch * NT, b = bh >> 3, hh = bh & 7;
        const int i = q0 + tid_op();
        if (kind == 0) {
#pragma unroll 1
            for (int half = 0; half < 2; ++half) {
                float o[64], l;
                nattn_rows<64, 64, 128>(QD + (size_t)bh * SEQ * 64, KD + (size_t)bh * SEQ * 64, VD + (size_t)(b * 4 + (hh >> 1)) * SEQ * 128 + half * 64, q0, o, l, smem);
                const float rl = 1.f / l;
#pragma unroll
                for (int d = 0; d < 64; ++d) OD[((size_t)bh * SEQ + i) * 128 + half * 64 + d] = (bf16_t)f2bf(o[d] * rl);
            }
        } else {
            float o[64], l;
            nattn_rows<96, 64, 64>(QM + (size_t)bh * SEQ * 96, KM + (size_t)bh * SEQ * 96, VM + (size_t)bh * SEQ * 64, q0, o, l, smem);
            const float rl = 1.f / l; const size_t t = (size_t)b * SEQ + i;
#pragma unroll
            for (int d = 0; d < 64; ++d) { const size_t idx = t * 1024 + 512 + hh * 64 + d; YC[idx] = (bf16_t)f2bf(o[d] * rl * bf2f(G[idx])); }
        }
    }
}

__device__ __forceinline__ void phase25_naive(const Params& P, int bid, int nb) {
    bid = sgpr_op(bid); nb = sgpr_op(nb);
    const bf16_t* OD = (const bf16_t*)(P.ws + WS_OD); const bf16_t* G = (const bf16_t*)(P.ws + WS_G); bf16_t* YC = (bf16_t*)(P.ws + WS_YCAT);
    const float lam = ((const float*)(P.ws + WS_MISC))[0];
    const int tid = tid_op(), lane = tid & 63, wave = tid >> 6;
    const int gw = bid * (NT / 64) + wave, ngw = nb * (NT / 64);
    for (int it = gw; it < T * 4; it += ngw) {
        const int t = it >> 2, h = it & 3, b = t / SEQ, s = t % SEQ;
        const bf16_t* o0 = OD + ((size_t)(b * 8 + 2 * h) * SEQ + s) * 128; const bf16_t* o1 = OD + ((size_t)(b * 8 + 2 * h + 1) * SEQ + s) * 128;
        const float d0 = bf2f(o0[lane]) - lam * bf2f(o1[lane]), d1 = bf2f(o0[lane + 64]) - lam * bf2f(o1[lane + 64]);
        const float ss = wave_sum(d0 * d0 + d1 * d1);
        const float rstd = 1.0f / sqrtf(ss * (1.f / 128.f) + RMS_EPS);
        const size_t base = (size_t)t * 1024 + h * 128;
        YC[base + lane] = (bf16_t)f2bf(d0 * rstd * P.subln_g[lane] * (1.f - LAM_INIT) * bf2f(G[base + lane]));
        YC[base + lane + 64] = (bf16_t)f2bf(d1 * rstd * P.subln_g[lane + 64] * (1.f - LAM_INIT) * bf2f(G[base + lane + 64]));
    }
}

__device__ __forceinline__ void phase3_naive(const Params& P, int bid, int nb, float* smem) {
    bid = sgpr_op(bid); nb = sgpr_op(nb);
    const int tid = tid_op();
    const bf16_t* YC = (const bf16_t*)(P.ws + WS_YCAT); const bf16_t* PB = (const bf16_t*)(P.ws + WS_PB);
    bf16_t* HB = (bf16_t*)(P.ws + WS_HB); bf16_t* PLE = (bf16_t*)(P.ws + WS_PLE);
    float* Cs = smem + 16 * 129 + 16 * 65;
    constexpr int NRT = T / 128;
    for (int item = bid; item < 32 * NRT; item += nb) {
        const int ct = item % 32, rt = item / 32, row0 = rt * 128, col0 = (ct & 15) * 64;
        if (ct < 16) {
            ngemm_tile(YC, DM, row0, P.w_out, DM, col0, 64, DM, nullptr, smem);
            _Pragma("unroll 1") for (int e = tid; e < 128 * 64; e += NT) { const int r = e >> 6, c = e & 63; const size_t idx = (size_t)(row0 + r) * DM + col0 + c;
                const float h = P.x[idx] + Cs[r * 65 + c]; P.out[idx] = h; HB[idx] = (bf16_t)f2bf(h); }
        } else {
            ngemm_tile(PB, PLE_DIM, row0, P.w_ple, DM, col0, 64, PLE_DIM, nullptr, smem);
            _Pragma("unroll 1") for (int e = tid; e < 128 * 64; e += NT) { const int r = e >> 6, c = e & 63; const size_t idx = (size_t)(row0 + r) * DM + col0 + c; PLE[idx] = (bf16_t)f2bf(Cs[r * 65 + c]); }
        }
    }
}
__device__ __forceinline__ void phase4_naive(const Params& P, int bid, int nb, float* smem) {
    bid = sgpr_op(bid); nb = sgpr_op(nb);
    const int tid = tid_op();
    const bf16_t* HB = (const bf16_t*)(P.ws + WS_HB); const bf16_t* PLE = (const bf16_t*)(P.ws + WS_PLE); float* SSQF = (float*)(P.ws + WS_SSQF);
    float* Cs = smem + 16 * 129 + 16 * 65;
    constexpr int NRT = T / 128;
    for (int item = bid; item < 16 * NRT; item += nb) {
        const int ct = item % 16, rt = item / 16, row0 = rt * 128, col0 = ct * 64;
        ngemm_tile(HB, DM, row0, P.w_gate, DM, col0, 64, DM, nullptr, smem);
        _Pragma("unroll 1") for (int e = tid; e < 128 * 64; e += NT) { const int r = e >> 6, c = e & 63; const size_t idx = (size_t)(row0 + r) * DM + col0 + c;
            const float h2 = P.out[idx] + bf2f(PLE[idx]) * sigmoid_f(Cs[r * 65 + c]); P.out[idx] = h2; Cs[r * 65 + c] = h2; }
        __syncthreads();
        if (tid < 128) { float s = 0.f; _Pragma("unroll 4") for (int c = 0; c < 64; ++c) { const float v = Cs[tid * 65 + c]; s += v * v; } atomicAdd(SSQF + row0 + tid, s); }
    }
}
__device__ __forceinline__ void phase5(const Params& P, int bid, int nb) {
    bid = sgpr_op(bid); nb = sgpr_op(nb);
    const float* SSQF = (const float*)(P.ws + WS_SSQF);
    const int tid = tid_op(), lane = tid & 63, wave = tid >> 6;
    const int gw = bid * (NT / 64) + wave, ngw = nb * (NT / 64);
    for (int t = gw; t < T; t += ngw) {
        const float rstd = 1.0f / sqrtf(SSQF[t] * (1.f / DM) + RMS_EPS);
        float4* o = (float4*)(P.out + (size_t)t * DM);
#pragma unroll
        for (int j = 0; j < 4; ++j) { float4 v = o[lane + 64 * j]; const float4 g = ((const float4*)P.final_g)[lane + 64 * j];
            v.x *= rstd * g.x; v.y *= rstd * g.y; v.z *= rstd * g.z; v.w *= rstd * g.w; o[lane + 64 * j] = v; }
    }
}

namespace pg8 {
#define PG8_LAS __attribute__((address_space(3)))
typedef unsigned short bf16_t;
typedef short bf16x8 __attribute__((ext_vector_type(8)));
typedef float f32x4 __attribute__((ext_vector_type(4)));
typedef unsigned u32x4 __attribute__((ext_vector_type(4)));
constexpr int BM = 256, BK = 64, HALF = 128, HTB = HALF * BK * 2  , STAGE_BYTES = 8 * HTB, NXCD = 8, WGM = 8;

__host__ __device__ __forceinline__ int lds_byte(int r, int c) { const int st = (r >> 4) * 2 + (c >> 5), rr = r & 15, cc = c & 31, ob = rr * 64 + cc * 2; return st * 1024 + (ob ^ (((ob >> 9) & 1) << 5)); }
__host__ __device__ __forceinline__ void stage_rc(int b, int& R, int& C) { const int st = b / 1024, sb = b % 1024, swz = sb ^ (((sb >> 9) & 1) << 5); R = (st >> 1) * 16 + swz / 64; C = (st & 1) * 32 + (swz % 64) / 2; }
__host__ __device__ __forceinline__ int perm32(int rho) { const int n = rho >> 4, i = rho & 15; return 8 * (i >> 2) + 4 * n + (i & 3); }

struct Unit { int pm, pn; };
struct Gemm { const bf16_t* A; const bf16_t* Bt; int M, N, K, lda; };

struct StaticOrder {
    int nM, nN, nwg, G, c;
    __host__ __device__ void init(int M, int N, int G_, int c_) { nM = M / BM; nN = N / BM; nwg = nM * nN; G = G_; c = c_; }
    __host__ __device__ bool next(int i, Unit& u) const {
        const long L = (long)i * G + c; if (L >= nwg) return false;
        int wgid = (int)L; { const int q = nwg / NXCD, r = nwg % NXCD, xcd = wgid % NXCD, off = wgid / NXCD; wgid = (xcd < r ? xcd * (q + 1) : r * (q + 1) + (xcd - r) * q) + off; }
        const int nig = WGM * nN, gid = wgid / nig, fm = gid * WGM, gsz = (nM - fm) < WGM ? (nM - fm) : WGM;
        u.pm = fm + ((wgid % nig) % gsz); u.pn = (wgid % nig) / gsz; return true;
    }
    __device__ __forceinline__ void a_ready(const Unit&) const {}
    __device__ __forceinline__ void done(const Unit&) const {}
};

__device__ __forceinline__ unsigned cvt_pk_bf16(float lo, float hi) { unsigned r; asm volatile("v_cvt_pk_bf16_f32 %0, %1, %2" : "=v"(r) : "v"(lo), "v"(hi)); return r; }
template <class Epi, class Sched, bool ALIGN_EPI = false, bool SP2 = false>
__device__ __forceinline__ void gemm_phase(PG8_LAS unsigned char* lds, const Gemm g, const Sched& S, const Epi& E) {
    const int tid = tid_op(), wid = __builtin_amdgcn_readfirstlane(tid >> 6), lane = tid & 63, wr = wid >> 2, wc = wid & 3, fr = lane & 15, fq = lane >> 4;
    const int K = g.K, nt = K / BK;
    unsigned voffA[2], voffB[2];
#pragma unroll
    for (int i = 0; i < 2; ++i) { int R, C; stage_rc(tid * 16 + i * 8192, R, C); const int Rb = Epi::PERM ? ((R & ~31) + perm32(R & 31)) : R;
        voffA[i] = (unsigned)(R * g.lda + C) * 2u; voffB[i] = (unsigned)(Rb * K + C) * 2u; }
    const size_t kstep = (size_t)(BK * 2);
    const size_t hstepA = (size_t)HALF * g.lda * 2, hstepB = (size_t)HALF * K * 2;
    const size_t tstepA = 2 * hstepA, tstepB = 2 * hstepB;
    const unsigned ldsw = (unsigned)wid * 1024u;
    const int aoff = lds_byte(wr * 64 + fr, fq * 8), boff = lds_byte(wc * 32 + fr, fq * 8);
#define PG8_SA(b, h) (((b) * 2 + (h)) * HTB)
#define PG8_SB(b, h) ((4 + (b) * 2 + (h)) * HTB)
#define PG8_STAGE(bufoff, gbase, voff) do { _Pragma("unroll") for (int _i = 0; _i < 2; ++_i) \
        __builtin_amdgcn_global_load_lds((const unsigned*)((const char*)(gbase) + (voff)[_i]), (PG8_LAS unsigned*)(lds + (bufoff) + ldsw + _i * 8192), 16, 0, 0); } while (0)
#define PG8_LDA(dst, b, h) do { _Pragma("unroll") for (int m = 0; m < 4; ++m) _Pragma("unroll") for (int k = 0; k < 2; ++k) dst[m][k] = *(const PG8_LAS bf16x8*)(lds + PG8_SA(b, h) + aoff + m * 2048 + k * 1024); } while (0)
#define PG8_LDB(dst, b, h) do { _Pragma("unroll") for (int n = 0; n < 2; ++n) _Pragma("unroll") for (int k = 0; k < 2; ++k) dst[n][k] = *(const PG8_LAS bf16x8*)(lds + PG8_SB(b, h) + boff + n * 2048 + k * 1024); } while (0)
#define PG8_MMA(ai, bj, At, Bt) do { __builtin_amdgcn_s_setprio(1); _Pragma("unroll") for (int m = 0; m < 4; ++m) _Pragma("unroll") for (int n = 0; n < 2; ++n) _Pragma("unroll") for (int k = 0; k < 2; ++k) \
        acc[ai][bj][m][n] = __builtin_amdgcn_mfma_f32_16x16x32_bf16(Bt[n][k], At[m][k], acc[ai][bj][m][n], 0, 0, 0); __builtin_amdgcn_s_setprio(0); } while (0)
#define PG8_WAIT_V(n) asm volatile("s_waitcnt vmcnt(" #n ")" ::: "memory")
#define PG8_WAIT_L(n) asm volatile("s_waitcnt lgkmcnt(" #n ")" ::: "memory")
#define PG8_BAR __builtin_amdgcn_s_barrier()
#define PG8_SCHED __builtin_amdgcn_sched_barrier(0)
    Unit cur, nxt; int ui = 0;
    if (!S.next(0, cur)) return;
    f32x4 acc[2][2][4][2];
#pragma unroll
    for (int a = 0; a < 2; ++a)
#pragma unroll
        for (int b = 0; b < 2; ++b)
#pragma unroll
            for (int m = 0; m < 4; ++m)
#pragma unroll
                for (int n = 0; n < 2; ++n) acc[a][b][m][n] = (f32x4){0.f, 0.f, 0.f, 0.f};
    bf16x8 At[4][2], B0[2][2], B1[2][2];
    const char* cA = (const char*)g.A + (size_t)cur.pm * tstepA; const char* cB = (const char*)g.Bt + (size_t)cur.pn * tstepB;
    S.a_ready(cur);
    if constexpr (SP2) {
        PG8_STAGE(PG8_SB(0, 0), cB, voffB); PG8_STAGE(PG8_SB(0, 1), cB + hstepB, voffB); PG8_STAGE(PG8_SA(0, 0), cA, voffA); PG8_STAGE(PG8_SA(0, 1), cA + hstepA, voffA);
        if (wr == 1) PG8_BAR;
        PG8_WAIT_V(2); PG8_BAR;
        PG8_STAGE(PG8_SB(1, 0), cB + kstep, voffB); PG8_STAGE(PG8_SA(1, 0), cA + kstep, voffA); PG8_STAGE(PG8_SB(1, 1), cB + hstepB + kstep, voffB);
        PG8_WAIT_V(6); PG8_BAR;
    } else {
        PG8_STAGE(PG8_SB(0, 0), cB, voffB); PG8_STAGE(PG8_SA(0, 0), cA, voffA); PG8_STAGE(PG8_SB(0, 1), cB + hstepB, voffB); PG8_STAGE(PG8_SA(0, 1), cA + hstepA, voffA);
        if (wr == 1) PG8_BAR;
        PG8_WAIT_V(4); PG8_BAR;
        PG8_STAGE(PG8_SB(1, 0), cB + kstep, voffB); PG8_STAGE(PG8_SA(1, 0), cA + kstep, voffA); PG8_STAGE(PG8_SB(1, 1), cB + hstepB + kstep, voffB);
        PG8_WAIT_V(6); PG8_BAR;
    }
    for (;;) {
        const bool has_next = S.next(ui + 1, nxt);
        const char* nA = has_next ? (const char*)g.A + (size_t)nxt.pm * tstepA : cA; const char* nB = has_next ? (const char*)g.Bt + (size_t)nxt.pn * tstepB : cB;
#pragma unroll 1
        for (int t = 0; t < nt; t += 2) {
            const bool last = (t == nt - 2);
            const char* a1 = cA + (size_t)(t + 1) * kstep;
            const char* a2 = last ? nA : cA + (size_t)(t + 2) * kstep; const char* b2 = last ? nB : cB + (size_t)(t + 2) * kstep;
            const char* a3 = a2 + kstep; const char* b3 = b2 + kstep;
            if (last && has_next) S.a_ready(nxt);
            if constexpr (SP2) {
            PG8_LDB(B0, 0, 0); PG8_LDB(B1, 0, 1); PG8_SCHED; PG8_LDA(At, 0, 0); PG8_STAGE(PG8_SA(1, 1), a1 + hstepA, voffA);
            PG8_WAIT_V(8); PG8_WAIT_L(0); PG8_BAR; PG8_MMA(0, 0, At, B0); PG8_MMA(0, 1, At, B1); PG8_BAR; PG8_SCHED;
            PG8_LDA(At, 0, 1); PG8_STAGE(PG8_SB(0, 0), b2, voffB); PG8_STAGE(PG8_SB(0, 1), b2 + hstepB, voffB); PG8_STAGE(PG8_SA(0, 0), a2, voffA);
            PG8_WAIT_V(8); PG8_WAIT_L(0); PG8_BAR; PG8_MMA(1, 0, At, B0); PG8_MMA(1, 1, At, B1); PG8_BAR; PG8_SCHED;
            PG8_LDB(B0, 1, 0); PG8_LDB(B1, 1, 1); PG8_SCHED; PG8_LDA(At, 1, 0); PG8_STAGE(PG8_SA(0, 1), a2 + hstepA, voffA);
            PG8_WAIT_V(8); PG8_WAIT_L(0); PG8_BAR; PG8_MMA(0, 0, At, B0); PG8_MMA(0, 1, At, B1); PG8_BAR; PG8_SCHED;
            PG8_LDA(At, 1, 1); PG8_STAGE(PG8_SB(1, 0), b3, voffB); PG8_STAGE(PG8_SB(1, 1), b3 + hstepB, voffB); PG8_STAGE(PG8_SA(1, 0), a3, voffA);
            PG8_WAIT_V(8); PG8_WAIT_L(0); PG8_BAR; PG8_MMA(1, 0, At, B0); PG8_MMA(1, 1, At, B1); PG8_BAR; PG8_SCHED;
            } else {
            PG8_LDB(B0, 0, 0); PG8_SCHED; PG8_LDA(At, 0, 0); PG8_STAGE(PG8_SA(1, 1), a1 + hstepA, voffA);
            PG8_WAIT_L(8); PG8_BAR; PG8_WAIT_L(0); PG8_MMA(0, 0, At, B0); PG8_BAR; PG8_SCHED;
            PG8_LDB(B1, 0, 1); PG8_STAGE(PG8_SB(0, 0), b2, voffB);
            PG8_BAR; PG8_WAIT_L(0); PG8_MMA(0, 1, At, B1); PG8_BAR;
            PG8_LDA(At, 0, 1); PG8_STAGE(PG8_SA(0, 0), a2, voffA);
            PG8_BAR; PG8_WAIT_L(0); PG8_MMA(1, 0, At, B0); PG8_BAR; PG8_SCHED;
            PG8_STAGE(PG8_SB(0, 1), b2 + hstepB, voffB);
            PG8_WAIT_V(6); PG8_BAR; PG8_MMA(1, 1, At, B1); PG8_BAR;
            PG8_LDB(B0, 1, 0); PG8_SCHED; PG8_LDA(At, 1, 0); PG8_STAGE(PG8_SA(0, 1), a2 + hstepA, voffA);
            PG8_WAIT_L(8); PG8_BAR; PG8_WAIT_L(0); PG8_MMA(0, 0, At, B0); PG8_BAR; PG8_SCHED;
            PG8_LDB(B1, 1, 1); PG8_STAGE(PG8_SB(1, 0), b3, voffB);
            PG8_BAR; PG8_WAIT_L(0); PG8_MMA(0, 1, At, B1); PG8_BAR;
            PG8_LDA(At, 1, 1); PG8_STAGE(PG8_SA(1, 0), a3, voffA);
            PG8_BAR; PG8_WAIT_L(0); PG8_MMA(1, 0, At, B0); PG8_BAR; PG8_SCHED;
            PG8_STAGE(PG8_SB(1, 1), b3 + hstepB, voffB);
            PG8_WAIT_V(6); PG8_BAR; PG8_MMA(1, 1, At, B1); PG8_BAR;
            }
        }
        if constexpr (ALIGN_EPI) { if (wr == 0) PG8_BAR; }
        if constexpr (!Epi::AFTER_DRAIN) { E(acc, cur, wr, wc, fr, fq); S.done(cur); }
        if (!has_next) break;
#pragma unroll
        for (int a = 0; a < 2; ++a)
#pragma unroll
            for (int b = 0; b < 2; ++b)
#pragma unroll
                for (int m = 0; m < 4; ++m)
#pragma unroll
                    for (int n = 0; n < 2; ++n) acc[a][b][m][n] = (f32x4){0.f, 0.f, 0.f, 0.f};
        cur = nxt; cA = nA; cB = nB; ++ui;
        if constexpr (ALIGN_EPI) { if (wr == 1) PG8_BAR; }
    }
    PG8_WAIT_V(0);
    if constexpr (!ALIGN_EPI) { if (wr == 0) PG8_BAR; }
    PG8_BAR;
    if constexpr (Epi::AFTER_DRAIN) { E.fused(acc, cur, wr, wc, fr, fq, lds, wid, lane); S.done(cur); }
#undef PG8_SA
#undef PG8_SB
#undef PG8_STAGE
#undef PG8_LDA
#undef PG8_LDB
#undef PG8_MMA
#undef PG8_WAIT_V
#undef PG8_WAIT_L
#undef PG8_BAR
#undef PG8_SCHED
}
}

#define LAS __attribute__((address_space(3)))
typedef float f32x4 __attribute__((ext_vector_type(4)));
typedef unsigned u32x4 __attribute__((ext_vector_type(4)));
using pg8::cvt_pk_bf16;
__device__ __forceinline__ u32x4 pack8(const f32x4 a, const f32x4 b) { u32x4 w; w.x = cvt_pk_bf16(a[0], a[1]); w.y = cvt_pk_bf16(a[2], a[3]); w.z = cvt_pk_bf16(b[0], b[1]); w.w = cvt_pk_bf16(b[2], b[3]); return w; }

struct MapIn {
    __device__ __forceinline__ int operator()(int g) const { const int pn = g >> 8, cc = g & 255, bj = cc >> 7, w = cc & 127;
        if (pn < 2) return OFF_DQ + (4 * pn + (w >> 5)) * 64 + bj * 32 + (w & 31);
        if (pn < 4) return OFF_DK + (4 * (pn - 2) + (w >> 5)) * 64 + bj * 32 + (w & 31);
        if (pn < 6) return OFF_DV + (pn - 4) * 256 + cc;
        if (pn < 8) return OFF_DG + (pn - 6) * 256 + cc;
        if (pn == 8) return OFF_CQ + cc;
        if (pn == 9) return bj == 0 ? OFF_CQ + 256 + w : OFF_CKV + w;
        if (pn < 12) return OFF_MG + (pn - 10) * 256 + cc;
        return w < 16 ? OFF_KR + bj * 16 + w : -1; } };
struct MapUq {
    __device__ __forceinline__ int operator()(int g) const { const int pn = g >> 8, cc = g & 255;
        if (pn == 0) { const int bj = cc >> 7, w = cc & 127; return (w >> 4) * 96 + 64 + bj * 16 + (w & 15); }
        const int gp = g - 256; return (gp >> 6) * 96 + (gp & 63); } };
struct MapId { __device__ __forceinline__ int operator()(int g) const { return g; } };
template <class Map>
__device__ __forceinline__ void wconv(const float* W, int K, int ldw, const float* kscale, bf16_t* Wt, int ldwt, int kdst_off, int Ng, Map map, LAS float* scr, int gw, int ngw, int lane) {
    const int nblk = Ng / 32, items = (K / 64) * nblk;
    for (int it = gw; it < items; it += ngw) {
        const int kb = it / nblk, nbk = it % nblk, k0 = 64 * kb, n0 = 32 * nbk;
        const int src = map(n0 + (lane & 31));
#pragma unroll 8
        for (int i = 0; i < 32; ++i) { const int kk = 2 * i + (lane >> 5);
            float v = 0.f; if (src >= 0) { v = W[(size_t)(k0 + kk) * ldw + src]; if (kscale) v *= kscale[k0 + kk]; }
            scr[kk * 33 + (lane & 31)] = v; }
        asm volatile("s_waitcnt lgkmcnt(0)" ::: "memory");
        const int c = lane & 7;
#pragma unroll
        for (int j = 0; j < 4; ++j) { const int n = (lane >> 3) + 8 * j; const LAS float* sp = scr + (8 * c) * 33 + n;
            u32x4 o; o.x = f2bf(sp[0]) | (f2bf(sp[33]) << 16); o.y = f2bf(sp[2 * 33]) | (f2bf(sp[3 * 33]) << 16); o.z = f2bf(sp[4 * 33]) | (f2bf(sp[5 * 33]) << 16); o.w = f2bf(sp[6 * 33]) | (f2bf(sp[7 * 33]) << 16);
            *(u32x4*)(Wt + (size_t)(n0 + n) * ldwt + kdst_off + k0 + 8 * c) = o; }
        asm volatile("s_waitcnt lgkmcnt(0)" ::: "memory");
    }
}
constexpr int NIN = 13 * 256;
__device__ __forceinline__ void phase0_weights(const Params& P, int bid, int nb, LAS unsigned char* lds) {
    const int tid = tid_op(), lane = tid & 63, wave = tid >> 6;
    const int gw = bid * (NT / 64) + wave, ngw = nb * (NT / 64);
    LAS float* scr = (LAS float*)(lds + wave * 16384);
    wconv(P.w_in, DM, DIN, nullptr, (bf16_t*)(P.ws + WS_WIN), DM, 0, NIN, MapIn(), scr, gw, ngw, lane);
    wconv(P.w_ple, PLE_DIM, DM, nullptr, (bf16_t*)(P.ws + WS_WPLE), PLE_DIM, 0, DM, MapId(), scr, gw, ngw, lane);
    wconv(P.w_uq, QLORA, 768, P.qn_g, (bf16_t*)(P.ws + WS_WUQ), QLORA, 0, 768, MapUq(), scr, gw, ngw, lane);
    wconv(P.w_ukv, KVLORA, 1024, P.kvn_g, (bf16_t*)(P.ws + WS_WUKV), 256, 128, 1024, MapId(), scr, gw, ngw, lane);
    wconv(P.w_out, DM, DM, nullptr, (bf16_t*)(P.ws + WS_WOUT), DM, 0, DM, MapId(), scr, gw, ngw, lane);
    wconv(P.w_gate, DM, DM, nullptr, (bf16_t*)(P.ws + WS_WG), DM, 0, DM, MapId(), scr, gw, ngw, lane);
    u32x4* z = (u32x4*)(P.ws + WS_WUKV);
    for (int i = bid * NT + tid; i < 1024 * 16; i += nb * NT) { const int g = i >> 4, c = i & 15; z[g * 32 + c] = (u32x4){0u, 0u, 0u, 0u}; }
}

struct Epi1 {
    static constexpr bool PERM = true, AFTER_DRAIN = false;
    bf16_t *QD, *KD, *VD, *G, *CQ, *KM; float *SSQQ, *SSQKV; const float2 *CSA, *CSB;
    __device__ __forceinline__ void operator()(const f32x4 (&acc)[2][2][4][2], const pg8::Unit& u, int wr, int wc, int fr, int fq) const {
        const int pn = u.pn, b = u.pm >> 4, s0 = (u.pm & 15) * 256 + wr * 64 + fr, t0 = u.pm * 256 + wr * 64 + fr;
        if (pn < 4) {
            bf16_t* dst = pn < 2 ? QD : KD; const float sc = pn < 2 ? C2D : 1.f; const int mh = 4 * (pn & 1) + wc;
#pragma unroll
            for (int ai = 0; ai < 2; ++ai)
#pragma unroll
                for (int m = 0; m < 4; ++m) { const int ro = ai * 128 + m * 16; const f32x4* cs = (const f32x4*)(CSA + (size_t)(t0 + ro) * 32 + 8 * fq);
                    f32x4 o1[2], o2[2];
#pragma unroll
                    for (int n = 0; n < 2; ++n) { const f32x4 ca = cs[2 * n], cb = cs[2 * n + 1]; const f32x4 x1 = acc[ai][0][m][n], x2 = acc[ai][1][m][n];
                        o1[n] = (f32x4){x1[0] * ca[0] - x2[0] * ca[1], x1[1] * ca[2] - x2[1] * ca[3], x1[2] * cb[0] - x2[2] * cb[1], x1[3] * cb[2] - x2[3] * cb[3]} * sc;
                        o2[n] = (f32x4){x2[0] * ca[0] + x1[0] * ca[1], x2[1] * ca[2] + x1[1] * ca[3], x2[2] * cb[0] + x1[2] * cb[1], x2[3] * cb[2] + x1[3] * cb[3]} * sc; }
                    bf16_t* rp = dst + ((size_t)(b * 8 + mh) * SEQ + s0 + ro) * 64 + 8 * fq;
                    *(u32x4*)rp = pack8(o1[0], o1[1]); *(u32x4*)(rp + 32) = pack8(o2[0], o2[1]); asm volatile("" ::: "memory"); }
        } else if (pn < 6) {
#pragma unroll
            for (int ai = 0; ai < 2; ++ai)
#pragma unroll
                for (int m = 0; m < 4; ++m)
#pragma unroll
                    for (int bj = 0; bj < 2; ++bj) { const int ro = ai * 128 + m * 16, h = 2 * (pn - 4) + bj;
                        *(u32x4*)(VD + ((size_t)(b * 4 + h) * SEQ + s0 + ro) * 128 + 32 * wc + 8 * fq) = pack8(acc[ai][bj][m][0], acc[ai][bj][m][1]); }
        } else if (pn < 8 || pn == 10 || pn == 11) {
            const int cb = (pn < 8 ? (pn - 6) * 256 : 512 + (pn - 10) * 256) + 32 * wc + 8 * fq;
#pragma unroll
            for (int ai = 0; ai < 2; ++ai)
#pragma unroll
                for (int m = 0; m < 4; ++m)
#pragma unroll
                    for (int bj = 0; bj < 2; ++bj) { const int ro = ai * 128 + m * 16; f32x4 a = acc[ai][bj][m][0], c = acc[ai][bj][m][1];
#pragma unroll
                        for (int j = 0; j < 4; ++j) { a[j] = silu_f(a[j]); c[j] = silu_f(c[j]); }
                        *(u32x4*)(G + (size_t)(t0 + ro) * 1024 + cb + 128 * bj) = pack8(a, c); }
        } else if (pn < 10) {
#pragma unroll
            for (int ai = 0; ai < 2; ++ai)
#pragma unroll
                for (int m = 0; m < 4; ++m) { const int ro = ai * 128 + m * 16; float ss[2];
#pragma unroll
                    for (int bj = 0; bj < 2; ++bj) { const f32x4 a = acc[ai][bj][m][0], c = acc[ai][bj][m][1];
                        *(u32x4*)(CQ + (size_t)(t0 + ro) * CQP + (pn - 8) * 256 + 128 * bj + 32 * wc + 8 * fq) = pack8(a, c);
                        float q = (a[0] * a[0] + a[1] * a[1]) + (a[2] * a[2] + a[3] * a[3]) + (c[0] * c[0] + c[1] * c[1]) + (c[2] * c[2] + c[3] * c[3]);
                        q += __shfl_xor(q, 16); q += __shfl_xor(q, 32); ss[bj] = q; }
                    if (fq == 0) { if (pn == 8) atomicAdd(SSQQ + t0 + ro, ss[0] + ss[1]); else { atomicAdd(SSQQ + t0 + ro, ss[0]); atomicAdd(SSQKV + t0 + ro, ss[1]); } } }
        } else {
            if (wc == 0 && fq < 2) {
#pragma unroll
                for (int ai = 0; ai < 2; ++ai)
#pragma unroll
                    for (int m = 0; m < 4; ++m) { const int ro = ai * 128 + m * 16; const f32x4* cs = (const f32x4*)(CSB + (size_t)(t0 + ro) * 16 + 8 * fq);
                        f32x4 o1[2], o2[2];
#pragma unroll
                        for (int n = 0; n < 2; ++n) { const f32x4 ca = cs[2 * n], cb = cs[2 * n + 1]; const f32x4 x1 = acc[ai][0][m][n], x2 = acc[ai][1][m][n];
                            o1[n] = (f32x4){x1[0] * ca[0] - x2[0] * ca[1], x1[1] * ca[2] - x2[1] * ca[3], x1[2] * cb[0] - x2[2] * cb[1], x1[3] * cb[2] - x2[3] * cb[3]};
                            o2[n] = (f32x4){x2[0] * ca[0] + x1[0] * ca[1], x2[1] * ca[2] + x1[1] * ca[3], x2[2] * cb[0] + x1[2] * cb[1], x2[3] * cb[2] + x1[3] * cb[3]}; }
                        const u32x4 w1 = pack8(o1[0], o1[1]), w2 = pack8(o2[0], o2[1]);
#pragma unroll
                        for (int h = 0; h < 8; ++h) { bf16_t* rp = KM + ((size_t)(b * 8 + h) * SEQ + s0 + ro) * 96 + 64 + 8 * fq; *(u32x4*)rp = w1; *(u32x4*)(rp + 16) = w2; } }
            }
        }
    }
};
struct EpiStore {
    static constexpr bool PERM = true, AFTER_DRAIN = false;
    bf16_t* O; int ldc;
    __device__ __forceinline__ void operator()(const f32x4 (&acc)[2][2][4][2], const pg8::Unit& u, int wr, int wc, int fr, int fq) const {
        const int t0 = u.pm * 256 + wr * 64 + fr, c0 = u.pn * 256 + 32 * wc + 8 * fq;
#pragma unroll
        for (int ai = 0; ai < 2; ++ai)
#pragma unroll
            for (int m = 0; m < 4; ++m)
#pragma unroll
                for (int bj = 0; bj < 2; ++bj) *(u32x4*)(O + (size_t)(t0 + ai * 128 + m * 16) * ldc + c0 + 128 * bj) = pack8(acc[ai][bj][m][0], acc[ai][bj][m][1]);
    }
};
struct EpiQ {
    static constexpr bool PERM = true, AFTER_DRAIN = false;
    bf16_t* QM; const float* SSQQ; const float2* CSB;
    __device__ __forceinline__ void operator()(const f32x4 (&acc)[2][2][4][2], const pg8::Unit& u, int wr, int wc, int fr, int fq) const {
        const int pn = u.pn, b = u.pm >> 4, s0 = (u.pm & 15) * 256 + wr * 64 + fr, t0 = u.pm * 256 + wr * 64 + fr;
#pragma unroll
        for (int ai = 0; ai < 2; ++ai)
#pragma unroll
            for (int m = 0; m < 4; ++m) { const int ro = ai * 128 + m * 16; const float sc = C2M * __builtin_amdgcn_rsqf(SSQQ[t0 + ro] * (1.f / QLORA) + RMS_EPS);
                if (pn == 0) { const int h = 2 * wc + (fq >> 1), i0 = 8 * (fq & 1); const f32x4* cs = (const f32x4*)(CSB + (size_t)(t0 + ro) * 16 + i0);
                    f32x4 o1[2], o2[2];
#pragma unroll
                    for (int n = 0; n < 2; ++n) { const f32x4 ca = cs[2 * n], cb = cs[2 * n + 1]; const f32x4 x1 = acc[ai][0][m][n], x2 = acc[ai][1][m][n];
                        o1[n] = (f32x4){x1[0] * ca[0] - x2[0] * ca[1], x1[1] * ca[2] - x2[1] * ca[3], x1[2] * cb[0] - x2[2] * cb[1], x1[3] * cb[2] - x2[3] * cb[3]} * sc;
                        o2[n] = (f32x4){x2[0] * ca[0] + x1[0] * ca[1], x2[1] * ca[2] + x1[1] * ca[3], x2[2] * cb[0] + x1[2] * cb[1], x2[3] * cb[2] + x1[3] * cb[3]} * sc; }
                    bf16_t* rp = QM + ((size_t)(b * 8 + h) * SEQ + s0 + ro) * 96 + 64 + i0;
                    *(u32x4*)rp = pack8(o1[0], o1[1]); *(u32x4*)(rp + 16) = pack8(o2[0], o2[1]);
                } else {
#pragma unroll
                    for (int bj = 0; bj < 2; ++bj) { const int h = 4 * (pn - 1) + 2 * bj + (wc >> 1), d = 32 * (wc & 1) + 8 * fq;
                        *(u32x4*)(QM + ((size_t)(b * 8 + h) * SEQ + s0 + ro) * 96 + d) = pack8(acc[ai][bj][m][0] * sc, acc[ai][bj][m][1] * sc); } }
                asm volatile("" ::: "memory");
            }
    }
};
struct EpiKV {
    static constexpr bool PERM = true, AFTER_DRAIN = false;
    bf16_t *KM, *VM; const float* SSQKV;
    __device__ __forceinline__ void operator()(const f32x4 (&acc)[2][2][4][2], const pg8::Unit& u, int wr, int wc, int fr, int fq) const {
        const int pn = u.pn, b = u.pm >> 4, s0 = (u.pm & 15) * 256 + wr * 64 + fr, t0 = u.pm * 256 + wr * 64 + fr;
#pragma unroll
        for (int ai = 0; ai < 2; ++ai)
#pragma unroll
            for (int m = 0; m < 4; ++m) { const int ro = ai * 128 + m * 16; const float sc = __builtin_amdgcn_rsqf(SSQKV[t0 + ro] * (1.f / KVLORA) + RMS_EPS);
#pragma unroll
                for (int bj = 0; bj < 2; ++bj) { const int h = 2 * pn + bj; const size_t rowi = (size_t)(b * 8 + h) * SEQ + s0 + ro;
                    bf16_t* rp = (wc < 2) ? KM + rowi * 96 + 32 * wc + 8 * fq : VM + rowi * 64 + 32 * (wc - 2) + 8 * fq;
                    *(u32x4*)rp = pack8(acc[ai][bj][m][0] * sc, acc[ai][bj][m][1] * sc); }
                asm volatile("" ::: "memory"); }
    }
};
struct Epi3 {
    static constexpr bool PERM = true, AFTER_DRAIN = false;
    const float* x; float* out; bf16_t* HB;
    __device__ __forceinline__ void operator()(const f32x4 (&acc)[2][2][4][2], const pg8::Unit& u, int wr, int wc, int fr, int fq) const {
        const int t0 = u.pm * 256 + wr * 64 + fr, c0 = u.pn * 256 + 32 * wc + 8 * fq;
#pragma unroll
        for (int ai = 0; ai < 2; ++ai)
#pragma unroll
            for (int m = 0; m < 4; ++m) {
#pragma unroll
                for (int bj = 0; bj < 2; ++bj) { const size_t idx = (size_t)(t0 + ai * 128 + m * 16) * DM + c0 + 128 * bj;
                    const f32x4 h0 = *(const f32x4*)(x + idx) + acc[ai][bj][m][0], h1 = *(const f32x4*)(x + idx + 4) + acc[ai][bj][m][1];
                    *(f32x4*)(out + idx) = h0; *(f32x4*)(out + idx + 4) = h1; *(u32x4*)(HB + idx) = pack8(h0, h1); }
                asm volatile("" ::: "memory"); }
    }
};
struct Epi4 {
    static constexpr bool PERM = true, AFTER_DRAIN = false;
    float* out; const bf16_t* PLE; float* SSQF;
    __device__ __forceinline__ void operator()(const f32x4 (&acc)[2][2][4][2], const pg8::Unit& u, int wr, int wc, int fr, int fq) const {
        const int t0 = u.pm * 256 + wr * 64 + fr, c0 = u.pn * 256 + 32 * wc + 8 * fq;
#pragma unroll
        for (int ai = 0; ai < 2; ++ai)
#pragma unroll
            for (int m = 0; m < 4; ++m) { float q = 0.f;
#pragma unroll
                for (int bj = 0; bj < 2; ++bj) { const size_t idx = (size_t)(t0 + ai * 128 + m * 16) * DM + c0 + 128 * bj;
                    const u32x4 pw = *(const u32x4*)(PLE + idx); f32x4 h0 = *(const f32x4*)(out + idx), h1 = *(const f32x4*)(out + idx + 4);
                    const f32x4 a = acc[ai][bj][m][0], c = acc[ai][bj][m][1];
                    h0[0] += __uint_as_float(pw.x << 16) * sigmoid_f(a[0]); h0[1] += __uint_as_float(pw.x & 0xffff0000u) * sigmoid_f(a[1]);
                    h0[2] += __uint_as_float(pw.y << 16) * sigmoid_f(a[2]); h0[3] += __uint_as_float(pw.y & 0xffff0000u) * sigmoid_f(a[3]);
                    h1[0] += __uint_as_float(pw.z << 16) * sigmoid_f(c[0]); h1[1] += __uint_as_float(pw.z & 0xffff0000u) * sigmoid_f(c[1]);
                    h1[2] += __uint_as_float(pw.w << 16) * sigmoid_f(c[2]); h1[3] += __uint_as_float(pw.w & 0xffff0000u) * sigmoid_f(c[3]);
                    *(f32x4*)(out + idx) = h0; *(f32x4*)(out + idx + 4) = h1;
                    q += (h0[0] * h0[0] + h0[1] * h0[1]) + (h0[2] * h0[2] + h0[3] * h0[3]) + (h1[0] * h1[0] + h1[1] * h1[1]) + (h1[2] * h1[2] + h1[3] * h1[3]); }
                q += __shfl_xor(q, 16); q += __shfl_xor(q, 32);
                if (fq == 0) atomicAdd(SSQF + t0 + ai * 128 + m * 16, q);
                asm volatile("" ::: "memory"); }
    }
};

#ifndef PG8_SP2
#define PG8_SP2 true
#endif
#ifndef PG8_ALIGN
#define PG8_ALIGN true
#endif
__device__ __forceinline__ void phase1_gemm(const Params& P, LAS unsigned char* lds) {
    pg8::Gemm g{(const bf16_t*)(P.ws + WS_XN), (const bf16_t*)(P.ws + WS_WIN), T, NIN, DM, DM}; pg8::StaticOrder S; S.init(T, NIN, (int)gridDim.x, (int)blockIdx.x);
    Epi1 E{(bf16_t*)(P.ws + WS_QD), (bf16_t*)(P.ws + WS_KD), (bf16_t*)(P.ws + WS_VD), (bf16_t*)(P.ws + WS_G), (bf16_t*)(P.ws + WS_CQ), (bf16_t*)(P.ws + WS_KM),
           (float*)(P.ws + WS_SSQQ), (float*)(P.ws + WS_SSQKV), (const float2*)(P.ws + WS_CSA), (const float2*)(P.ws + WS_CSB)};
    pg8::gemm_phase<Epi1, pg8::StaticOrder, PG8_ALIGN, PG8_SP2>(lds, g, S, E);
}
__device__ __forceinline__ void phase15_gemm(const Params& P, LAS unsigned char* lds) {
    { pg8::Gemm g{(const bf16_t*)(P.ws + WS_CQ), (const bf16_t*)(P.ws + WS_WUQ), T, 768, QLORA, CQP}; pg8::StaticOrder S; S.init(T, 768, (int)gridDim.x, (int)blockIdx.x);
      EpiQ E{(bf16_t*)(P.ws + WS_QM), (const float*)(P.ws + WS_SSQQ), (const float2*)(P.ws + WS_CSB)};
      pg8::gemm_phase<EpiQ, pg8::StaticOrder, PG8_ALIGN, PG8_SP2>(lds, g, S, E); }
    { pg8::Gemm g{(const bf16_t*)(P.ws + WS_CQ) + 256, (const bf16_t*)(P.ws + WS_WUKV), T, 1024, 256, CQP}; pg8::StaticOrder S; S.init(T, 1024, (int)gridDim.x, (int)blockIdx.x);
      EpiKV E{(bf16_t*)(P.ws + WS_KM), (bf16_t*)(P.ws + WS_VM), (const float*)(P.ws + WS_SSQKV)};
      pg8::gemm_phase<EpiKV, pg8::StaticOrder, PG8_ALIGN, PG8_SP2>(lds, g, S, E); }
}
__device__ __forceinline__ void phase3_gemm(const Params& P, LAS unsigned char* lds) {
    { pg8::Gemm g{(const bf16_t*)(P.ws + WS_YCAT), (const bf16_t*)(P.ws + WS_WOUT), T, DM, DM, DM}; pg8::StaticOrder S; S.init(T, DM, (int)gridDim.x, (int)blockIdx.x);
      Epi3 E{P.x, P.out, (bf16_t*)(P.ws + WS_HB)};
      pg8::gemm_phase<Epi3, pg8::StaticOrder, PG8_ALIGN, PG8_SP2>(lds, g, S, E); }
    { pg8::Gemm g{(const bf16_t*)(P.ws + WS_PB), (const bf16_t*)(P.ws + WS_WPLE), T, DM, PLE_DIM, PLE_DIM}; pg8::StaticOrder S; S.init(T, DM, (int)gridDim.x, (int)blockIdx.x);
      EpiStore E{(bf16_t*)(P.ws + WS_PLE), DM};
      pg8::gemm_phase<EpiStore, pg8::StaticOrder, PG8_ALIGN, PG8_SP2>(lds, g, S, E); }
}
__device__ __forceinline__ void phase4_gemm(const Params& P, LAS unsigned char* lds) {
    pg8::Gemm g{(const bf16_t*)(P.ws + WS_HB), (const bf16_t*)(P.ws + WS_WG), T, DM, DM, DM}; pg8::StaticOrder S; S.init(T, DM, (int)gridDim.x, (int)blockIdx.x);
    Epi4 E{P.out, (const bf16_t*)(P.ws + WS_PLE), (float*)(P.ws + WS_SSQF)};
    pg8::gemm_phase<Epi4, pg8::StaticOrder, PG8_ALIGN, PG8_SP2>(lds, g, S, E);
}

namespace att {
typedef short bf16x8 __attribute__((ext_vector_type(8)));
typedef short s16x4 __attribute__((ext_vector_type(4)));
typedef float f32x16 __attribute__((ext_vector_type(16)));
#define SBAR() __builtin_amdgcn_sched_barrier(0)
constexpr float THR = 8.f;
constexpr int BUF_BYTES = 32768, K_OFF = 0, V_OFF = 16384;
constexpr int WS_OFF = 2 * BUF_BYTES;
constexpr int ATT_LDS_BYTES = WS_OFF + 8 * 64 * 4;
__device__ __forceinline__ int crow(int r, int hi) { return (r & 3) + 8 * (r >> 2) + 4 * hi; }
__device__ __forceinline__ unsigned cvtpk(float lo, float hi) { unsigned r; asm volatile("v_cvt_pk_bf16_f32 %0, %1, %2" : "=v"(r) : "v"(lo), "v"(hi)); return r; }

__device__ __forceinline__ void partialSM(f32x16& p0, f32x16& p1, float& m_reg, float& alpha) {
    float pmax = p0[0];
#pragma unroll
    for (int r = 1; r < 16; ++r) pmax = fmaxf(pmax, p0[r]);
#pragma unroll
    for (int r = 0; r < 16; ++r) pmax = fmaxf(pmax, p1[r]);
    { auto rr = __builtin_amdgcn_permlane32_swap(__float_as_uint(pmax), __float_as_uint(pmax), false, false); pmax = fmaxf(__uint_as_float(rr[0]), __uint_as_float(rr[1])); }
    float mn;
    if (__builtin_expect(__all(pmax - m_reg <= THR), 1)) { mn = m_reg; alpha = 1.f; }
    else { mn = fmaxf(m_reg, pmax); alpha = __builtin_amdgcn_exp2f(m_reg - mn); m_reg = mn; }
#pragma unroll
    for (int r = 0; r < 16; ++r) { p0[r] -= mn; p1[r] -= mn; }
#pragma unroll
    for (int r = 0; r < 16; ++r) p0[r] = __builtin_amdgcn_exp2f(p0[r]);
}
__device__ __forceinline__ void finishSM(f32x16& p0, f32x16& p1, float alpha, float& l_reg, bf16x8& pa0, bf16x8& pa1, bf16x8& pa2, bf16x8& pa3) {
#pragma unroll
    for (int r = 0; r < 16; ++r) p1[r] = __builtin_amdgcn_exp2f(p1[r]);
    float ps = 0.f;
#pragma unroll
    for (int r = 0; r < 16; ++r) ps += p0[r];
#pragma unroll
    for (int r = 0; r < 16; ++r) ps += p1[r];
    { auto rr = __builtin_amdgcn_permlane32_swap(__float_as_uint(ps), __float_as_uint(ps), false, false); ps = __uint_as_float(rr[0]) + __uint_as_float(rr[1]); }
    l_reg = l_reg * alpha + ps;
#define PK4(P, BASE, OUT) do { unsigned a0 = cvtpk(P[BASE + 0], P[BASE + 1]), a1 = cvtpk(P[BASE + 2], P[BASE + 3]);   \
    unsigned b0 = cvtpk(P[BASE + 4], P[BASE + 5]), b1 = cvtpk(P[BASE + 6], P[BASE + 7]);                              \
    auto r0 = __builtin_amdgcn_permlane32_swap(a0, b0, false, false); auto r1 = __builtin_amdgcn_permlane32_swap(a1, b1, false, false); \
    u32x4 w = {r0[0], r1[0], r0[1], r1[1]}; OUT = __builtin_bit_cast(bf16x8, w); } while (0)
    PK4(p0, 0, pa0); PK4(p0, 8, pa1); PK4(p1, 0, pa2); PK4(p1, 8, pa3);
#undef PK4
}
__device__ __forceinline__ void cmask(f32x16& p0, f32x16& p1, int jb, int qrel, int hi) {
    const int kb = 64 * jb + 4 * hi;
#pragma unroll
    for (int r = 0; r < 16; ++r) { const int kv = kb + (r & 3) + 8 * (r >> 2); if (kv > qrel) p0[r] = -INFINITY; if (kv + 32 > qrel) p1[r] = -INFINITY; }
}
template <int DQK> __device__ __forceinline__ void qkt(f32x16& p0, f32x16& p1, LAS const unsigned char* kp  , const bf16x8* qr) {
    constexpr int PITCH = 2 * DQK + 16;
    p0 = f32x16{}; p1 = f32x16{};
#pragma unroll
    for (int d0 = 0; d0 < DQK / 16; ++d0) {
        const bf16x8 b0 = *(LAS const bf16x8*)(kp + d0 * 32), b1 = *(LAS const bf16x8*)(kp + 32 * PITCH + d0 * 32);
        p0 = __builtin_amdgcn_mfma_f32_32x32x16_bf16(b0, qr[d0], p0, 0, 0, 0);
        p1 = __builtin_amdgcn_mfma_f32_32x32x16_bf16(b1, qr[d0], p1, 0, 0, 0); }
}
template <int NCB> __device__ __forceinline__ int v_st(int k, int c) { const int kk = (k & ~0xC) | ((k & 4) << 1) | ((k & 8) >> 1); return ((kk >> 3) * NCB + (c >> 5)) * 512 + ((kk & 7) * 32 + (c & 31)) * 2; }
__device__ __forceinline__ int v_rd_base(int lane) { return ((lane & 3) << 3) | (((lane >> 2) & 3) << 6) | (((lane >> 4) & 1) << 5) | (((lane >> 5) & 1) << 8); }
template <int OFF> __device__ __forceinline__ s16x4 tr_read(int vb) { s16x4 r; asm volatile("ds_read_b64_tr_b16 %0, %1 offset:%2" : "=&v"(r) : "v"(vb), "i"(OFF) : "memory"); return r; }
template <int NCB, int D0> __device__ __forceinline__ void pv_one(f32x16& od, int vb, bf16x8 pa0, bf16x8 pa1, bf16x8 pa2, bf16x8 pa3) {
    constexpr int KS = 2 * NCB * 512, HF = NCB * 512, B0 = D0 * 512;
    const s16x4 l0 = tr_read<B0>(vb), h0 = tr_read<B0 + HF>(vb), l1 = tr_read<B0 + KS>(vb), h1 = tr_read<B0 + KS + HF>(vb);
    const s16x4 l2 = tr_read<B0 + 2 * KS>(vb), h2 = tr_read<B0 + 2 * KS + HF>(vb), l3 = tr_read<B0 + 3 * KS>(vb), h3 = tr_read<B0 + 3 * KS + HF>(vb);
    asm volatile("s_waitcnt lgkmcnt(0)" ::: "memory"); SBAR();
#define PK(L, H) (bf16x8){L[0], L[1], L[2], L[3], H[0], H[1], H[2], H[3]}
    od = __builtin_amdgcn_mfma_f32_32x32x16_bf16(pa0, PK(l0, h0), od, 0, 0, 0);
    od = __builtin_amdgcn_mfma_f32_32x32x16_bf16(pa1, PK(l1, h1), od, 0, 0, 0);
    od = __builtin_amdgcn_mfma_f32_32x32x16_bf16(pa2, PK(l2, h2), od, 0, 0, 0);
    od = __builtin_amdgcn_mfma_f32_32x32x16_bf16(pa3, PK(l3, h3), od, 0, 0, 0);
#undef PK
}
template <int NCB> __device__ __forceinline__ void pv_all(f32x16* o, int vb, bf16x8 pa0, bf16x8 pa1, bf16x8 pa2, bf16x8 pa3) {
    pv_one<NCB, 0>(o[0], vb, pa0, pa1, pa2, pa3); pv_one<NCB, 1>(o[1], vb, pa0, pa1, pa2, pa3);
    if constexpr (NCB == 4) { pv_one<NCB, 2>(o[2], vb, pa0, pa1, pa2, pa3); pv_one<NCB, 3>(o[3], vb, pa0, pa1, pa2, pa3); }
}

template <int DQK, int DV, int VP, int KIND>
__device__ __forceinline__ void attn_unit(const bf16_t* Qh, const bf16_t* Kh, const bf16_t* Vh, int qb, bf16_t* OUT, const bf16_t* GATE, LAS unsigned char* lds) {
    constexpr int NCB = DV / 32, NKS = DQK / 16, PITCH = 2 * DQK + 16, NKCH = DQK / 8, KCHUNKS = 64 * NKCH, NKI = (KCHUNKS + NT - 1) / NT, NVI = (64 * DV / 8) / NT;
    const int tid = tid_op(), lane = tid & 63, r32 = lane & 31, hi = lane >> 5; const int wid = __builtin_amdgcn_readfirstlane(tid >> 6);
    LAS float* wsf = (LAS float*)(lds + WS_OFF) + wid * 64; LAS float* li_l = wsf; LAS float* al_l = wsf + 32;
    const int q0 = qb * 256, NTL = (q0 + 256) / 64;
    float m_reg = -1e30f, l_reg = 0.f; f32x16 o[NCB]; bf16x8 qr[NKS];
#pragma unroll
    for (int d = 0; d < NCB; ++d) o[d] = f32x16{};
    { const bf16_t* Qw = Qh + (size_t)(q0 + wid * 32 + r32) * DQK + hi * 8;
#pragma unroll
      for (int d0 = 0; d0 < NKS; ++d0) qr[d0] = *(const bf16x8*)(Qw + d0 * 16); }
    int kgo[NKI], klo[NKI];
#pragma unroll
    for (int i = 0; i < NKI; ++i) { const int id = (tid + i * NT < KCHUNKS) ? tid + i * NT : tid; const int row = id / NKCH, ch = id % NKCH; kgo[i] = row * DQK + ch * 8; klo[i] = K_OFF + row * PITCH + ch * 16; }
    int vgo[NVI], vlo[NVI];
#pragma unroll
    for (int i = 0; i < NVI; ++i) { const int id = tid + i * NT; const int key = id / (DV / 8), c = (id % (DV / 8)) * 8; vgo[i] = key * VP + c; vlo[i] = V_OFF + v_st<NCB>(key, c); }
    bf16x8 ks[2][NKI], vs[2][NVI];
#define SLOAD(sl, t) do { const bf16_t* kt_ = Kh + (size_t)(t) * 64 * DQK; const bf16_t* vt_ = Vh + (size_t)(t) * 64 * VP; \
    _Pragma("unroll") for (int i_ = 0; i_ < NKI; ++i_) ks[sl][i_] = *(const bf16x8*)(kt_ + kgo[i_]); \
    _Pragma("unroll") for (int i_ = 0; i_ < NVI; ++i_) vs[sl][i_] = *(const bf16x8*)(vt_ + vgo[i_]); } while (0)
#define SWRITE(b, sl) do { LAS unsigned char* bb_ = lds + (b) * BUF_BYTES; \
    _Pragma("unroll") for (int i_ = 0; i_ < NKI; ++i_) *(LAS bf16x8*)(bb_ + klo[i_]) = ks[sl][i_]; \
    _Pragma("unroll") for (int i_ = 0; i_ < NVI; ++i_) *(LAS bf16x8*)(bb_ + vlo[i_]) = vs[sl][i_]; } while (0)
#define RESC(a) do { if (__any((a) < 1.f)) { if (hi == 0) al_l[r32] = (a); asm volatile("s_waitcnt lgkmcnt(0)" ::: "memory"); \
    _Pragma("unroll") for (int d_ = 0; d_ < NCB; ++d_) _Pragma("unroll") for (int r_ = 0; r_ < 16; ++r_) o[d_][r_] *= al_l[crow(r_, hi)]; } } while (0)
#define CMASK(P0, P1, t) do { const int jb_ = (t) - (NTL - 4); if (jb_ >= 0) cmask(P0, P1, jb_, qrel, hi); } while (0)
    LAS const unsigned char* kp0 = lds + K_OFF + r32 * PITCH + hi * 16; LAS const unsigned char* kp1 = kp0 + BUF_BYTES;
    const int vb0 = (int)(uintptr_t)(lds + V_OFF) + v_rd_base(lane), vb1 = vb0 + BUF_BYTES;
    const int qrel = wid * 32 + r32;
    f32x16 pA0, pA1, pB0, pB1; float alA, alB; bf16x8 pa0, pa1, pa2, pa3;
    SLOAD(0, 0); SWRITE(0, 0); __syncthreads();
    qkt<DQK>(pA0, pA1, kp0, qr); CMASK(pA0, pA1, 0); partialSM(pA0, pA1, m_reg, alA);
    SLOAD(1, 1); SLOAD(0, 2);
    SWRITE(1, 1); __syncthreads();
#pragma unroll 1
    for (int j = 1; j + 1 < NTL; j += 2) {
        SBAR(); qkt<DQK>(pB0, pB1, kp1, qr);
        finishSM(pA0, pA1, alA, l_reg, pa0, pa1, pa2, pa3); SBAR();
        SLOAD(1, j + 2); SBAR();
        pv_all<NCB>(o, vb0, pa0, pa1, pa2, pa3); CMASK(pB0, pB1, j); partialSM(pB0, pB1, m_reg, alB);
        __syncthreads(); SWRITE(0, 0);
        RESC(alB); __syncthreads();
        SBAR(); qkt<DQK>(pA0, pA1, kp0, qr);
        finishSM(pB0, pB1, alB, l_reg, pa0, pa1, pa2, pa3); SBAR();
        if (j + 3 < NTL) SLOAD(0, j + 3); SBAR();
        pv_all<NCB>(o, vb1, pa0, pa1, pa2, pa3); CMASK(pA0, pA1, j + 1); partialSM(pA0, pA1, m_reg, alA);
        __syncthreads(); SWRITE(1, 1);
        RESC(alA); __syncthreads();
    }
    SBAR(); qkt<DQK>(pB0, pB1, kp1, qr);
    finishSM(pA0, pA1, alA, l_reg, pa0, pa1, pa2, pa3); SBAR();
    pv_all<NCB>(o, vb0, pa0, pa1, pa2, pa3); CMASK(pB0, pB1, NTL - 1); partialSM(pB0, pB1, m_reg, alB);
    RESC(alB);
    finishSM(pB0, pB1, alB, l_reg, pa0, pa1, pa2, pa3); SBAR();
    pv_all<NCB>(o, vb1, pa0, pa1, pa2, pa3);
    if (hi == 0) li_l[r32] = l_reg; asm volatile("s_waitcnt lgkmcnt(0)" ::: "memory");
    float rli[16];
#pragma unroll
    for (int r = 0; r < 16; ++r) rli[r] = __builtin_amdgcn_rcpf(li_l[crow(r, hi)]);
    __syncthreads();
    LAS bf16_t* stg = (LAS bf16_t*)(lds + wid * 8192);
#pragma unroll
    for (int r = 0; r < 16; ++r) { const int orow = crow(r, hi);
#pragma unroll
        for (int d0 = 0; d0 < NCB; ++d0) stg[orow * DV + d0 * 32 + r32] = (bf16_t)f2bf(o[d0][r] * rli[r]); }
    asm volatile("s_waitcnt lgkmcnt(0)" ::: "memory");
    constexpr int CPR = DV / 8;
#pragma unroll
    for (int i = 0; i < (32 * CPR) / 64; ++i) { const int id = i * 64 + lane, row = id / CPR, ch = id % CPR; u32x4 v = *(LAS const u32x4*)(stg + row * DV + ch * 8);
        const size_t ro = (size_t)(q0 + wid * 32 + row);
        if constexpr (KIND == 0) { *(u32x4*)(OUT + ro * 128 + ch * 8) = v; }
        else { const u32x4 g = *(const u32x4*)(GATE + ro * 1024 + ch * 8); u32x4 w;
            w.x = cvtpk(__uint_as_float(v.x << 16) * __uint_as_float(g.x << 16), __uint_as_float(v.x & 0xffff0000u) * __uint_as_float(g.x & 0xffff0000u));
            w.y = cvtpk(__uint_as_float(v.y << 16) * __uint_as_float(g.y << 16), __uint_as_float(v.y & 0xffff0000u) * __uint_as_float(g.y & 0xffff0000u));
            w.z = cvtpk(__uint_as_float(v.z << 16) * __uint_as_float(g.z << 16), __uint_as_float(v.z & 0xffff0000u) * __uint_as_float(g.z & 0xffff0000u));
            w.w = cvtpk(__uint_as_float(v.w << 16) * __uint_as_float(g.w << 16), __uint_as_float(v.w & 0xffff0000u) * __uint_as_float(g.w & 0xffff0000u));
            *(u32x4*)(OUT + ro * 1024 + ch * 8) = w; } }
    asm volatile("s_waitcnt lgkmcnt(0)" ::: "memory");
    __syncthreads();
#undef SLOAD
#undef SWRITE
#undef RESC
#undef CMASK
}
#undef SBAR
}

__device__ __forceinline__ void phase2_mfma(const Params& P, LAS unsigned char* lds) {
    const bf16_t* QD = (const bf16_t*)(P.ws + WS_QD); const bf16_t* KD = (const bf16_t*)(P.ws + WS_KD); const bf16_t* VD = (const bf16_t*)(P.ws + WS_VD);
    const bf16_t* QM = (const bf16_t*)(P.ws + WS_QM); const bf16_t* KM = (const bf16_t*)(P.ws + WS_KM); const bf16_t* VM = (const bf16_t*)(P.ws + WS_VM);
    const bf16_t* G = (const bf16_t*)(P.ws + WS_G); bf16_t* OD = (bf16_t*)(P.ws + WS_OD); bf16_t* YC = (bf16_t*)(P.ws + WS_YCAT);
    const int Gn = (int)gridDim.x, bx = (int)blockIdx.x, vcu = (Gn % 8 == 0) ? (bx % 8) * (Gn / 8) + bx / 8 : bx;
#pragma unroll 1
    for (int pr = vcu; pr < 1024; pr += Gn) {
        const int kind = pr >> 9, rem = pr & 511, bh = rem >> 3, sidx = rem & 7, b = bh >> 3, hh = bh & 7;
#pragma unroll 1
        for (int half = 0; half < 2; ++half) {
            const int qb = half == 0 ? 15 - sidx : sidx;
            if (kind == 0) att::attn_unit<64, 128, 128, 0>(QD + (size_t)bh * SEQ * 64, KD + (size_t)bh * SEQ * 64, VD + (size_t)(b * 4 + (hh >> 1)) * SEQ * 128, qb, OD + (size_t)bh * SEQ * 128, nullptr, lds);
            else att::attn_unit<96, 64, 64, 1>(QM + (size_t)bh * SEQ * 96, KM + (size_t)bh * SEQ * 96, VM + (size_t)bh * SEQ * 64, qb, YC + (size_t)b * SEQ * 1024 + 512 + hh * 64, G + (size_t)b * SEQ * 1024 + 512 + hh * 64, lds);
        }
    }
}

#ifndef OPT_P1
#define OPT_P1 1
#endif
#ifndef OPT_P2
#define OPT_P2 1
#endif
#ifndef OPT_P15
#define OPT_P15 1
#endif
#ifndef OPT_P3
#define OPT_P3 1
#endif
#ifndef OPT_P4
#define OPT_P4 1
#endif
constexpr int LDS_BYTES = 147456;
__global__ void __launch_bounds__(NT, 2) fwd_megakernel(Params P) {
    extern __shared__ __attribute__((aligned(16))) unsigned char lds_raw[];
    LAS unsigned char* lds = (LAS unsigned char*)lds_raw;
    float* smem = (float*)lds_raw;
    cg::grid_group grid = cg::this_grid();
    const int bid = blockIdx.x, nb = gridDim.x;
    phase0(P, bid, nb);
    phase0_weights(P, bid, nb, lds);
    grid.sync();
#if OPT_P1
    phase1_gemm(P, lds);
#else
    phase1_naive(P, bid, nb, smem);
#endif
    grid.sync();
#if OPT_P15
    phase15_gemm(P, lds);
#else
    phase15_naive(P, bid, nb, smem);
#endif
    grid.sync();
#if OPT_P2
    phase2_mfma(P, lds);
#else
    phase2_naive(P, bid, nb, smem);
#endif
    grid.sync();
    phase25_naive(P, bid, nb);
    grid.sync();
#if OPT_P3
    phase3_gemm(P, lds);
#else
    phase3_naive(P, bid, nb, smem);
#endif
    grid.sync();
#if OPT_P4
    phase4_gemm(P, lds);
#else
    phase4_naive(P, bid, nb, smem);
#endif
    grid.sync();
    phase5(P, bid, nb);
}

extern "C" void kernel_launch(void* const* d_in, const int* in_sizes, int n_in, void* d_out, int out_size, void* d_ws, size_t ws_size, hipStream_t stream) {
    if (n_in != 15 || out_size != T * DM || ws_size < WS_END) { fprintf(stderr, "kernel_launch: unexpected shapes (n_in %d out %d ws %zu)\n", n_in, out_size, ws_size); return; }
    static int grid_blocks = 0;
    if (!grid_blocks) {
        int dev = 0, cus = 0, per_cu = 0;
        (void)hipGetDevice(&dev);
        (void)hipDeviceGetAttribute(&cus, hipDeviceAttributeMultiprocessorCount, dev);
        if (hipFuncSetAttribute((const void*)fwd_megakernel, hipFuncAttributeMaxDynamicSharedMemorySize, LDS_BYTES) != hipSuccess) { fprintf(stderr, "kernel_launch: hipFuncSetAttribute failed\n"); return; }
        if (hipOccupancyMaxActiveBlocksPerMultiprocessor(&per_cu, (const void*)fwd_megakernel, NT, LDS_BYTES) != hipSuccess || per_cu < 1) { fprintf(stderr, "kernel_launch: occupancy query says %d blocks/CU\n", per_cu); return; }
        grid_blocks = cus;
    }
    Params P{};
    P.x = (const float*)d_in[0]; P.p = (const float*)d_in[1]; P.pos = (const int*)d_in[2]; P.norm_g = (const float*)d_in[3]; P.w_in = (const float*)d_in[4];
    P.diff_lambda = (const float*)d_in[5]; P.subln_g = (const float*)d_in[6]; P.qn_g = (const float*)d_in[7]; P.w_uq = (const float*)d_in[8]; P.kvn_g = (const float*)d_in[9];
    P.w_ukv = (const float*)d_in[10]; P.w_out = (const float*)d_in[11]; P.w_ple = (const float*)d_in[12]; P.w_gate = (const float*)d_in[13]; P.final_g = (const float*)d_in[14];
    P.out = (float*)d_out; P.ws = (unsigned char*)d_ws;
    void* args[] = {&P};
    hipError_t e = hipLaunchCooperativeKernel((void*)fwd_megakernel, dim3(grid_blocks), dim3(NT), args, LDS_BYTES, stream);
    if (e != hipSuccess) fprintf(stderr, "cooperative launch failed: %s (grid %d)\n", hipGetErrorString(e), grid_blocks);
}
```

```cpp
#include <hip/hip_runtime.h>
#include <hip/hip_cooperative_groups.h>
#include <cstdio>
#include <cstdint>

namespace cg = cooperative_groups;
typedef unsigned short bf16_t;

constexpr int BATCH = 8, SEQ = 4096, T = BATCH * SEQ, DM = 1024, DIN = 3104, PLE_DIM = 256;
constexpr int OFF_DQ = 0, OFF_DK = 512, OFF_DV = 1024, OFF_DG = 1536, OFF_CQ = 2048, OFF_CKV = 2432, OFF_KR = 2560, OFF_MG = 2592;
constexpr int QLORA = 384, KVLORA = 128, CQP = 512;
constexpr float RMS_EPS = 1e-6f;
constexpr float LOG2E = 1.4426950408889634f;
constexpr float C2D = 0.125f * LOG2E;
constexpr float C2M = 0.10206207261596575f * LOG2E;
constexpr float LAM_INIT = 0.2f;
constexpr int NT = 512;

constexpr size_t MiB = 1u << 20;
constexpr size_t WS_CTL = 0;
constexpr size_t WS_MISC = 1 * MiB;
constexpr size_t WS_SSQQ = 1 * MiB + 65536, WS_SSQKV = WS_SSQQ + 131072, WS_SSQF = WS_SSQKV + 131072;
constexpr size_t WS_CSA = 2 * MiB, WS_CSB = 10 * MiB;
constexpr size_t WS_WIN = 14 * MiB, WS_WPLE = 21 * MiB, WS_WUQ = 22 * MiB, WS_WUKV = 23 * MiB, WS_WOUT = 24 * MiB, WS_WG = 26 * MiB;
constexpr size_t WS_PB = 28 * MiB, WS_CQ = 44 * MiB  , WS_XN = 76 * MiB, WS_OD = WS_XN;
constexpr size_t WS_QD = 140 * MiB, WS_KD = 172 * MiB, WS_PLE = WS_QD, WS_VD = 204 * MiB, WS_G = 236 * MiB, WS_HB = WS_G;
constexpr size_t WS_QM = 300 * MiB, WS_KM = 348 * MiB, WS_VM = 396 * MiB, WS_YCAT = 428 * MiB, WS_END = 492 * MiB;

struct Params {
    const float* x; const float* p; const int* pos; const float* norm_g; const float* w_in; const float* diff_lambda;
    const float* subln_g; const float* qn_g; const float* w_uq; const float* kvn_g; const float* w_ukv; const float* w_out;
    const float* w_ple; const float* w_gate; const float* final_g; float* out; unsigned char* ws;
};

__device__ __forceinline__ unsigned f2bf(float f) { unsigned u = __float_as_uint(f); return (u + 0x7fffu + ((u >> 16) & 1u)) >> 16; }
__device__ __forceinline__ float bf2f(bf16_t h) { return __uint_as_float(((unsigned)h) << 16); }
__device__ __forceinline__ float wave_sum(float v) {
#pragma unroll
    for (int o = 1; o < 64; o <<= 1) v += __shfl_xor(v, o);
    return v;
}
__device__ __forceinline__ int tid_op() { int t = threadIdx.x; asm volatile("" : "+v"(t)); return t; }
__device__ __forceinline__ int sgpr_op(int v) { asm volatile("" : "+s"(v)); return v; }
__device__ __forceinline__ float silu_f(float v) { return v / (1.f + __expf(-v)); }
__device__ __forceinline__ float sigmoid_f(float v) { return 1.f / (1.f + __expf(-v)); }

__device__ __forceinline__ void phase0(const Params& P, int bid, int nb) {
    bid = sgpr_op(bid); nb = sgpr_op(nb);
    const int tid = tid_op(), lane = tid & 63, wave = tid >> 6;
    const int gw = bid * (NT / 64) + wave, ngw = nb * (NT / 64);
    const int gt = bid * NT + tid, ngt = nb * NT;
    bf16_t* XN = (bf16_t*)(P.ws + WS_XN);
    for (int t = gw; t < T; t += ngw) {
        const float4* xr = (const float4*)(P.x + (size_t)t * DM);
        float4 v[4]; float s = 0.f;
#pragma unroll
        for (int j = 0; j < 4; ++j) { v[j] = xr[lane + 64 * j]; s += v[j].x * v[j].x + v[j].y * v[j].y + v[j].z * v[j].z + v[j].w * v[j].w; }
        s = wave_sum(s);
        const float rstd = 1.0f / sqrtf(s * (1.f / DM) + RMS_EPS);
#pragma unroll
        for (int j = 0; j < 4; ++j) {
            const float4 g = ((const float4*)P.norm_g)[lane + 64 * j];
            uint2 o; o.x = f2bf(v[j].x * rstd * g.x) | (f2bf(v[j].y * rstd * g.y) << 16); o.y = f2bf(v[j].z * rstd * g.z) | (f2bf(v[j].w * rstd * g.w) << 16);
            ((uint2*)(XN + (size_t)t * DM))[lane + 64 * j] = o;
        }
    }
    bf16_t* PB = (bf16_t*)(P.ws + WS_PB);
    for (int i = gt; i < T * PLE_DIM / 4; i += ngt) {
        const float4 v = ((const float4*)P.p)[i];
        uint2 o; o.x = f2bf(v.x) | (f2bf(v.y) << 16); o.y = f2bf(v.z) | (f2bf(v.w) << 16);
        ((uint2*)PB)[i] = o;
    }
    float2* CSA = (float2*)(P.ws + WS_CSA); float2* CSB = (float2*)(P.ws + WS_CSB);
    for (int i = gt; i < T * 32; i += ngt) {
        const int t = i >> 5, k = i & 31;
        const double inv = pow(10000.0, -(double)k / 32.0);
        const double ang = (double)P.pos[t] * inv;
        double sn, cs; sincos(ang, &sn, &cs);
        CSA[i] = make_float2((float)cs, (float)sn);
    }
    for (int i = gt; i < T * 16; i += ngt) {
        const int t = i >> 4, k = i & 15;
        const double inv = pow(10000.0, -(double)k / 16.0);
        const double ang = (double)P.pos[t] * inv;
        double sn, cs; sincos(ang, &sn, &cs);
        CSB[i] = make_float2((float)cs, (float)sn);
    }
    float* ssq = (float*)(P.ws + WS_SSQQ);
    for (int i = gt; i < 3 * T; i += ngt) ssq[i] = 0.f;
    if (bid == 0 && tid == 0) {
        float s1 = 0.f, s2 = 0.f;
        for (int i = 0; i < 64; ++i) { s1 += P.diff_lambda[i] * P.diff_lambda[64 + i]; s2 += P.diff_lambda[128 + i] * P.diff_lambda[192 + i]; }
        ((float*)(P.ws + WS_MISC))[0] = expf(s1) - expf(s2) + LAM_INIT;
    }
}

constexpr int NG_SMEM_FLOATS = 16 * 129 + 16 * 65 + 128 * 65;
__device__ __forceinline__ void ngemm_tile(const bf16_t* A, int lda, int row0, const float* W, int ldw, int col0, int ncol, int K, const float* kscale, float* smem) {
    float* As = smem; float* Bs = smem + 16 * 129; float* Cs = Bs + 16 * 65;
    const int tid = tid_op(), ty = tid >> 4, tx = tid & 15;
    float acc[4][4];
#pragma unroll
    for (int i = 0; i < 4; ++i)
#pragma unroll
        for (int j = 0; j < 4; ++j) acc[i][j] = 0.f;
#pragma unroll 1
    for (int k0 = 0; k0 < K; k0 += 16) {
        __syncthreads();
#pragma unroll
        for (int i = 0; i < 4; ++i) { const int idx = tid + i * NT, r = idx >> 4, kk = idx & 15; As[kk * 129 + r] = bf2f(A[(size_t)(row0 + r) * lda + k0 + kk]); }
#pragma unroll
        for (int i = 0; i < 2; ++i) { const int idx = tid + i * NT, kk = idx >> 6, c = idx & 63;
            float w = 0.f; if (c < ncol) { w = W[(size_t)(k0 + kk) * ldw + col0 + c]; if (kscale) w *= kscale[k0 + kk]; }
            Bs[kk * 65 + c] = w; }
        __syncthreads();
#pragma unroll
        for (int kk = 0; kk < 16; ++kk) {
            float a[4], b[4];
#pragma unroll
            for (int i = 0; i < 4; ++i) a[i] = As[kk * 129 + ty * 4 + i];
#pragma unroll
            for (int j = 0; j < 4; ++j) b[j] = Bs[kk * 65 + tx * 4 + j];
#pragma unroll
            for (int i = 0; i < 4; ++i)
#pragma unroll
                for (int j = 0; j < 4; ++j) acc[i][j] += a[i] * b[j];
        }
    }
    __syncthreads();
#pragma unroll
    for (int i = 0; i < 4; ++i)
#pragma unroll
        for (int j = 0; j < 4; ++j) Cs[(ty * 4 + i) * 65 + tx * 4 + j] = acc[i][j];
    __syncthreads();
}

__device__ __forceinline__ void phase1_naive(const Params& P, int bid, int nb, float* smem) {
    bid = sgpr_op(bid); nb = sgpr_op(nb);
    const int tid = tid_op();
    const bf16_t* XN = (const bf16_t*)(P.ws + WS_XN);
    bf16_t* QD = (bf16_t*)(P.ws + WS_QD); bf16_t* KD = (bf16_t*)(P.ws + WS_KD); bf16_t* VD = (bf16_t*)(P.ws + WS_VD); bf16_t* G = (bf16_t*)(P.ws + WS_G);
    bf16_t* CQ = (bf16_t*)(P.ws + WS_CQ); bf16_t* KM = (bf16_t*)(P.ws + WS_KM);
    float* SSQQ = (float*)(P.ws + WS_SSQQ); float* SSQKV = (float*)(P.ws + WS_SSQKV);
    const float2* CSA = (const float2*)(P.ws + WS_CSA); const float2* CSB = (const float2*)(P.ws + WS_CSB);
    float* Cs = smem + 16 * 129 + 16 * 65;
    constexpr int NCT = 49, NRT = T / 128;
    for (int item = bid; item < NCT * NRT; item += nb) {
        const int ct = item % NCT, rt = item / NCT, row0 = rt * 128;
        int col0, ncol = 64;
        if (ct < 40) col0 = ct * 64; else if (ct == 40) { col0 = OFF_KR; ncol = 32; } else col0 = OFF_MG + (ct - 41) * 64;
        ngemm_tile(XN, DM, row0, P.w_in, DIN, col0, ncol, DM, nullptr, smem);
        _Pragma("unroll 1") for (int e = tid; e < 128 * 64; e += NT) {
            const int r = e >> 6, c = e & 63, t = row0 + r, b = t / SEQ, s = t % SEQ;
            const float v = Cs[r * 65 + c];
            if (col0 < OFF_DV) {
                const int i = c & 31; const float x1 = Cs[r * 65 + i], x2 = Cs[r * 65 + i + 32]; const float2 cs = CSA[(size_t)t * 32 + i];
                const float o = (c < 32) ? (x1 * cs.x - x2 * cs.y) : (x2 * cs.x + x1 * cs.y);
                if (col0 < OFF_DK) { const int mh = col0 / 64; QD[((size_t)(b * 8 + mh) * SEQ + s) * 64 + c] = (bf16_t)f2bf(o * C2D); }
                else { const int mh = (col0 - OFF_DK) / 64; KD[((size_t)(b * 8 + mh) * SEQ + s) * 64 + c] = (bf16_t)f2bf(o); }
            } else if (col0 < OFF_DG) { const int col = col0 - OFF_DV + c, h = col >> 7, d = col & 127; VD[((size_t)(b * 4 + h) * SEQ + s) * 128 + d] = (bf16_t)f2bf(v); }
            else if (col0 < OFF_CQ) { const int col = col0 - OFF_DG + c; G[(size_t)t * 1024 + col] = (bf16_t)f2bf(silu_f(v)); }
            else if (col0 < OFF_CKV) { const int col = col0 - OFF_CQ + c; CQ[(size_t)t * CQP + col] = (bf16_t)f2bf(v); }
            else if (col0 < OFF_KR) { const int col = col0 - OFF_CKV + c; CQ[(size_t)t * CQP + QLORA + col] = (bf16_t)f2bf(v); }
            else if (col0 == OFF_KR) { if (c < 32) { const int i = c & 15; const float x1 = Cs[r * 65 + i], x2 = Cs[r * 65 + i + 16]; const float2 cs = CSB[(size_t)t * 16 + i];
                    const float o = (c < 16) ? (x1 * cs.x - x2 * cs.y) : (x2 * cs.x + x1 * cs.y);
                    for (int h = 0; h < 8; ++h) KM[((size_t)(b * 8 + h) * SEQ + s) * 96 + 64 + c] = (bf16_t)f2bf(o); } }
            else { const int col = col0 - OFF_MG + c; G[(size_t)t * 1024 + 512 + col] = (bf16_t)f2bf(silu_f(v)); }
        }
        if (col0 >= OFF_CQ && col0 < OFF_KR && tid < 128) {
            float s = 0.f; _Pragma("unroll 4") for (int c = 0; c < 64; ++c) { const float v = Cs[tid * 65 + c]; s += v * v; }
            atomicAdd((col0 < OFF_CKV ? SSQQ : SSQKV) + row0 + tid, s);
        }
    }
}

__device__ __forceinline__ void phase15_naive(const Params& P, int bid, int nb, float* smem) {
    bid = sgpr_op(bid); nb = sgpr_op(nb);
    const int tid = tid_op();
    const bf16_t* CQ = (const bf16_t*)(P.ws + WS_CQ); const bf16_t* CKV = CQ + QLORA;
    bf16_t* QM = (bf16_t*)(P.ws + WS_QM); bf16_t* KM = (bf16_t*)(P.ws + WS_KM); bf16_t* VM = (bf16_t*)(P.ws + WS_VM);
    const float* SSQQ = (const float*)(P.ws + WS_SSQQ); const float* SSQKV = (const float*)(P.ws + WS_SSQKV);
    const float2* CSB = (const float2*)(P.ws + WS_CSB);
    float* Cs = smem + 16 * 129 + 16 * 65;
    constexpr int NCT = 12 + 16, NRT = T / 128;
    for (int item = bid; item < NCT * NRT; item += nb) {
        const int ct = item % NCT, rt = item / NCT, row0 = rt * 128;
        if (ct < 12) {
            const int col0 = ct * 64;
            ngemm_tile(CQ, CQP, row0, P.w_uq, 768, col0, 64, QLORA, P.qn_g, smem);
            _Pragma("unroll 1") for (int e = tid; e < 128 * 64; e += NT) {
                const int r = e >> 6, c = e & 63, t = row0 + r, b = t / SEQ, s = t % SEQ, col = col0 + c, h = col / 96, j = col % 96;
                const float rstd = 1.0f / sqrtf(SSQQ[t] * (1.f / QLORA) + RMS_EPS);
                float o;
                if (j < 64) o = Cs[r * 65 + c];
                else { const int jj = j - 64, i = jj & 15, cb = c - jj; const float x1 = Cs[r * 65 + cb + i], x2 = Cs[r * 65 + cb + i + 16]; const float2 cs = CSB[(size_t)t * 16 + i];
                    o = (jj < 16) ? (x1 * cs.x - x2 * cs.y) : (x2 * cs.x + x1 * cs.y); }
                QM[((size_t)(b * 8 + h) * SEQ + s) * 96 + j] = (bf16_t)f2bf(o * rstd * C2M);
            }
        } else {
            const int col0 = (ct - 12) * 64;
            ngemm_tile(CKV, CQP, row0, P.w_ukv, 1024, col0, 64, KVLORA, P.kvn_g, smem);
            _Pragma("unroll 1") for (int e = tid; e < 128 * 64; e += NT) {
                const int r = e >> 6, c = e & 63, t = row0 + r, b = t / SEQ, s = t % SEQ, col = col0 + c, h = col >> 7, j = col & 127;
                const float rstd = 1.0f / sqrtf(SSQKV[t] * (1.f / KVLORA) + RMS_EPS);
                const float o = Cs[r * 65 + c] * rstd;
                if (j < 64) KM[((size_t)(b * 8 + h) * SEQ + s) * 96 + j] = (bf16_t)f2bf(o);
                else VM[((size_t)(b * 8 + h) * SEQ + s) * 64 + j - 64] = (bf16_t)f2bf(o);
            }
        }
    }
}

template <int DQK, int DV, int DVS>
__device__ __forceinline__ void nattn_rows(const bf16_t* Qh, const bf16_t* Kh, const bf16_t* Vh, int q0, float* o, float& l_out, unsigned* smem) {
    const int tid = tid_op(), i = q0 + tid;
    unsigned* Ks = smem; unsigned* Vs = smem + 32 * (DQK / 2);
    unsigned q2[DQK / 2];
#pragma unroll
    for (int d = 0; d < DQK / 2; ++d) q2[d] = ((const unsigned*)(Qh + (size_t)i * DQK))[d];
#pragma unroll
    for (int d = 0; d < DV; ++d) o[d] = 0.f;
    float m = -1e30f, l = 0.f;
    const int jend = q0 + NT;
#pragma unroll 1
    for (int j0 = 0; j0 < jend; j0 += 32) {
        __syncthreads();
        for (int idx = tid; idx < 32 * (DQK / 2); idx += NT) Ks[idx] = ((const unsigned*)(Kh + (size_t)j0 * DQK))[idx];
        for (int idx = tid; idx < 32 * (DV / 2); idx += NT) { const int r = idx / (DV / 2), c = idx % (DV / 2); Vs[idx] = ((const unsigned*)(Vh + (size_t)(j0 + r) * DVS))[c]; }
        __syncthreads();
#pragma unroll 1
        for (int jj = 0; jj < 32; jj += 2) {
            float sc[2];
#pragma unroll
            for (int k = 0; k < 2; ++k) {
                const unsigned* kr = Ks + (jj + k) * (DQK / 2); float s = 0.f;
#pragma unroll
                for (int d = 0; d < DQK / 2; ++d) { const unsigned kk = kr[d]; unsigned qq = q2[d]; asm volatile("" : "+v"(qq));
                    s += __uint_as_float(qq << 16) * __uint_as_float(kk << 16); s += __uint_as_float(qq & 0xffff0000u) * __uint_as_float(kk & 0xffff0000u); }
                sc[k] = (j0 + jj + k <= i) ? s : -1e30f;
                asm volatile("" : "+v"(sc[k]));
            }
            const float mn = fmaxf(fmaxf(sc[0], sc[1]), m);
            const float alpha = exp2f(m - mn);
            float pr[2];
#pragma unroll
            for (int k = 0; k < 2; ++k) pr[k] = (j0 + jj + k <= i) ? exp2f(sc[k] - mn) : 0.f;
            l = l * alpha + (pr[0] + pr[1]); m = mn;
#pragma unroll
            for (int d = 0; d < DV; ++d) o[d] *= alpha;
#pragma unroll
            for (int k = 0; k < 2; ++k) { const unsigned* vr = Vs + (jj + k) * (DV / 2);
#pragma unroll
                for (int d = 0; d < DV / 2; ++d) { const unsigned vv = vr[d]; o[2 * d] += pr[k] * __uint_as_float(vv << 16); o[2 * d + 1] += pr[k] * __uint_as_float(vv & 0xffff0000u); } }
        }
    }
    l_out = l;
}
__device__ __forceinline__ void phase2_naive(const Params& P, int bid, int nb, float* smemf) {
    bid = sgpr_op(bid); nb = sgpr_op(nb);
    unsigned* smem = (unsigned*)smemf;
    const bf16_t* QD = (const bf16_t*)(P.ws + WS_QD); const bf16_t* KD = (const bf16_t*)(P.ws + WS_KD); const bf16_t* VD = (const bf16_t*)(P.ws + WS_VD);
    const bf16_t* QM = (const bf16_t*)(P.ws + WS_QM); const bf16_t* KM = (const bf16_t*)(P.ws + WS_KM); const bf16_t* VM = (const bf16_t*)(P.ws + WS_VM);
    const bf16_t* G = (const bf16_t*)(P.ws + WS_G); bf16_t* OD = (bf16_t*)(P.ws + WS_OD); bf16_t* YC = (bf16_t*)(P.ws + WS_YCAT);
    constexpr int NCH = SEQ / NT;
    for (int item = bid; item < 2 * 64 * NCH; item += nb) {
        const int kind = item / (64 * NCH), rem = item % (64 * NCH), bh = rem / NCH, ch = NCH - 1 - rem % NCH, q0 = ch * NT, b = bh >> 3, hh = bh & 7;
        const int i = q0 + tid_op();
        if (kind == 0) {
#pragma unroll 1
            for (int half = 0; half < 2; ++half) {
                float o[64], l;
                nattn_rows<64, 64, 128>(QD + (size_t)bh * SEQ * 64, KD + (size_t)bh * SEQ * 64, VD + (size_t)(b * 4 + (hh >> 1)) * SEQ * 128 + half * 64, q0, o, l, smem);
                const float rl = 1.f / l;
#pragma unroll
                for (int d = 0; d < 64; ++d) OD[((size_t)bh * SEQ + i) * 128 + half * 64 + d] = (bf16_t)f2bf(o[d] * rl);
            }
        } else {
            float o[64], l;
            nattn_rows<96, 64, 64>(QM + (size_t)bh * SEQ * 96, KM + (size_t)bh * SEQ * 96, VM + (size_t)bh * SEQ * 64, q0, o, l, smem);
            const float rl = 1.f / l; const size_t t = (size_t)b * SEQ + i;
#pragma unroll
            for (int d = 0; d < 64; ++d) { const size_t idx = t * 1024 + 512 + hh * 64 + d; YC[idx] = (bf16_t)f2bf(o[d] * rl * bf2f(G[idx])); }
        }
    }
}

__device__ __forceinline__ void phase25_naive(const Params& P, int bid, int nb) {
    bid = sgpr_op(bid); nb = sgpr_op(nb);
    const bf16_t* OD = (const bf16_t*)(P.ws + WS_OD); const bf16_t* G = (const bf16_t*)(P.ws + WS_G); bf16_t* YC = (bf16_t*)(P.ws + WS_YCAT);
    const float lam = ((const float*)(P.ws + WS_MISC))[0];
    const int tid = tid_op(), lane = tid & 63, wave = tid >> 6;
    const int gw = bid * (NT / 64) + wave, ngw = nb * (NT / 64);
    for (int it = gw; it < T * 4; it += ngw) {
        const int t = it >> 2, h = it & 3, b = t / SEQ, s = t % SEQ;
        const bf16_t* o0 = OD + ((size_t)(b * 8 + 2 * h) * SEQ + s) * 128; const bf16_t* o1 = OD + ((size_t)(b * 8 + 2 * h + 1) * SEQ + s) * 128;
        const float d0 = bf2f(o0[lane]) - lam * bf2f(o1[lane]), d1 = bf2f(o0[lane + 64]) - lam * bf2f(o1[lane + 64]);
        const float ss = wave_sum(d0 * d0 + d1 * d1);
        const float rstd = 1.0f / sqrtf(ss * (1.f / 128.f) + RMS_EPS);
        const size_t base = (size_t)t * 1024 + h * 128;
        YC[base + lane] = (bf16_t)f2bf(d0 * rstd * P.subln_g[lane] * (1.f - LAM_INIT) * bf2f(G[base + lane]));
        YC[base + lane + 64] = (bf16_t)f2bf(d1 * rstd * P.subln_g[lane + 64] * (1.f - LAM_INIT) * bf2f(G[base + lane + 64]));
    }
}

__device__ __forceinline__ void phase3_naive(const Params& P, int bid, int nb, float* smem) {
    bid = sgpr_op(bid); nb = sgpr_op(nb);
    const int tid = tid_op();
    const bf16_t* YC = (const bf16_t*)(P.ws + WS_YCAT); const bf16_t* PB = (const bf16_t*)(P.ws + WS_PB);
    bf16_t* HB = (bf16_t*)(P.ws + WS_HB); bf16_t* PLE = (bf16_t*)(P.ws + WS_PLE);
    float* Cs = smem + 16 * 129 + 16 * 65;
    constexpr int NRT = T / 128;
    for (int item = bid; item < 32 * NRT; item += nb) {
        const int ct = item % 32, rt = item / 32, row0 = rt * 128, col0 = (ct & 15) * 64;
        if (ct < 16) {
            ngemm_tile(YC, DM, row0, P.w_out, DM, col0, 64, DM, nullptr, smem);
            _Pragma("unroll 1") for (int e = tid; e < 128 * 64; e += NT) { const int r = e >> 6, c = e & 63; const size_t idx = (size_t)(row0 + r) * DM + col0 + c;
                const float h = P.x[idx] + Cs[r * 65 + c]; P.out[idx] = h; HB[idx] = (bf16_t)f2bf(h); }
        } else {
            ngemm_tile(PB, PLE_DIM, row0, P.w_ple, DM, col0, 64, PLE_DIM, nullptr, smem);
            _Pragma("unroll 1") for (int e = tid; e < 128 * 64; e += NT) { const int r = e >> 6, c = e & 63; const size_t idx = (size_t)(row0 + r) * DM + col0 + c; PLE[idx] = (bf16_t)f2bf(Cs[r * 65 + c]); }
        }
    }
}
__device__ __forceinline__ void phase4_naive(const Params& P, int bid, int nb, float* smem) {
    bid = sgpr_op(bid); nb = sgpr_op(nb);
    const int tid = tid_op();
    const bf16_t* HB = (const bf16_t*)(P.ws + WS_HB); const bf16_t* PLE = (const bf16_t*)(P.ws + WS_PLE); float* SSQF = (float*)(P.ws + WS_SSQF);
    float* Cs = smem + 16 * 129 + 16 * 65;
    constexpr int NRT = T / 128;
    for (int item = bid; item < 16 * NRT; item += nb) {
        const int ct = item % 16, rt = item / 16, row0 = rt * 128, col0 = ct * 64;
        ngemm_tile(HB, DM, row0, P.w_gate, DM, col0, 64, DM, nullptr, smem);
        _Pragma("unroll 1") for (int e = tid; e < 128 * 64; e += NT) { const int r = e >> 6, c = e & 63; const size_t idx = (size_t)(row0 + r) * DM + col0 + c;
            const float h2 = P.out[idx] + bf2f(PLE[idx]) * sigmoid_f(Cs[r * 65 + c]); P.out[idx] = h2; Cs[r * 65 + c] = h2; }
        __syncthreads();
        if (tid < 128) { float s = 0.f; _Pragma("unroll 4") for (int c = 0; c < 64; ++c) { const float v = Cs[tid * 65 + c]; s += v * v; } atomicAdd(SSQF + row0 + tid, s); }
    }
}
__device__ __forceinline__ void phase5(const Params& P, int bid, int nb) {
    bid = sgpr_op(bid); nb = sgpr_op(nb);
    const float* SSQF = (const float*)(P.ws + WS_SSQF);
    const int tid = tid_op(), lane = tid & 63, wave = tid >> 6;
    const int gw = bid * (NT / 64) + wave, ngw = nb * (NT / 64);
    for (int t = gw; t < T; t += ngw) {
        const float rstd = 1.0f / sqrtf(SSQF[t] * (1.f / DM) + RMS_EPS);
        float4* o = (float4*)(P.out + (size_t)t * DM);
#pragma unroll
        for (int j = 0; j < 4; ++j) { float4 v = o[lane + 64 * j]; const float4 g = ((const float4*)P.final_g)[lane + 64 * j];
            v.x *= rstd * g.x; v.y *= rstd * g.y; v.z *= rstd * g.z; v.w *= rstd * g.w; o[lane + 64 * j] = v; }
    }
}

namespace pg8 {
#define PG8_LAS __attribute__((address_space(3)))
typedef unsigned short bf16_t;
typedef short bf16x8 __attribute__((ext_vector_type(8)));
typedef float f32x4 __attribute__((ext_vector_type(4)));
typedef unsigned u32x4 __attribute__((ext_vector_type(4)));
constexpr int BM = 256, BK = 64, HALF = 128, HTB = HALF * BK * 2  , STAGE_BYTES = 8 * HTB, NXCD = 8, WGM = 8;

__host__ __device__ __forceinline__ int lds_byte(int r, int c) { const int st = (r >> 4) * 2 + (c >> 5), rr = r & 15, cc = c & 31, ob = rr * 64 + cc * 2; return st * 1024 + (ob ^ (((ob >> 9) & 1) << 5)); }
__host__ __device__ __forceinline__ void stage_rc(int b, int& R, int& C) { const int st = b / 1024, sb = b % 1024, swz = sb ^ (((sb >> 9) & 1) << 5); R = (st >> 1) * 16 + swz / 64; C = (st & 1) * 32 + (swz % 64) / 2; }
__host__ __device__ __forceinline__ int perm32(int rho) { const int n = rho >> 4, i = rho & 15; return 8 * (i >> 2) + 4 * n + (i & 3); }

struct Unit { int pm, pn; };
struct Gemm { const bf16_t* A; const bf16_t* Bt; int M, N, K, lda; };

struct StaticOrder {
    int nM, nN, nwg, G, c;
    __host__ __device__ void init(int M, int N, int G_, int c_) { nM = M / BM; nN = N / BM; nwg = nM * nN; G = G_; c = c_; }
    __host__ __device__ bool next(int i, Unit& u) const {
        const long L = (long)i * G + c; if (L >= nwg) return false;
        int wgid = (int)L; { const int q = nwg / NXCD, r = nwg % NXCD, xcd = wgid % NXCD, off = wgid / NXCD; wgid = (xcd < r ? xcd * (q + 1) : r * (q + 1) + (xcd - r) * q) + off; }
        const int nig = WGM * nN, gid = wgid / nig, fm = gid * WGM, gsz = (nM - fm) < WGM ? (nM - fm) : WGM;
        u.pm = fm + ((wgid % nig) % gsz); u.pn = (wgid % nig) / gsz; return true;
    }
    __device__ __forceinline__ void a_ready(const Unit&) const {}
    __device__ __forceinline__ void done(const Unit&) const {}
};

__device__ __forceinline__ unsigned cvt_pk_bf16(float lo, float hi) { unsigned r; asm volatile("v_cvt_pk_bf16_f32 %0, %1, %2" : "=v"(r) : "v"(lo), "v"(hi)); return r; }
template <class Epi, class Sched, bool ALIGN_EPI = false, bool SP2 = false>
__device__ __forceinline__ void gemm_phase(PG8_LAS unsigned char* lds, const Gemm g, const Sched& S, const Epi& E) {
    const int tid = tid_op(), wid = __builtin_amdgcn_readfirstlane(tid >> 6), lane = tid & 63, wr = wid >> 2, wc = wid & 3, fr = lane & 15, fq = lane >> 4;
    const int K = g.K, nt = K / BK;
    unsigned voffA[2], voffB[2];
#pragma unroll
    for (int i = 0; i < 2; ++i) { int R, C; stage_rc(tid * 16 + i * 8192, R, C); const int Rb = Epi::PERM ? ((R & ~31) + perm32(R & 31)) : R;
        voffA[i] = (unsigned)(R * g.lda + C) * 2u; voffB[i] = (unsigned)(Rb * K + C) * 2u; }
    const size_t kstep = (size_t)(BK * 2);
    const size_t hstepA = (size_t)HALF * g.lda * 2, hstepB = (size_t)HALF * K * 2;
    const size_t tstepA = 2 * hstepA, tstepB = 2 * hstepB;
    const unsigned ldsw = (unsigned)wid * 1024u;
    const int aoff = lds_byte(wr * 64 + fr, fq * 8), boff = lds_byte(wc * 32 + fr, fq * 8);
#define PG8_SA(b, h) (((b) * 2 + (h)) * HTB)
#define PG8_SB(b, h) ((4 + (b) * 2 + (h)) * HTB)
#define PG8_STAGE(bufoff, gbase, voff) do { _Pragma("unroll") for (int _i = 0; _i < 2; ++_i) \
        __builtin_amdgcn_global_load_lds((const unsigned*)((const char*)(gbase) + (voff)[_i]), (PG8_LAS unsigned*)(lds + (bufoff) + ldsw + _i * 8192), 16, 0, 0); } while (0)
#define PG8_LDA(dst, b, h) do { _Pragma("unroll") for (int m = 0; m < 4; ++m) _Pragma("unroll") for (int k = 0; k < 2; ++k) dst[m][k] = *(const PG8_LAS bf16x8*)(lds + PG8_SA(b, h) + aoff + m * 2048 + k * 1024); } while (0)
#define PG8_LDB(dst, b, h) do { _Pragma("unroll") for (int n = 0; n < 2; ++n) _Pragma("unroll") for (int k = 0; k < 2; ++k) dst[n][k] = *(const PG8_LAS bf16x8*)(lds + PG8_SB(b, h) + boff + n * 2048 + k * 1024); } while (0)
#define PG8_MMA(ai, bj, At, Bt) do { __builtin_amdgcn_s_setprio(1); _Pragma("unroll") for (int m = 0; m < 4; ++m) _Pragma("unroll") for (int n = 0; n < 2; ++n) _Pragma("unroll") for (int k = 0; k < 2; ++k) \
        acc[ai][bj][m][n] = __builtin_amdgcn_mfma_f32_16x16x32_bf16(Bt[n][k], At[m][k], acc[ai][bj][m][n], 0, 0, 0); __builtin_amdgcn_s_setprio(0); } while (0)
#define PG8_WAIT_V(n) asm volatile("s_waitcnt vmcnt(" #n ")" ::: "memory")
#define PG8_WAIT_L(n) asm volatile("s_waitcnt lgkmcnt(" #n ")" ::: "memory")
#define PG8_BAR __builtin_amdgcn_s_barrier()
#define PG8_SCHED __builtin_amdgcn_sched_barrier(0)
    Unit cur, nxt; int ui = 0;
    if (!S.next(0, cur)) return;
    f32x4 acc[2][2][4][2];
#pragma unroll
    for (int a = 0; a < 2; ++a)
#pragma unroll
        for (int b = 0; b < 2; ++b)
#pragma unroll
            for (int m = 0; m < 4; ++m)
#pragma unroll
                for (int n = 0; n < 2; ++n) acc[a][b][m][n] = (f32x4){0.f, 0.f, 0.f, 0.f};
    bf16x8 At[4][2], B0[2][2], B1[2][2];
    const char* cA = (const char*)g.A + (size_t)cur.pm * tstepA; const char* cB = (const char*)g.Bt + (size_t)cur.pn * tstepB;
    S.a_ready(cur);
    if constexpr (SP2) {
        PG8_STAGE(PG8_SB(0, 0), cB, voffB); PG8_STAGE(PG8_SB(0, 1), cB + hstepB, voffB); PG8_STAGE(PG8_SA(0, 0), cA, voffA); PG8_STAGE(PG8_SA(0, 1), cA + hstepA, voffA);
        if (wr == 1) PG8_BAR;
        PG8_WAIT_V(2); PG8_BAR;
        PG8_STAGE(PG8_SB(1, 0), cB + kstep, voffB); PG8_STAGE(PG8_SA(1, 0), cA + kstep, voffA); PG8_STAGE(PG8_SB(1, 1), cB + hstepB + kstep, voffB);
        PG8_WAIT_V(6); PG8_BAR;
    } else {
        PG8_STAGE(PG8_SB(0, 0), cB, voffB); PG8_STAGE(PG8_SA(0, 0), cA, voffA); PG8_STAGE(PG8_SB(0, 1), cB + hstepB, voffB); PG8_STAGE(PG8_SA(0, 1), cA + hstepA, voffA);
        if (wr == 1) PG8_BAR;
        PG8_WAIT_V(4); PG8_BAR;
        PG8_STAGE(PG8_SB(1, 0), cB + kstep, voffB); PG8_STAGE(PG8_SA(1, 0), cA + kstep, voffA); PG8_STAGE(PG8_SB(1, 1), cB + hstepB + kstep, voffB);
        PG8_WAIT_V(6); PG8_BAR;
    }
    for (;;) {
        const bool has_next = S.next(ui + 1, nxt);
        const char* nA = has_next ? (const char*)g.A + (size_t)nxt.pm * tstepA : cA; const char* nB = has_next ? (const char*)g.Bt + (size_t)nxt.pn * tstepB : cB;
#pragma unroll 1
        for (int t = 0; t < nt; t += 2) {
            const bool last = (t == nt - 2);
            const char* a1 = cA + (size_t)(t + 1) * kstep;
            const char* a2 = last ? nA : cA + (size_t)(t + 2) * kstep; const char* b2 = last ? nB : cB + (size_t)(t + 2) * kstep;
            const char* a3 = a2 + kstep; const char* b3 = b2 + kstep;
            if (last && has_next) S.a_ready(nxt);
            if constexpr (SP2) {
            PG8_LDB(B0, 0, 0); PG8_LDB(B1, 0, 1); PG8_SCHED; PG8_LDA(At, 0, 0); PG8_STAGE(PG8_SA(1, 1), a1 + hstepA, voffA);
            PG8_WAIT_V(8); PG8_WAIT_L(0); PG8_BAR; PG8_MMA(0, 0, At, B0); PG8_MMA(0, 1, At, B1); PG8_BAR; PG8_SCHED;
            PG8_LDA(At, 0, 1); PG8_STAGE(PG8_SB(0, 0), b2, voffB); PG8_STAGE(PG8_SB(0, 1), b2 + hstepB, voffB); PG8_STAGE(PG8_SA(0, 0), a2, voffA);
            PG8_WAIT_V(8); PG8_WAIT_L(0); PG8_BAR; PG8_MMA(1, 0, At, B0); PG8_MMA(1, 1, At, B1); PG8_BAR; PG8_SCHED;
            PG8_LDB(B0, 1, 0); PG8_LDB(B1, 1, 1); PG8_SCHED; PG8_LDA(At, 1, 0); PG8_STAGE(PG8_SA(0, 1), a2 + hstepA, voffA);
            PG8_WAIT_V(8); PG8_WAIT_L(0); PG8_BAR; PG8_MMA(0, 0, At, B0); PG8_MMA(0, 1, At, B1); PG8_BAR; PG8_SCHED;
            PG8_LDA(At, 1, 1); PG8_STAGE(PG8_SB(1, 0), b3, voffB); PG8_STAGE(PG8_SB(1, 1), b3 + hstepB, voffB); PG8_STAGE(PG8_SA(1, 0), a3, voffA);
            PG8_WAIT_V(8); PG8_WAIT_L(0); PG8_BAR; PG8_MMA(1, 0, At, B0); PG8_MMA(1, 1, At, B1); PG8_BAR; PG8_SCHED;
            } else {
            PG8_LDB(B0, 0, 0); PG8_SCHED; PG8_LDA(At, 0, 0); PG8_STAGE(PG8_SA(1, 1), a1 + hstepA, voffA);
            PG8_WAIT_L(8); PG8_BAR; PG8_WAIT_L(0); PG8_MMA(0, 0, At, B0); PG8_BAR; PG8_SCHED;
            PG8_LDB(B1, 0, 1); PG8_STAGE(PG8_SB(0, 0), b2, voffB);
            PG8_BAR; PG8_WAIT_L(0); PG8_MMA(0, 1, At, B1); PG8_BAR;
            PG8_LDA(At, 0, 1); PG8_STAGE(PG8_SA(0, 0), a2, voffA);
            PG8_BAR; PG8_WAIT_L(0); PG8_MMA(1, 0, At, B0); PG8_BAR; PG8_SCHED;
            PG8_STAGE(PG8_SB(0, 1), b2 + hstepB, voffB);
            PG8_WAIT_V(6); PG8_BAR; PG8_MMA(1, 1, At, B1); PG8_BAR;
            PG8_LDB(B0, 1, 0); PG8_SCHED; PG8_LDA(At, 1, 0); PG8_STAGE(PG8_SA(0, 1), a2 + hstepA, voffA);
            PG8_WAIT_L(8); PG8_BAR; PG8_WAIT_L(0); PG8_MMA(0, 0, At, B0); PG8_BAR; PG8_SCHED;
            PG8_LDB(B1, 1, 1); PG8_STAGE(PG8_SB(1, 0), b3, voffB);
            PG8_BAR; PG8_WAIT_L(0); PG8_MMA(0, 1, At, B1); PG8_BAR;
            PG8_LDA(At, 1, 1); PG8_STAGE(PG8_SA(1, 0), a3, voffA);
            PG8_BAR; PG8_WAIT_L(0); PG8_MMA(1, 0, At, B0); PG8_BAR; PG8_SCHED;
            PG8_STAGE(PG8_SB(1, 1), b3 + hstepB, voffB);
            PG8_WAIT_V(6); PG8_BAR; PG8_MMA(1, 1, At, B1); PG8_BAR;
            }
        }
        if constexpr (ALIGN_EPI) { if (wr == 0) PG8_BAR; }
        if constexpr (!Epi::AFTER_DRAIN) { E(acc, cur, wr, wc, fr, fq); S.done(cur); }
        if (!has_next) break;
#pragma unroll
        for (int a = 0; a < 2; ++a)
#pragma unroll
            for (int b = 0; b < 2; ++b)
#pragma unroll
                for (int m = 0; m < 4; ++m)
#pragma unroll
                    for (int n = 0; n < 2; ++n) acc[a][b][m][n] = (f32x4){0.f, 0.f, 0.f, 0.f};
        cur = nxt; cA = nA; cB = nB; ++ui;
        if constexpr (ALIGN_EPI) { if (wr == 1) PG8_BAR; }
    }
    PG8_WAIT_V(0);
    if constexpr (!ALIGN_EPI) { if (wr == 0) PG8_BAR; }
    PG8_BAR;
    if constexpr (Epi::AFTER_DRAIN) { E.fused(acc, cur, wr, wc, fr, fq, lds, wid, lane); S.done(cur); }
#undef PG8_SA
#undef PG8_SB
#undef PG8_STAGE
#undef PG8_LDA
#undef PG8_LDB
#undef PG8_MMA
#undef PG8_WAIT_V
#undef PG8_WAIT_L
#undef PG8_BAR
#undef PG8_SCHED
}
}

#define LAS __attribute__((address_space(3)))
typedef float f32x4 __attribute__((ext_vector_type(4)));
typedef unsigned u32x4 __attribute__((ext_vector_type(4)));
using pg8::cvt_pk_bf16;
__device__ __forceinline__ u32x4 pack8(const f32x4 a, const f32x4 b) { u32x4 w; w.x = cvt_pk_bf16(a[0], a[1]); w.y = cvt_pk_bf16(a[2], a[3]); w.z = cvt_pk_bf16(b[0], b[1]); w.w = cvt_pk_bf16(b[2], b[3]); return w; }

struct MapIn {
    __device__ __forceinline__ int operator()(int g) const { const int pn = g >> 8, cc = g & 255, bj = cc >> 7, w = cc & 127;
        if (pn < 2) return OFF_DQ + (4 * pn + (w >> 5)) * 64 + bj * 32 + (w & 31);
        if (pn < 4) return OFF_DK + (4 * (pn - 2) + (w >> 5)) * 64 + bj * 32 + (w & 31);
        if (pn < 6) return OFF_DV + (pn - 4) * 256 + cc;
        if (pn < 8) return OFF_DG + (pn - 6) * 256 + cc;
        if (pn == 8) return OFF_CQ + cc;
        if (pn == 9) return bj == 0 ? OFF_CQ + 256 + w : OFF_CKV + w;
        if (pn < 12) return OFF_MG + (pn - 10) * 256 + cc;
        return w < 16 ? OFF_KR + bj * 16 + w : -1; } };
struct MapUq {
    __device__ __forceinline__ int operator()(int g) const { const int pn = g >> 8, cc = g & 255;
        if (pn == 0) { const int bj = cc >> 7, w = cc & 127; return (w >> 4) * 96 + 64 + bj * 16 + (w & 15); }
        const int gp = g - 256; return (gp >> 6) * 96 + (gp & 63); } };
struct MapId { __device__ __forceinline__ int operator()(int g) const { return g; } };
template <class Map>
__device__ __forceinline__ void wconv(const float* W, int K, int ldw, const float* kscale, bf16_t* Wt, int ldwt, int kdst_off, int Ng, Map map, LAS float* scr, int gw, int ngw, int lane) {
    const int nblk = Ng / 32, items = (K / 64) * nblk;
    for (int it = gw; it < items; it += ngw) {
        const int kb = it / nblk, nbk = it % nblk, k0 = 64 * kb, n0 = 32 * nbk;
        const int src = map(n0 + (lane & 31));
#pragma unroll 8
        for (int i = 0; i < 32; ++i) { const int kk = 2 * i + (lane >> 5);
            float v = 0.f; if (src >= 0) { v = W[(size_t)(k0 + kk) * ldw + src]; if (kscale) v *= kscale[k0 + kk]; }
            scr[kk * 33 + (lane & 31)] = v; }
        asm volatile("s_waitcnt lgkmcnt(0)" ::: "memory");
        const int c = lane & 7;
#pragma unroll
        for (int j = 0; j < 4; ++j) { const int n = (lane >> 3) + 8 * j; const LAS float* sp = scr + (8 * c) * 33 + n;
            u32x4 o; o.x = f2bf(sp[0]) | (f2bf(sp[33]) << 16); o.y = f2bf(sp[2 * 33]) | (f2bf(sp[3 * 33]) << 16); o.z = f2bf(sp[4 * 33]) | (f2bf(sp[5 * 33]) << 16); o.w = f2bf(sp[6 * 33]) | (f2bf(sp[7 * 33]) << 16);
            *(u32x4*)(Wt + (size_t)(n0 + n) * ldwt + kdst_off + k0 + 8 * c) = o; }
        asm volatile("s_waitcnt lgkmcnt(0)" ::: "memory");
    }
}
constexpr int NIN = 13 * 256;
__device__ __forceinline__ void phase0_weights(const Params& P, int bid, int nb, LAS unsigned char* lds) {
    const int tid = tid_op(), lane = tid & 63, wave = tid >> 6;
    const int gw = bid * (NT / 64) + wave, ngw = nb * (NT / 64);
    LAS float* scr = (LAS float*)(lds + wave * 16384);
    wconv(P.w_in, DM, DIN, nullptr, (bf16_t*)(P.ws + WS_WIN), DM, 0, NIN, MapIn(), scr, gw, ngw, lane);
    wconv(P.w_ple, PLE_DIM, DM, nullptr, (bf16_t*)(P.ws + WS_WPLE), PLE_DIM, 0, DM, MapId(), scr, gw, ngw, lane);
    wconv(P.w_uq, QLORA, 768, P.qn_g, (bf16_t*)(P.ws + WS_WUQ), QLORA, 0, 768, MapUq(), scr, gw, ngw, lane);
    wconv(P.w_ukv, KVLORA, 1024, P.kvn_g, (bf16_t*)(P.ws + WS_WUKV), 256, 128, 1024, MapId(), scr, gw, ngw, lane);
    wconv(P.w_out, DM, DM, nullptr, (bf16_t*)(P.ws + WS_WOUT), DM, 0, DM, MapId(), scr, gw, ngw, lane);
    wconv(P.w_gate, DM, DM, nullptr, (bf16_t*)(P.ws + WS_WG), DM, 0, DM, MapId(), scr, gw, ngw, lane);
    u32x4* z = (u32x4*)(P.ws + WS_WUKV);
    for (int i = bid * NT + tid; i < 1024 * 16; i += nb * NT) { const int g = i >> 4, c = i & 15; z[g * 32 + c] = (u32x4){0u, 0u, 0u, 0u}; }
}

struct Epi1 {
    static constexpr bool PERM = true, AFTER_DRAIN = false;
    bf16_t *QD, *KD, *VD, *G, *CQ, *KM; float *SSQQ, *SSQKV; const float2 *CSA, *CSB;
    __device__ __forceinline__ void operator()(const f32x4 (&acc)[2][2][4][2], const pg8::Unit& u, int wr, int wc, int fr, int fq) const {
        const int pn = u.pn, b = u.pm >> 4, s0 = (u.pm & 15) * 256 + wr * 64 + fr, t0 = u.pm * 256 + wr * 64 + fr;
        if (pn < 4) {
            bf16_t* dst = pn < 2 ? QD : KD; const float sc = pn < 2 ? C2D : 1.f; const int mh = 4 * (pn & 1) + wc;
#pragma unroll
            for (int ai = 0; ai < 2; ++ai)
#pragma unroll
                for (int m = 0; m < 4; ++m) { const int ro = ai * 128 + m * 16; const f32x4* cs = (const f32x4*)(CSA + (size_t)(t0 + ro) * 32 + 8 * fq);
                    f32x4 o1[2], o2[2];
#pragma unroll
                    for (int n = 0; n < 2; ++n) { const f32x4 ca = cs[2 * n], cb = cs[2 * n + 1]; const f32x4 x1 = acc[ai][0][m][n], x2 = acc[ai][1][m][n];
                        o1[n] = (f32x4){x1[0] * ca[0] - x2[0] * ca[1], x1[1] * ca[2] - x2[1] * ca[3], x1[2] * cb[0] - x2[2] * cb[1], x1[3] * cb[2] - x2[3] * cb[3]} * sc;
                        o2[n] = (f32x4){x2[0] * ca[0] + x1[0] * ca[1], x2[1] * ca[2] + x1[1] * ca[3], x2[2] * cb[0] + x1[2] * cb[1], x2[3] * cb[2] + x1[3] * cb[3]} * sc; }
                    bf16_t* rp = dst + ((size_t)(b * 8 + mh) * SEQ + s0 + ro) * 64 + 8 * fq;
                    *(u32x4*)rp = pack8(o1[0], o1[1]); *(u32x4*)(rp + 32) = pack8(o2[0], o2[1]); asm volatile("" ::: "memory"); }
        } else if (pn < 6) {
#pragma unroll
            for (int ai = 0; ai < 2; ++ai)
#pragma unroll
                for (int m = 0; m < 4; ++m)
#pragma unroll
                    for (int bj = 0; bj < 2; ++bj) { const int ro = ai * 128 + m * 16, h = 2 * (pn - 4) + bj;
                        *(u32x4*)(VD + ((size_t)(b * 4 + h) * SEQ + s0 + ro) * 128 + 32 * wc + 8 * fq) = pack8(acc[ai][bj][m][0], acc[ai][bj][m][1]); }
        } else if (pn < 8 || pn == 10 || pn == 11) {
            const int cb = (pn < 8 ? (pn - 6) * 256 : 512 + (pn - 10) * 256) + 32 * wc + 8 * fq;
#pragma unroll
            for (int ai = 0; ai < 2; ++ai)
#pragma unroll
                for (int m = 0; m < 4; ++m)
#pragma unroll
                    for (int bj = 0; bj < 2; ++bj) { const int ro = ai * 128 + m * 16; f32x4 a = acc[ai][bj][m][0], c = acc[ai][bj][m][1];
#pragma unroll
                        for (int j = 0; j < 4; ++j) { a[j] = silu_f(a[j]); c[j] = silu_f(c[j]); }
                        *(u32x4*)(G + (size_t)(t0 + ro) * 1024 + cb + 128 * bj) = pack8(a, c); }
        } else if (pn < 10) {
#pragma unroll
            for (int ai = 0; ai < 2; ++ai)
#pragma unroll
                for (int m = 0; m < 4; ++m) { const int ro = ai * 128 + m * 16; float ss[2];
#pragma unroll
                    for (int bj = 0; bj < 2; ++bj) { const f32x4 a = acc[ai][bj][m][0], c = acc[ai][bj][m][1];
                        *(u32x4*)(CQ + (size_t)(t0 + ro) * CQP + (pn - 8) * 256 + 128 * bj + 32 * wc + 8 * fq) = pack8(a, c);
                        float q = (a[0] * a[0] + a[1] * a[1]) + (a[2] * a[2] + a[3] * a[3]) + (c[0] * c[0] + c[1] * c[1]) + (c[2] * c[2] + c[3] * c[3]);
                        q += __shfl_xor(q, 16); q += __shfl_xor(q, 32); ss[bj] = q; }
                    if (fq == 0) { if (pn == 8) atomicAdd(SSQQ + t0 + ro, ss[0] + ss[1]); else { atomicAdd(SSQQ + t0 + ro, ss[0]); atomicAdd(SSQKV + t0 + ro, ss[1]); } } }
        } else {
            if (wc == 0 && fq < 2) {
#pragma unroll
                for (int ai = 0; ai < 2; ++ai)
#pragma unroll
                    for (int m = 0; m < 4; ++m) { const int ro = ai * 128 + m * 16; const f32x4* cs = (const f32x4*)(CSB + (size_t)(t0 + ro) * 16 + 8 * fq);
                        f32x4 o1[2], o2[2];
#pragma unroll
                        for (int n = 0; n < 2; ++n) { const f32x4 ca = cs[2 * n], cb = cs[2 * n + 1]; const f32x4 x1 = acc[ai][0][m][n], x2 = acc[ai][1][m][n];
                            o1[n] = (f32x4){x1[0] * ca[0] - x2[0] * ca[1], x1[1] * ca[2] - x2[1] * ca[3], x1[2] * cb[0] - x2[2] * cb[1], x1[3] * cb[2] - x2[3] * cb[3]};
                            o2[n] = (f32x4){x2[0] * ca[0] + x1[0] * ca[1], x2[1] * ca[2] + x1[1] * ca[3], x2[2] * cb[0] + x1[2] * cb[1], x2[3] * cb[2] + x1[3] * cb[3]}; }
                        const u32x4 w1 = pack8(o1[0], o1[1]), w2 = pack8(o2[0], o2[1]);
#pragma unroll
                        for (int h = 0; h < 8; ++h) { bf16_t* rp = KM + ((size_t)(b * 8 + h) * SEQ + s0 + ro) * 96 + 64 + 8 * fq; *(u32x4*)rp = w1; *(u32x4*)(rp + 16) = w2; } }
            }
        }
    }
};
struct EpiStore {
    static constexpr bool PERM = true, AFTER_DRAIN = false;
    bf16_t* O; int ldc;
    __device__ __forceinline__ void operator()(const f32x4 (&acc)[2][2][4][2], const pg8::Unit& u, int wr, int wc, int fr, int fq) const {
        const int t0 = u.pm * 256 + wr * 64 + fr, c0 = u.pn * 256 + 32 * wc + 8 * fq;
#pragma unroll
        for (int ai = 0; ai < 2; ++ai)
#pragma unroll
            for (int m = 0; m < 4; ++m)
#pragma unroll
                for (int bj = 0; bj < 2; ++bj) *(u32x4*)(O + (size_t)(t0 + ai * 128 + m * 16) * ldc + c0 + 128 * bj) = pack8(acc[ai][bj][m][0], acc[ai][bj][m][1]);
    }
};
struct EpiQ {
    static constexpr bool PERM = true, AFTER_DRAIN = false;
    bf16_t* QM; const float* SSQQ; const float2* CSB;
    __device__ __forceinline__ void operator()(const f32x4 (&acc)[2][2][4][2], const pg8::Unit& u, int wr, int wc, int fr, int fq) const {
        const int pn = u.pn, b = u.pm >> 4, s0 = (u.pm & 15) * 256 + wr * 64 + fr, t0 = u.pm * 256 + wr * 64 + fr;
#pragma unroll
        for (int ai = 0; ai < 2; ++ai)
#pragma unroll
            for (int m = 0; m < 4; ++m) { const int ro = ai * 128 + m * 16; const float sc = C2M * __builtin_amdgcn_rsqf(SSQQ[t0 + ro] * (1.f / QLORA) + RMS_EPS);
                if (pn == 0) { const int h = 2 * wc + (fq >> 1), i0 = 8 * (fq & 1); const f32x4* cs = (const f32x4*)(CSB + (size_t)(t0 + ro) * 16 + i0);
                    f32x4 o1[2], o2[2];
#pragma unroll
                    for (int n = 0; n < 2; ++n) { const f32x4 ca = cs[2 * n], cb = cs[2 * n + 1]; const f32x4 x1 = acc[ai][0][m][n], x2 = acc[ai][1][m][n];
                        o1[n] = (f32x4){x1[0] * ca[0] - x2[0] * ca[1], x1[1] * ca[2] - x2[1] * ca[3], x1[2] * cb[0] - x2[2] * cb[1], x1[3] * cb[2] - x2[3] * cb[3]} * sc;
                        o2[n] = (f32x4){x2[0] * ca[0] + x1[0] * ca[1], x2[1] * ca[2] + x1[1] * ca[3], x2[2] * cb[0] + x1[2] * cb[1], x2[3] * cb[2] + x1[3] * cb[3]} * sc; }
                    bf16_t* rp = QM + ((size_t)(b * 8 + h) * SEQ + s0 + ro) * 96 + 64 + i0;
                    *(u32x4*)rp = pack8(o1[0], o1[1]); *(u32x4*)(rp + 16) = pack8(o2[0], o2[1]);
                } else {
#pragma unroll
                    for (int bj = 0; bj < 2; ++bj) { const int h = 4 * (pn - 1) + 2 * bj + (wc >> 1), d = 32 * (wc & 1) + 8 * fq;
                        *(u32x4*)(QM + ((size_t)(b * 8 + h) * SEQ + s0 + ro) * 96 + d) = pack8(acc[ai][bj][m][0] * sc, acc[ai][bj][m][1] * sc); } }
                asm volatile("" ::: "memory");
            }
    }
};
struct EpiKV {
    static constexpr bool PERM = true, AFTER_DRAIN = false;
    bf16_t *KM, *VM; const float* SSQKV;
    __device__ __forceinline__ void operator()(const f32x4 (&acc)[2][2][4][2], const pg8::Unit& u, int wr, int wc, int fr, int fq) const {
        const int pn = u.pn, b = u.pm >> 4, s0 = (u.pm & 15) * 256 + wr * 64 + fr, t0 = u.pm * 256 + wr * 64 + fr;
#pragma unroll
        for (int ai = 0; ai < 2; ++ai)
#pragma unroll
            for (int m = 0; m < 4; ++m) { const int ro = ai * 128 + m * 16; const float sc = __builtin_amdgcn_rsqf(SSQKV[t0 + ro] * (1.f / KVLORA) + RMS_EPS);
#pragma unroll
                for (int bj = 0; bj < 2; ++bj) { const int h = 2 * pn + bj; const size_t rowi = (size_t)(b * 8 + h) * SEQ + s0 + ro;
                    bf16_t* rp = (wc < 2) ? KM + rowi * 96 + 32 * wc + 8 * fq : VM + rowi * 64 + 32 * (wc - 2) + 8 * fq;
                    *(u32x4*)rp = pack8(acc[ai][bj][m][0] * sc, acc[ai][bj][m][1] * sc); }
                asm volatile("" ::: "memory"); }
    }
};
struct Epi3 {
    static constexpr bool PERM = true, AFTER_DRAIN = false;
    const float* x; float* out; bf16_t* HB;
    __device__ __forceinline__ void operator()(const f32x4 (&acc)[2][2][4][2], const pg8::Unit& u, int wr, int wc, int fr, int fq) const {
        const int t0 = u.pm * 256 + wr * 64 + fr, c0 = u.pn * 256 + 32 * wc + 8 * fq;
#pragma unroll
        for (int ai = 0; ai < 2; ++ai)
#pragma unroll
            for (int m = 0; m < 4; ++m) {
#pragma unroll
                for (int bj = 0; bj < 2; ++bj) { const size_t idx = (size_t)(t0 + ai * 128 + m * 16) * DM + c0 + 128 * bj;
                    const f32x4 h0 = *(const f32x4*)(x + idx) + acc[ai][bj][m][0], h1 = *(const f32x4*)(x + idx + 4) + acc[ai][bj][m][1];
                    *(f32x4*)(out + idx) = h0; *(f32x4*)(out + idx + 4) = h1; *(u32x4*)(HB + idx) = pack8(h0, h1); }
                asm volatile("" ::: "memory"); }
    }
};
struct Epi4 {
    static constexpr bool PERM = true, AFTER_DRAIN = false;
    float* out; const bf16_t* PLE; float* SSQF;
    __device__ __forceinline__ void operator()(const f32x4 (&acc)[2][2][4][2], const pg8::Unit& u, int wr, int wc, int fr, int fq) const {
        const int t0 = u.pm * 256 + wr * 64 + fr, c0 = u.pn * 256 + 32 * wc + 8 * fq;
#pragma unroll
        for (int ai = 0; ai < 2; ++ai)
#pragma unroll
            for (int m = 0; m < 4; ++m) { float q = 0.f;
#pragma unroll
                for (int bj = 0; bj < 2; ++bj) { const size_t idx = (size_t)(t0 + ai * 128 + m * 16) * DM + c0 + 128 * bj;
                    const u32x4 pw = *(const u32x4*)(PLE + idx); f32x4 h0 = *(const f32x4*)(out + idx), h1 = *(const f32x4*)(out + idx + 4);
                    const f32x4 a = acc[ai][bj][m][0], c = acc[ai][bj][m][1];
                    h0[0] += __uint_as_float(pw.x << 16) * sigmoid_f(a[0]); h0[1] += __uint_as_float(pw.x & 0xffff0000u) * sigmoid_f(a[1]);
                    h0[2] += __uint_as_float(pw.y << 16) * sigmoid_f(a[2]); h0[3] += __uint_as_float(pw.y & 0xffff0000u) * sigmoid_f(a[3]);
                    h1[0] += __uint_as_float(pw.z << 16) * sigmoid_f(c[0]); h1[1] += __uint_as_float(pw.z & 0xffff0000u) * sigmoid_f(c[1]);
                    h1[2] += __uint_as_float(pw.w << 16) * sigmoid_f(c[2]); h1[3] += __uint_as_float(pw.w & 0xffff0000u) * sigmoid_f(c[3]);
                    *(f32x4*)(out + idx) = h0; *(f32x4*)(out + idx + 4) = h1;
                    q += (h0[0] * h0[0] + h0[1] * h0[1]) + (h0[2] * h0[2] + h0[3] * h0[3]) + (h1[0] * h1[0] + h1[1] * h1[1]) + (h1[2] * h1[2] + h1[3] * h1[3]); }
                q += __shfl_xor(q, 16); q += __shfl_xor(q, 32);
                if (fq == 0) atomicAdd(SSQF + t0 + ai * 128 + m * 16, q);
                asm volatile("" ::: "memory"); }
    }
};

#ifndef PG8_SP2
#define PG8_SP2 true
#endif
#ifndef PG8_ALIGN
#define PG8_ALIGN true
#endif
__device__ __forceinline__ void phase1_gemm(const Params& P, LAS unsigned char* lds) {
    pg8::Gemm g{(const bf16_t*)(P.ws + WS_XN), (const bf16_t*)(P.ws + WS_WIN), T, NIN, DM, DM}; pg8::StaticOrder S; S.init(T, NIN, (int)gridDim.x, (int)blockIdx.x);
    Epi1 E{(bf16_t*)(P.ws + WS_QD), (bf16_t*)(P.ws + WS_KD), (bf16_t*)(P.ws + WS_VD), (bf16_t*)(P.ws + WS_G), (bf16_t*)(P.ws + WS_CQ), (bf16_t*)(P.ws + WS_KM),
           (float*)(P.ws + WS_SSQQ), (float*)(P.ws + WS_SSQKV), (const float2*)(P.ws + WS_CSA), (const float2*)(P.ws + WS_CSB)};
    pg8::gemm_phase<Epi1, pg8::StaticOrder, PG8_ALIGN, PG8_SP2>(lds, g, S, E);
}
__device__ __forceinline__ void phase15_gemm(const Params& P, LAS unsigned char* lds) {
    { pg8::Gemm g{(const bf16_t*)(P.ws + WS_CQ), (const bf16_t*)(P.ws + WS_WUQ), T, 768, QLORA, CQP}; pg8::StaticOrder S; S.init(T, 768, (int)gridDim.x, (int)blockIdx.x);
      EpiQ E{(bf16_t*)(P.ws + WS_QM), (const float*)(P.ws + WS_SSQQ), (const float2*)(P.ws + WS_CSB)};
      pg8::gemm_phase<EpiQ, pg8::StaticOrder, PG8_ALIGN, PG8_SP2>(lds, g, S, E); }
    { pg8::Gemm g{(const bf16_t*)(P.ws + WS_CQ) + 256, (const bf16_t*)(P.ws + WS_WUKV), T, 1024, 256, CQP}; pg8::StaticOrder S; S.init(T, 1024, (int)gridDim.x, (int)blockIdx.x);
      EpiKV E{(bf16_t*)(P.ws + WS_KM), (bf16_t*)(P.ws + WS_VM), (const float*)(P.ws + WS_SSQKV)};
      pg8::gemm_phase<EpiKV, pg8::StaticOrder, PG8_ALIGN, PG8_SP2>(lds, g, S, E); }
}
__device__ __forceinline__ void phase3_gemm(const Params& P, LAS unsigned char* lds) {
    { pg8::Gemm g{(const bf16_t*)(P.ws + WS_YCAT), (const bf16_t*)(P.ws + WS_WOUT), T, DM, DM, DM}; pg8::StaticOrder S; S.init(T, DM, (int)gridDim.x, (int)blockIdx.x);
      Epi3 E{P.x, P.out, (bf16_t*)(P.ws + WS_HB)};
      pg8::gemm_phase<Epi3, pg8::StaticOrder, PG8_ALIGN, PG8_SP2>(lds, g, S, E); }
    { pg8::Gemm g{(const bf16_t*)(P.ws + WS_PB), (const bf16_t*)(P.ws + WS_WPLE), T, DM, PLE_DIM, PLE_DIM}; pg8::StaticOrder S; S.init(T, DM, (int)gridDim.x, (int)blockIdx.x);
      EpiStore E{(bf16_t*)(P.ws + WS_PLE), DM};
      pg8::gemm_phase<EpiStore, pg8::StaticOrder, PG8_ALIGN, PG8_SP2>(lds, g, S, E); }
}
__device__ __forceinline__ void phase4_gemm(const Params& P, LAS unsigned char* lds) {
    pg8::Gemm g{(const bf16_t*)(P.ws + WS_HB), (const bf16_t*)(P.ws + WS_WG), T, DM, DM, DM}; pg8::StaticOrder S; S.init(T, DM, (int)gridDim.x, (int)blockIdx.x);
    Epi4 E{P.out, (const bf16_t*)(P.ws + WS_PLE), (float*)(P.ws + WS_SSQF)};
    pg8::gemm_phase<Epi4, pg8::StaticOrder, PG8_ALIGN, PG8_SP2>(lds, g, S, E);
}

namespace att {
typedef short bf16x8 __attribute__((ext_vector_type(8)));
typedef short s16x4 __attribute__((ext_vector_type(4)));
typedef float f32x16 __attribute__((ext_vector_type(16)));
#define SBAR() __builtin_amdgcn_sched_barrier(0)
constexpr float THR = 8.f;
constexpr int BUF_BYTES = 32768, K_OFF = 0, V_OFF = 16384;
constexpr int WS_OFF = 2 * BUF_BYTES;
constexpr int ATT_LDS_BYTES = WS_OFF + 8 * 64 * 4;
__device__ __forceinline__ int crow(int r, int hi) { return (r & 3) + 8 * (r >> 2) + 4 * hi; }
__device__ __forceinline__ unsigned cvtpk(float lo, float hi) { unsigned r; asm volatile("v_cvt_pk_bf16_f32 %0, %1, %2" : "=v"(r) : "v"(lo), "v"(hi)); return r; }

__device__ __forceinline__ void partialSM(f32x16& p0, f32x16& p1, float& m_reg, float& alpha) {
    float pmax = p0[0];
#pragma unroll
    for (int r = 1; r < 16; ++r) pmax = fmaxf(pmax, p0[r]);
#pragma unroll
    for (int r = 0; r < 16; ++r) pmax = fmaxf(pmax, p1[r]);
    { auto rr = __builtin_amdgcn_permlane32_swap(__float_as_uint(pmax), __float_as_uint(pmax), false, false); pmax = fmaxf(__uint_as_float(rr[0]), __uint_as_float(rr[1])); }
    float mn;
    if (__builtin_expect(__all(pmax - m_reg <= THR), 1)) { mn = m_reg; alpha = 1.f; }
    else { mn = fmaxf(m_reg, pmax); alpha = __builtin_amdgcn_exp2f(m_reg - mn); m_reg = mn; }
#pragma unroll
    for (int r = 0; r < 16; ++r) { p0[r] -= mn; p1[r] -= mn; }
#pragma unroll
    for (int r = 0; r < 16; ++r) p0[r] = __builtin_amdgcn_exp2f(p0[r]);
}
__device__ __forceinline__ void finishSM(f32x16& p0, f32x16& p1, float alpha, float& l_reg, bf16x8& pa0, bf16x8& pa1, bf16x8& pa2, bf16x8& pa3) {
#pragma unroll
    for (int r = 0; r < 16; ++r) p1[r] = __builtin_amdgcn_exp2f(p1[r]);
    float ps = 0.f;
#pragma unroll
    for (int r = 0; r < 16; ++r) ps += p0[r];
#pragma unroll
    for (int r = 0; r < 16; ++r) ps += p1[r];
    { auto rr = __builtin_amdgcn_permlane32_swap(__float_as_uint(ps), __float_as_uint(ps), false, false); ps = __uint_as_float(rr[0]) + __uint_as_float(rr[1]); }
    l_reg = l_reg * alpha + ps;
#define PK4(P, BASE, OUT) do { unsigned a0 = cvtpk(P[BASE + 0], P[BASE + 1]), a1 = cvtpk(P[BASE + 2], P[BASE + 3]);   \
    unsigned b0 = cvtpk(P[BASE + 4], P[BASE + 5]), b1 = cvtpk(P[BASE + 6], P[BASE + 7]);                              \
    auto r0 = __builtin_amdgcn_permlane32_swap(a0, b0, false, false); auto r1 = __builtin_amdgcn_permlane32_swap(a1, b1, false, false); \
    u32x4 w = {r0[0], r1[0], r0[1], r1[1]}; OUT = __builtin_bit_cast(bf16x8, w); } while (0)
    PK4(p0, 0, pa0); PK4(p0, 8, pa1); PK4(p1, 0, pa2); PK4(p1, 8, pa3);
#undef PK4
}
__device__ __forceinline__ void cmask(f32x16& p0, f32x16& p1, int jb, int qrel, int hi) {
    const int kb = 64 * jb + 4 * hi;
#pragma unroll
    for (int r = 0; r < 16; ++r) { const int kv = kb + (r & 3) + 8 * (r >> 2); if (kv > qrel) p0[r] = -INFINITY; if (kv + 32 > qrel) p1[r] = -INFINITY; }
}
template <int DQK> __device__ __forceinline__ void qkt(f32x16& p0, f32x16& p1, LAS const unsigned char* kp  , const bf16x8* qr) {
    constexpr int PITCH = 2 * DQK + 16;
    p0 = f32x16{}; p1 = f32x16{};
#pragma unroll
    for (int d0 = 0; d0 < DQK / 16; ++d0) {
        const bf16x8 b0 = *(LAS const bf16x8*)(kp + d0 * 32), b1 = *(LAS const bf16x8*)(kp + 32 * PITCH + d0 * 32);
        p0 = __builtin_amdgcn_mfma_f32_32x32x16_bf16(b0, qr[d0], p0, 0, 0, 0);
        p1 = __builtin_amdgcn_mfma_f32_32x32x16_bf16(b1, qr[d0], p1, 0, 0, 0); }
}
template <int NCB> __device__ __forceinline__ int v_st(int k, int c) { const int kk = (k & ~0xC) | ((k & 4) << 1) | ((k & 8) >> 1); return ((kk >> 3) * NCB + (c >> 5)) * 512 + ((kk & 7) * 32 + (c & 31)) * 2; }
__device__ __forceinline__ int v_rd_base(int lane) { return ((lane & 3) << 3) | (((lane >> 2) & 3) << 6) | (((lane >> 4) & 1) << 5) | (((lane >> 5) & 1) << 8); }
template <int OFF> __device__ __forceinline__ s16x4 tr_read(int vb) { s16x4 r; asm volatile("ds_read_b64_tr_b16 %0, %1 offset:%2" : "=&v"(r) : "v"(vb), "i"(OFF) : "memory"); return r; }
template <int NCB, int D0> __device__ __forceinline__ void pv_one(f32x16& od, int vb, bf16x8 pa0, bf16x8 pa1, bf16x8 pa2, bf16x8 pa3) {
    constexpr int KS = 2 * NCB * 512, HF = NCB * 512, B0 = D0 * 512;
    const s16x4 l0 = tr_read<B0>(vb), h0 = tr_read<B0 + HF>(vb), l1 = tr_read<B0 + KS>(vb), h1 = tr_read<B0 + KS + HF>(vb);
    const s16x4 l2 = tr_read<B0 + 2 * KS>(vb), h2 = tr_read<B0 + 2 * KS + HF>(vb), l3 = tr_read<B0 + 3 * KS>(vb), h3 = tr_read<B0 + 3 * KS + HF>(vb);
    asm volatile("s_waitcnt lgkmcnt(0)" ::: "memory"); SBAR();
#define PK(L, H) (bf16x8){L[0], L[1], L[2], L[3], H[0], H[1], H[2], H[3]}
    od = __builtin_amdgcn_mfma_f32_32x32x16_bf16(pa0, PK(l0, h0), od, 0, 0, 0);
    od = __builtin_amdgcn_mfma_f32_32x32x16_bf16(pa1, PK(l1, h1), od, 0, 0, 0);
    od = __builtin_amdgcn_mfma_f32_32x32x16_bf16(pa2, PK(l2, h2), od, 0, 0, 0);
    od = __builtin_amdgcn_mfma_f32_32x32x16_bf16(pa3, PK(l3, h3), od, 0, 0, 0);
#undef PK
}
template <int NCB> __device__ __forceinline__ void pv_all(f32x16* o, int vb, bf16x8 pa0, bf16x8 pa1, bf16x8 pa2, bf16x8 pa3) {
    pv_one<NCB, 0>(o[0], vb, pa0, pa1, pa2, pa3); pv_one<NCB, 1>(o[1], vb, pa0, pa1, pa2, pa3);
    if constexpr (NCB == 4) { pv_one<NCB, 2>(o[2], vb, pa0, pa1, pa2, pa3); pv_one<NCB, 3>(o[3], vb, pa0, pa1, pa2, pa3); }
}

template <int DQK, int DV, int VP, int KIND>
__device__ __forceinline__ void attn_unit(const bf16_t* Qh, const bf16_t* Kh, const bf16_t* Vh, int qb, bf16_t* OUT, const bf16_t* GATE, LAS unsigned char* lds) {
    constexpr int NCB = DV / 32, NKS = DQK / 16, PITCH = 2 * DQK + 16, NKCH = DQK / 8, KCHUNKS = 64 * NKCH, NKI = (KCHUNKS + NT - 1) / NT, NVI = (64 * DV / 8) / NT;
    const int tid = tid_op(), lane = tid & 63, r32 = lane & 31, hi = lane >> 5; const int wid = __builtin_amdgcn_readfirstlane(tid >> 6);
    LAS float* wsf = (LAS float*)(lds + WS_OFF) + wid * 64; LAS float* li_l = wsf; LAS float* al_l = wsf + 32;
    const int q0 = qb * 256, NTL = (q0 + 256) / 64;
    float m_reg = -1e30f, l_reg = 0.f; f32x16 o[NCB]; bf16x8 qr[NKS];
#pragma unroll
    for (int d = 0; d < NCB; ++d) o[d] = f32x16{};
    { const bf16_t* Qw = Qh + (size_t)(q0 + wid * 32 + r32) * DQK + hi * 8;
#pragma unroll
      for (int d0 = 0; d0 < NKS; ++d0) qr[d0] = *(const bf16x8*)(Qw + d0 * 16); }
    int kgo[NKI], klo[NKI];
#pragma unroll
    for (int i = 0; i < NKI; ++i) { const int id = (tid + i * NT < KCHUNKS) ? tid + i * NT : tid; const int row = id / NKCH, ch = id % NKCH; kgo[i] = row * DQK + ch * 8; klo[i] = K_OFF + row * PITCH + ch * 16; }
    int vgo[NVI], vlo[NVI];
#pragma unroll
    for (int i = 0; i < NVI; ++i) { const int id = tid + i * NT; const int key = id / (DV / 8), c = (id % (DV / 8)) * 8; vgo[i] = key * VP + c; vlo[i] = V_OFF + v_st<NCB>(key, c); }
    bf16x8 ks[2][NKI], vs[2][NVI];
#define SLOAD(sl, t) do { const bf16_t* kt_ = Kh + (size_t)(t) * 64 * DQK; const bf16_t* vt_ = Vh + (size_t)(t) * 64 * VP; \
    _Pragma("unroll") for (int i_ = 0; i_ < NKI; ++i_) ks[sl][i_] = *(const bf16x8*)(kt_ + kgo[i_]); \
    _Pragma("unroll") for (int i_ = 0; i_ < NVI; ++i_) vs[sl][i_] = *(const bf16x8*)(vt_ + vgo[i_]); } while (0)
#define SWRITE(b, sl) do { LAS unsigned char* bb_ = lds + (b) * BUF_BYTES; \
    _Pragma("unroll") for (int i_ = 0; i_ < NKI; ++i_) *(LAS bf16x8*)(bb_ + klo[i_]) = ks[sl][i_]; \
    _Pragma("unroll") for (int i_ = 0; i_ < NVI; ++i_) *(LAS bf16x8*)(bb_ + vlo[i_]) = vs[sl][i_]; } while (0)
#define RESC(a) do { if (__any((a) < 1.f)) { if (hi == 0) al_l[r32] = (a); asm volatile("s_waitcnt lgkmcnt(0)" ::: "memory"); \
    _Pragma("unroll") for (int d_ = 0; d_ < NCB; ++d_) _Pragma("unroll") for (int r_ = 0; r_ < 16; ++r_) o[d_][r_] *= al_l[crow(r_, hi)]; } } while (0)
#define CMASK(P0, P1, t) do { const int jb_ = (t) - (NTL - 4); if (jb_ >= 0) cmask(P0, P1, jb_, qrel, hi); } while (0)
    LAS const unsigned char* kp0 = lds + K_OFF + r32 * PITCH + hi * 16; LAS const unsigned char* kp1 = kp0 + BUF_BYTES;
    const int vb0 = (int)(uintptr_t)(lds + V_OFF) + v_rd_base(lane), vb1 = vb0 + BUF_BYTES;
    const int qrel = wid * 32 + r32;
    f32x16 pA0, pA1, pB0, pB1; float alA, alB; bf16x8 pa0, pa1, pa2, pa3;
    SLOAD(0, 0); SWRITE(0, 0); __syncthreads();
    qkt<DQK>(pA0, pA1, kp0, qr); CMASK(pA0, pA1, 0); partialSM(pA0, pA1, m_reg, alA);
    SLOAD(1, 1); SLOAD(0, 2);
    SWRITE(1, 1); __syncthreads();
#pragma unroll 1
    for (int j = 1; j + 1 < NTL; j += 2) {
        SBAR(); qkt<DQK>(pB0, pB1, kp1, qr);
        finishSM(pA0, pA1, alA, l_reg, pa0, pa1, pa2, pa3); SBAR();
        SLOAD(1, j + 2); SBAR();
        pv_all<NCB>(o, vb0, pa0, pa1, pa2, pa3); CMASK(pB0, pB1, j); partialSM(pB0, pB1, m_reg, alB);
        __syncthreads(); SWRITE(0, 0);
        RESC(alB); __syncthreads();
        SBAR(); qkt<DQK>(pA0, pA1, kp0, qr);
        finishSM(pB0, pB1, alB, l_reg, pa0, pa1, pa2, pa3); SBAR();
        if (j + 3 < NTL) SLOAD(0, j + 3); SBAR();
        pv_all<NCB>(o, vb1, pa0, pa1, pa2, pa3); CMASK(pA0, pA1, j + 1); partialSM(pA0, pA1, m_reg, alA);
        __syncthreads(); SWRITE(1, 1);
        RESC(alA); __syncthreads();
    }
    SBAR(); qkt<DQK>(pB0, pB1, kp1, qr);
    finishSM(pA0, pA1, alA, l_reg, pa0, pa1, pa2, pa3); SBAR();
    pv_all<NCB>(o, vb0, pa0, pa1, pa2, pa3); CMASK(pB0, pB1, NTL - 1); partialSM(pB0, pB1, m_reg, alB);
    RESC(alB);
    finishSM(pB0, pB1, alB, l_reg, pa0, pa1, pa2, pa3); SBAR();
    pv_all<NCB>(o, vb1, pa0, pa1, pa2, pa3);
    if (hi == 0) li_l[r32] = l_reg; asm volatile("s_waitcnt lgkmcnt(0)" ::: "memory");
    float rli[16];
#pragma unroll
    for (int r = 0; r < 16; ++r) rli[r] = __builtin_amdgcn_rcpf(li_l[crow(r, hi)]);
    __syncthreads();
    LAS bf16_t* stg = (LAS bf16_t*)(lds + wid * 8192);
#pragma unroll
    for (int r = 0; r < 16; ++r) { const int orow = crow(r, hi);
#pragma unroll
        for (int d0 = 0; d0 < NCB; ++d0) stg[orow * DV + d0 * 32 + r32] = (bf16_t)f2bf(o[d0][r] * rli[r]); }
    asm volatile("s_waitcnt lgkmcnt(0)" ::: "memory");
    constexpr int CPR = DV / 8;
#pragma unroll
    for (int i = 0; i < (32 * CPR) / 64; ++i) { const int id = i * 64 + lane, row = id / CPR, ch = id % CPR; u32x4 v = *(LAS const u32x4*)(stg + row * DV + ch * 8);
        const size_t ro = (size_t)(q0 + wid * 32 + row);
        if constexpr (KIND == 0) { *(u32x4*)(OUT + ro * 128 + ch * 8) = v; }
        else { const u32x4 g = *(const u32x4*)(GATE + ro * 1024 + ch * 8); u32x4 w;
            w.x = cvtpk(__uint_as_float(v.x << 16) * __uint_as_float(g.x << 16), __uint_as_float(v.x & 0xffff0000u) * __uint_as_float(g.x & 0xffff0000u));
            w.y = cvtpk(__uint_as_float(v.y << 16) * __uint_as_float(g.y << 16), __uint_as_float(v.y & 0xffff0000u) * __uint_as_float(g.y & 0xffff0000u));
            w.z = cvtpk(__uint_as_float(v.z << 16) * __uint_as_float(g.z << 16), __uint_as_float(v.z & 0xffff0000u) * __uint_as_float(g.z & 0xffff0000u));
            w.w = cvtpk(__uint_as_float(v.w << 16) * __uint_as_float(g.w << 16), __uint_as_float(v.w & 0xffff0000u) * __uint_as_float(g.w & 0xffff0000u));
            *(u32x4*)(OUT + ro * 1024 + ch * 8) = w; } }
    asm volatile("s_waitcnt lgkmcnt(0)" ::: "memory");
    __syncthreads();
#undef SLOAD
#undef SWRITE
#undef RESC
#undef CMASK
}
#undef SBAR
}

__device__ __forceinline__ void phase2_mfma(const Params& P, LAS unsigned char* lds) {
    const bf16_t* QD = (const bf16_t*)(P.ws + WS_QD); const bf16_t* KD = (const bf16_t*)(P.ws + WS_KD); const bf16_t* VD = (const bf16_t*)(P.ws + WS_VD);
    const bf16_t* QM = (const bf16_t*)(P.ws + WS_QM); const bf16_t* KM = (const bf16_t*)(P.ws + WS_KM); const bf16_t* VM = (const bf16_t*)(P.ws + WS_VM);
    const bf16_t* G = (const bf16_t*)(P.ws + WS_G); bf16_t* OD = (bf16_t*)(P.ws + WS_OD); bf16_t* YC = (bf16_t*)(P.ws + WS_YCAT);
    const int Gn = (int)gridDim.x, bx = (int)blockIdx.x, vcu = (Gn % 8 == 0) ? (bx % 8) * (Gn / 8) + bx / 8 : bx;
#pragma unroll 1
    for (int pr = vcu; pr < 1024; pr += Gn) {
        const int kind = pr >> 9, rem = pr & 511, bh = rem >> 3, sidx = rem & 7, b = bh >> 3, hh = bh & 7;
#pragma unroll 1
        for (int half = 0; half < 2; ++half) {
            const int qb = half == 0 ? 15 - sidx : sidx;
            if (kind == 0) att::attn_unit<64, 128, 128, 0>(QD + (size_t)bh * SEQ * 64, KD + (size_t)bh * SEQ * 64, VD + (size_t)(b * 4 + (hh >> 1)) * SEQ * 128, qb, OD + (size_t)bh * SEQ * 128, nullptr, lds);
            else att::attn_unit<96, 64, 64, 1>(QM + (size_t)bh * SEQ * 96, KM + (size_t)bh * SEQ * 96, VM + (size_t)bh * SEQ * 64, qb, YC + (size_t)b * SEQ * 1024 + 512 + hh * 64, G + (size_t)b * SEQ * 1024 + 512 + hh * 64, lds);
        }
    }
}

#define GAS __attribute__((address_space(1)))
constexpr int CW_BAR = 4096;
constexpr int LDSCTL_OFF = 131072, MISC_OFF = LDSCTL_OFF + 320;
#define XB_TMO      128
#define XB_XCNT(j)  (256  + 64 * (j))
#define XB_XSUB(j)  (1280 + 64 * (j))
#define XB_XGEN(j)  (2304 + 64 * (j))
#define XB_TOP      3328
#define XB_TOPGEN   3392
#define XCD_BAR_WORDS 3456
#define XB_SPIN_CAP (1u << 18)

__device__ __forceinline__ unsigned xb_ld(unsigned* p)              { return __hip_atomic_load(p, __ATOMIC_RELAXED, __HIP_MEMORY_SCOPE_AGENT); }
__device__ __forceinline__ unsigned xb_add(unsigned* p, unsigned v) { return __hip_atomic_fetch_add(p, v, __ATOMIC_RELAXED, __HIP_MEMORY_SCOPE_AGENT); }
__device__ __forceinline__ unsigned xb_xcc_id() { return (unsigned)__builtin_amdgcn_s_getreg((3 << 11) | 20) & 0xFu; }
#define XB_SPIN(cond, bar) do { unsigned _sp = 0; while (cond) { __builtin_amdgcn_s_sleep(1); \
    if ((++_sp & 255u) == 0u) { if (xb_ld(&(bar)[XB_TMO])) break; if (_sp > XB_SPIN_CAP) { atomicAdd(&(bar)[XB_TMO], 1u); break; } } } } while (0)

struct XcdBarrier {
    unsigned* bar; unsigned x;
    volatile LAS unsigned* st;
};

__device__ __forceinline__ XcdBarrier xcd_barrier_post(unsigned* bar, volatile LAS unsigned* st) {
    XcdBarrier b; b.bar = bar; b.x = xb_xcc_id(); b.st = st;
    if (threadIdx.x == 0) (void)xb_add(&bar[XB_XCNT(b.x)], 1u);
    return b;
}
__device__ __forceinline__ void xcd_barrier_complete(unsigned* bar, unsigned x, unsigned& nloc, unsigned& nx) {
    const unsigned G = gridDim.x * gridDim.y * gridDim.z;
    unsigned sum, cnt, mine, sp = 0u;
    for (;;) {
        sum = 0u; cnt = 0u; mine = 0u;
#pragma unroll
        for (unsigned j = 0; j < 16; ++j) { const unsigned c = xb_ld(&bar[XB_XCNT(j)]); sum += c; cnt += (c > 0u) ? 1u : 0u; mine = (j == x) ? c : mine; }
        if (sum == G) break;
        __builtin_amdgcn_s_sleep(1);
        if ((++sp & 255u) == 0u) { if (xb_ld(&bar[XB_TMO])) break; if (sp > XB_SPIN_CAP) { atomicAdd(&bar[XB_TMO], 1u); break; } }
    }
    nloc = mine > 0u ? mine : 1u; nx = cnt > 0u ? cnt : 1u;
}

__device__ __forceinline__ void xcd_barrier(const XcdBarrier& b) {
    asm volatile("s_waitcnt vmcnt(0)" ::: "memory");
    __syncthreads();
    if (threadIdx.x == 0) {
        unsigned* bar = b.bar;
        __builtin_amdgcn_s_waitcnt(0);
        unsigned nloc = b.st[0], nx = b.st[1];
        if (nloc == 0u) { xcd_barrier_complete(bar, b.x, nloc, nx); b.st[0] = nloc; b.st[1] = nx; }
        const unsigned old = xb_add(&bar[XB_XSUB(b.x)], 1u);
        const unsigned gen = old / nloc;
        if (old + 1u == (gen + 1u) * nloc) {
            __builtin_amdgcn_fence(__ATOMIC_RELEASE, "agent");
            asm volatile("s_waitcnt vmcnt(0)" ::: "memory");
            const unsigned og = xb_add(&bar[XB_TOP], 1u);
            const unsigned tg = og / nx;
            if (og + 1u == (tg + 1u) * nx) xb_add(&bar[XB_TOPGEN], 1u);
            else XB_SPIN(xb_ld(&bar[XB_TOPGEN]) == tg, bar);
            __builtin_amdgcn_fence(__ATOMIC_ACQUIRE, "agent");
            xb_add(&bar[XB_XGEN(b.x)], 1u);
            asm volatile("s_waitcnt vmcnt(0)" ::: "memory");
        } else {
            XB_SPIN(xb_ld(&bar[XB_XGEN(b.x)]) == gen, bar);
            __builtin_amdgcn_fence(__ATOMIC_ACQUIRE, "agent");
            asm volatile("s_waitcnt vmcnt(0)" ::: "memory");
        }
    }
    __syncthreads();
}

#ifndef OPT_P1
#define OPT_P1 1
#endif
#ifndef OPT_P2
#define OPT_P2 1
#endif
#ifndef OPT_P15
#define OPT_P15 1
#endif
#ifndef OPT_P3
#define OPT_P3 1
#endif
#ifndef OPT_P4
#define OPT_P4 1
#endif
constexpr int LDS_BYTES = 147456;
__global__ void __launch_bounds__(NT, 2) fwd_megakernel(Params P) {
    extern __shared__ __attribute__((aligned(16))) unsigned char lds_raw[];
    LAS unsigned char* lds = (LAS unsigned char*)lds_raw;
    float* smem = (float*)lds_raw;
    cg::grid_group grid = cg::this_grid();
    const int bid = blockIdx.x, nb = gridDim.x;
    for (int u = threadIdx.x; u < (LDS_BYTES - LDSCTL_OFF) / 4; u += NT) ((LAS unsigned*)(lds + LDSCTL_OFF))[u] = 0u;
    __syncthreads();
    const XcdBarrier bar = xcd_barrier_post((unsigned*)(P.ws + WS_CTL) + CW_BAR, (volatile LAS unsigned*)(lds + MISC_OFF) + 8);
    phase0(P, bid, nb);
    phase0_weights(P, bid, nb, lds);
    grid.sync();
#if OPT_P1
    phase1_gemm(P, lds);
#else
    phase1_naive(P, bid, nb, smem);
#endif
    xcd_barrier(bar);
#if OPT_P15
    phase15_gemm(P, lds);
#else
    phase15_naive(P, bid, nb, smem);
#endif
    xcd_barrier(bar);
#if OPT_P2
    phase2_mfma(P, lds);
#else
    phase2_naive(P, bid, nb, smem);
#endif
    xcd_barrier(bar);
    phase25_naive(P, bid, nb);
    xcd_barrier(bar);
#if OPT_P3
    phase3_gemm(P, lds);
#else
    phase3_naive(P, bid, nb, smem);
#endif
    xcd_barrier(bar);
#if OPT_P4
    phase4_gemm(P, lds);
#else
    phase4_naive(P, bid, nb, smem);
#endif
    xcd_barrier(bar);
    phase5(P, bid, nb);
}

extern "C" void kernel_launch(void* const* d_in, const int* in_sizes, int n_in, void* d_out, int out_size, void* d_ws, size_t ws_size, hipStream_t stream) {
    if (n_in != 15 || out_size != T * DM || ws_size < WS_END) { fprintf(stderr, "kernel_launch: unexpected shapes (n_in %d out %d ws %zu)\n", n_in, out_size, ws_size); return; }
    static int grid_blocks = 0;
    if (!grid_blocks) {
        int dev = 0, cus = 0, per_cu = 0;
        (void)hipGetDevice(&dev);
        (void)hipDeviceGetAttribute(&cus, hipDeviceAttributeMultiprocessorCount, dev);
        if (hipFuncSetAttribute((const void*)fwd_megakernel, hipFuncAttributeMaxDynamicSharedMemorySize, LDS_BYTES) != hipSuccess) { fprintf(stderr, "kernel_launch: hipFuncSetAttribute failed\n"); return; }
        if (hipOccupancyMaxActiveBlocksPerMultiprocessor(&per_cu, (const void*)fwd_megakernel, NT, LDS_BYTES) != hipSuccess || per_cu < 1) { fprintf(stderr, "kernel_launch: occupancy query says %d blocks/CU\n", per_cu); return; }
        grid_blocks = cus;
    }
    Params P{};
    P.x = (const float*)d_in[0]; P.p = (const float*)d_in[1]; P.pos = (const int*)d_in[2]; P.norm_g = (const float*)d_in[3]; P.w_in = (const float*)d_in[4];
    P.diff_lambda = (const float*)d_in[5]; P.subln_g = (const float*)d_in[6]; P.qn_g = (const float*)d_in[7]; P.w_uq = (const float*)d_in[8]; P.kvn_g = (const float*)d_in[9];
    P.w_ukv = (const float*)d_in[10]; P.w_out = (const float*)d_in[11]; P.w_ple = (const float*)d_in[12]; P.w_gate = (const float*)d_in[13]; P.final_g = (const float*)d_in[14];
    P.out = (float*)d_out; P.ws = (unsigned char*)d_ws;
    if (hipMemsetAsync((char*)d_ws + WS_CTL, 0, 65536, stream) != hipSuccess) { fprintf(stderr, "kernel_launch: memset failed\n"); return; }
    void* args[] = {&P};
    hipError_t e = hipLaunchCooperativeKernel((void*)fwd_megakernel, dim3(grid_blocks), dim3(NT), args, LDS_BYTES, stream);
    if (e != hipSuccess) fprintf(stderr, "cooperative launch failed: %s (grid %d)\n", hipGetErrorString(e), grid_blocks);
}
```

```cpp
#include <hip/hip_runtime.h>
#include <hip/hip_cooperative_groups.h>
#include <cstdio>
#include <cstdint>

namespace cg = cooperative_groups;
typedef unsigned short bf16_t;

constexpr int BATCH = 8, SEQ = 4096, T = BATCH * SEQ, DM = 1024, DIN = 3104, PLE_DIM = 256;
constexpr int OFF_DQ = 0, OFF_DK = 512, OFF_DV = 1024, OFF_DG = 1536, OFF_CQ = 2048, OFF_CKV = 2432, OFF_KR = 2560, OFF_MG = 2592;
constexpr int QLORA = 384, KVLORA = 128, CQP = 512;
constexpr float RMS_EPS = 1e-6f;
constexpr float LOG2E = 1.4426950408889634f;
constexpr float C2D = 0.125f * LOG2E;
constexpr float C2M = 0.10206207261596575f * LOG2E;
constexpr float LAM_INIT = 0.2f;
constexpr int NT = 512;

constexpr size_t MiB = 1u << 20;
constexpr size_t WS_CTL = 0;
constexpr size_t WS_MISC = 1 * MiB;
constexpr size_t WS_SSQQ = 1 * MiB + 65536, WS_SSQKV = WS_SSQQ + 131072, WS_SSQF = WS_SSQKV + 131072;
constexpr size_t WS_CSA = 2 * MiB, WS_CSB = 10 * MiB;
constexpr size_t WS_WIN = 14 * MiB, WS_WPLE = 21 * MiB, WS_WUQ = 22 * MiB, WS_WUKV = 23 * MiB, WS_WOUT = 24 * MiB, WS_WG = 26 * MiB;
constexpr size_t WS_PB = 28 * MiB, WS_CQ = 44 * MiB  , WS_XN = 76 * MiB, WS_OD = WS_XN;
constexpr size_t WS_QD = 140 * MiB, WS_KD = 172 * MiB, WS_PLE = WS_QD, WS_VD = 204 * MiB, WS_G = 236 * MiB, WS_HB = WS_G;
constexpr size_t WS_QM = 300 * MiB, WS_KM = 348 * MiB, WS_VM = 396 * MiB, WS_YCAT = 428 * MiB, WS_END = 492 * MiB;

struct Params {
    const float* x; const float* p; const int* pos; const float* norm_g; const float* w_in; const float* diff_lambda;
    const float* subln_g; const float* qn_g; const float* w_uq; const float* kvn_g; const float* w_ukv; const float* w_out;
    const float* w_ple; const float* w_gate; const float* final_g; float* out; unsigned char* ws;
};

__device__ __forceinline__ unsigned f2bf(float f) { unsigned u = __float_as_uint(f); return (u + 0x7fffu + ((u >> 16) & 1u)) >> 16; }
__device__ __forceinline__ float bf2f(bf16_t h) { return __uint_as_float(((unsigned)h) << 16); }
__device__ __forceinline__ float wave_sum(float v) {
#pragma unroll
    for (int o = 1; o < 64; o <<= 1) v += __shfl_xor(v, o);
    return v;
}
__device__ __forceinline__ int tid_op() { int t = threadIdx.x; asm volatile("" : "+v"(t)); return t; }
__device__ __forceinline__ int sgpr_op(int v) { asm volatile("" : "+s"(v)); return v; }
__device__ __forceinline__ float silu_f(float v) { return v / (1.f + __expf(-v)); }
__device__ __forceinline__ float sigmoid_f(float v) { return 1.f / (1.f + __expf(-v)); }

__device__ __forceinline__ void phase0(const Params& P, int bid, int nb) {
    bid = sgpr_op(bid); nb = sgpr_op(nb);
    const int tid = tid_op(), lane = tid & 63, wave = tid >> 6;
    const int gw = bid * (NT / 64) + wave, ngw = nb * (NT / 64);
    const int gt = bid * NT + tid, ngt = nb * NT;
    bf16_t* XN = (bf16_t*)(P.ws + WS_XN);
    for (int t = gw; t < T; t += ngw) {
        const float4* xr = (const float4*)(P.x + (size_t)t * DM);
        float4 v[4]; float s = 0.f;
#pragma unroll
        for (int j = 0; j < 4; ++j) { v[j] = xr[lane + 64 * j]; s += v[j].x * v[j].x + v[j].y * v[j].y + v[j].z * v[j].z + v[j].w * v[j].w; }
        s = wave_sum(s);
        const float rstd = 1.0f / sqrtf(s * (1.f / DM) + RMS_EPS);
#pragma unroll
        for (int j = 0; j < 4; ++j) {
            const float4 g = ((const float4*)P.norm_g)[lane + 64 * j];
            uint2 o; o.x = f2bf(v[j].x * rstd * g.x) | (f2bf(v[j].y * rstd * g.y) << 16); o.y = f2bf(v[j].z * rstd * g.z) | (f2bf(v[j].w * rstd * g.w) << 16);
            ((uint2*)(XN + (size_t)t * DM))[lane + 64 * j] = o;
        }
    }
    bf16_t* PB = (bf16_t*)(P.ws + WS_PB);
    for (int i = gt; i < T * PLE_DIM / 4; i += ngt) {
        const float4 v = ((const float4*)P.p)[i];
        uint2 o; o.x = f2bf(v.x) | (f2bf(v.y) << 16); o.y = f2bf(v.z) | (f2bf(v.w) << 16);
        ((uint2*)PB)[i] = o;
    }
    float2* CSA = (float2*)(P.ws + WS_CSA); float2* CSB = (float2*)(P.ws + WS_CSB);
    for (int i = gt; i < T * 32; i += ngt) {
        const int t = i >> 5, k = i & 31;
        const double inv = pow(10000.0, -(double)k / 32.0);
        const double ang = (double)P.pos[t] * inv;
        double sn, cs; sincos(ang, &sn, &cs);
        CSA[i] = make_float2((float)cs, (float)sn);
    }
    for (int i = gt; i < T * 16; i += ngt) {
        const int t = i >> 4, k = i & 15;
        const double inv = pow(10000.0, -(double)k / 16.0);
        const double ang = (double)P.pos[t] * inv;
        double sn, cs; sincos(ang, &sn, &cs);
        CSB[i] = make_float2((float)cs, (float)sn);
    }
    float* ssq = (float*)(P.ws + WS_SSQQ);
    for (int i = gt; i < 3 * T; i += ngt) ssq[i] = 0.f;
    if (bid == 0 && tid == 0) {
        float s1 = 0.f, s2 = 0.f;
        for (int i = 0; i < 64; ++i) { s1 += P.diff_lambda[i] * P.diff_lambda[64 + i]; s2 += P.diff_lambda[128 + i] * P.diff_lambda[192 + i]; }
        ((float*)(P.ws + WS_MISC))[0] = expf(s1) - expf(s2) + LAM_INIT;
    }
}

constexpr int NG_SMEM_FLOATS = 16 * 129 + 16 * 65 + 128 * 65;
__device__ __forceinline__ void ngemm_tile(const bf16_t* A, int lda, int row0, const float* W, int ldw, int col0, int ncol, int K, const float* kscale, float* smem) {
    float* As = smem; float* Bs = smem + 16 * 129; float* Cs = Bs + 16 * 65;
    const int tid = tid_op(), ty = tid >> 4, tx = tid & 15;
    float acc[4][4];
#pragma unroll
    for (int i = 0; i < 4; ++i)
#pragma unroll
        for (int j = 0; j < 4; ++j) acc[i][j] = 0.f;
#pragma unroll 1
    for (int k0 = 0; k0 < K; k0 += 16) {
        __syncthreads();
#pragma unroll
        for (int i = 0; i < 4; ++i) { const int idx = tid + i * NT, r = idx >> 4, kk = idx & 15; As[kk * 129 + r] = bf2f(A[(size_t)(row0 + r) * lda + k0 + kk]); }
#pragma unroll
        for (int i = 0; i < 2; ++i) { const int idx = tid + i * NT, kk = idx >> 6, c = idx & 63;
            float w = 0.f; if (c < ncol) { w = W[(size_t)(k0 + kk) * ldw + col0 + c]; if (kscale) w *= kscale[k0 + kk]; }
            Bs[kk * 65 + c] = w; }
        __syncthreads();
#pragma unroll
        for (int kk = 0; kk < 16; ++kk) {
            float a[4], b[4];
#pragma unroll
            for (int i = 0; i < 4; ++i) a[i] = As[kk * 129 + ty * 4 + i];
#pragma unroll
            for (int j = 0; j < 4; ++j) b[j] = Bs[kk * 65 + tx * 4 + j];
#pragma unroll
            for (int i = 0; i < 4; ++i)
#pragma unroll
                for (int j = 0; j < 4; ++j) acc[i][j] += a[i] * b[j];
        }
    }
    __syncthreads();
#pragma unroll
    for (int i = 0; i < 4; ++i)
#pragma unroll
        for (int j = 0; j < 4; ++j) Cs[(ty * 4 + i) * 65 + tx * 4 + j] = acc[i][j];
    __syncthreads();
}

__device__ __forceinline__ void phase1_naive(const Params& P, int bid, int nb, float* smem) {
    bid = sgpr_op(bid); nb = sgpr_op(nb);
    const int tid = tid_op();
    const bf16_t* XN = (const bf16_t*)(P.ws + WS_XN);
    bf16_t* QD = (bf16_t*)(P.ws + WS_QD); bf16_t* KD = (bf16_t*)(P.ws + WS_KD); bf16_t* VD = (bf16_t*)(P.ws + WS_VD); bf16_t* G = (bf16_t*)(P.ws + WS_G);
    bf16_t* CQ = (bf16_t*)(P.ws + WS_CQ); bf16_t* KM = (bf16_t*)(P.ws + WS_KM);
    float* SSQQ = (float*)(P.ws + WS_SSQQ); float* SSQKV = (float*)(P.ws + WS_SSQKV);
    const float2* CSA = (const float2*)(P.ws + WS_CSA); const float2* CSB = (const float2*)(P.ws + WS_CSB);
    float* Cs = smem + 16 * 129 + 16 * 65;
    constexpr int NCT = 49, NRT = T / 128;
    for (int item = bid; item < NCT * NRT; item += nb) {
        const int ct = item % NCT, rt = item / NCT, row0 = rt * 128;
        int col0, ncol = 64;
        if (ct < 40) col0 = ct * 64; else if (ct == 40) { col0 = OFF_KR; ncol = 32; } else col0 = OFF_MG + (ct - 41) * 64;
        ngemm_tile(XN, DM, row0, P.w_in, DIN, col0, ncol, DM, nullptr, smem);
        _Pragma("unroll 1") for (int e = tid; e < 128 * 64; e += NT) {
            const int r = e >> 6, c = e & 63, t = row0 + r, b = t / SEQ, s = t % SEQ;
            const float v = Cs[r * 65 + c];
            if (col0 < OFF_DV) {
                const int i = c & 31; const float x1 = Cs[r * 65 + i], x2 = Cs[r * 65 + i + 32]; const float2 cs = CSA[(size_t)t * 32 + i];
                const float o = (c < 32) ? (x1 * cs.x - x2 * cs.y) : (x2 * cs.x + x1 * cs.y);
                if (col0 < OFF_DK) { const int mh = col0 / 64; QD[((size_t)(b * 8 + mh) * SEQ + s) * 64 + c] = (bf16_t)f2bf(o * C2D); }
                else { const int mh = (col0 - OFF_DK) / 64; KD[((size_t)(b * 8 + mh) * SEQ + s) * 64 + c] = (bf16_t)f2bf(o); }
            } else if (col0 < OFF_DG) { const int col = col0 - OFF_DV + c, h = col >> 7, d = col & 127; VD[((size_t)(b * 4 + h) * SEQ + s) * 128 + d] = (bf16_t)f2bf(v); }
            else if (col0 < OFF_CQ) { const int col = col0 - OFF_DG + c; G[(size_t)t * 1024 + col] = (bf16_t)f2bf(silu_f(v)); }
            else if (col0 < OFF_CKV) { const int col = col0 - OFF_CQ + c; CQ[(size_t)t * CQP + col] = (bf16_t)f2bf(v); }
            else if (col0 < OFF_KR) { const int col = col0 - OFF_CKV + c; CQ[(size_t)t * CQP + QLORA + col] = (bf16_t)f2bf(v); }
            else if (col0 == OFF_KR) { if (c < 32) { const int i = c & 15; const float x1 = Cs[r * 65 + i], x2 = Cs[r * 65 + i + 16]; const float2 cs = CSB[(size_t)t * 16 + i];
                    const float o = (c < 16) ? (x1 * cs.x - x2 * cs.y) : (x2 * cs.x + x1 * cs.y);
                    for (int h = 0; h < 8; ++h) KM[((size_t)(b * 8 + h) * SEQ + s) * 96 + 64 + c] = (bf16_t)f2bf(o); } }
            else { const int col = col0 - OFF_MG + c; G[(size_t)t * 1024 + 512 + col] = (bf16_t)f2bf(silu_f(v)); }
        }
        if (col0 >= OFF_CQ && col0 < OFF_KR && tid < 128) {
            float s = 0.f; _Pragma("unroll 4") for (int c = 0; c < 64; ++c) { const float v = Cs[tid * 65 + c]; s += v * v; }
            atomicAdd((col0 < OFF_CKV ? SSQQ : SSQKV) + row0 + tid, s);
        }
    }
}

__device__ __forceinline__ void phase15_naive(const Params& P, int bid, int nb, float* smem) {
    bid = sgpr_op(bid); nb = sgpr_op(nb);
    const int tid = tid_op();
    const bf16_t* CQ = (const bf16_t*)(P.ws + WS_CQ); const bf16_t* CKV = CQ + QLORA;
    bf16_t* QM = (bf16_t*)(P.ws + WS_QM); bf16_t* KM = (bf16_t*)(P.ws + WS_KM); bf16_t* VM = (bf16_t*)(P.ws + WS_VM);
    const float* SSQQ = (const float*)(P.ws + WS_SSQQ); const float* SSQKV = (const float*)(P.ws + WS_SSQKV);
    const float2* CSB = (const float2*)(P.ws + WS_CSB);
    float* Cs = smem + 16 * 129 + 16 * 65;
    constexpr int NCT = 12 + 16, NRT = T / 128;
    for (int item = bid; item < NCT * NRT; item += nb) {
        const int ct = item % NCT, rt = item / NCT, row0 = rt * 128;
        if (ct < 12) {
            const int col0 = ct * 64;
            ngemm_tile(CQ, CQP, row0, P.w_uq, 768, col0, 64, QLORA, P.qn_g, smem);
            _Pragma("unroll 1") for (int e = tid; e < 128 * 64; e += NT) {
                const int r = e >> 6, c = e & 63, t = row0 + r, b = t / SEQ, s = t % SEQ, col = col0 + c, h = col / 96, j = col % 96;
                const float rstd = 1.0f / sqrtf(SSQQ[t] * (1.f / QLORA) + RMS_EPS);
                float o;
                if (j < 64) o = Cs[r * 65 + c];
                else { const int jj = j - 64, i = jj & 15, cb = c - jj; const float x1 = Cs[r * 65 + cb + i], x2 = Cs[r * 65 + cb + i + 16]; const float2 cs = CSB[(size_t)t * 16 + i];
                    o = (jj < 16) ? (x1 * cs.x - x2 * cs.y) : (x2 * cs.x + x1 * cs.y); }
                QM[((size_t)(b * 8 + h) * SEQ + s) * 96 + j] = (bf16_t)f2bf(o * rstd * C2M);
            }
        } else {
            const int col0 = (ct - 12) * 64;
            ngemm_tile(CKV, CQP, row0, P.w_ukv, 1024, col0, 64, KVLORA, P.kvn_g, smem);
            _Pragma("unroll 1") for (int e = tid; e < 128 * 64; e += NT) {
                const int r = e >> 6, c = e & 63, t = row0 + r, b = t / SEQ, s = t % SEQ, col = col0 + c, h = col >> 7, j = col & 127;
                const float rstd = 1.0f / sqrtf(SSQKV[t] * (1.f / KVLORA) + RMS_EPS);
                const float o = Cs[r * 65 + c] * rstd;
                if (j < 64) KM[((size_t)(b * 8 + h) * SEQ + s) * 96 + j] = (bf16_t)f2bf(o);
                else VM[((size_t)(b * 8 + h) * SEQ + s) * 64 + j - 64] = (bf16_t)f2bf(o);
            }
        }
    }
}

template <int DQK, int DV, int DVS>
__device__ __forceinline__ void nattn_rows(const bf16_t* Qh, const bf16_t* Kh, const bf16_t* Vh, int q0, float* o, float& l_out, unsigned* smem) {
    const int tid = tid_op(), i = q0 + tid;
    unsigned* Ks = smem; unsigned* Vs = smem + 32 * (DQK / 2);
    unsigned q2[DQK / 2];
#pragma unroll
    for (int d = 0; d < DQK / 2; ++d) q2[d] = ((const unsigned*)(Qh + (size_t)i * DQK))[d];
#pragma unroll
    for (int d = 0; d < DV; ++d) o[d] = 0.f;
    float m = -1e30f, l = 0.f;
    const int jend = q0 + NT;
#pragma unroll 1
    for (int j0 = 0; j0 < jend; j0 += 32) {
        __syncthreads();
        for (int idx = tid; idx < 32 * (DQK / 2); idx += NT) Ks[idx] = ((const unsigned*)(Kh + (size_t)j0 * DQK))[idx];
        for (int idx = tid; idx < 32 * (DV / 2); idx += NT) { const int r = idx / (DV / 2), c = idx % (DV / 2); Vs[idx] = ((const unsigned*)(Vh + (size_t)(j0 + r) * DVS))[c]; }
        __syncthreads();
#pragma unroll 1
        for (int jj = 0; jj < 32; jj += 2) {
            float sc[2];
#pragma unroll
            for (int k = 0; k < 2; ++k) {
                const unsigned* kr = Ks + (jj + k) * (DQK / 2); float s = 0.f;
#pragma unroll
                for (int d = 0; d < DQK / 2; ++d) { const unsigned kk = kr[d]; unsigned qq = q2[d]; asm volatile("" : "+v"(qq));
                    s += __uint_as_float(qq << 16) * __uint_as_float(kk << 16); s += __uint_as_float(qq & 0xffff0000u) * __uint_as_float(kk & 0xffff0000u); }
                sc[k] = (j0 + jj + k <= i) ? s : -1e30f;
                asm volatile("" : "+v"(sc[k]));
            }
            const float mn = fmaxf(fmaxf(sc[0], sc[1]), m);
            const float alpha = exp2f(m - mn);
            float pr[2];
#pragma unroll
            for (int k = 0; k < 2; ++k) pr[k] = (j0 + jj + k <= i) ? exp2f(sc[k] - mn) : 0.f;
            l = l * alpha + (pr[0] + pr[1]); m = mn;
#pragma unroll
            for (int d = 0; d < DV; ++d) o[d] *= alpha;
#pragma unroll
            for (int k = 0; k < 2; ++k) { const unsigned* vr = Vs + (jj + k) * (DV / 2);
#pragma unroll
                for (int d = 0; d < DV / 2; ++d) { const unsigned vv = vr[d]; o[2 * d] += pr[k] * __uint_as_float(vv << 16); o[2 * d + 1] += pr[k] * __uint_as_float(vv & 0xffff0000u); } }
        }
    }
    l_out = l;
}
__device__ __forceinline__ void phase2_naive(const Params& P, int bid, int nb, float* smemf) {
    bid = sgpr_op(bid); nb = sgpr_op(nb);
    unsigned* smem = (unsigned*)smemf;
    const bf16_t* QD = (const bf16_t*)(P.ws + WS_QD); const bf16_t* KD = (const bf16_t*)(P.ws + WS_KD); const bf16_t* VD = (const bf16_t*)(P.ws + WS_VD);
    const bf16_t* QM = (const bf16_t*)(P.ws + WS_QM); const bf16_t* KM = (const bf16_t*)(P.ws + WS_KM); const bf16_t* VM = (const bf16_t*)(P.ws + WS_VM);
    const bf16_t* G = (const bf16_t*)(P.ws + WS_G); bf16_t* OD = (bf16_t*)(P.ws + WS_OD); bf16_t* YC = (bf16_t*)(P.ws + WS_YCAT);
    constexpr int NCH = SEQ / NT;
    for (int item = bid; item < 2 * 64 * NCH; item += nb) {
        const int kind = item / (64 * NCH), rem = item % (64 * NCH), bh = rem / NCH, ch = NCH - 1 - rem % NCH, q0 = ch * NT, b = bh >> 3, hh = bh & 7;
        const int i = q0 + tid_op();
        if (kind == 0) {
#pragma unroll 1
            for (int half = 0; half < 2; ++half) {
                float o[64], l;
                nattn_rows<64, 64, 128>(QD + (size_t)bh * SEQ * 64, KD + (size_t)bh * SEQ * 64, VD + (size_t)(b * 4 + (hh >> 1)) * SEQ * 128 + half * 64, q0, o, l, smem);
                const float rl = 1.f / l;
#pragma unroll
                for (int d = 0; d < 64; ++d) OD[((size_t)bh * SEQ + i) * 128 + half * 64 + d] = (bf16_t)f2bf(o[d] * rl);
            }
        } else {
            float o[64], l;
            nattn_rows<96, 64, 64>(QM + (size_t)bh * SEQ * 96, KM + (size_t)bh * SEQ * 96, VM + (size_t)bh * SEQ * 64, q0, o, l, smem);
            const float rl = 1.f / l; const size_t t = (size_t)b * SEQ + i;
#pragma unroll
            for (int d = 0; d < 64; ++d) { const size_t idx = t * 1024 + 512 + hh * 64 + d; YC[idx] = (bf16_t)f2bf(o[d] * rl * bf2f(G[idx])); }
        }
    }
}

__device__ __forceinline__ void phase25_naive(const Params& P, int bid, int nb) {
    bid = sgpr_op(bid); nb = sgpr_op(nb);
    const bf16_t* OD = (const bf16_t*)(P.ws + WS_OD); const bf16_t* G = (const bf16_t*)(P.ws + WS_G); bf16_t* YC = (bf16_t*)(P.ws + WS_YCAT);
    const float lam = ((const float*)(P.ws + WS_MISC))[0];
    const int tid = tid_op(), lane = tid & 63, wave = tid >> 6;
    const int gw = bid * (NT / 64) + wave, ngw = nb * (NT / 64);
    for (int it = gw; it < T * 4; it += ngw) {
        const int t = it >> 2, h = it & 3, b = t / SEQ, s = t % SEQ;
        const bf16_t* o0 = OD + ((size_t)(b * 8 + 2 * h) * SEQ + s) * 128; const bf16_t* o1 = OD + ((size_t)(b * 8 + 2 * h + 1) * SEQ + s) * 128;
        const float d0 = bf2f(o0[lane]) - lam * bf2f(o1[lane]), d1 = bf2f(o0[lane + 64]) - lam * bf2f(o1[lane + 64]);
        const float ss = wave_sum(d0 * d0 + d1 * d1);
        const float rstd = 1.0f / sqrtf(ss * (1.f / 128.f) + RMS_EPS);
        const size_t base = (size_t)t * 1024 + h * 128;
        YC[base + lane] = (bf16_t)f2bf(d0 * rstd * P.subln_g[lane] * (1.f - LAM_INIT) * bf2f(G[base + lane]));
        YC[base + lane + 64] = (bf16_t)f2bf(d1 * rstd * P.subln_g[lane + 64] * (1.f - LAM_INIT) * bf2f(G[base + lane + 64]));
    }
}

__device__ __forceinline__ void phase3_naive(const Params& P, int bid, int nb, float* smem) {
    bid = sgpr_op(bid); nb = sgpr_op(nb);
    const int tid = tid_op();
    const bf16_t* YC = (const bf16_t*)(P.ws + WS_YCAT); const bf16_t* PB = (const bf16_t*)(P.ws + WS_PB);
    bf16_t* HB = (bf16_t*)(P.ws + WS_HB); bf16_t* PLE = (bf16_t*)(P.ws + WS_PLE);
    float* Cs = smem + 16 * 129 + 16 * 65;
    constexpr int NRT = T / 128;
    for (int item = bid; item < 32 * NRT; item += nb) {
        const int ct = item % 32, rt = item / 32, row0 = rt * 128, col0 = (ct & 15) * 64;
        if (ct < 16) {
            ngemm_tile(YC, DM, row0, P.w_out, DM, col0, 64, DM, nullptr, smem);
            _Pragma("unroll 1") for (int e = tid; e < 128 * 64; e += NT) { const int r = e >> 6, c = e & 63; const size_t idx = (size_t)(row0 + r) * DM + col0 + c;
                const float h = P.x[idx] + Cs[r * 65 + c]; P.out[idx] = h; HB[idx] = (bf16_t)f2bf(h); }
        } else {
            ngemm_tile(PB, PLE_DIM, row0, P.w_ple, DM, col0, 64, PLE_DIM, nullptr, smem);
            _Pragma("unroll 1") for (int e = tid; e < 128 * 64; e += NT) { const int r = e >> 6, c = e & 63; const size_t idx = (size_t)(row0 + r) * DM + col0 + c; PLE[idx] = (bf16_t)f2bf(Cs[r * 65 + c]); }
        }
    }
}
__device__ __forceinline__ void phase4_naive(const Params& P, int bid, int nb, float* smem) {
    bid = sgpr_op(bid); nb = sgpr_op(nb);
    const int tid = tid_op();
    const bf16_t* HB = (const bf16_t*)(P.ws + WS_HB); const bf16_t* PLE = (const bf16_t*)(P.ws + WS_PLE); float* SSQF = (float*)(P.ws + WS_SSQF);
    float* Cs = smem + 16 * 129 + 16 * 65;
    constexpr int NRT = T / 128;
    for (int item = bid; item < 16 * NRT; item += nb) {
        const int ct = item % 16, rt = item / 16, row0 = rt * 128, col0 = ct * 64;
        ngemm_tile(HB, DM, row0, P.w_gate, DM, col0, 64, DM, nullptr, smem);
        _Pragma("unroll 1") for (int e = tid; e < 128 * 64; e += NT) { const int r = e >> 6, c = e & 63; const size_t idx = (size_t)(row0 + r) * DM + col0 + c;
            const float h2 = P.out[idx] + bf2f(PLE[idx]) * sigmoid_f(Cs[r * 65 + c]); P.out[idx] = h2; Cs[r * 65 + c] = h2; }
        __syncthreads();
        if (tid < 128) { float s = 0.f; _Pragma("unroll 4") for (int c = 0; c < 64; ++c) { const float v = Cs[tid * 65 + c]; s += v * v; } atomicAdd(SSQF + row0 + tid, s); }
    }
}
__device__ __forceinline__ void phase5(const Params& P, int bid, int nb) {
    bid = sgpr_op(bid); nb = sgpr_op(nb);
    const float* SSQF = (const float*)(P.ws + WS_SSQF);
    const int tid = tid_op(), lane = tid & 63, wave = tid >> 6;
    const int gw = bid * (NT / 64) + wave, ngw = nb * (NT / 64);
    for (int t = gw; t < T; t += ngw) {
        const float rstd = 1.0f / sqrtf(SSQF[t] * (1.f / DM) + RMS_EPS);
        float4* o = (float4*)(P.out + (size_t)t * DM);
#pragma unroll
        for (int j = 0; j < 4; ++j) { float4 v = o[lane + 64 * j]; const float4 g = ((const float4*)P.final_g)[lane + 64 * j];
            v.x *= rstd * g.x; v.y *= rstd * g.y; v.z *= rstd * g.z; v.w *= rstd * g.w; o[lane + 64 * j] = v; }
    }
}

namespace pg8 {
#define PG8_LAS __attribute__((address_space(3)))
typedef unsigned short bf16_t;
typedef short bf16x8 __attribute__((ext_vector_type(8)));
typedef float f32x4 __attribute__((ext_vector_type(4)));
typedef unsigned u32x4 __attribute__((ext_vector_type(4)));
constexpr int BM = 256, BK = 64, HALF = 128, HTB = HALF * BK * 2  , STAGE_BYTES = 8 * HTB, NXCD = 8, WGM = 8;

__host__ __device__ __forceinline__ int lds_byte(int r, int c) { const int st = (r >> 4) * 2 + (c >> 5), rr = r & 15, cc = c & 31, ob = rr * 64 + cc * 2; return st * 1024 + (ob ^ (((ob >> 9) & 1) << 5)); }
__host__ __device__ __forceinline__ void stage_rc(int b, int& R, int& C) { const int st = b / 1024, sb = b % 1024, swz = sb ^ (((sb >> 9) & 1) << 5); R = (st >> 1) * 16 + swz / 64; C = (st & 1) * 32 + (swz % 64) / 2; }
__host__ __device__ __forceinline__ int perm32(int rho) { const int n = rho >> 4, i = rho & 15; return 8 * (i >> 2) + 4 * n + (i & 3); }

struct Unit { int pm, pn; };
struct Gemm { const bf16_t* A; const bf16_t* Bt; int M, N, K, lda; };

struct StaticOrder {
    int nM, nN, nwg, G, c;
    __host__ __device__ void init(int M, int N, int G_, int c_) { nM = M / BM; nN = N / BM; nwg = nM * nN; G = G_; c = c_; }
    __host__ __device__ bool next(int i, Unit& u) const {
        const long L = (long)i * G + c; if (L >= nwg) return false;
        int wgid = (int)L; { const int q = nwg / NXCD, r = nwg % NXCD, xcd = wgid % NXCD, off = wgid / NXCD; wgid = (xcd < r ? xcd * (q + 1) : r * (q + 1) + (xcd - r) * q) + off; }
        const int nig = WGM * nN, gid = wgid / nig, fm = gid * WGM, gsz = (nM - fm) < WGM ? (nM - fm) : WGM;
        u.pm = fm + ((wgid % nig) % gsz); u.pn = (wgid % nig) / gsz; return true;
    }
    __device__ __forceinline__ void a_ready(const Unit&) const {}
    __device__ __forceinline__ void done(const Unit&) const {}
};

__device__ __forceinline__ unsigned cvt_pk_bf16(float lo, float hi) { unsigned r; asm volatile("v_cvt_pk_bf16_f32 %0, %1, %2" : "=v"(r) : "v"(lo), "v"(hi)); return r; }
template <class Epi, class Sched, bool ALIGN_EPI = false, bool SP2 = false>
__device__ __forceinline__ void gemm_phase(PG8_LAS unsigned char* lds, const Gemm g, const Sched& S, const Epi& E) {
    const int tid = tid_op(), wid = __builtin_amdgcn_readfirstlane(tid >> 6), lane = tid & 63, wr = wid >> 2, wc = wid & 3, fr = lane & 15, fq = lane >> 4;
    const int K = g.K, nt = K / BK;
    unsigned voffA[2], voffB[2];
#pragma unroll
    for (int i = 0; i < 2; ++i) { int R, C; stage_rc(tid * 16 + i * 8192, R, C); const int Rb = Epi::PERM ? ((R & ~31) + perm32(R & 31)) : R;
        voffA[i] = (unsigned)(R * g.lda + C) * 2u; voffB[i] = (unsigned)(Rb * K + C) * 2u; }
    const size_t kstep = (size_t)(BK * 2);
    const size_t hstepA = (size_t)HALF * g.lda * 2, hstepB = (size_t)HALF * K * 2;
    const size_t tstepA = 2 * hstepA, tstepB = 2 * hstepB;
    const unsigned ldsw = (unsigned)wid * 1024u;
    const int aoff = lds_byte(wr * 64 + fr, fq * 8), boff = lds_byte(wc * 32 + fr, fq * 8);
#define PG8_SA(b, h) (((b) * 2 + (h)) * HTB)
#define PG8_SB(b, h) ((4 + (b) * 2 + (h)) * HTB)
#define PG8_STAGE(bufoff, gbase, voff) do { _Pragma("unroll") for (int _i = 0; _i < 2; ++_i) \
        __builtin_amdgcn_global_load_lds((const unsigned*)((const char*)(gbase) + (voff)[_i]), (PG8_LAS unsigned*)(lds + (bufoff) + ldsw + _i * 8192), 16, 0, 0); } while (0)
#define PG8_LDA(dst, b, h) do { _Pragma("unroll") for (int m = 0; m < 4; ++m) _Pragma("unroll") for (int k = 0; k < 2; ++k) dst[m][k] = *(const PG8_LAS bf16x8*)(lds + PG8_SA(b, h) + aoff + m * 2048 + k * 1024); } while (0)
#define PG8_LDB(dst, b, h) do { _Pragma("unroll") for (int n = 0; n < 2; ++n) _Pragma("unroll") for (int k = 0; k < 2; ++k) dst[n][k] = *(const PG8_LAS bf16x8*)(lds + PG8_SB(b, h) + boff + n * 2048 + k * 1024); } while (0)
#define PG8_MMA(ai, bj, At, Bt) do { __builtin_amdgcn_s_setprio(1); _Pragma("unroll") for (int m = 0; m < 4; ++m) _Pragma("unroll") for (int n = 0; n < 2; ++n) _Pragma("unroll") for (int k = 0; k < 2; ++k) \
        acc[ai][bj][m][n] = __builtin_amdgcn_mfma_f32_16x16x32_bf16(Bt[n][k], At[m][k], acc[ai][bj][m][n], 0, 0, 0); __builtin_amdgcn_s_setprio(0); } while (0)
#define PG8_WAIT_V(n) asm volatile("s_waitcnt vmcnt(" #n ")" ::: "memory")
#define PG8_WAIT_L(n) asm volatile("s_waitcnt lgkmcnt(" #n ")" ::: "memory")
#define PG8_BAR __builtin_amdgcn_s_barrier()
#define PG8_SCHED __builtin_amdgcn_sched_barrier(0)
    Unit cur, nxt; int ui = 0;
    if (!S.next(0, cur)) return;
    f32x4 acc[2][2][4][2];
#pragma unroll
    for (int a = 0; a < 2; ++a)
#pragma unroll
        for (int b = 0; b < 2; ++b)
#pragma unroll
            for (int m = 0; m < 4; ++m)
#pragma unroll
                for (int n = 0; n < 2; ++n) acc[a][b][m][n] = (f32x4){0.f, 0.f, 0.f, 0.f};
    bf16x8 At[4][2], B0[2][2], B1[2][2];
    const char* cA = (const char*)g.A + (size_t)cur.pm * tstepA; const char* cB = (const char*)g.Bt + (size_t)cur.pn * tstepB;
    S.a_ready(cur);
    if constexpr (SP2) {
        PG8_STAGE(PG8_SB(0, 0), cB, voffB); PG8_STAGE(PG8_SB(0, 1), cB + hstepB, voffB); PG8_STAGE(PG8_SA(0, 0), cA, voffA); PG8_STAGE(PG8_SA(0, 1), cA + hstepA, voffA);
        if (wr == 1) PG8_BAR;
        PG8_WAIT_V(2); PG8_BAR;
        PG8_STAGE(PG8_SB(1, 0), cB + kstep, voffB); PG8_STAGE(PG8_SA(1, 0), cA + kstep, voffA); PG8_STAGE(PG8_SB(1, 1), cB + hstepB + kstep, voffB);
        PG8_WAIT_V(6); PG8_BAR;
    } else {
        PG8_STAGE(PG8_SB(0, 0), cB, voffB); PG8_STAGE(PG8_SA(0, 0), cA, voffA); PG8_STAGE(PG8_SB(0, 1), cB + hstepB, voffB); PG8_STAGE(PG8_SA(0, 1), cA + hstepA, voffA);
        if (wr == 1) PG8_BAR;
        PG8_WAIT_V(4); PG8_BAR;
        PG8_STAGE(PG8_SB(1, 0), cB + kstep, voffB); PG8_STAGE(PG8_SA(1, 0), cA + kstep, voffA); PG8_STAGE(PG8_SB(1, 1), cB + hstepB + kstep, voffB);
        PG8_WAIT_V(6); PG8_BAR;
    }
    for (;;) {
        const bool has_next = S.next(ui + 1, nxt);
        const char* nA = has_next ? (const char*)g.A + (size_t)nxt.pm * tstepA : cA; const char* nB = has_next ? (const char*)g.Bt + (size_t)nxt.pn * tstepB : cB;
#pragma unroll 1
        for (int t = 0; t < nt; t += 2) {
            const bool last = (t == nt - 2);
            const char* a1 = cA + (size_t)(t + 1) * kstep;
            const char* a2 = last ? nA : cA + (size_t)(t + 2) * kstep; const char* b2 = last ? nB : cB + (size_t)(t + 2) * kstep;
            const char* a3 = a2 + kstep; const char* b3 = b2 + kstep;
            if (last && has_next) S.a_ready(nxt);
            if constexpr (SP2) {
            PG8_LDB(B0, 0, 0); PG8_LDB(B1, 0, 1); PG8_SCHED; PG8_LDA(At, 0, 0); PG8_STAGE(PG8_SA(1, 1), a1 + hstepA, voffA);
            PG8_WAIT_V(8); PG8_WAIT_L(0); PG8_BAR; PG8_MMA(0, 0, At, B0); PG8_MMA(0, 1, At, B1); PG8_BAR; PG8_SCHED;
            PG8_LDA(At, 0, 1); PG8_STAGE(PG8_SB(0, 0), b2, voffB); PG8_STAGE(PG8_SB(0, 1), b2 + hstepB, voffB); PG8_STAGE(PG8_SA(0, 0), a2, voffA);
            PG8_WAIT_V(8); PG8_WAIT_L(0); PG8_BAR; PG8_MMA(1, 0, At, B0); PG8_MMA(1, 1, At, B1); PG8_BAR; PG8_SCHED;
            PG8_LDB(B0, 1, 0); PG8_LDB(B1, 1, 1); PG8_SCHED; PG8_LDA(At, 1, 0); PG8_STAGE(PG8_SA(0, 1), a2 + hstepA, voffA);
            PG8_WAIT_V(8); PG8_WAIT_L(0); PG8_BAR; PG8_MMA(0, 0, At, B0); PG8_MMA(0, 1, At, B1); PG8_BAR; PG8_SCHED;
            PG8_LDA(At, 1, 1); PG8_STAGE(PG8_SB(1, 0), b3, voffB); PG8_STAGE(PG8_SB(1, 1), b3 + hstepB, voffB); PG8_STAGE(PG8_SA(1, 0), a3, voffA);
            PG8_WAIT_V(8); PG8_WAIT_L(0); PG8_BAR; PG8_MMA(1, 0, At, B0); PG8_MMA(1, 1, At, B1); PG8_BAR; PG8_SCHED;
            } else {
            PG8_LDB(B0, 0, 0); PG8_SCHED; PG8_LDA(At, 0, 0); PG8_STAGE(PG8_SA(1, 1), a1 + hstepA, voffA);
            PG8_WAIT_L(8); PG8_BAR; PG8_WAIT_L(0); PG8_MMA(0, 0, At, B0); PG8_BAR; PG8_SCHED;
            PG8_LDB(B1, 0, 1); PG8_STAGE(PG8_SB(0, 0), b2, voffB);
            PG8_BAR; PG8_WAIT_L(0); PG8_MMA(0, 1, At, B1); PG8_BAR;
            PG8_LDA(At, 0, 1); PG8_STAGE(PG8_SA(0, 0), a2, voffA);
            PG8_BAR; PG8_WAIT_L(0); PG8_MMA(1, 0, At, B0); PG8_BAR; PG8_SCHED;
            PG8_STAGE(PG8_SB(0, 1), b2 + hstepB, voffB);
            PG8_WAIT_V(6); PG8_BAR; PG8_MMA(1, 1, At, B1); PG8_BAR;
            PG8_LDB(B0, 1, 0); PG8_SCHED; PG8_LDA(At, 1, 0); PG8_STAGE(PG8_SA(0, 1), a2 + hstepA, voffA);
            PG8_WAIT_L(8); PG8_BAR; PG8_WAIT_L(0); PG8_MMA(0, 0, At, B0); PG8_BAR; PG8_SCHED;
            PG8_LDB(B1, 1, 1); PG8_STAGE(PG8_SB(1, 0), b3, voffB);
            PG8_BAR; PG8_WAIT_L(0); PG8_MMA(0, 1, At, B1); PG8_BAR;
            PG8_LDA(At, 1, 1); PG8_STAGE(PG8_SA(1, 0), a3, voffA);
            PG8_BAR; PG8_WAIT_L(0); PG8_MMA(1, 0, At, B0); PG8_BAR; PG8_SCHED;
            PG8_STAGE(PG8_SB(1, 1), b3 + hstepB, voffB);
            PG8_WAIT_V(6); PG8_BAR; PG8_MMA(1, 1, At, B1); PG8_BAR;
            }
        }
        if constexpr (ALIGN_EPI) { if (wr == 0) PG8_BAR; }
        if constexpr (!Epi::AFTER_DRAIN) { E(acc, cur, wr, wc, fr, fq); S.done(cur); }
        if (!has_next) break;
#pragma unroll
        for (int a = 0; a < 2; ++a)
#pragma unroll
            for (int b = 0; b < 2; ++b)
#pragma unroll
                for (int m = 0; m < 4; ++m)
#pragma unroll
                    for (int n = 0; n < 2; ++n) acc[a][b][m][n] = (f32x4){0.f, 0.f, 0.f, 0.f};
        cur = nxt; cA = nA; cB = nB; ++ui;
        if constexpr (ALIGN_EPI) { if (wr == 1) PG8_BAR; }
    }
    PG8_WAIT_V(0);
    if constexpr (!ALIGN_EPI) { if (wr == 0) PG8_BAR; }
    PG8_BAR;
    if constexpr (Epi::AFTER_DRAIN) { E.fused(acc, cur, wr, wc, fr, fq, lds, wid, lane); S.done(cur); }
#undef PG8_SA
#undef PG8_SB
#undef PG8_STAGE
#undef PG8_LDA
#undef PG8_LDB
#undef PG8_MMA
#undef PG8_WAIT_V
#undef PG8_WAIT_L
#undef PG8_BAR
#undef PG8_SCHED
}
}

#define LAS __attribute__((address_space(3)))
typedef float f32x4 __attribute__((ext_vector_type(4)));
typedef unsigned u32x4 __attribute__((ext_vector_type(4)));
using pg8::cvt_pk_bf16;
__device__ __forceinline__ u32x4 pack8(const f32x4 a, const f32x4 b) { u32x4 w; w.x = cvt_pk_bf16(a[0], a[1]); w.y = cvt_pk_bf16(a[2], a[3]); w.z = cvt_pk_bf16(b[0], b[1]); w.w = cvt_pk_bf16(b[2], b[3]); return w; }

struct MapIn {
    __device__ __forceinline__ int operator()(int g) const { const int pn = g >> 8, cc = g & 255, bj = cc >> 7, w = cc & 127;
        if (pn < 2) return OFF_DQ + (4 * pn + (w >> 5)) * 64 + bj * 32 + (w & 31);
        if (pn < 4) return OFF_DK + (4 * (pn - 2) + (w >> 5)) * 64 + bj * 32 + (w & 31);
        if (pn < 6) return OFF_DV + (pn - 4) * 256 + cc;
        if (pn < 8) return OFF_DG + (pn - 6) * 256 + cc;
        if (pn == 8) return OFF_CQ + cc;
        if (pn == 9) return bj == 0 ? OFF_CQ + 256 + w : OFF_CKV + w;
        if (pn < 12) return OFF_MG + (pn - 10) * 256 + cc;
        return w < 16 ? OFF_KR + bj * 16 + w : -1; } };
struct MapUq {
    __device__ __forceinline__ int operator()(int g) const { const int pn = g >> 8, cc = g & 255;
        if (pn == 0) { const int bj = cc >> 7, w = cc & 127; return (w >> 4) * 96 + 64 + bj * 16 + (w & 15); }
        const int gp = g - 256; return (gp >> 6) * 96 + (gp & 63); } };
struct MapId { __device__ __forceinline__ int operator()(int g) const { return g; } };
template <class Map>
__device__ __forceinline__ void wconv(const float* W, int K, int ldw, const float* kscale, bf16_t* Wt, int ldwt, int kdst_off, int Ng, Map map, LAS float* scr, int gw, int ngw, int lane) {
    const int nblk = Ng / 32, items = (K / 64) * nblk;
    for (int it = gw; it < items; it += ngw) {
        const int kb = it / nblk, nbk = it % nblk, k0 = 64 * kb, n0 = 32 * nbk;
        const int src = map(n0 + (lane & 31));
#pragma unroll 8
        for (int i = 0; i < 32; ++i) { const int kk = 2 * i + (lane >> 5);
            float v = 0.f; if (src >= 0) { v = W[(size_t)(k0 + kk) * ldw + src]; if (kscale) v *= kscale[k0 + kk]; }
            scr[kk * 33 + (lane & 31)] = v; }
        asm volatile("s_waitcnt lgkmcnt(0)" ::: "memory");
        const int c = lane & 7;
#pragma unroll
        for (int j = 0; j < 4; ++j) { const int n = (lane >> 3) + 8 * j; const LAS float* sp = scr + (8 * c) * 33 + n;
            u32x4 o; o.x = f2bf(sp[0]) | (f2bf(sp[33]) << 16); o.y = f2bf(sp[2 * 33]) | (f2bf(sp[3 * 33]) << 16); o.z = f2bf(sp[4 * 33]) | (f2bf(sp[5 * 33]) << 16); o.w = f2bf(sp[6 * 33]) | (f2bf(sp[7 * 33]) << 16);
            *(u32x4*)(Wt + (size_t)(n0 + n) * ldwt + kdst_off + k0 + 8 * c) = o; }
        asm volatile("s_waitcnt lgkmcnt(0)" ::: "memory");
    }
}
constexpr int NIN = 13 * 256;
__device__ __forceinline__ void phase0_weights(const Params& P, int bid, int nb, LAS unsigned char* lds) {
    const int tid = tid_op(), lane = tid & 63, wave = tid >> 6;
    const int gw = bid * (NT / 64) + wave, ngw = nb * (NT / 64);
    LAS float* scr = (LAS float*)(lds + wave * 16384);
    wconv(P.w_in, DM, DIN, nullptr, (bf16_t*)(P.ws + WS_WIN), DM, 0, NIN, MapIn(), scr, gw, ngw, lane);
    wconv(P.w_ple, PLE_DIM, DM, nullptr, (bf16_t*)(P.ws + WS_WPLE), PLE_DIM, 0, DM, MapId(), scr, gw, ngw, lane);
    wconv(P.w_uq, QLORA, 768, P.qn_g, (bf16_t*)(P.ws + WS_WUQ), QLORA, 0, 768, MapUq(), scr, gw, ngw, lane);
    wconv(P.w_ukv, KVLORA, 1024, P.kvn_g, (bf16_t*)(P.ws + WS_WUKV), 256, 128, 1024, MapId(), scr, gw, ngw, lane);
    wconv(P.w_out, DM, DM, nullptr, (bf16_t*)(P.ws + WS_WOUT), DM, 0, DM, MapId(), scr, gw, ngw, lane);
    wconv(P.w_gate, DM, DM, nullptr, (bf16_t*)(P.ws + WS_WG), DM, 0, DM, MapId(), scr, gw, ngw, lane);
    u32x4* z = (u32x4*)(P.ws + WS_WUKV);
    for (int i = bid * NT + tid; i < 1024 * 16; i += nb * NT) { const int g = i >> 4, c = i & 15; z[g * 32 + c] = (u32x4){0u, 0u, 0u, 0u}; }
}

struct Epi1 {
    static constexpr bool PERM = true, AFTER_DRAIN = false;
    bf16_t *QD, *KD, *VD, *G, *CQ, *KM; float *SSQQ, *SSQKV; const float2 *CSA, *CSB;
    __device__ __forceinline__ void operator()(const f32x4 (&acc)[2][2][4][2], const pg8::Unit& u, int wr, int wc, int fr, int fq) const {
        const int pn = u.pn, b = u.pm >> 4, s0 = (u.pm & 15) * 256 + wr * 64 + fr, t0 = u.pm * 256 + wr * 64 + fr;
        if (pn < 4) {
            bf16_t* dst = pn < 2 ? QD : KD; const float sc = pn < 2 ? C2D : 1.f; const int mh = 4 * (pn & 1) + wc;
#pragma unroll
            for (int ai = 0; ai < 2; ++ai)
#pragma unroll
                for (int m = 0; m < 4; ++m) { const int ro = ai * 128 + m * 16; const f32x4* cs = (const f32x4*)(CSA + (size_t)(t0 + ro) * 32 + 8 * fq);
                    f32x4 o1[2], o2[2];
#pragma unroll
                    for (int n = 0; n < 2; ++n) { const f32x4 ca = cs[2 * n], cb = cs[2 * n + 1]; const f32x4 x1 = acc[ai][0][m][n], x2 = acc[ai][1][m][n];
                        o1[n] = (f32x4){x1[0] * ca[0] - x2[0] * ca[1], x1[1] * ca[2] - x2[1] * ca[3], x1[2] * cb[0] - x2[2] * cb[1], x1[3] * cb[2] - x2[3] * cb[3]} * sc;
                        o2[n] = (f32x4){x2[0] * ca[0] + x1[0] * ca[1], x2[1] * ca[2] + x1[1] * ca[3], x2[2] * cb[0] + x1[2] * cb[1], x2[3] * cb[2] + x1[3] * cb[3]} * sc; }
                    bf16_t* rp = dst + ((size_t)(b * 8 + mh) * SEQ + s0 + ro) * 64 + 8 * fq;
                    *(u32x4*)rp = pack8(o1[0], o1[1]); *(u32x4*)(rp + 32) = pack8(o2[0], o2[1]); asm volatile("" ::: "memory"); }
        } else if (pn < 6) {
#pragma unroll
            for (int ai = 0; ai < 2; ++ai)
#pragma unroll
                for (int m = 0; m < 4; ++m)
#pragma unroll
                    for (int bj = 0; bj < 2; ++bj) { const int ro = ai * 128 + m * 16, h = 2 * (pn - 4) + bj;
                        *(u32x4*)(VD + ((size_t)(b * 4 + h) * SEQ + s0 + ro) * 128 + 32 * wc + 8 * fq) = pack8(acc[ai][bj][m][0], acc[ai][bj][m][1]); }
        } else if (pn < 8 || pn == 10 || pn == 11) {
            const int cb = (pn < 8 ? (pn - 6) * 256 : 512 + (pn - 10) * 256) + 32 * wc + 8 * fq;
#pragma unroll
            for (int ai = 0; ai < 2; ++ai)
#pragma unroll
                for (int m = 0; m < 4; ++m)
#pragma unroll
                    for (int bj = 0; bj < 2; ++bj) { const int ro = ai * 128 + m * 16; f32x4 a = acc[ai][bj][m][0], c = acc[ai][bj][m][1];
#pragma unroll
                        for (int j = 0; j < 4; ++j) { a[j] = silu_f(a[j]); c[j] = silu_f(c[j]); }
                        *(u32x4*)(G + (size_t)(t0 + ro) * 1024 + cb + 128 * bj) = pack8(a, c); }
        } else if (pn < 10) {
#pragma unroll
            for (int ai = 0; ai < 2; ++ai)
#pragma unroll
                for (int m = 0; m < 4; ++m) { const int ro = ai * 128 + m * 16; float ss[2];
#pragma unroll
                    for (int bj = 0; bj < 2; ++bj) { const f32x4 a = acc[ai][bj][m][0], c = acc[ai][bj][m][1];
                        *(u32x4*)(CQ + (size_t)(t0 + ro) * CQP + (pn - 8) * 256 + 128 * bj + 32 * wc + 8 * fq) = pack8(a, c);
                        float q = (a[0] * a[0] + a[1] * a[1]) + (a[2] * a[2] + a[3] * a[3]) + (c[0] * c[0] + c[1] * c[1]) + (c[2] * c[2] + c[3] * c[3]);
                        q += __shfl_xor(q, 16); q += __shfl_xor(q, 32); ss[bj] = q; }
                    if (fq == 0) { if (pn == 8) atomicAdd(SSQQ + t0 + ro, ss[0] + ss[1]); else { atomicAdd(SSQQ + t0 + ro, ss[0]); atomicAdd(SSQKV + t0 + ro, ss[1]); } } }
        } else {
            if (wc == 0 && fq < 2) {
#pragma unroll
                for (int ai = 0; ai < 2; ++ai)
#pragma unroll
                    for (int m = 0; m < 4; ++m) { const int ro = ai * 128 + m * 16; const f32x4* cs = (const f32x4*)(CSB + (size_t)(t0 + ro) * 16 + 8 * fq);
                        f32x4 o1[2], o2[2];
#pragma unroll
                        for (int n = 0; n < 2; ++n) { const f32x4 ca = cs[2 * n], cb = cs[2 * n + 1]; const f32x4 x1 = acc[ai][0][m][n], x2 = acc[ai][1][m][n];
                            o1[n] = (f32x4){x1[0] * ca[0] - x2[0] * ca[1], x1[1] * ca[2] - x2[1] * ca[3], x1[2] * cb[0] - x2[2] * cb[1], x1[3] * cb[2] - x2[3] * cb[3]};
                            o2[n] = (f32x4){x2[0] * ca[0] + x1[0] * ca[1], x2[1] * ca[2] + x1[1] * ca[3], x2[2] * cb[0] + x1[2] * cb[1], x2[3] * cb[2] + x1[3] * cb[3]}; }
                        const u32x4 w1 = pack8(o1[0], o1[1]), w2 = pack8(o2[0], o2[1]);
#pragma unroll
                        for (int h = 0; h < 8; ++h) { bf16_t* rp = KM + ((size_t)(b * 8 + h) * SEQ + s0 + ro) * 96 + 64 + 8 * fq; *(u32x4*)rp = w1; *(u32x4*)(rp + 16) = w2; } }
            }
        }
    }
};
struct EpiStore {
    static constexpr bool PERM = true, AFTER_DRAIN = false;
    bf16_t* O; int ldc;
    __device__ __forceinline__ void operator()(const f32x4 (&acc)[2][2][4][2], const pg8::Unit& u, int wr, int wc, int fr, int fq) const {
        const int t0 = u.pm * 256 + wr * 64 + fr, c0 = u.pn * 256 + 32 * wc + 8 * fq;
#pragma unroll
        for (int ai = 0; ai < 2; ++ai)
#pragma unroll
            for (int m = 0; m < 4; ++m)
#pragma unroll
                for (int bj = 0; bj < 2; ++bj) *(u32x4*)(O + (size_t)(t0 + ai * 128 + m * 16) * ldc + c0 + 128 * bj) = pack8(acc[ai][bj][m][0], acc[ai][bj][m][1]);
    }
};
struct EpiQ {
    static constexpr bool PERM = true, AFTER_DRAIN = false;
    bf16_t* QM; const float* SSQQ; const float2* CSB;
    __device__ __forceinline__ void operator()(const f32x4 (&acc)[2][2][4][2], const pg8::Unit& u, int wr, int wc, int fr, int fq) const {
        const int pn = u.pn, b = u.pm >> 4, s0 = (u.pm & 15) * 256 + wr * 64 + fr, t0 = u.pm * 256 + wr * 64 + fr;
#pragma unroll
        for (int ai = 0; ai < 2; ++ai)
#pragma unroll
            for (int m = 0; m < 4; ++m) { const int ro = ai * 128 + m * 16; const float sc = C2M * __builtin_amdgcn_rsqf(SSQQ[t0 + ro] * (1.f / QLORA) + RMS_EPS);
                if (pn == 0) { const int h = 2 * wc + (fq >> 1), i0 = 8 * (fq & 1); const f32x4* cs = (const f32x4*)(CSB + (size_t)(t0 + ro) * 16 + i0);
                    f32x4 o1[2], o2[2];
#pragma unroll
                    for (int n = 0; n < 2; ++n) { const f32x4 ca = cs[2 * n], cb = cs[2 * n + 1]; const f32x4 x1 = acc[ai][0][m][n], x2 = acc[ai][1][m][n];
                        o1[n] = (f32x4){x1[0] * ca[0] - x2[0] * ca[1], x1[1] * ca[2] - x2[1] * ca[3], x1[2] * cb[0] - x2[2] * cb[1], x1[3] * cb[2] - x2[3] * cb[3]} * sc;
                        o2[n] = (f32x4){x2[0] * ca[0] + x1[0] * ca[1], x2[1] * ca[2] + x1[1] * ca[3], x2[2] * cb[0] + x1[2] * cb[1], x2[3] * cb[2] + x1[3] * cb[3]} * sc; }
                    bf16_t* rp = QM + ((size_t)(b * 8 + h) * SEQ + s0 + ro) * 96 + 64 + i0;
                    *(u32x4*)rp = pack8(o1[0], o1[1]); *(u32x4*)(rp + 16) = pack8(o2[0], o2[1]);
                } else {
#pragma unroll
                    for (int bj = 0; bj < 2; ++bj) { const int h = 4 * (pn - 1) + 2 * bj + (wc >> 1), d = 32 * (wc & 1) + 8 * fq;
                        *(u32x4*)(QM + ((size_t)(b * 8 + h) * SEQ + s0 + ro) * 96 + d) = pack8(acc[ai][bj][m][0] * sc, acc[ai][bj][m][1] * sc); } }
                asm volatile("" ::: "memory");
            }
    }
};
struct EpiKV {
    static constexpr bool PERM = true, AFTER_DRAIN = false;
    bf16_t *KM, *VM; const float* SSQKV;
    __device__ __forceinline__ void operator()(const f32x4 (&acc)[2][2][4][2], const pg8::Unit& u, int wr, int wc, int fr, int fq) const {
        const int pn = u.pn, b = u.pm >> 4, s0 = (u.pm & 15) * 256 + wr * 64 + fr, t0 = u.pm * 256 + wr * 64 + fr;
#pragma unroll
        for (int ai = 0; ai < 2; ++ai)
#pragma unroll
            for (int m = 0; m < 4; ++m) { const int ro = ai * 128 + m * 16; const float sc = __builtin_amdgcn_rsqf(SSQKV[t0 + ro] * (1.f / KVLORA) + RMS_EPS);
#pragma unroll
                for (int bj = 0; bj < 2; ++bj) { const int h = 2 * pn + bj; const size_t rowi = (size_t)(b * 8 + h) * SEQ + s0 + ro;
                    bf16_t* rp = (wc < 2) ? KM + rowi * 96 + 32 * wc + 8 * fq : VM + rowi * 64 + 32 * (wc - 2) + 8 * fq;
                    *(u32x4*)rp = pack8(acc[ai][bj][m][0] * sc, acc[ai][bj][m][1] * sc); }
                asm volatile("" ::: "memory"); }
    }
};
struct Epi3 {
    static constexpr bool PERM = true, AFTER_DRAIN = false;
    const float* x; float* out; bf16_t* HB;
    __device__ __forceinline__ void operator()(const f32x4 (&acc)[2][2][4][2], const pg8::Unit& u, int wr, int wc, int fr, int fq) const {
        const int t0 = u.pm * 256 + wr * 64 + fr, c0 = u.pn * 256 + 32 * wc + 8 * fq;
#pragma unroll
        for (int ai = 0; ai < 2; ++ai)
#pragma unroll
            for (int m = 0; m < 4; ++m) {
#pragma unroll
                for (int bj = 0; bj < 2; ++bj) { const size_t idx = (size_t)(t0 + ai * 128 + m * 16) * DM + c0 + 128 * bj;
                    const f32x4 h0 = *(const f32x4*)(x + idx) + acc[ai][bj][m][0], h1 = *(const f32x4*)(x + idx + 4) + acc[ai][bj][m][1];
                    *(f32x4*)(out + idx) = h0; *(f32x4*)(out + idx + 4) = h1; *(u32x4*)(HB + idx) = pack8(h0, h1); }
                asm volatile("" ::: "memory"); }
    }
};
struct Epi4 {
    static constexpr bool PERM = true, AFTER_DRAIN = false;
    float* out; const bf16_t* PLE; float* SSQF;
    __device__ __forceinline__ void operator()(const f32x4 (&acc)[2][2][4][2], const pg8::Unit& u, int wr, int wc, int fr, int fq) const {
        const int t0 = u.pm * 256 + wr * 64 + fr, c0 = u.pn * 256 + 32 * wc + 8 * fq;
#pragma unroll
        for (int ai = 0; ai < 2; ++ai)
#pragma unroll
            for (int m = 0; m < 4; ++m) { float q = 0.f;
#pragma unroll
                for (int bj = 0; bj < 2; ++bj) { const size_t idx = (size_t)(t0 + ai * 128 + m * 16) * DM + c0 + 128 * bj;
                    const u32x4 pw = *(const u32x4*)(PLE + idx); f32x4 h0 = *(const f32x4*)(out + idx), h1 = *(const f32x4*)(out + idx + 4);
                    const f32x4 a = acc[ai][bj][m][0], c = acc[ai][bj][m][1];
                    h0[0] += __uint_as_float(pw.x << 16) * sigmoid_f(a[0]); h0[1] += __uint_as_float(pw.x & 0xffff0000u) * sigmoid_f(a[1]);
                    h0[2] += __uint_as_float(pw.y << 16) * sigmoid_f(a[2]); h0[3] += __uint_as_float(pw.y & 0xffff0000u) * sigmoid_f(a[3]);
                    h1[0] += __uint_as_float(pw.z << 16) * sigmoid_f(c[0]); h1[1] += __uint_as_float(pw.z & 0xffff0000u) * sigmoid_f(c[1]);
                    h1[2] += __uint_as_float(pw.w << 16) * sigmoid_f(c[2]); h1[3] += __uint_as_float(pw.w & 0xffff0000u) * sigmoid_f(c[3]);
                    *(f32x4*)(out + idx) = h0; *(f32x4*)(out + idx + 4) = h1;
                    q += (h0[0] * h0[0] + h0[1] * h0[1]) + (h0[2] * h0[2] + h0[3] * h0[3]) + (h1[0] * h1[0] + h1[1] * h1[1]) + (h1[2] * h1[2] + h1[3] * h1[3]); }
                q += __shfl_xor(q, 16); q += __shfl_xor(q, 32);
                if (fq == 0) atomicAdd(SSQF + t0 + ai * 128 + m * 16, q);
                asm volatile("" ::: "memory"); }
    }
};

#ifndef PG8_SP2
#define PG8_SP2 true
#endif
#ifndef PG8_ALIGN
#define PG8_ALIGN true
#endif
__device__ __forceinline__ void phase1_gemm(const Params& P, LAS unsigned char* lds) {
    pg8::Gemm g{(const bf16_t*)(P.ws + WS_XN), (const bf16_t*)(P.ws + WS_WIN), T, NIN, DM, DM}; pg8::StaticOrder S; S.init(T, NIN, (int)gridDim.x, (int)blockIdx.x);
    Epi1 E{(bf16_t*)(P.ws + WS_QD), (bf16_t*)(P.ws + WS_KD), (bf16_t*)(P.ws + WS_VD), (bf16_t*)(P.ws + WS_G), (bf16_t*)(P.ws + WS_CQ), (bf16_t*)(P.ws + WS_KM),
           (float*)(P.ws + WS_SSQQ), (float*)(P.ws + WS_SSQKV), (const float2*)(P.ws + WS_CSA), (const float2*)(P.ws + WS_CSB)};
    pg8::gemm_phase<Epi1, pg8::StaticOrder, PG8_ALIGN, PG8_SP2>(lds, g, S, E);
}
__device__ __forceinline__ void phase15_gemm(const Params& P, LAS unsigned char* lds) {
    { pg8::Gemm g{(const bf16_t*)(P.ws + WS_CQ), (const bf16_t*)(P.ws + WS_WUQ), T, 768, QLORA, CQP}; pg8::StaticOrder S; S.init(T, 768, (int)gridDim.x, (int)blockIdx.x);
      EpiQ E{(bf16_t*)(P.ws + WS_QM), (const float*)(P.ws + WS_SSQQ), (const float2*)(P.ws + WS_CSB)};
      pg8::gemm_phase<EpiQ, pg8::StaticOrder, PG8_ALIGN, PG8_SP2>(lds, g, S, E); }
    { pg8::Gemm g{(const bf16_t*)(P.ws + WS_CQ) + 256, (const bf16_t*)(P.ws + WS_WUKV), T, 1024, 256, CQP}; pg8::StaticOrder S; S.init(T, 1024, (int)gridDim.x, (int)blockIdx.x);
      EpiKV E{(bf16_t*)(P.ws + WS_KM), (bf16_t*)(P.ws + WS_VM), (const float*)(P.ws + WS_SSQKV)};
      pg8::gemm_phase<EpiKV, pg8::StaticOrder, PG8_ALIGN, PG8_SP2>(lds, g, S, E); }
}
__device__ __forceinline__ void phase3_gemm(const Params& P, LAS unsigned char* lds) {
    { pg8::Gemm g{(const bf16_t*)(P.ws + WS_YCAT), (const bf16_t*)(P.ws + WS_WOUT), T, DM, DM, DM}; pg8::StaticOrder S; S.init(T, DM, (int)gridDim.x, (int)blockIdx.x);
      Epi3 E{P.x, P.out, (bf16_t*)(P.ws + WS_HB)};
      pg8::gemm_phase<Epi3, pg8::StaticOrder, PG8_ALIGN, PG8_SP2>(lds, g, S, E); }
    { pg8::Gemm g{(const bf16_t*)(P.ws + WS_PB), (const bf16_t*)(P.ws + WS_WPLE), T, DM, PLE_DIM, PLE_DIM}; pg8::StaticOrder S; S.init(T, DM, (int)gridDim.x, (int)blockIdx.x);
      EpiStore E{(bf16_t*)(P.ws + WS_PLE), DM};
      pg8::gemm_phase<EpiStore, pg8::StaticOrder, PG8_ALIGN, PG8_SP2>(lds, g, S, E); }
}
__device__ __forceinline__ void phase4_gemm(const Params& P, LAS unsigned char* lds) {
    pg8::Gemm g{(const bf16_t*)(P.ws + WS_HB), (const bf16_t*)(P.ws + WS_WG), T, DM, DM, DM}; pg8::StaticOrder S; S.init(T, DM, (int)gridDim.x, (int)blockIdx.x);
    Epi4 E{P.out, (const bf16_t*)(P.ws + WS_PLE), (float*)(P.ws + WS_SSQF)};
    pg8::gemm_phase<Epi4, pg8::StaticOrder, PG8_ALIGN, PG8_SP2>(lds, g, S, E);
}

namespace att {
typedef short bf16x8 __attribute__((ext_vector_type(8)));
typedef short s16x4 __attribute__((ext_vector_type(4)));
typedef float f32x16 __attribute__((ext_vector_type(16)));
#define SBAR() __builtin_amdgcn_sched_barrier(0)
constexpr float THR = 8.f;
constexpr int BUF_BYTES = 32768, K_OFF = 0, V_OFF = 16384;
constexpr int WS_OFF = 2 * BUF_BYTES;
constexpr int ATT_LDS_BYTES = WS_OFF + 8 * 64 * 4;
__device__ __forceinline__ int crow(int r, int hi) { return (r & 3) + 8 * (r >> 2) + 4 * hi; }
__device__ __forceinline__ unsigned cvtpk(float lo, float hi) { unsigned r; asm volatile("v_cvt_pk_bf16_f32 %0, %1, %2" : "=v"(r) : "v"(lo), "v"(hi)); return r; }

__device__ __forceinline__ void partialSM(f32x16& p0, f32x16& p1, float& m_reg, float& alpha) {
    float pmax = p0[0];
#pragma unroll
    for (int r = 1; r < 16; ++r) pmax = fmaxf(pmax, p0[r]);
#pragma unroll
    for (int r = 0; r < 16; ++r) pmax = fmaxf(pmax, p1[r]);
    { auto rr = __builtin_amdgcn_permlane32_swap(__float_as_uint(pmax), __float_as_uint(pmax), false, false); pmax = fmaxf(__uint_as_float(rr[0]), __uint_as_float(rr[1])); }
    float mn;
    if (__builtin_expect(__all(pmax - m_reg <= THR), 1)) { mn = m_reg; alpha = 1.f; }
    else { mn = fmaxf(m_reg, pmax); alpha = __builtin_amdgcn_exp2f(m_reg - mn); m_reg = mn; }
#pragma unroll
    for (int r = 0; r < 16; ++r) { p0[r] -= mn; p1[r] -= mn; }
#pragma unroll
    for (int r = 0; r < 16; ++r) p0[r] = __builtin_amdgcn_exp2f(p0[r]);
}
__device__ __forceinline__ void finishSM(f32x16& p0, f32x16& p1, float alpha, float& l_reg, bf16x8& pa0, bf16x8& pa1, bf16x8& pa2, bf16x8& pa3) {
#pragma unroll
    for (int r = 0; r < 16; ++r) p1[r] = __builtin_amdgcn_exp2f(p1[r]);
    float ps = 0.f;
#pragma unroll
    for (int r = 0; r < 16; ++r) ps += p0[r];
#pragma unroll
    for (int r = 0; r < 16; ++r) ps += p1[r];
    { auto rr = __builtin_amdgcn_permlane32_swap(__float_as_uint(ps), __float_as_uint(ps), false, false); ps = __uint_as_float(rr[0]) + __uint_as_float(rr[1]); }
    l_reg = l_reg * alpha + ps;
#define PK4(P, BASE, OUT) do { unsigned a0 = cvtpk(P[BASE + 0], P[BASE + 1]), a1 = cvtpk(P[BASE + 2], P[BASE + 3]);   \
    unsigned b0 = cvtpk(P[BASE + 4], P[BASE + 5]), b1 = cvtpk(P[BASE + 6], P[BASE + 7]);                              \
    auto r0 = __builtin_amdgcn_permlane32_swap(a0, b0, false, false); auto r1 = __builtin_amdgcn_permlane32_swap(a1, b1, false, false); \
    u32x4 w = {r0[0], r1[0], r0[1], r1[1]}; OUT = __builtin_bit_cast(bf16x8, w); } while (0)
    PK4(p0, 0, pa0); PK4(p0, 8, pa1); PK4(p1, 0, pa2); PK4(p1, 8, pa3);
#undef PK4
}
__device__ __forceinline__ void cmask(f32x16& p0, f32x16& p1, int jb, int qrel, int hi) {
    const int kb = 64 * jb + 4 * hi;
#pragma unroll
    for (int r = 0; r < 16; ++r) { const int kv = kb + (r & 3) + 8 * (r >> 2); if (kv > qrel) p0[r] = -INFINITY; if (kv + 32 > qrel) p1[r] = -INFINITY; }
}
template <int DQK> __device__ __forceinline__ void qkt(f32x16& p0, f32x16& p1, LAS const unsigned char* kp  , const bf16x8* qr) {
    constexpr int PITCH = 2 * DQK + 16;
    p0 = f32x16{}; p1 = f32x16{};
#pragma unroll
    for (int d0 = 0; d0 < DQK / 16; ++d0) {
        const bf16x8 b0 = *(LAS const bf16x8*)(kp + d0 * 32), b1 = *(LAS const bf16x8*)(kp + 32 * PITCH + d0 * 32);
        p0 = __builtin_amdgcn_mfma_f32_32x32x16_bf16(b0, qr[d0], p0, 0, 0, 0);
        p1 = __builtin_amdgcn_mfma_f32_32x32x16_bf16(b1, qr[d0], p1, 0, 0, 0); }
}
template <int NCB> __device__ __forceinline__ int v_st(int k, int c) { const int kk = (k & ~0xC) | ((k & 4) << 1) | ((k & 8) >> 1); return ((kk >> 3) * NCB + (c >> 5)) * 512 + ((kk & 7) * 32 + (c & 31)) * 2; }
__device__ __forceinline__ int v_rd_base(int lane) { return ((lane & 3) << 3) | (((lane >> 2) & 3) << 6) | (((lane >> 4) & 1) << 5) | (((lane >> 5) & 1) << 8); }
template <int OFF> __device__ __forceinline__ s16x4 tr_read(int vb) { s16x4 r; asm volatile("ds_read_b64_tr_b16 %0, %1 offset:%2" : "=&v"(r) : "v"(vb), "i"(OFF) : "memory"); return r; }
template <int NCB, int D0> __device__ __forceinline__ void pv_one(f32x16& od, int vb, bf16x8 pa0, bf16x8 pa1, bf16x8 pa2, bf16x8 pa3) {
    constexpr int KS = 2 * NCB * 512, HF = NCB * 512, B0 = D0 * 512;
    const s16x4 l0 = tr_read<B0>(vb), h0 = tr_read<B0 + HF>(vb), l1 = tr_read<B0 + KS>(vb), h1 = tr_read<B0 + KS + HF>(vb);
    const s16x4 l2 = tr_read<B0 + 2 * KS>(vb), h2 = tr_read<B0 + 2 * KS + HF>(vb), l3 = tr_read<B0 + 3 * KS>(vb), h3 = tr_read<B0 + 3 * KS + HF>(vb);
    asm volatile("s_waitcnt lgkmcnt(0)" ::: "memory"); SBAR();
#define PK(L, H) (bf16x8){L[0], L[1], L[2], L[3], H[0], H[1], H[2], H[3]}
    od = __builtin_amdgcn_mfma_f32_32x32x16_bf16(pa0, PK(l0, h0), od, 0, 0, 0);
    od = __builtin_amdgcn_mfma_f32_32x32x16_bf16(pa1, PK(l1, h1), od, 0, 0, 0);
    od = __builtin_amdgcn_mfma_f32_32x32x16_bf16(pa2, PK(l2, h2), od, 0, 0, 0);
    od = __builtin_amdgcn_mfma_f32_32x32x16_bf16(pa3, PK(l3, h3), od, 0, 0, 0);
#undef PK
}
template <int NCB> __device__ __forceinline__ void pv_all(f32x16* o, int vb, bf16x8 pa0, bf16x8 pa1, bf16x8 pa2, bf16x8 pa3) {
    pv_one<NCB, 0>(o[0], vb, pa0, pa1, pa2, pa3); pv_one<NCB, 1>(o[1], vb, pa0, pa1, pa2, pa3);
    if constexpr (NCB == 4) { pv_one<NCB, 2>(o[2], vb, pa0, pa1, pa2, pa3); pv_one<NCB, 3>(o[3], vb, pa0, pa1, pa2, pa3); }
}

template <int DQK, int DV, int VP, int KIND>
__device__ __forceinline__ void attn_unit(const bf16_t* Qh, const bf16_t* Kh, const bf16_t* Vh, int qb, bf16_t* OUT, const bf16_t* GATE, LAS unsigned char* lds) {
    constexpr int NCB = DV / 32, NKS = DQK / 16, PITCH = 2 * DQK + 16, NKCH = DQK / 8, KCHUNKS = 64 * NKCH, NKI = (KCHUNKS + NT - 1) / NT, NVI = (64 * DV / 8) / NT;
    const int tid = tid_op(), lane = tid & 63, r32 = lane & 31, hi = lane >> 5; const int wid = __builtin_amdgcn_readfirstlane(tid >> 6);
    LAS float* wsf = (LAS float*)(lds + WS_OFF) + wid * 64; LAS float* li_l = wsf; LAS float* al_l = wsf + 32;
    const int q0 = qb * 256, NTL = (q0 + 256) / 64;
    float m_reg = -1e30f, l_reg = 0.f; f32x16 o[NCB]; bf16x8 qr[NKS];
#pragma unroll
    for (int d = 0; d < NCB; ++d) o[d] = f32x16{};
    { const bf16_t* Qw = Qh + (size_t)(q0 + wid * 32 + r32) * DQK + hi * 8;
#pragma unroll
      for (int d0 = 0; d0 < NKS; ++d0) qr[d0] = *(const bf16x8*)(Qw + d0 * 16); }
    int kgo[NKI], klo[NKI];
#pragma unroll
    for (int i = 0; i < NKI; ++i) { const int id = (tid + i * NT < KCHUNKS) ? tid + i * NT : tid; const int row = id / NKCH, ch = id % NKCH; kgo[i] = row * DQK + ch * 8; klo[i] = K_OFF + row * PITCH + ch * 16; }
    int vgo[NVI], vlo[NVI];
#pragma unroll
    for (int i = 0; i < NVI; ++i) { const int id = tid + i * NT; const int key = id / (DV / 8), c = (id % (DV / 8)) * 8; vgo[i] = key * VP + c; vlo[i] = V_OFF + v_st<NCB>(key, c); }
    bf16x8 ks[2][NKI], vs[2][NVI];
#define SLOAD(sl, t) do { const bf16_t* kt_ = Kh + (size_t)(t) * 64 * DQK; const bf16_t* vt_ = Vh + (size_t)(t) * 64 * VP; \
    _Pragma("unroll") for (int i_ = 0; i_ < NKI; ++i_) ks[sl][i_] = *(const bf16x8*)(kt_ + kgo[i_]); \
    _Pragma("unroll") for (int i_ = 0; i_ < NVI; ++i_) vs[sl][i_] = *(const bf16x8*)(vt_ + vgo[i_]); } while (0)
#define SWRITE(b, sl) do { LAS unsigned char* bb_ = lds + (b) * BUF_BYTES; \
    _Pragma("unroll") for (int i_ = 0; i_ < NKI; ++i_) *(LAS bf16x8*)(bb_ + klo[i_]) = ks[sl][i_]; \
    _Pragma("unroll") for (int i_ = 0; i_ < NVI; ++i_) *(LAS bf16x8*)(bb_ + vlo[i_]) = vs[sl][i_]; } while (0)
#define RESC(a) do { if (__any((a) < 1.f)) { if (hi == 0) al_l[r32] = (a); asm volatile("s_waitcnt lgkmcnt(0)" ::: "memory"); \
    _Pragma("unroll") for (int d_ = 0; d_ < NCB; ++d_) _Pragma("unroll") for (int r_ = 0; r_ < 16; ++r_) o[d_][r_] *= al_l[crow(r_, hi)]; } } while (0)
#define CMASK(P0, P1, t) do { const int jb_ = (t) - (NTL - 4); if (jb_ >= 0) cmask(P0, P1, jb_, qrel, hi); } while (0)
    LAS const unsigned char* kp0 = lds + K_OFF + r32 * PITCH + hi * 16; LAS const unsigned char* kp1 = kp0 + BUF_BYTES;
    const int vb0 = (int)(uintptr_t)(lds + V_OFF) + v_rd_base(lane), vb1 = vb0 + BUF_BYTES;
    const int qrel = wid * 32 + r32;
    f32x16 pA0, pA1, pB0, pB1; float alA, alB; bf16x8 pa0, pa1, pa2, pa3;
    SLOAD(0, 0); SWRITE(0, 0); __syncthreads();
    qkt<DQK>(pA0, pA1, kp0, qr); CMASK(pA0, pA1, 0); partialSM(pA0, pA1, m_reg, alA);
    SLOAD(1, 1); SLOAD(0, 2);
    SWRITE(1, 1); __syncthreads();
#pragma unroll 1
    for (int j = 1; j + 1 < NTL; j += 2) {
        SBAR(); qkt<DQK>(pB0, pB1, kp1, qr);
        finishSM(pA0, pA1, alA, l_reg, pa0, pa1, pa2, pa3); SBAR();
        SLOAD(1, j + 2); SBAR();
        pv_all<NCB>(o, vb0, pa0, pa1, pa2, pa3); CMASK(pB0, pB1, j); partialSM(pB0, pB1, m_reg, alB);
        __syncthreads(); SWRITE(0, 0);
        RESC(alB); __syncthreads();
        SBAR(); qkt<DQK>(pA0, pA1, kp0, qr);
        finishSM(pB0, pB1, alB, l_reg, pa0, pa1, pa2, pa3); SBAR();
        if (j + 3 < NTL) SLOAD(0, j + 3); SBAR();
        pv_all<NCB>(o, vb1, pa0, pa1, pa2, pa3); CMASK(pA0, pA1, j + 1); partialSM(pA0, pA1, m_reg, alA);
        __syncthreads(); SWRITE(1, 1);
        RESC(alA); __syncthreads();
    }
    SBAR(); qkt<DQK>(pB0, pB1, kp1, qr);
    finishSM(pA0, pA1, alA, l_reg, pa0, pa1, pa2, pa3); SBAR();
    pv_all<NCB>(o, vb0, pa0, pa1, pa2, pa3); CMASK(pB0, pB1, NTL - 1); partialSM(pB0, pB1, m_reg, alB);
    RESC(alB);
    finishSM(pB0, pB1, alB, l_reg, pa0, pa1, pa2, pa3); SBAR();
    pv_all<NCB>(o, vb1, pa0, pa1, pa2, pa3);
    if (hi == 0) li_l[r32] = l_reg; asm volatile("s_waitcnt lgkmcnt(0)" ::: "memory");
    float rli[16];
#pragma unroll
    for (int r = 0; r < 16; ++r) rli[r] = __builtin_amdgcn_rcpf(li_l[crow(r, hi)]);
    __syncthreads();
    LAS bf16_t* stg = (LAS bf16_t*)(lds + wid * 8192);
#pragma unroll
    for (int r = 0; r < 16; ++r) { const int orow = crow(r, hi);
#pragma unroll
        for (int d0 = 0; d0 < NCB; ++d0) stg[orow * DV + d0 * 32 + r32] = (bf16_t)f2bf(o[d0][r] * rli[r]); }
    asm volatile("s_waitcnt lgkmcnt(0)" ::: "memory");
    constexpr int CPR = DV / 8;
#pragma unroll
    for (int i = 0; i < (32 * CPR) / 64; ++i) { const int id = i * 64 + lane, row = id / CPR, ch = id % CPR; u32x4 v = *(LAS const u32x4*)(stg + row * DV + ch * 8);
        const size_t ro = (size_t)(q0 + wid * 32 + row);
        if constexpr (KIND == 0) { *(u32x4*)(OUT + ro * 128 + ch * 8) = v; }
        else { const u32x4 g = *(const u32x4*)(GATE + ro * 1024 + ch * 8); u32x4 w;
            w.x = cvtpk(__uint_as_float(v.x << 16) * __uint_as_float(g.x << 16), __uint_as_float(v.x & 0xffff0000u) * __uint_as_float(g.x & 0xffff0000u));
            w.y = cvtpk(__uint_as_float(v.y << 16) * __uint_as_float(g.y << 16), __uint_as_float(v.y & 0xffff0000u) * __uint_as_float(g.y & 0xffff0000u));
            w.z = cvtpk(__uint_as_float(v.z << 16) * __uint_as_float(g.z << 16), __uint_as_float(v.z & 0xffff0000u) * __uint_as_float(g.z & 0xffff0000u));
            w.w = cvtpk(__uint_as_float(v.w << 16) * __uint_as_float(g.w << 16), __uint_as_float(v.w & 0xffff0000u) * __uint_as_float(g.w & 0xffff0000u));
            *(u32x4*)(OUT + ro * 1024 + ch * 8) = w; } }
    asm volatile("s_waitcnt lgkmcnt(0)" ::: "memory");
    __syncthreads();
#undef SLOAD
#undef SWRITE
#undef RESC
#undef CMASK
}
#undef SBAR
}

namespace att2 {
using att::bf16x8; using att::s16x4; using att::f32x16; using att::crow; using att::cvtpk; using att::cmask; using att::tr_read;
#define SBAR() __builtin_amdgcn_sched_barrier(0)
#define WAIT_BAR(N) asm volatile("s_waitcnt vmcnt(" #N ") lgkmcnt(0)\n\ts_barrier" ::: "memory")
constexpr float THR = 8.f;
__device__ __forceinline__ void glds16(const void* gsrc, unsigned lds_dst) { unsigned keep;
    asm volatile("s_mov_b32 %0, m0\n\ts_mov_b32 m0, %2\n\ts_nop 0\n\tglobal_load_lds_dwordx4 %1, off\n\ts_mov_b32 m0, %0" : "=&s"(keep) : "v"(gsrc), "s"(lds_dst) : "memory"); }
__device__ __forceinline__ void partialSM(f32x16& p0, f32x16& p1, float& m_reg, float& alpha) {
    float pmax = p0[0];
#pragma unroll
    for (int r = 1; r < 16; ++r) pmax = fmaxf(pmax, p0[r]);
#pragma unroll
    for (int r = 0; r < 16; ++r) pmax = fmaxf(pmax, p1[r]);
    { auto rr = __builtin_amdgcn_permlane32_swap(__float_as_uint(pmax), __float_as_uint(pmax), false, false); pmax = fmaxf(__uint_as_float(rr[0]), __uint_as_float(rr[1])); }
    float mn;
    if (__builtin_expect(__all(pmax - m_reg <= THR), 1)) { mn = m_reg; alpha = 1.f; }
    else { mn = fmaxf(m_reg, pmax); alpha = __builtin_amdgcn_exp2f(m_reg - mn); m_reg = mn; }
#pragma unroll
    for (int r = 0; r < 16; ++r) { p0[r] -= mn; p1[r] -= mn; }
#pragma unroll
    for (int r = 0; r < 16; ++r) p0[r] = __builtin_amdgcn_exp2f(p0[r]);
}
__device__ __forceinline__ void finishSM(f32x16& p0, f32x16& p1, float alpha, float& l_reg, bf16x8& pa0, bf16x8& pa1, bf16x8& pa2, bf16x8& pa3) {
#pragma unroll
    for (int r = 0; r < 16; ++r) p1[r] = __builtin_amdgcn_exp2f(p1[r]);
    float ps = 0.f;
#pragma unroll
    for (int r = 0; r < 16; ++r) ps += p0[r];
#pragma unroll
    for (int r = 0; r < 16; ++r) ps += p1[r];
    { auto rr = __builtin_amdgcn_permlane32_swap(__float_as_uint(ps), __float_as_uint(ps), false, false); ps = __uint_as_float(rr[0]) + __uint_as_float(rr[1]); }
    l_reg = l_reg * alpha + ps;
#define PK8(P, B) __builtin_bit_cast(bf16x8, (u32x4){cvtpk(P[B], P[B + 1]), cvtpk(P[B + 2], P[B + 3]), cvtpk(P[B + 4], P[B + 5]), cvtpk(P[B + 6], P[B + 7])})
    pa0 = PK8(p0, 0); pa1 = PK8(p0, 8); pa2 = PK8(p1, 0); pa3 = PK8(p1, 8);
#undef PK8
}
template <int NKS> __device__ __forceinline__ void qkt(f32x16& p0, f32x16& p1, LAS const unsigned char* kp  , const bf16x8* qr) {
    p0 = f32x16{}; p1 = f32x16{};
#pragma unroll
    for (int d0 = 0; d0 < NKS; ++d0) {
        const bf16x8 b0 = *(LAS const bf16x8*)(kp + d0 * 2048), b1 = *(LAS const bf16x8*)(kp + d0 * 2048 + 512);
        p0 = __builtin_amdgcn_mfma_f32_32x32x16_bf16(b0, qr[d0], p0, 0, 0, 0);
        p1 = __builtin_amdgcn_mfma_f32_32x32x16_bf16(b1, qr[d0], p1, 0, 0, 0); }
}
template <int D0> __device__ __forceinline__ void pv_one(f32x16& od, int vb, bf16x8 pa0, bf16x8 pa1, bf16x8 pa2, bf16x8 pa3) {
    constexpr int B0 = D0 * 4096;
    const s16x4 l0 = tr_read<B0>(vb), h0 = tr_read<B0 + 512>(vb), l1 = tr_read<B0 + 1024>(vb), h1 = tr_read<B0 + 1536>(vb);
    const s16x4 l2 = tr_read<B0 + 2048>(vb), h2 = tr_read<B0 + 2560>(vb), l3 = tr_read<B0 + 3072>(vb), h3 = tr_read<B0 + 3584>(vb);
    asm volatile("s_waitcnt lgkmcnt(0)" ::: "memory"); SBAR();
#define PK(L, H) (bf16x8){L[0], L[1], L[2], L[3], H[0], H[1], H[2], H[3]}
    od = __builtin_amdgcn_mfma_f32_32x32x16_bf16(pa0, PK(l0, h0), od, 0, 0, 0);
    od = __builtin_amdgcn_mfma_f32_32x32x16_bf16(pa1, PK(l1, h1), od, 0, 0, 0);
    od = __builtin_amdgcn_mfma_f32_32x32x16_bf16(pa2, PK(l2, h2), od, 0, 0, 0);
    od = __builtin_amdgcn_mfma_f32_32x32x16_bf16(pa3, PK(l3, h3), od, 0, 0, 0);
#undef PK
}
template <int NCB> __device__ __forceinline__ void pv_all(f32x16* o, int vb, bf16x8 pa0, bf16x8 pa1, bf16x8 pa2, bf16x8 pa3) {
    pv_one<0>(o[0], vb, pa0, pa1, pa2, pa3); pv_one<1>(o[1], vb, pa0, pa1, pa2, pa3);
    if constexpr (NCB == 4) { pv_one<2>(o[2], vb, pa0, pa1, pa2, pa3); pv_one<3>(o[3], vb, pa0, pa1, pa2, pa3); }
}
template <int DQK, int DV> struct Geo {
    static constexpr int NCB = DV / 32, NKS = DQK / 16, NKCH = DQK / 8, KSLOT = NKCH * 1024, VSLOT = NCB * 4096, K_OFF = 0, V_OFF = 3 * KSLOT, WS_OFF = V_OFF + 3 * VSLOT, STG_OFF = WS_OFF + 2048;
    static constexpr int NKI = (NKCH + 7) / 8, NVI = (NCB * 4) / 8, NDMA = NKI + NVI;
};
template <int DQK, int DV, int VP>
__device__ __forceinline__ void attn_pass(const bf16_t* Qh, const bf16_t* Kh, const bf16_t* Vh, int qb, LAS unsigned char* lds, f32x16 (&o)[DV / 32], float (&rli)[16]) {
    typedef Geo<DQK, DV> Gm; constexpr int NCB = Gm::NCB, NKS = Gm::NKS, NKI = Gm::NKI, NVI = Gm::NVI, KSLOT = Gm::KSLOT, VSLOT = Gm::VSLOT;
    static_assert(Gm::NDMA == 3, "the ring waits below count 3 LDS-DMA pieces per wave and step (NVI of them V pieces)");
    const int tid = tid_op(), lane = tid & 63, r32 = lane & 31, hi = lane >> 5; const int wid = __builtin_amdgcn_readfirstlane(tid >> 6);
    LAS float* wsf = (LAS float*)(lds + Gm::WS_OFF) + wid * 64; LAS float* li_l = wsf; LAS float* al_l = wsf + 32;
    const unsigned lds0 = (unsigned)(uintptr_t)lds;
    const int q0 = qb * 256, NTL = (q0 + 256) / 64;
    const bf16_t* ksrc[NKI]; unsigned kdst[NKI]; const bf16_t* vsrc[NVI]; unsigned vdst[NVI];
#pragma unroll
    for (int i = 0; i < NKI; ++i) { const int c = (wid + 8 * i < Gm::NKCH) ? wid + 8 * i : wid; ksrc[i] = Kh + (size_t)lane * DQK + c * 8; kdst[i] = lds0 + Gm::K_OFF + c * 1024; }
#pragma unroll
    for (int i = 0; i < NVI; ++i) { const int pi = wid + 8 * i, dblk = pi >> 2, kq = pi & 3; vsrc[i] = Vh + (size_t)(16 * kq + (lane >> 2)) * VP + dblk * 32 + (lane & 3) * 8; vdst[i] = lds0 + Gm::V_OFF + pi * 1024; }
#define DMA_K(t, so) do { _Pragma("unroll") for (int i_ = 0; i_ < NKI; ++i_) glds16(ksrc[i_] + (size_t)(t) * 64 * DQK, (unsigned)__builtin_amdgcn_readfirstlane(kdst[i_] + (so) * KSLOT)); } while (0)
#define DMA_V(t, so) do { _Pragma("unroll") for (int i_ = 0; i_ < NVI; ++i_) glds16(vsrc[i_] + (size_t)(t) * 64 * VP, (unsigned)__builtin_amdgcn_readfirstlane(vdst[i_] + (so) * VSLOT)); } while (0)
    DMA_K(0, 0); DMA_V(0, 0); DMA_K(1, 1);
    float m_reg = -1e30f, l_reg = 0.f; bf16x8 qr[NKS];
#pragma unroll
    for (int d = 0; d < NCB; ++d) o[d] = f32x16{};
    { const bf16_t* Qw = Qh + (size_t)(q0 + wid * 32 + r32) * DQK + hi * 8;
#pragma unroll
      for (int d0 = 0; d0 < NKS; ++d0) qr[d0] = *(const bf16x8*)(Qw + d0 * 16); }
    LAS const unsigned char* kp0 = lds + Gm::K_OFF + hi * 1024 + r32 * 16;
    const int vb0 = (int)lds0 + Gm::V_OFF + ((lane >> 4) & 1) * 32 + (lane & 3) * 8 + (4 * hi + ((lane & 15) >> 2)) * 64;
    const int qrel = wid * 32 + r32;
#define RESC(a) do { if (__any((a) < 1.f)) { if (hi == 0) al_l[r32] = (a); asm volatile("s_waitcnt lgkmcnt(0)" ::: "memory"); \
    _Pragma("unroll") for (int d_ = 0; d_ < NCB; ++d_) _Pragma("unroll") for (int r_ = 0; r_ < 16; ++r_) o[d_][r_] *= al_l[crow(r_, hi)]; } } while (0)
#define CMASK(P0, P1, t) do { const int jb_ = (t) - (NTL - 4); if (jb_ >= 0) cmask(P0, P1, jb_, qrel, hi); } while (0)
    int sp = 2, sc = 0, sn = 1;
#define ROT() do { const int t_ = sp; sp = sc; sc = sn; sn = t_; } while (0)
    f32x16 pA0, pA1, pB0, pB1; float alA, alB; bf16x8 pa0, pa1, pa2, pa3;
    asm volatile("s_waitcnt vmcnt(0)" ::: "memory"); __builtin_amdgcn_s_barrier();
    DMA_K(2, sp); DMA_V(1, sn);
    qkt<NKS>(pA0, pA1, kp0 + sc * KSLOT, qr); CMASK(pA0, pA1, 0); partialSM(pA0, pA1, m_reg, alA);
    WAIT_BAR(3); ROT();
#define STEP(C0, C1, alC, P0, P1, alP, t) do { \
    if ((t) + 2 < NTL) DMA_K((t) + 2, sp); if ((t) + 1 < NTL) DMA_V((t) + 1, sn); \
    SBAR(); qkt<NKS>(C0, C1, kp0 + sc * KSLOT, qr); \
    finishSM(P0, P1, alP, l_reg, pa0, pa1, pa2, pa3); SBAR(); \
    pv_all<NCB>(o, vb0 + sp * VSLOT, pa0, pa1, pa2, pa3); CMASK(C0, C1, t); partialSM(C0, C1, m_reg, alC); \
    RESC(alC); \
    if ((t) + 2 < NTL) { WAIT_BAR(3); } else if ((t) + 1 < NTL) { if (NVI == 2) { WAIT_BAR(2); } else { WAIT_BAR(1); } } else { WAIT_BAR(0); } \
    ROT(); } while (0)
#pragma unroll 1
    for (int t = 1; t + 1 < NTL; t += 2) { STEP(pB0, pB1, alB, pA0, pA1, alA, t); STEP(pA0, pA1, alA, pB0, pB1, alB, t + 1); }
    STEP(pB0, pB1, alB, pA0, pA1, alA, NTL - 1);
    finishSM(pB0, pB1, alB, l_reg, pa0, pa1, pa2, pa3); SBAR();
    pv_all<NCB>(o, vb0 + sp * VSLOT, pa0, pa1, pa2, pa3);
    if (hi == 0) li_l[r32] = l_reg; asm volatile("s_waitcnt lgkmcnt(0)" ::: "memory");
#pragma unroll
    for (int r = 0; r < 16; ++r) rli[r] = __builtin_amdgcn_rcpf(li_l[crow(r, hi)]);
    WAIT_BAR(0);
#undef DMA_K
#undef DMA_V
#undef RESC
#undef CMASK
#undef ROT
#undef STEP
}
template <int DV, bool GATED>
__device__ __forceinline__ void store_rows(LAS const bf16_t* stg, bf16_t* out, const bf16_t* gate, int pitch, int lane) {
    constexpr int CPR = DV / 8;
#pragma unroll
    for (int i = 0; i < (32 * CPR) / 64; ++i) { const int id = i * 64 + lane, row = id / CPR, ch = id % CPR; const u32x4 v = *(LAS const u32x4*)(stg + row * DV + ch * 8);
        if constexpr (!GATED) { *(u32x4*)(out + (size_t)row * pitch + ch * 8) = v; }
        else { const u32x4 g = *(const u32x4*)(gate + (size_t)row * pitch + ch * 8); u32x4 w;
            w.x = cvtpk(__uint_as_float(v.x << 16) * __uint_as_float(g.x << 16), __uint_as_float(v.x & 0xffff0000u) * __uint_as_float(g.x & 0xffff0000u));
            w.y = cvtpk(__uint_as_float(v.y << 16) * __uint_as_float(g.y << 16), __uint_as_float(v.y & 0xffff0000u) * __uint_as_float(g.y & 0xffff0000u));
            w.z = cvtpk(__uint_as_float(v.z << 16) * __uint_as_float(g.z << 16), __uint_as_float(v.z & 0xffff0000u) * __uint_as_float(g.z & 0xffff0000u));
            w.w = cvtpk(__uint_as_float(v.w << 16) * __uint_as_float(g.w << 16), __uint_as_float(v.w & 0xffff0000u) * __uint_as_float(g.w & 0xffff0000u));
            *(u32x4*)(out + (size_t)row * pitch + ch * 8) = w; } }
}
__device__ __forceinline__ void mla_unit(const bf16_t* Qh, const bf16_t* Kh, const bf16_t* Vh, int qb, bf16_t* YC, const bf16_t* G, LAS unsigned char* lds) {
    typedef Geo<96, 64> Gm; f32x16 o[2]; float rli[16];
    attn_pass<96, 64, 64>(Qh, Kh, Vh, qb, lds, o, rli);
    const int tid = tid_op(), lane = tid & 63, r32 = lane & 31, hi = lane >> 5; const int wid = __builtin_amdgcn_readfirstlane(tid >> 6);
    LAS bf16_t* stg = (LAS bf16_t*)(lds + Gm::STG_OFF + wid * 4096);
#pragma unroll
    for (int r = 0; r < 16; ++r) { const int orow = crow(r, hi);
#pragma unroll
        for (int d0 = 0; d0 < 2; ++d0) stg[orow * 64 + d0 * 32 + r32] = (bf16_t)f2bf(o[d0][r] * rli[r]); }
    asm volatile("s_waitcnt lgkmcnt(0)" ::: "memory");
    const size_t ro = (size_t)(qb * 256 + wid * 32) * 1024;
    store_rows<64, true>(stg, YC + ro, G + ro, 1024, lane);
    asm volatile("s_waitcnt lgkmcnt(0)" ::: "memory");
    __syncthreads();
}
__device__ __forceinline__ void diff_unit(const bf16_t* Q0, const bf16_t* K0, const bf16_t* Vh, int qb, bf16_t* YC, const bf16_t* G, const float* subln_g, float lam, LAS unsigned char* lds) {
    typedef Geo<64, 128> Gm; f32x16 o[4]; float rli[16];
    const int tid = tid_op(), lane = tid & 63, r32 = lane & 31, hi = lane >> 5; const int wid = __builtin_amdgcn_readfirstlane(tid >> 6);
    LAS unsigned* park = (LAS unsigned*)(lds + Gm::STG_OFF + wid * 8192);
    attn_pass<64, 128, 128>(Q0, K0, Vh, qb, lds, o, rli);
#pragma unroll
    for (int r = 0; r < 16; r += 2)
#pragma unroll
        for (int d0 = 0; d0 < 4; ++d0) park[((r >> 1) * 4 + d0) * 64 + lane] = cvtpk(o[d0][r] * rli[r], o[d0][r + 1] * rli[r + 1]);
    attn_pass<64, 128, 128>(Q0 + (size_t)SEQ * 64, K0 + (size_t)SEQ * 64, Vh, qb, lds, o, rli);
    asm volatile("s_waitcnt lgkmcnt(0)" ::: "memory");
    float ss[16];
#pragma unroll
    for (int r = 0; r < 16; r += 2) { float s0 = 0.f, s1 = 0.f;
#pragma unroll
        for (int d0 = 0; d0 < 4; ++d0) { const unsigned w = park[((r >> 1) * 4 + d0) * 64 + lane];
            const float a = __uint_as_float(w << 16) - lam * (o[d0][r] * rli[r]), b = __uint_as_float(w & 0xffff0000u) - lam * (o[d0][r + 1] * rli[r + 1]);
            o[d0][r] = a; o[d0][r + 1] = b; s0 += a * a; s1 += b * b; }
        ss[r] = s0; ss[r + 1] = s1; }
#pragma unroll
    for (int r = 0; r < 16; ++r) { float v = ss[r];
        v += __shfl_xor(v, 1); v += __shfl_xor(v, 2); v += __shfl_xor(v, 4); v += __shfl_xor(v, 8); v += __shfl_xor(v, 16);
        ss[r] = __builtin_amdgcn_rsqf(v * (1.f / 128.f) + RMS_EPS) * (1.f - LAM_INIT); }
    float gcol[4];
#pragma unroll
    for (int d0 = 0; d0 < 4; ++d0) gcol[d0] = subln_g[d0 * 32 + r32];
    asm volatile("s_waitcnt lgkmcnt(0)" ::: "memory");
    LAS bf16_t* stg = (LAS bf16_t*)park;
#pragma unroll
    for (int r = 0; r < 16; ++r) { const int orow = crow(r, hi);
#pragma unroll
        for (int d0 = 0; d0 < 4; ++d0) stg[orow * 128 + d0 * 32 + r32] = (bf16_t)f2bf(o[d0][r] * ss[r] * gcol[d0]); }
    asm volatile("s_waitcnt lgkmcnt(0)" ::: "memory");
    const size_t ro = (size_t)(qb * 256 + wid * 32) * 1024;
    store_rows<128, true>(stg, YC + ro, G + ro, 1024, lane);
    asm volatile("s_waitcnt lgkmcnt(0)" ::: "memory");
    __syncthreads();
}
#undef SBAR
#undef WAIT_BAR
}

__device__ __forceinline__ void phase2_v2(const Params& P, LAS unsigned char* lds) {
    const bf16_t* QD = (const bf16_t*)(P.ws + WS_QD); const bf16_t* KD = (const bf16_t*)(P.ws + WS_KD); const bf16_t* VD = (const bf16_t*)(P.ws + WS_VD);
    const bf16_t* QM = (const bf16_t*)(P.ws + WS_QM); const bf16_t* KM = (const bf16_t*)(P.ws + WS_KM); const bf16_t* VM = (const bf16_t*)(P.ws + WS_VM);
    const bf16_t* G = (const bf16_t*)(P.ws + WS_G); bf16_t* YC = (bf16_t*)(P.ws + WS_YCAT);
    const float lam = ((const float*)(P.ws + WS_MISC))[0];
    const int Gn = (int)gridDim.x, bx = (int)blockIdx.x, vcu = (Gn % 8 == 0) ? (bx % 8) * (Gn / 8) + bx / 8 : bx;
#pragma unroll 1
    for (int it = vcu; it < 256 + 512; it += Gn) {
        if (it < 256) {
            const int bh4 = it >> 3, sidx = it & 7, b = bh4 >> 2, h = bh4 & 3;
#pragma unroll 1
            for (int half = 0; half < 2; ++half) { const int qb = half == 0 ? 15 - sidx : sidx;
                att2::diff_unit(QD + (size_t)(b * 8 + 2 * h) * SEQ * 64, KD + (size_t)(b * 8 + 2 * h) * SEQ * 64, VD + (size_t)(b * 4 + h) * SEQ * 128, qb,
                                YC + (size_t)b * SEQ * 1024 + h * 128, G + (size_t)b * SEQ * 1024 + h * 128, P.subln_g, lam, lds); }
        } else {
            const int rem = it - 256, bh = rem >> 3, sidx = rem & 7, b = bh >> 3, hh = bh & 7;
#pragma unroll 1
            for (int half = 0; half < 2; ++half) { const int qb = half == 0 ? 15 - sidx : sidx;
                att2::mla_unit(QM + (size_t)bh * SEQ * 96, KM + (size_t)bh * SEQ * 96, VM + (size_t)bh * SEQ * 64, qb, YC + (size_t)b * SEQ * 1024 + 512 + hh * 64, G + (size_t)b * SEQ * 1024 + 512 + hh * 64, lds); }
        }
    }
    __syncthreads();
}

__device__ __forceinline__ void phase2_mfma(const Params& P, LAS unsigned char* lds) {
    const bf16_t* QD = (const bf16_t*)(P.ws + WS_QD); const bf16_t* KD = (const bf16_t*)(P.ws + WS_KD); const bf16_t* VD = (const bf16_t*)(P.ws + WS_VD);
    const bf16_t* QM = (const bf16_t*)(P.ws + WS_QM); const bf16_t* KM = (const bf16_t*)(P.ws + WS_KM); const bf16_t* VM = (const bf16_t*)(P.ws + WS_VM);
    const bf16_t* G = (const bf16_t*)(P.ws + WS_G); bf16_t* OD = (bf16_t*)(P.ws + WS_OD); bf16_t* YC = (bf16_t*)(P.ws + WS_YCAT);
    const int Gn = (int)gridDim.x, bx = (int)blockIdx.x, vcu = (Gn % 8 == 0) ? (bx % 8) * (Gn / 8) + bx / 8 : bx;
#pragma unroll 1
    for (int pr = vcu; pr < 1024; pr += Gn) {
        const int kind = pr >> 9, rem = pr & 511, bh = rem >> 3, sidx = rem & 7, b = bh >> 3, hh = bh & 7;
#pragma unroll 1
        for (int half = 0; half < 2; ++half) {
            const int qb = half == 0 ? 15 - sidx : sidx;
            if (kind == 0) att::attn_unit<64, 128, 128, 0>(QD + (size_t)bh * SEQ * 64, KD + (size_t)bh * SEQ * 64, VD + (size_t)(b * 4 + (hh >> 1)) * SEQ * 128, qb, OD + (size_t)bh * SEQ * 128, nullptr, lds);
            else att::attn_unit<96, 64, 64, 1>(QM + (size_t)bh * SEQ * 96, KM + (size_t)bh * SEQ * 96, VM + (size_t)bh * SEQ * 64, qb, YC + (size_t)b * SEQ * 1024 + 512 + hh * 64, G + (size_t)b * SEQ * 1024 + 512 + hh * 64, lds);
        }
    }
}

#define GAS __attribute__((address_space(1)))
constexpr int CW_BAR = 4096;
constexpr int LDSCTL_OFF = 162816, MISC_OFF = LDSCTL_OFF + 320;
#define XB_TMO      128
#define XB_XCNT(j)  (256  + 64 * (j))
#define XB_XSUB(j)  (1280 + 64 * (j))
#define XB_XGEN(j)  (2304 + 64 * (j))
#define XB_TOP      3328
#define XB_TOPGEN   3392
#define XCD_BAR_WORDS 3456
#define XB_SPIN_CAP (1u << 18)

__device__ __forceinline__ unsigned xb_ld(unsigned* p)              { return __hip_atomic_load(p, __ATOMIC_RELAXED, __HIP_MEMORY_SCOPE_AGENT); }
__device__ __forceinline__ unsigned xb_add(unsigned* p, unsigned v) { return __hip_atomic_fetch_add(p, v, __ATOMIC_RELAXED, __HIP_MEMORY_SCOPE_AGENT); }
__device__ __forceinline__ unsigned xb_xcc_id() { return (unsigned)__builtin_amdgcn_s_getreg((3 << 11) | 20) & 0xFu; }
#define XB_SPIN(cond, bar) do { unsigned _sp = 0; while (cond) { __builtin_amdgcn_s_sleep(1); \
    if ((++_sp & 255u) == 0u) { if (xb_ld(&(bar)[XB_TMO])) break; if (_sp > XB_SPIN_CAP) { atomicAdd(&(bar)[XB_TMO], 1u); break; } } } } while (0)

struct XcdBarrier {
    unsigned* bar; unsigned x;
    volatile LAS unsigned* st;
};

__device__ __forceinline__ XcdBarrier xcd_barrier_post(unsigned* bar, volatile LAS unsigned* st) {
    XcdBarrier b; b.bar = bar; b.x = xb_xcc_id(); b.st = st;
    if (threadIdx.x == 0) (void)xb_add(&bar[XB_XCNT(b.x)], 1u);
    return b;
}
__device__ __forceinline__ void xcd_barrier_complete(unsigned* bar, unsigned x, unsigned& nloc, unsigned& nx) {
    const unsigned G = gridDim.x * gridDim.y * gridDim.z;
    unsigned sum, cnt, mine, sp = 0u;
    for (;;) {
        sum = 0u; cnt = 0u; mine = 0u;
#pragma unroll
        for (unsigned j = 0; j < 16; ++j) { const unsigned c = xb_ld(&bar[XB_XCNT(j)]); sum += c; cnt += (c > 0u) ? 1u : 0u; mine = (j == x) ? c : mine; }
        if (sum == G) break;
        __builtin_amdgcn_s_sleep(1);
        if ((++sp & 255u) == 0u) { if (xb_ld(&bar[XB_TMO])) break; if (sp > XB_SPIN_CAP) { atomicAdd(&bar[XB_TMO], 1u); break; } }
    }
    nloc = mine > 0u ? mine : 1u; nx = cnt > 0u ? cnt : 1u;
}

__device__ __forceinline__ void xcd_barrier(const XcdBarrier& b) {
    asm volatile("s_waitcnt vmcnt(0)" ::: "memory");
    __syncthreads();
    if (threadIdx.x == 0) {
        unsigned* bar = b.bar;
        __builtin_amdgcn_s_waitcnt(0);
        unsigned nloc = b.st[0], nx = b.st[1];
        if (nloc == 0u) { xcd_barrier_complete(bar, b.x, nloc, nx); b.st[0] = nloc; b.st[1] = nx; }
        const unsigned old = xb_add(&bar[XB_XSUB(b.x)], 1u);
        const unsigned gen = old / nloc;
        if (old + 1u == (gen + 1u) * nloc) {
            __builtin_amdgcn_fence(__ATOMIC_RELEASE, "agent");
            asm volatile("s_waitcnt vmcnt(0)" ::: "memory");
            const unsigned og = xb_add(&bar[XB_TOP], 1u);
            const unsigned tg = og / nx;
            if (og + 1u == (tg + 1u) * nx) xb_add(&bar[XB_TOPGEN], 1u);
            else XB_SPIN(xb_ld(&bar[XB_TOPGEN]) == tg, bar);
            __builtin_amdgcn_fence(__ATOMIC_ACQUIRE, "agent");
            xb_add(&bar[XB_XGEN(b.x)], 1u);
            asm volatile("s_waitcnt vmcnt(0)" ::: "memory");
        } else {
            XB_SPIN(xb_ld(&bar[XB_XGEN(b.x)]) == gen, bar);
            __builtin_amdgcn_fence(__ATOMIC_ACQUIRE, "agent");
            asm volatile("s_waitcnt vmcnt(0)" ::: "memory");
        }
    }
    __syncthreads();
}

#ifndef OPT_P1
#define OPT_P1 1
#endif
#ifndef OPT_P2
#define OPT_P2 2
#endif
#ifndef OPT_P15
#define OPT_P15 1
#endif
#ifndef OPT_P3
#define OPT_P3 1
#endif
#ifndef OPT_P4
#define OPT_P4 1
#endif
constexpr int LDS_BYTES = 163840;
__global__ void __launch_bounds__(NT, 2) fwd_megakernel(Params P) {
    extern __shared__ __attribute__((aligned(16))) unsigned char lds_raw[];
    LAS unsigned char* lds = (LAS unsigned char*)lds_raw;
    float* smem = (float*)lds_raw;
    cg::grid_group grid = cg::this_grid();
    const int bid = blockIdx.x, nb = gridDim.x;
    for (int u = threadIdx.x; u < (LDS_BYTES - LDSCTL_OFF) / 4; u += NT) ((LAS unsigned*)(lds + LDSCTL_OFF))[u] = 0u;
    __syncthreads();
    const XcdBarrier bar = xcd_barrier_post((unsigned*)(P.ws + WS_CTL) + CW_BAR, (volatile LAS unsigned*)(lds + MISC_OFF) + 8);
    phase0(P, bid, nb);
    phase0_weights(P, bid, nb, lds);
    grid.sync();
#if OPT_P1
    phase1_gemm(P, lds);
#else
    phase1_naive(P, bid, nb, smem);
#endif
    xcd_barrier(bar);
#if OPT_P15
    phase15_gemm(P, lds);
#else
    phase15_naive(P, bid, nb, smem);
#endif
    xcd_barrier(bar);
#if OPT_P2 == 2
    phase2_v2(P, lds);
    xcd_barrier(bar);
#elif OPT_P2
    phase2_mfma(P, lds);
    xcd_barrier(bar);
    phase25_naive(P, bid, nb);
    xcd_barrier(bar);
#else
    phase2_naive(P, bid, nb, smem);
    xcd_barrier(bar);
    phase25_naive(P, bid, nb);
    xcd_barrier(bar);
#endif
#if OPT_P3
    phase3_gemm(P, lds);
#else
    phase3_naive(P, bid, nb, smem);
#endif
    xcd_barrier(bar);
#if OPT_P4
    phase4_gemm(P, lds);
#else
    phase4_naive(P, bid, nb, smem);
#endif
    xcd_barrier(bar);
    phase5(P, bid, nb);
}

extern "C" void kernel_launch(void* const* d_in, const int* in_sizes, int n_in, void* d_out, int out_size, void* d_ws, size_t ws_size, hipStream_t stream) {
    if (n_in != 15 || out_size != T * DM || ws_size < WS_END) { fprintf(stderr, "kernel_launch: unexpected shapes (n_in %d out %d ws %zu)\n", n_in, out_size, ws_size); return; }
    static int grid_blocks = 0;
    if (!grid_blocks) {
        int dev = 0, cus = 0, per_cu = 0;
        (void)hipGetDevice(&dev);
        (void)hipDeviceGetAttribute(&cus, hipDeviceAttributeMultiprocessorCount, dev);
        if (hipFuncSetAttribute((const void*)fwd_megakernel, hipFuncAttributeMaxDynamicSharedMemorySize, LDS_BYTES) != hipSuccess) { fprintf(stderr, "kernel_launch: hipFuncSetAttribute failed\n"); return; }
        if (hipOccupancyMaxActiveBlocksPerMultiprocessor(&per_cu, (const void*)fwd_megakernel, NT, LDS_BYTES) != hipSuccess || per_cu < 1) { fprintf(stderr, "kernel_launch: occupancy query says %d blocks/CU\n", per_cu); return; }
        grid_blocks = cus;
    }
    Params P{};
    P.x = (const float*)d_in[0]; P.p = (const float*)d_in[1]; P.pos = (const int*)d_in[2]; P.norm_g = (const float*)d_in[3]; P.w_in = (const float*)d_in[4];
    P.diff_lambda = (const float*)d_in[5]; P.subln_g = (const float*)d_in[6]; P.qn_g = (const float*)d_in[7]; P.w_uq = (const float*)d_in[8]; P.kvn_g = (const float*)d_in[9];
    P.w_ukv = (const float*)d_in[10]; P.w_out = (const float*)d_in[11]; P.w_ple = (const float*)d_in[12]; P.w_gate = (const float*)d_in[13]; P.final_g = (const float*)d_in[14];
    P.out = (float*)d_out; P.ws = (unsigned char*)d_ws;
    if (hipMemsetAsync((char*)d_ws + WS_CTL, 0, 65536, stream) != hipSuccess) { fprintf(stderr, "kernel_launch: memset failed\n"); return; }
    void* args[] = {&P};
    hipError_t e = hipLaunchCooperativeKernel((void*)fwd_megakernel, dim3(grid_blocks), dim3(NT), args, LDS_BYTES, stream);
    if (e != hipSuccess) fprintf(stderr, "cooperative launch failed: %s (grid %d)\n", hipGetErrorString(e), grid_blocks);
}
```

```cpp
#include <hip/hip_runtime.h>
#include <hip/hip_cooperative_groups.h>
#include <cstdio>
#include <cstdint>

namespace cg = cooperative_groups;
typedef unsigned short bf16_t;

constexpr int BATCH = 8, SEQ = 4096, T = BATCH * SEQ, DM = 1024, DIN = 3104, PLE_DIM = 256;
constexpr int OFF_DQ = 0, OFF_DK = 512, OFF_DV = 1024, OFF_DG = 1536, OFF_CQ = 2048, OFF_CKV = 2432, OFF_KR = 2560, OFF_MG = 2592;
constexpr int QLORA = 384, KVLORA = 128, CQP = 512;
constexpr float RMS_EPS = 1e-6f;
constexpr float LOG2E = 1.4426950408889634f;
constexpr float C2D = 0.125f * LOG2E;
constexpr float C2M = 0.10206207261596575f * LOG2E;
constexpr float LAM_INIT = 0.2f;
constexpr int NT = 512;

constexpr size_t MiB = 1u << 20;
constexpr size_t WS_CTL = 0;
constexpr size_t WS_MISC = 1 * MiB;
constexpr size_t WS_SSQQ = 1 * MiB + 65536, WS_SSQKV = WS_SSQQ + 131072, WS_SSQF = WS_SSQKV + 131072;
constexpr size_t WS_CSA = 2 * MiB, WS_CSB = 10 * MiB;
constexpr size_t WS_WIN = 14 * MiB, WS_WPLE = 21 * MiB, WS_WUQ = 22 * MiB, WS_WUKV = 23 * MiB, WS_WOUT = 24 * MiB, WS_WG = 26 * MiB;
constexpr size_t WS_PB = 28 * MiB, WS_CQ = 44 * MiB  , WS_XN = 76 * MiB, WS_OD = WS_XN;
constexpr size_t WS_QD = 140 * MiB, WS_KD = 172 * MiB, WS_PLE = WS_QD, WS_VD = 204 * MiB, WS_G = 236 * MiB, WS_HB = WS_G;
constexpr size_t WS_QM = 300 * MiB, WS_KM = 348 * MiB, WS_VM = 396 * MiB, WS_YCAT = 428 * MiB, WS_END = 492 * MiB;

struct Params {
    const float* x; const float* p; const int* pos; const float* norm_g; const float* w_in; const float* diff_lambda;
    const float* subln_g; const float* qn_g; const float* w_uq; const float* kvn_g; const float* w_ukv; const float* w_out;
    const float* w_ple; const float* w_gate; const float* final_g; float* out; unsigned char* ws;
};

__device__ __forceinline__ unsigned f2bf(float f) { unsigned u = __float_as_uint(f); return (u + 0x7fffu + ((u >> 16) & 1u)) >> 16; }
__device__ __forceinline__ float bf2f(bf16_t h) { return __uint_as_float(((unsigned)h) << 16); }
__device__ __forceinline__ float wave_sum(float v) {
#pragma unroll
    for (int o = 1; o < 64; o <<= 1) v += __shfl_xor(v, o);
    return v;
}
__device__ __forceinline__ int tid_op() { int t = threadIdx.x; asm volatile("" : "+v"(t)); return t; }
__device__ __forceinline__ int sgpr_op(int v) { asm volatile("" : "+s"(v)); return v; }
__device__ __forceinline__ float silu_f(float v) { return v / (1.f + __expf(-v)); }
__device__ __forceinline__ float sigmoid_f(float v) { return 1.f / (1.f + __expf(-v)); }

__device__ __forceinline__ void phase0(const Params& P, int bid, int nb) {
    bid = sgpr_op(bid); nb = sgpr_op(nb);
    const int tid = tid_op(), lane = tid & 63, wave = tid >> 6;
    const int gw = bid * (NT / 64) + wave, ngw = nb * (NT / 64);
    const int gt = bid * NT + tid, ngt = nb * NT;
    bf16_t* XN = (bf16_t*)(P.ws + WS_XN);
    for (int t = gw; t < T; t += 2 * ngw) {
        const int t2 = t + ngw;
        const bool has2 = t2 < T;
        const float4* xr = (const float4*)(P.x + (size_t)t * DM); const float4* xr2 = (const float4*)(P.x + (size_t)(has2 ? t2 : t) * DM);
        float4 v[4], w[4]; float s = 0.f, s2 = 0.f;
#pragma unroll
        for (int j = 0; j < 4; ++j) { v[j] = xr[lane + 64 * j]; w[j] = xr2[lane + 64 * j]; }
#pragma unroll
        for (int j = 0; j < 4; ++j) { s += v[j].x * v[j].x + v[j].y * v[j].y + v[j].z * v[j].z + v[j].w * v[j].w; s2 += w[j].x * w[j].x + w[j].y * w[j].y + w[j].z * w[j].z + w[j].w * w[j].w; }
        s = wave_sum(s); s2 = wave_sum(s2);
        const float rstd = 1.0f / sqrtf(s * (1.f / DM) + RMS_EPS), rstd2 = 1.0f / sqrtf(s2 * (1.f / DM) + RMS_EPS);
#pragma unroll
        for (int j = 0; j < 4; ++j) {
            const float4 g = ((const float4*)P.norm_g)[lane + 64 * j];
            uint2 o; o.x = f2bf(v[j].x * rstd * g.x) | (f2bf(v[j].y * rstd * g.y) << 16); o.y = f2bf(v[j].z * rstd * g.z) | (f2bf(v[j].w * rstd * g.w) << 16);
            ((uint2*)(XN + (size_t)t * DM))[lane + 64 * j] = o;
            if (has2) { uint2 o2; o2.x = f2bf(w[j].x * rstd2 * g.x) | (f2bf(w[j].y * rstd2 * g.y) << 16); o2.y = f2bf(w[j].z * rstd2 * g.z) | (f2bf(w[j].w * rstd2 * g.w) << 16);
                ((uint2*)(XN + (size_t)t2 * DM))[lane + 64 * j] = o2; }
        }
    }
    bf16_t* PB = (bf16_t*)(P.ws + WS_PB);
    for (int i = gt; i < T * PLE_DIM / 4; i += ngt) {
        const float4 v = ((const float4*)P.p)[i];
        uint2 o; o.x = f2bf(v.x) | (f2bf(v.y) << 16); o.y = f2bf(v.z) | (f2bf(v.w) << 16);
        ((uint2*)PB)[i] = o;
    }
    float2* CSA = (float2*)(P.ws + WS_CSA); float2* CSB = (float2*)(P.ws + WS_CSB);
    {
        const double invA = pow(10000.0, -(double)(gt & 31) / 32.0) * 0.15915494309189535, invB = pow(10000.0, -(double)(gt & 15) / 16.0) * 0.15915494309189535;
        if ((ngt & 31) == 0) {
            for (int i = gt; i < T * 32; i += ngt) { double rev = (double)P.pos[i >> 5] * invA; rev -= floor(rev); const float rf = (float)rev; CSA[i] = make_float2(__builtin_amdgcn_cosf(rf), __builtin_amdgcn_sinf(rf)); }
            for (int i = gt; i < T * 16; i += ngt) { double rev = (double)P.pos[i >> 4] * invB; rev -= floor(rev); const float rf = (float)rev; CSB[i] = make_float2(__builtin_amdgcn_cosf(rf), __builtin_amdgcn_sinf(rf)); }
        } else {
            for (int i = gt; i < T * 32; i += ngt) { double rev = (double)P.pos[i >> 5] * pow(10000.0, -(double)(i & 31) / 32.0) * 0.15915494309189535; rev -= floor(rev); const float rf = (float)rev; CSA[i] = make_float2(__builtin_amdgcn_cosf(rf), __builtin_amdgcn_sinf(rf)); }
            for (int i = gt; i < T * 16; i += ngt) { double rev = (double)P.pos[i >> 4] * pow(10000.0, -(double)(i & 15) / 16.0) * 0.15915494309189535; rev -= floor(rev); const float rf = (float)rev; CSB[i] = make_float2(__builtin_amdgcn_cosf(rf), __builtin_amdgcn_sinf(rf)); }
        }
    }
    float* ssq = (float*)(P.ws + WS_SSQQ);
    for (int i = gt; i < 3 * T; i += ngt) ssq[i] = 0.f;
    if (bid == 0 && tid == 0) {
        float s1 = 0.f, s2 = 0.f;
        for (int i = 0; i < 64; ++i) { s1 += P.diff_lambda[i] * P.diff_lambda[64 + i]; s2 += P.diff_lambda[128 + i] * P.diff_lambda[192 + i]; }
        ((float*)(P.ws + WS_MISC))[0] = expf(s1) - expf(s2) + LAM_INIT;
    }
}

constexpr int NG_SMEM_FLOATS = 16 * 129 + 16 * 65 + 128 * 65;
__device__ __forceinline__ void ngemm_tile(const bf16_t* A, int lda, int row0, const float* W, int ldw, int col0, int ncol, int K, const float* kscale, float* smem) {
    float* As = smem; float* Bs = smem + 16 * 129; float* Cs = Bs + 16 * 65;
    const int tid = tid_op(), ty = tid >> 4, tx = tid & 15;
    float acc[4][4];
#pragma unroll
    for (int i = 0; i < 4; ++i)
#pragma unroll
        for (int j = 0; j < 4; ++j) acc[i][j] = 0.f;
#pragma unroll 1
    for (int k0 = 0; k0 < K; k0 += 16) {
        __syncthreads();
#pragma unroll
        for (int i = 0; i < 4; ++i) { const int idx = tid + i * NT, r = idx >> 4, kk = idx & 15; As[kk * 129 + r] = bf2f(A[(size_t)(row0 + r) * lda + k0 + kk]); }
#pragma unroll
        for (int i = 0; i < 2; ++i) { const int idx = tid + i * NT, kk = idx >> 6, c = idx & 63;
            float w = 0.f; if (c < ncol) { w = W[(size_t)(k0 + kk) * ldw + col0 + c]; if (kscale) w *= kscale[k0 + kk]; }
            Bs[kk * 65 + c] = w; }
        __syncthreads();
#pragma unroll
        for (int kk = 0; kk < 16; ++kk) {
            float a[4], b[4];
#pragma unroll
            for (int i = 0; i < 4; ++i) a[i] = As[kk * 129 + ty * 4 + i];
#pragma unroll
            for (int j = 0; j < 4; ++j) b[j] = Bs[kk * 65 + tx * 4 + j];
#pragma unroll
            for (int i = 0; i < 4; ++i)
#pragma unroll
                for (int j = 0; j < 4; ++j) acc[i][j] += a[i] * b[j];
        }
    }
    __syncthreads();
#pragma unroll
    for (int i = 0; i < 4; ++i)
#pragma unroll
        for (int j = 0; j < 4; ++j) Cs[(ty * 4 + i) * 65 + tx * 4 + j] = acc[i][j];
    __syncthreads();
}

__device__ __forceinline__ void phase1_naive(const Params& P, int bid, int nb, float* smem) {
    bid = sgpr_op(bid); nb = sgpr_op(nb);
    const int tid = tid_op();
    const bf16_t* XN = (const bf16_t*)(P.ws + WS_XN);
    bf16_t* QD = (bf16_t*)(P.ws + WS_QD); bf16_t* KD = (bf16_t*)(P.ws + WS_KD); bf16_t* VD = (bf16_t*)(P.ws + WS_VD); bf16_t* G = (bf16_t*)(P.ws + WS_G);
    bf16_t* CQ = (bf16_t*)(P.ws + WS_CQ); bf16_t* KM = (bf16_t*)(P.ws + WS_KM);
    float* SSQQ = (float*)(P.ws + WS_SSQQ); float* SSQKV = (float*)(P.ws + WS_SSQKV);
    const float2* CSA = (const float2*)(P.ws + WS_CSA); const float2* CSB = (const float2*)(P.ws + WS_CSB);
    float* Cs = smem + 16 * 129 + 16 * 65;
    constexpr int NCT = 49, NRT = T / 128;
    for (int item = bid; item < NCT * NRT; item += nb) {
        const int ct = item % NCT, rt = item / NCT, row0 = rt * 128;
        int col0, ncol = 64;
        if (ct < 40) col0 = ct * 64; else if (ct == 40) { col0 = OFF_KR; ncol = 32; } else col0 = OFF_MG + (ct - 41) * 64;
        ngemm_tile(XN, DM, row0, P.w_in, DIN, col0, ncol, DM, nullptr, smem);
        _Pragma("unroll 1") for (int e = tid; e < 128 * 64; e += NT) {
            const int r = e >> 6, c = e & 63, t = row0 + r, b = t / SEQ, s = t % SEQ;
            const float v = Cs[r * 65 + c];
            if (col0 < OFF_DV) {
                const int i = c & 31; const float x1 = Cs[r * 65 + i], x2 = Cs[r * 65 + i + 32]; const float2 cs = CSA[(size_t)t * 32 + i];
                const float o = (c < 32) ? (x1 * cs.x - x2 * cs.y) : (x2 * cs.x + x1 * cs.y);
                if (col0 < OFF_DK) { const int mh = col0 / 64; QD[((size_t)(b * 8 + mh) * SEQ + s) * 64 + c] = (bf16_t)f2bf(o * C2D); }
                else { const int mh = (col0 - OFF_DK) / 64; KD[((size_t)(b * 8 + mh) * SEQ + s) * 64 + c] = (bf16_t)f2bf(o); }
            } else if (col0 < OFF_DG) { const int col = col0 - OFF_DV + c, h = col >> 7, d = col & 127; VD[((size_t)(b * 4 + h) * SEQ + s) * 128 + d] = (bf16_t)f2bf(v); }
            else if (col0 < OFF_CQ) { const int col = col0 - OFF_DG + c; G[(size_t)t * 1024 + col] = (bf16_t)f2bf(silu_f(v)); }
            else if (col0 < OFF_CKV) { const int col = col0 - OFF_CQ + c; CQ[(size_t)t * CQP + col] = (bf16_t)f2bf(v); }
            else if (col0 < OFF_KR) { const int col = col0 - OFF_CKV + c; CQ[(size_t)t * CQP + QLORA + col] = (bf16_t)f2bf(v); }
            else if (col0 == OFF_KR) { if (c < 32) { const int i = c & 15; const float x1 = Cs[r * 65 + i], x2 = Cs[r * 65 + i + 16]; const float2 cs = CSB[(size_t)t * 16 + i];
                    const float o = (c < 16) ? (x1 * cs.x - x2 * cs.y) : (x2 * cs.x + x1 * cs.y);
                    for (int h = 0; h < 8; ++h) KM[((size_t)(b * 8 + h) * SEQ + s) * 96 + 64 + c] = (bf16_t)f2bf(o); } }
            else { const int col = col0 - OFF_MG + c; G[(size_t)t * 1024 + 512 + col] = (bf16_t)f2bf(silu_f(v)); }
        }
        if (col0 >= OFF_CQ && col0 < OFF_KR && tid < 128) {
            float s = 0.f; _Pragma("unroll 4") for (int c = 0; c < 64; ++c) { const float v = Cs[tid * 65 + c]; s += v * v; }
            atomicAdd((col0 < OFF_CKV ? SSQQ : SSQKV) + row0 + tid, s);
        }
    }
}

__device__ __forceinline__ void phase15_naive(const Params& P, int bid, int nb, float* smem) {
    bid = sgpr_op(bid); nb = sgpr_op(nb);
    const int tid = tid_op();
    const bf16_t* CQ = (const bf16_t*)(P.ws + WS_CQ); const bf16_t* CKV = CQ + QLORA;
    bf16_t* QM = (bf16_t*)(P.ws + WS_QM); bf16_t* KM = (bf16_t*)(P.ws + WS_KM); bf16_t* VM = (bf16_t*)(P.ws + WS_VM);
    const float* SSQQ = (const float*)(P.ws + WS_SSQQ); const float* SSQKV = (const float*)(P.ws + WS_SSQKV);
    const float2* CSB = (const float2*)(P.ws + WS_CSB);
    float* Cs = smem + 16 * 129 + 16 * 65;
    constexpr int NCT = 12 + 16, NRT = T / 128;
    for (int item = bid; item < NCT * NRT; item += nb) {
        const int ct = item % NCT, rt = item / NCT, row0 = rt * 128;
        if (ct < 12) {
            const int col0 = ct * 64;
            ngemm_tile(CQ, CQP, row0, P.w_uq, 768, col0, 64, QLORA, P.qn_g, smem);
            _Pragma("unroll 1") for (int e = tid; e < 128 * 64; e += NT) {
                const int r = e >> 6, c = e & 63, t = row0 + r, b = t / SEQ, s = t % SEQ, col = col0 + c, h = col / 96, j = col % 96;
                const float rstd = 1.0f / sqrtf(SSQQ[t] * (1.f / QLORA) + RMS_EPS);
                float o;
                if (j < 64) o = Cs[r * 65 + c];
                else { const int jj = j - 64, i = jj & 15, cb = c - jj; const float x1 = Cs[r * 65 + cb + i], x2 = Cs[r * 65 + cb + i + 16]; const float2 cs = CSB[(size_t)t * 16 + i];
                    o = (jj < 16) ? (x1 * cs.x - x2 * cs.y) : (x2 * cs.x + x1 * cs.y); }
                QM[((size_t)(b * 8 + h) * SEQ + s) * 96 + j] = (bf16_t)f2bf(o * rstd * C2M);
            }
        } else {
            const int col0 = (ct - 12) * 64;
            ngemm_tile(CKV, CQP, row0, P.w_ukv, 1024, col0, 64, KVLORA, P.kvn_g, smem);
            _Pragma("unroll 1") for (int e = tid; e < 128 * 64; e += NT) {
                const int r = e >> 6, c = e & 63, t = row0 + r, b = t / SEQ, s = t % SEQ, col = col0 + c, h = col >> 7, j = col & 127;
                const float rstd = 1.0f / sqrtf(SSQKV[t] * (1.f / KVLORA) + RMS_EPS);
                const float o = Cs[r * 65 + c] * rstd;
                if (j < 64) KM[((size_t)(b * 8 + h) * SEQ + s) * 96 + j] = (bf16_t)f2bf(o);
                else VM[((size_t)(b * 8 + h) * SEQ + s) * 64 + j - 64] = (bf16_t)f2bf(o);
            }
        }
    }
}

template <int DQK, int DV, int DVS>
__device__ __forceinline__ void nattn_rows(const bf16_t* Qh, const bf16_t* Kh, const bf16_t* Vh, int q0, float* o, float& l_out, unsigned* smem) {
    const int tid = tid_op(), i = q0 + tid;
    unsigned* Ks = smem; unsigned* Vs = smem + 32 * (DQK / 2);
    unsigned q2[DQK / 2];
#pragma unroll
    for (int d = 0; d < DQK / 2; ++d) q2[d] = ((const unsigned*)(Qh + (size_t)i * DQK))[d];
#pragma unroll
    for (int d = 0; d < DV; ++d) o[d] = 0.f;
    float m = -1e30f, l = 0.f;
    const int jend = q0 + NT;
#pragma unroll 1
    for (int j0 = 0; j0 < jend; j0 += 32) {
        __syncthreads();
        for (int idx = tid; idx < 32 * (DQK / 2); idx += NT) Ks[idx] = ((const unsigned*)(Kh + (size_t)j0 * DQK))[idx];
        for (int idx = tid; idx < 32 * (DV / 2); idx += NT) { const int r = idx / (DV / 2), c = idx % (DV / 2); Vs[idx] = ((const unsigned*)(Vh + (size_t)(j0 + r) * DVS))[c]; }
        __syncthreads();
#pragma unroll 1
        for (int jj = 0; jj < 32; jj += 2) {
            float sc[2];
#pragma unroll
            for (int k = 0; k < 2; ++k) {
                const unsigned* kr = Ks + (jj + k) * (DQK / 2); float s = 0.f;
#pragma unroll
                for (int d = 0; d < DQK / 2; ++d) { const unsigned kk = kr[d]; unsigned qq = q2[d]; asm volatile("" : "+v"(qq));
                    s += __uint_as_float(qq << 16) * __uint_as_float(kk << 16); s += __uint_as_float(qq & 0xffff0000u) * __uint_as_float(kk & 0xffff0000u); }
                sc[k] = (j0 + jj + k <= i) ? s : -1e30f;
                asm volatile("" : "+v"(sc[k]));
            }
            const float mn = fmaxf(fmaxf(sc[0], sc[1]), m);
            const float alpha = exp2f(m - mn);
            float pr[2];
#pragma unroll
            for (int k = 0; k < 2; ++k) pr[k] = (j0 + jj + k <= i) ? exp2f(sc[k] - mn) : 0.f;
            l = l * alpha + (pr[0] + pr[1]); m = mn;
#pragma unroll
            for (int d = 0; d < DV; ++d) o[d] *= alpha;
#pragma unroll
            for (int k = 0; k < 2; ++k) { const unsigned* vr = Vs + (jj + k) * (DV / 2);
#pragma unroll
                for (int d = 0; d < DV / 2; ++d) { const unsigned vv = vr[d]; o[2 * d] += pr[k] * __uint_as_float(vv << 16); o[2 * d + 1] += pr[k] * __uint_as_float(vv & 0xffff0000u); } }
        }
    }
    l_out = l;
}
__device__ __forceinline__ void phase2_naive(const Params& P, int bid, int nb, float* smemf) {
    bid = sgpr_op(bid); nb = sgpr_op(nb);
    unsigned* smem = (unsigned*)smemf;
    const bf16_t* QD = (const bf16_t*)(P.ws + WS_QD); const bf16_t* KD = (const bf16_t*)(P.ws + WS_KD); const bf16_t* VD = (const bf16_t*)(P.ws + WS_VD);
    const bf16_t* QM = (const bf16_t*)(P.ws + WS_QM); const bf16_t* KM = (const bf16_t*)(P.ws + WS_KM); const bf16_t* VM = (const bf16_t*)(P.ws + WS_VM);
    const bf16_t* G = (const bf16_t*)(P.ws + WS_G); bf16_t* OD = (bf16_t*)(P.ws + WS_OD); bf16_t* YC = (bf16_t*)(P.ws + WS_YCAT);
    constexpr int NCH = SEQ / NT;
    for (int item = bid; item < 2 * 64 * NCH; item += nb) {
        const int kind = item / (64 * NCH), rem = item % (64 * NCH), bh = rem / NCH, ch = NCH - 1 - rem % NCH, q0 = ch * NT, b = bh >> 3, hh = bh & 7;
        const int i = q0 + tid_op();
        if (kind == 0) {
#pragma unroll 1
            for (int half = 0; half < 2; ++half) {
                float o[64], l;
                nattn_rows<64, 64, 128>(QD + (size_t)bh * SEQ * 64, KD + (size_t)bh * SEQ * 64, VD + (size_t)(b * 4 + (hh >> 1)) * SEQ * 128 + half * 64, q0, o, l, smem);
                const float rl = 1.f / l;
#pragma unroll
                for (int d = 0; d < 64; ++d) OD[((size_t)bh * SEQ + i) * 128 + half * 64 + d] = (bf16_t)f2bf(o[d] * rl);
            }
        } else {
            float o[64], l;
            nattn_rows<96, 64, 64>(QM + (size_t)bh * SEQ * 96, KM + (size_t)bh * SEQ * 96, VM + (size_t)bh * SEQ * 64, q0, o, l, smem);
            const float rl = 1.f / l; const size_t t = (size_t)b * SEQ + i;
#pragma unroll
            for (int d = 0; d < 64; ++d) { const size_t idx = t * 1024 + 512 + hh * 64 + d; YC[idx] = (bf16_t)f2bf(o[d] * rl * bf2f(G[idx])); }
        }
    }
}

__device__ __forceinline__ void phase25_naive(const Params& P, int bid, int nb) {
    bid = sgpr_op(bid); nb = sgpr_op(nb);
    const bf16_t* OD = (const bf16_t*)(P.ws + WS_OD); const bf16_t* G = (const bf16_t*)(P.ws + WS_G); bf16_t* YC = (bf16_t*)(P.ws + WS_YCAT);
    const float lam = ((const float*)(P.ws + WS_MISC))[0];
    const int tid = tid_op(), lane = tid & 63, wave = tid >> 6;
    const int gw = bid * (NT / 64) + wave, ngw = nb * (NT / 64);
    for (int it = gw; it < T * 4; it += ngw) {
        const int t = it >> 2, h = it & 3, b = t / SEQ, s = t % SEQ;
        const bf16_t* o0 = OD + ((size_t)(b * 8 + 2 * h) * SEQ + s) * 128; const bf16_t* o1 = OD + ((size_t)(b * 8 + 2 * h + 1) * SEQ + s) * 128;
        const float d0 = bf2f(o0[lane]) - lam * bf2f(o1[lane]), d1 = bf2f(o0[lane + 64]) - lam * bf2f(o1[lane + 64]);
        const float ss = wave_sum(d0 * d0 + d1 * d1);
        const float rstd = 1.0f / sqrtf(ss * (1.f / 128.f) + RMS_EPS);
        const size_t base = (size_t)t * 1024 + h * 128;
        YC[base + lane] = (bf16_t)f2bf(d0 * rstd * P.subln_g[lane] * (1.f - LAM_INIT) * bf2f(G[base + lane]));
        YC[base + lane + 64] = (bf16_t)f2bf(d1 * rstd * P.subln_g[lane + 64] * (1.f - LAM_INIT) * bf2f(G[base + lane + 64]));
    }
}

__device__ __forceinline__ void phase3_naive(const Params& P, int bid, int nb, float* smem) {
    bid = sgpr_op(bid); nb = sgpr_op(nb);
    const int tid = tid_op();
    const bf16_t* YC = (const bf16_t*)(P.ws + WS_YCAT); const bf16_t* PB = (const bf16_t*)(P.ws + WS_PB);
    bf16_t* HB = (bf16_t*)(P.ws + WS_HB); bf16_t* PLE = (bf16_t*)(P.ws + WS_PLE);
    float* Cs = smem + 16 * 129 + 16 * 65;
    constexpr int NRT = T / 128;
    for (int item = bid; item < 32 * NRT; item += nb) {
        const int ct = item % 32, rt = item / 32, row0 = rt * 128, col0 = (ct & 15) * 64;
        if (ct < 16) {
            ngemm_tile(YC, DM, row0, P.w_out, DM, col0, 64, DM, nullptr, smem);
            _Pragma("unroll 1") for (int e = tid; e < 128 * 64; e += NT) { const int r = e >> 6, c = e & 63; const size_t idx = (size_t)(row0 + r) * DM + col0 + c;
                const float h = P.x[idx] + Cs[r * 65 + c]; P.out[idx] = h; HB[idx] = (bf16_t)f2bf(h); }
        } else {
            ngemm_tile(PB, PLE_DIM, row0, P.w_ple, DM, col0, 64, PLE_DIM, nullptr, smem);
            _Pragma("unroll 1") for (int e = tid; e < 128 * 64; e += NT) { const int r = e >> 6, c = e & 63; const size_t idx = (size_t)(row0 + r) * DM + col0 + c; PLE[idx] = (bf16_t)f2bf(Cs[r * 65 + c]); }
        }
    }
}
__device__ __forceinline__ void phase4_naive(const Params& P, int bid, int nb, float* smem) {
    bid = sgpr_op(bid); nb = sgpr_op(nb);
    const int tid = tid_op();
    const bf16_t* HB = (const bf16_t*)(P.ws + WS_HB); const bf16_t* PLE = (const bf16_t*)(P.ws + WS_PLE); float* SSQF = (float*)(P.ws + WS_SSQF);
    float* Cs = smem + 16 * 129 + 16 * 65;
    constexpr int NRT = T / 128;
    for (int item = bid; item < 16 * NRT; item += nb) {
        const int ct = item % 16, rt = item / 16, row0 = rt * 128, col0 = ct * 64;
        ngemm_tile(HB, DM, row0, P.w_gate, DM, col0, 64, DM, nullptr, smem);
        _Pragma("unroll 1") for (int e = tid; e < 128 * 64; e += NT) { const int r = e >> 6, c = e & 63; const size_t idx = (size_t)(row0 + r) * DM + col0 + c;
            const float h2 = P.out[idx] + bf2f(PLE[idx]) * sigmoid_f(Cs[r * 65 + c]); P.out[idx] = h2; Cs[r * 65 + c] = h2; }
        __syncthreads();
        if (tid < 128) { float s = 0.f; _Pragma("unroll 4") for (int c = 0; c < 64; ++c) { const float v = Cs[tid * 65 + c]; s += v * v; } atomicAdd(SSQF + row0 + tid, s); }
    }
}
__device__ __forceinline__ void phase5(const Params& P, int bid, int nb) {
    bid = sgpr_op(bid); nb = sgpr_op(nb);
    const float* SSQF = (const float*)(P.ws + WS_SSQF);
    const int tid = tid_op(), lane = tid & 63, wave = tid >> 6;
    const int gw = bid * (NT / 64) + wave, ngw = nb * (NT / 64);
    for (int t = gw; t < T; t += ngw) {
        const float rstd = 1.0f / sqrtf(SSQF[t] * (1.f / DM) + RMS_EPS);
        float4* o = (float4*)(P.out + (size_t)t * DM);
#pragma unroll
        for (int j = 0; j < 4; ++j) { float4 v = o[lane + 64 * j]; const float4 g = ((const float4*)P.final_g)[lane + 64 * j];
            v.x *= rstd * g.x; v.y *= rstd * g.y; v.z *= rstd * g.z; v.w *= rstd * g.w; o[lane + 64 * j] = v; }
    }
}

namespace pg8 {
#define PG8_LAS __attribute__((address_space(3)))
typedef unsigned short bf16_t;
typedef short bf16x8 __attribute__((ext_vector_type(8)));
typedef float f32x4 __attribute__((ext_vector_type(4)));
typedef unsigned u32x4 __attribute__((ext_vector_type(4)));
constexpr int BM = 256, BK = 64, HALF = 128, HTB = HALF * BK * 2  , STAGE_BYTES = 8 * HTB, NXCD = 8, WGM = 8;

__host__ __device__ __forceinline__ int lds_byte(int r, int c) { const int st = (r >> 4) * 2 + (c >> 5), rr = r & 15, cc = c & 31, ob = rr * 64 + cc * 2; return st * 1024 + (ob ^ (((ob >> 9) & 1) << 5)); }
__host__ __device__ __forceinline__ void stage_rc(int b, int& R, int& C) { const int st = b / 1024, sb = b % 1024, swz = sb ^ (((sb >> 9) & 1) << 5); R = (st >> 1) * 16 + swz / 64; C = (st & 1) * 32 + (swz % 64) / 2; }
__host__ __device__ __forceinline__ int perm32(int rho) { const int n = rho >> 4, i = rho & 15; return 8 * (i >> 2) + 4 * n + (i & 3); }

struct Unit { int pm, pn; };
struct Gemm { const bf16_t* A; const bf16_t* Bt; int M, N, K, lda; };

struct StaticOrder {
    int nM, nN, nwg, G, c;
    __host__ __device__ void init(int M, int N, int G_, int c_) { nM = M / BM; nN = N / BM; nwg = nM * nN; G = G_; c = c_; }
    __host__ __device__ bool next(int i, Unit& u) const {
        const long L = (long)i * G + c; if (L >= nwg) return false;
        int wgid = (int)L; { const int q = nwg / NXCD, r = nwg % NXCD, xcd = wgid % NXCD, off = wgid / NXCD; wgid = (xcd < r ? xcd * (q + 1) : r * (q + 1) + (xcd - r) * q) + off; }
        const int nig = WGM * nN, gid = wgid / nig, fm = gid * WGM, gsz = (nM - fm) < WGM ? (nM - fm) : WGM;
        u.pm = fm + ((wgid % nig) % gsz); u.pn = (wgid % nig) / gsz; return true;
    }
    __device__ __forceinline__ void a_ready(const Unit&) const {}
    __device__ __forceinline__ void done(const Unit&) const {}
};

__device__ __forceinline__ unsigned cvt_pk_bf16(float lo, float hi) { unsigned r; asm volatile("v_cvt_pk_bf16_f32 %0, %1, %2" : "=v"(r) : "v"(lo), "v"(hi)); return r; }
template <class Epi, class Sched, bool ALIGN_EPI = false, bool SP2 = false>
__device__ __forceinline__ void gemm_phase(PG8_LAS unsigned char* lds, const Gemm g, const Sched& S, const Epi& E) {
    const int tid = tid_op(), wid = __builtin_amdgcn_readfirstlane(tid >> 6), lane = tid & 63, wr = wid >> 2, wc = wid & 3, fr = lane & 15, fq = lane >> 4;
    const int K = g.K, nt = K / BK;
    unsigned voffA[2], voffB[2];
#pragma unroll
    for (int i = 0; i < 2; ++i) { int R, C; stage_rc(tid * 16 + i * 8192, R, C); const int Rb = Epi::PERM ? ((R & ~31) + perm32(R & 31)) : R;
        voffA[i] = (unsigned)(R * g.lda + C) * 2u; voffB[i] = (unsigned)(Rb * K + C) * 2u; }
    const size_t kstep = (size_t)(BK * 2);
    const size_t hstepA = (size_t)HALF * g.lda * 2, hstepB = (size_t)HALF * K * 2;
    const size_t tstepA = 2 * hstepA, tstepB = 2 * hstepB;
    const unsigned ldsw = (unsigned)wid * 1024u;
    const int aoff = lds_byte(wr * 64 + fr, fq * 8), boff = lds_byte(wc * 32 + fr, fq * 8);
#define PG8_SA(b, h) (((b) * 2 + (h)) * HTB)
#define PG8_SB(b, h) ((4 + (b) * 2 + (h)) * HTB)
#define PG8_STAGE(bufoff, gbase, voff) do { _Pragma("unroll") for (int _i = 0; _i < 2; ++_i) \
        __builtin_amdgcn_global_load_lds((const unsigned*)((const char*)(gbase) + (voff)[_i]), (PG8_LAS unsigned*)(lds + (bufoff) + ldsw + _i * 8192), 16, 0, 0); } while (0)
#define PG8_LDA(dst, b, h) do { _Pragma("unroll") for (int m = 0; m < 4; ++m) _Pragma("unroll") for (int k = 0; k < 2; ++k) dst[m][k] = *(const PG8_LAS bf16x8*)(lds + PG8_SA(b, h) + aoff + m * 2048 + k * 1024); } while (0)
#define PG8_LDB(dst, b, h) do { _Pragma("unroll") for (int n = 0; n < 2; ++n) _Pragma("unroll") for (int k = 0; k < 2; ++k) dst[n][k] = *(const PG8_LAS bf16x8*)(lds + PG8_SB(b, h) + boff + n * 2048 + k * 1024); } while (0)
#define PG8_MMA(ai, bj, At, Bt) do { __builtin_amdgcn_s_setprio(1); _Pragma("unroll") for (int m = 0; m < 4; ++m) _Pragma("unroll") for (int n = 0; n < 2; ++n) _Pragma("unroll") for (int k = 0; k < 2; ++k) \
        acc[ai][bj][m][n] = __builtin_amdgcn_mfma_f32_16x16x32_bf16(Bt[n][k], At[m][k], acc[ai][bj][m][n], 0, 0, 0); __builtin_amdgcn_s_setprio(0); } while (0)
#define PG8_WAIT_V(n) asm volatile("s_waitcnt vmcnt(" #n ")" ::: "memory")
#define PG8_WAIT_L(n) asm volatile("s_waitcnt lgkmcnt(" #n ")" ::: "memory")
#define PG8_BAR __builtin_amdgcn_s_barrier()
#define PG8_SCHED __builtin_amdgcn_sched_barrier(0)
    Unit cur, nxt; int ui = 0;
    if (!S.next(0, cur)) return;
    f32x4 acc[2][2][4][2];
#pragma unroll
    for (int a = 0; a < 2; ++a)
#pragma unroll
        for (int b = 0; b < 2; ++b)
#pragma unroll
            for (int m = 0; m < 4; ++m)
#pragma unroll
                for (int n = 0; n < 2; ++n) acc[a][b][m][n] = (f32x4){0.f, 0.f, 0.f, 0.f};
    bf16x8 At[4][2], B0[2][2], B1[2][2];
    const char* cA = (const char*)g.A + (size_t)cur.pm * tstepA; const char* cB = (const char*)g.Bt + (size_t)cur.pn * tstepB;
    S.a_ready(cur);
    if constexpr (SP2) {
        PG8_STAGE(PG8_SB(0, 0), cB, voffB); PG8_STAGE(PG8_SB(0, 1), cB + hstepB, voffB); PG8_STAGE(PG8_SA(0, 0), cA, voffA); PG8_STAGE(PG8_SA(0, 1), cA + hstepA, voffA);
        if (wr == 1) PG8_BAR;
        PG8_WAIT_V(2); PG8_BAR;
        PG8_STAGE(PG8_SB(1, 0), cB + kstep, voffB); PG8_STAGE(PG8_SA(1, 0), cA + kstep, voffA); PG8_STAGE(PG8_SB(1, 1), cB + hstepB + kstep, voffB);
        PG8_WAIT_V(6); PG8_BAR;
    } else {
        PG8_STAGE(PG8_SB(0, 0), cB, voffB); PG8_STAGE(PG8_SA(0, 0), cA, voffA); PG8_STAGE(PG8_SB(0, 1), cB + hstepB, voffB); PG8_STAGE(PG8_SA(0, 1), cA + hstepA, voffA);
        if (wr == 1) PG8_BAR;
        PG8_WAIT_V(4); PG8_BAR;
        PG8_STAGE(PG8_SB(1, 0), cB + kstep, voffB); PG8_STAGE(PG8_SA(1, 0), cA + kstep, voffA); PG8_STAGE(PG8_SB(1, 1), cB + hstepB + kstep, voffB);
        PG8_WAIT_V(6); PG8_BAR;
    }
    for (;;) {
        const bool has_next = S.next(ui + 1, nxt);
        const char* nA = has_next ? (const char*)g.A + (size_t)nxt.pm * tstepA : cA; const char* nB = has_next ? (const char*)g.Bt + (size_t)nxt.pn * tstepB : cB;
#pragma unroll 1
        for (int t = 0; t < nt; t += 2) {
            const bool last = (t == nt - 2);
            const char* a1 = cA + (size_t)(t + 1) * kstep;
            const char* a2 = last ? nA : cA + (size_t)(t + 2) * kstep; const char* b2 = last ? nB : cB + (size_t)(t + 2) * kstep;
            const char* a3 = a2 + kstep; const char* b3 = b2 + kstep;
            if (last && has_next) S.a_ready(nxt);
            if constexpr (SP2) {
            PG8_LDB(B0, 0, 0); PG8_LDB(B1, 0, 1); PG8_SCHED; PG8_LDA(At, 0, 0); PG8_STAGE(PG8_SA(1, 1), a1 + hstepA, voffA);
            PG8_WAIT_V(8); PG8_WAIT_L(0); PG8_BAR; PG8_MMA(0, 0, At, B0); PG8_MMA(0, 1, At, B1); PG8_BAR; PG8_SCHED;
            PG8_LDA(At, 0, 1); PG8_STAGE(PG8_SB(0, 0), b2, voffB); PG8_STAGE(PG8_SB(0, 1), b2 + hstepB, voffB); PG8_STAGE(PG8_SA(0, 0), a2, voffA);
            PG8_WAIT_V(8); PG8_WAIT_L(0); PG8_BAR; PG8_MMA(1, 0, At, B0); PG8_MMA(1, 1, At, B1); PG8_BAR; PG8_SCHED;
            PG8_LDB(B0, 1, 0); PG8_LDB(B1, 1, 1); PG8_SCHED; PG8_LDA(At, 1, 0); PG8_STAGE(PG8_SA(0, 1), a2 + hstepA, voffA);
            PG8_WAIT_V(8); PG8_WAIT_L(0); PG8_BAR; PG8_MMA(0, 0, At, B0); PG8_MMA(0, 1, At, B1); PG8_BAR; PG8_SCHED;
            PG8_LDA(At, 1, 1); PG8_STAGE(PG8_SB(1, 0), b3, voffB); PG8_STAGE(PG8_SB(1, 1), b3 + hstepB, voffB); PG8_STAGE(PG8_SA(1, 0), a3, voffA);
            PG8_WAIT_V(8); PG8_WAIT_L(0); PG8_BAR; PG8_MMA(1, 0, At, B0); PG8_MMA(1, 1, At, B1); PG8_BAR; PG8_SCHED;
            } else {
            PG8_LDB(B0, 0, 0); PG8_SCHED; PG8_LDA(At, 0, 0); PG8_STAGE(PG8_SA(1, 1), a1 + hstepA, voffA);
            PG8_WAIT_L(8); PG8_BAR; PG8_WAIT_L(0); PG8_MMA(0, 0, At, B0); PG8_BAR; PG8_SCHED;
            PG8_LDB(B1, 0, 1); PG8_STAGE(PG8_SB(0, 0), b2, voffB);
            PG8_BAR; PG8_WAIT_L(0); PG8_MMA(0, 1, At, B1); PG8_BAR;
            PG8_LDA(At, 0, 1); PG8_STAGE(PG8_SA(0, 0), a2, voffA);
            PG8_BAR; PG8_WAIT_L(0); PG8_MMA(1, 0, At, B0); PG8_BAR; PG8_SCHED;
            PG8_STAGE(PG8_SB(0, 1), b2 + hstepB, voffB);
            PG8_WAIT_V(6); PG8_BAR; PG8_MMA(1, 1, At, B1); PG8_BAR;
            PG8_LDB(B0, 1, 0); PG8_SCHED; PG8_LDA(At, 1, 0); PG8_STAGE(PG8_SA(0, 1), a2 + hstepA, voffA);
            PG8_WAIT_L(8); PG8_BAR; PG8_WAIT_L(0); PG8_MMA(0, 0, At, B0); PG8_BAR; PG8_SCHED;
            PG8_LDB(B1, 1, 1); PG8_STAGE(PG8_SB(1, 0), b3, voffB);
            PG8_BAR; PG8_WAIT_L(0); PG8_MMA(0, 1, At, B1); PG8_BAR;
            PG8_LDA(At, 1, 1); PG8_STAGE(PG8_SA(1, 0), a3, voffA);
            PG8_BAR; PG8_WAIT_L(0); PG8_MMA(1, 0, At, B0); PG8_BAR; PG8_SCHED;
            PG8_STAGE(PG8_SB(1, 1), b3 + hstepB, voffB);
            PG8_WAIT_V(6); PG8_BAR; PG8_MMA(1, 1, At, B1); PG8_BAR;
            }
        }
        if constexpr (ALIGN_EPI) { if (wr == 0) PG8_BAR; }
        if constexpr (!Epi::AFTER_DRAIN) { E(acc, cur, wr, wc, fr, fq); S.done(cur); }
        if (!has_next) break;
#pragma unroll
        for (int a = 0; a < 2; ++a)
#pragma unroll
            for (int b = 0; b < 2; ++b)
#pragma unroll
                for (int m = 0; m < 4; ++m)
#pragma unroll
                    for (int n = 0; n < 2; ++n) acc[a][b][m][n] = (f32x4){0.f, 0.f, 0.f, 0.f};
        cur = nxt; cA = nA; cB = nB; ++ui;
        if constexpr (ALIGN_EPI) { if (wr == 1) PG8_BAR; }
    }
    PG8_WAIT_V(0);
    if constexpr (!ALIGN_EPI) { if (wr == 0) PG8_BAR; }
    PG8_BAR;
    if constexpr (Epi::AFTER_DRAIN) { E.fused(acc, cur, wr, wc, fr, fq, lds, wid, lane); S.done(cur); }
#undef PG8_SA
#undef PG8_SB
#undef PG8_STAGE
#undef PG8_LDA
#undef PG8_LDB
#undef PG8_MMA
#undef PG8_WAIT_V
#undef PG8_WAIT_L
#undef PG8_BAR
#undef PG8_SCHED
}
}

#define LAS __attribute__((address_space(3)))
typedef float f32x4 __attribute__((ext_vector_type(4)));
typedef unsigned u32x4 __attribute__((ext_vector_type(4)));
using pg8::cvt_pk_bf16;
__device__ __forceinline__ u32x4 pack8(const f32x4 a, const f32x4 b) { u32x4 w; w.x = cvt_pk_bf16(a[0], a[1]); w.y = cvt_pk_bf16(a[2], a[3]); w.z = cvt_pk_bf16(b[0], b[1]); w.w = cvt_pk_bf16(b[2], b[3]); return w; }

struct MapIn {
    __device__ __forceinline__ int operator()(int g) const { const int pn = g >> 8, cc = g & 255, bj = cc >> 7, w = cc & 127;
        if (pn < 2) return OFF_DQ + (4 * pn + (w >> 5)) * 64 + bj * 32 + (w & 31);
        if (pn < 4) return OFF_DK + (4 * (pn - 2) + (w >> 5)) * 64 + bj * 32 + (w & 31);
        if (pn < 6) return OFF_DV + (pn - 4) * 256 + cc;
        if (pn < 8) return OFF_DG + (pn - 6) * 256 + cc;
        if (pn == 8) return OFF_CQ + cc;
        if (pn == 9) return bj == 0 ? OFF_CQ + 256 + w : OFF_CKV + w;
        if (pn < 12) return OFF_MG + (pn - 10) * 256 + cc;
        return w < 16 ? OFF_KR + bj * 16 + w : -1; } };
struct MapUq {
    __device__ __forceinline__ int operator()(int g) const { const int pn = g >> 8, cc = g & 255;
        if (pn == 0) { const int bj = cc >> 7, w = cc & 127; return (w >> 4) * 96 + 64 + bj * 16 + (w & 15); }
        const int gp = g - 256; return (gp >> 6) * 96 + (gp & 63); } };
struct MapId { __device__ __forceinline__ int operator()(int g) const { return g; } };
template <class Map>
__device__ __forceinline__ void wconv(const float* W, int K, int ldw, const float* kscale, bf16_t* Wt, int ldwt, int kdst_off, int Ng, Map map, LAS float* scr, int gw, int ngw, int lane) {
    const int nblk = Ng / 32, items = (K / 64) * nblk;
    for (int it = gw; it < items; it += ngw) {
        const int kb = it / nblk, nbk = it % nblk, k0 = 64 * kb, n0 = 32 * nbk;
        const int src = map(n0 + (lane & 31));
#pragma unroll 8
        for (int i = 0; i < 32; ++i) { const int kk = 2 * i + (lane >> 5);
            float v = 0.f; if (src >= 0) { v = W[(size_t)(k0 + kk) * ldw + src]; if (kscale) v *= kscale[k0 + kk]; }
            scr[kk * 33 + (lane & 31)] = v; }
        asm volatile("s_waitcnt lgkmcnt(0)" ::: "memory");
        const int c = lane & 7;
#pragma unroll
        for (int j = 0; j < 4; ++j) { const int n = (lane >> 3) + 8 * j; const LAS float* sp = scr + (8 * c) * 33 + n;
            u32x4 o; o.x = f2bf(sp[0]) | (f2bf(sp[33]) << 16); o.y = f2bf(sp[2 * 33]) | (f2bf(sp[3 * 33]) << 16); o.z = f2bf(sp[4 * 33]) | (f2bf(sp[5 * 33]) << 16); o.w = f2bf(sp[6 * 33]) | (f2bf(sp[7 * 33]) << 16);
            *(u32x4*)(Wt + (size_t)(n0 + n) * ldwt + kdst_off + k0 + 8 * c) = o; }
        asm volatile("s_waitcnt lgkmcnt(0)" ::: "memory");
    }
}
constexpr int NIN = 13 * 256;
__device__ __forceinline__ void phase0_weights(const Params& P, int bid, int nb, LAS unsigned char* lds) {
    const int tid = tid_op(), lane = tid & 63, wave = tid >> 6;
    const int gw = bid * (NT / 64) + wave, ngw = nb * (NT / 64);
    LAS float* scr = (LAS float*)(lds + wave * 16384);
    wconv(P.w_in, DM, DIN, nullptr, (bf16_t*)(P.ws + WS_WIN), DM, 0, NIN, MapIn(), scr, gw, ngw, lane);
    wconv(P.w_ple, PLE_DIM, DM, nullptr, (bf16_t*)(P.ws + WS_WPLE), PLE_DIM, 0, DM, MapId(), scr, gw, ngw, lane);
    wconv(P.w_uq, QLORA, 768, P.qn_g, (bf16_t*)(P.ws + WS_WUQ), QLORA, 0, 768, MapUq(), scr, gw, ngw, lane);
    wconv(P.w_ukv, KVLORA, 1024, P.kvn_g, (bf16_t*)(P.ws + WS_WUKV), 256, 128, 1024, MapId(), scr, gw, ngw, lane);
    wconv(P.w_out, DM, DM, nullptr, (bf16_t*)(P.ws + WS_WOUT), DM, 0, DM, MapId(), scr, gw, ngw, lane);
    wconv(P.w_gate, DM, DM, nullptr, (bf16_t*)(P.ws + WS_WG), DM, 0, DM, MapId(), scr, gw, ngw, lane);
    u32x4* z = (u32x4*)(P.ws + WS_WUKV);
    for (int i = bid * NT + tid; i < 1024 * 16; i += nb * NT) { const int g = i >> 4, c = i & 15; z[g * 32 + c] = (u32x4){0u, 0u, 0u, 0u}; }
}

struct Epi1 {
    static constexpr bool PERM = true, AFTER_DRAIN = false;
    bf16_t *QD, *KD, *VD, *G, *CQ, *KM; float *SSQQ, *SSQKV; const float2 *CSA, *CSB;
    __device__ __forceinline__ void operator()(const f32x4 (&acc)[2][2][4][2], const pg8::Unit& u, int wr, int wc, int fr, int fq) const {
        const int pn = u.pn, b = u.pm >> 4, s0 = (u.pm & 15) * 256 + wr * 64 + fr, t0 = u.pm * 256 + wr * 64 + fr;
        if (pn < 4) {
            bf16_t* dst = pn < 2 ? QD : KD; const float sc = pn < 2 ? C2D : 1.f; const int mh = 4 * (pn & 1) + wc;
#pragma unroll
            for (int ai = 0; ai < 2; ++ai)
#pragma unroll
                for (int m = 0; m < 4; ++m) { const int ro = ai * 128 + m * 16; const f32x4* cs = (const f32x4*)(CSA + (size_t)(t0 + ro) * 32 + 8 * fq);
                    f32x4 o1[2], o2[2];
#pragma unroll
                    for (int n = 0; n < 2; ++n) { const f32x4 ca = cs[2 * n], cb = cs[2 * n + 1]; const f32x4 x1 = acc[ai][0][m][n], x2 = acc[ai][1][m][n];
                        o1[n] = (f32x4){x1[0] * ca[0] - x2[0] * ca[1], x1[1] * ca[2] - x2[1] * ca[3], x1[2] * cb[0] - x2[2] * cb[1], x1[3] * cb[2] - x2[3] * cb[3]} * sc;
                        o2[n] = (f32x4){x2[0] * ca[0] + x1[0] * ca[1], x2[1] * ca[2] + x1[1] * ca[3], x2[2] * cb[0] + x1[2] * cb[1], x2[3] * cb[2] + x1[3] * cb[3]} * sc; }
                    bf16_t* rp = dst + ((size_t)(b * 8 + mh) * SEQ + s0 + ro) * 64 + 8 * fq;
                    *(u32x4*)rp = pack8(o1[0], o1[1]); *(u32x4*)(rp + 32) = pack8(o2[0], o2[1]); asm volatile("" ::: "memory"); }
        } else if (pn < 6) {
#pragma unroll
            for (int ai = 0; ai < 2; ++ai)
#pragma unroll
                for (int m = 0; m < 4; ++m)
#pragma unroll
                    for (int bj = 0; bj < 2; ++bj) { const int ro = ai * 128 + m * 16, h = 2 * (pn - 4) + bj;
                        *(u32x4*)(VD + ((size_t)(b * 4 + h) * SEQ + s0 + ro) * 128 + 32 * wc + 8 * fq) = pack8(acc[ai][bj][m][0], acc[ai][bj][m][1]); }
        } else if (pn < 8 || pn == 10 || pn == 11) {
            const int cb = (pn < 8 ? (pn - 6) * 256 : 512 + (pn - 10) * 256) + 32 * wc + 8 * fq;
#pragma unroll
            for (int ai = 0; ai < 2; ++ai)
#pragma unroll
                for (int m = 0; m < 4; ++m)
#pragma unroll
                    for (int bj = 0; bj < 2; ++bj) { const int ro = ai * 128 + m * 16; f32x4 a = acc[ai][bj][m][0], c = acc[ai][bj][m][1];
#pragma unroll
                        for (int j = 0; j < 4; ++j) { a[j] = silu_f(a[j]); c[j] = silu_f(c[j]); }
                        *(u32x4*)(G + (size_t)(t0 + ro) * 1024 + cb + 128 * bj) = pack8(a, c); }
        } else if (pn < 10) {
#pragma unroll
            for (int ai = 0; ai < 2; ++ai)
#pragma unroll
                for (int m = 0; m < 4; ++m) { const int ro = ai * 128 + m * 16; float ss[2];
#pragma unroll
                    for (int bj = 0; bj < 2; ++bj) { const f32x4 a = acc[ai][bj][m][0], c = acc[ai][bj][m][1];
                        *(u32x4*)(CQ + (size_t)(t0 + ro) * CQP + (pn - 8) * 256 + 128 * bj + 32 * wc + 8 * fq) = pack8(a, c);
                        float q = (a[0] * a[0] + a[1] * a[1]) + (a[2] * a[2] + a[3] * a[3]) + (c[0] * c[0] + c[1] * c[1]) + (c[2] * c[2] + c[3] * c[3]);
                        q += __shfl_xor(q, 16); q += __shfl_xor(q, 32); ss[bj] = q; }
                    if (fq == 0) { if (pn == 8) atomicAdd(SSQQ + t0 + ro, ss[0] + ss[1]); else { atomicAdd(SSQQ + t0 + ro, ss[0]); atomicAdd(SSQKV + t0 + ro, ss[1]); } } }
        } else {
            if (wc == 0 && fq < 2) {
#pragma unroll
                for (int ai = 0; ai < 2; ++ai)
#pragma unroll
                    for (int m = 0; m < 4; ++m) { const int ro = ai * 128 + m * 16; const f32x4* cs = (const f32x4*)(CSB + (size_t)(t0 + ro) * 16 + 8 * fq);
                        f32x4 o1[2], o2[2];
#pragma unroll
                        for (int n = 0; n < 2; ++n) { const f32x4 ca = cs[2 * n], cb = cs[2 * n + 1]; const f32x4 x1 = acc[ai][0][m][n], x2 = acc[ai][1][m][n];
                            o1[n] = (f32x4){x1[0] * ca[0] - x2[0] * ca[1], x1[1] * ca[2] - x2[1] * ca[3], x1[2] * cb[0] - x2[2] * cb[1], x1[3] * cb[2] - x2[3] * cb[3]};
                            o2[n] = (f32x4){x2[0] * ca[0] + x1[0] * ca[1], x2[1] * ca[2] + x1[1] * ca[3], x2[2] * cb[0] + x1[2] * cb[1], x2[3] * cb[2] + x1[3] * cb[3]}; }
                        const u32x4 w1 = pack8(o1[0], o1[1]), w2 = pack8(o2[0], o2[1]);
#pragma unroll
                        for (int h = 0; h < 8; ++h) { bf16_t* rp = KM + ((size_t)(b * 8 + h) * SEQ + s0 + ro) * 96 + 64 + 8 * fq; *(u32x4*)rp = w1; *(u32x4*)(rp + 16) = w2; } }
            }
        }
    }
};
struct EpiStore {
    static constexpr bool PERM = true, AFTER_DRAIN = false;
    bf16_t* O; int ldc;
    __device__ __forceinline__ void operator()(const f32x4 (&acc)[2][2][4][2], const pg8::Unit& u, int wr, int wc, int fr, int fq) const {
        const int t0 = u.pm * 256 + wr * 64 + fr, c0 = u.pn * 256 + 32 * wc + 8 * fq;
#pragma unroll
        for (int ai = 0; ai < 2; ++ai)
#pragma unroll
            for (int m = 0; m < 4; ++m)
#pragma unroll
                for (int bj = 0; bj < 2; ++bj) *(u32x4*)(O + (size_t)(t0 + ai * 128 + m * 16) * ldc + c0 + 128 * bj) = pack8(acc[ai][bj][m][0], acc[ai][bj][m][1]);
    }
};
struct EpiQ {
    static constexpr bool PERM = true, AFTER_DRAIN = false;
    bf16_t* QM; const float* SSQQ; const float2* CSB;
    __device__ __forceinline__ void operator()(const f32x4 (&acc)[2][2][4][2], const pg8::Unit& u, int wr, int wc, int fr, int fq) const {
        const int pn = u.pn, b = u.pm >> 4, s0 = (u.pm & 15) * 256 + wr * 64 + fr, t0 = u.pm * 256 + wr * 64 + fr;
#pragma unroll
        for (int ai = 0; ai < 2; ++ai)
#pragma unroll
            for (int m = 0; m < 4; ++m) { const int ro = ai * 128 + m * 16; const float sc = C2M * __builtin_amdgcn_rsqf(SSQQ[t0 + ro] * (1.f / QLORA) + RMS_EPS);
                if (pn == 0) { const int h = 2 * wc + (fq >> 1), i0 = 8 * (fq & 1); const f32x4* cs = (const f32x4*)(CSB + (size_t)(t0 + ro) * 16 + i0);
                    f32x4 o1[2], o2[2];
#pragma unroll
                    for (int n = 0; n < 2; ++n) { const f32x4 ca = cs[2 * n], cb = cs[2 * n + 1]; const f32x4 x1 = acc[ai][0][m][n], x2 = acc[ai][1][m][n];
                        o1[n] = (f32x4){x1[0] * ca[0] - x2[0] * ca[1], x1[1] * ca[2] - x2[1] * ca[3], x1[2] * cb[0] - x2[2] * cb[1], x1[3] * cb[2] - x2[3] * cb[3]} * sc;
                        o2[n] = (f32x4){x2[0] * ca[0] + x1[0] * ca[1], x2[1] * ca[2] + x1[1] * ca[3], x2[2] * cb[0] + x1[2] * cb[1], x2[3] * cb[2] + x1[3] * cb[3]} * sc; }
                    bf16_t* rp = QM + ((size_t)(b * 8 + h) * SEQ + s0 + ro) * 96 + 64 + i0;
                    *(u32x4*)rp = pack8(o1[0], o1[1]); *(u32x4*)(rp + 16) = pack8(o2[0], o2[1]);
                } else {
#pragma unroll
                    for (int bj = 0; bj < 2; ++bj) { const int h = 4 * (pn - 1) + 2 * bj + (wc >> 1), d = 32 * (wc & 1) + 8 * fq;
                        *(u32x4*)(QM + ((size_t)(b * 8 + h) * SEQ + s0 + ro) * 96 + d) = pack8(acc[ai][bj][m][0] * sc, acc[ai][bj][m][1] * sc); } }
                asm volatile("" ::: "memory");
            }
    }
};
struct EpiKV {
    static constexpr bool PERM = true, AFTER_DRAIN = false;
    bf16_t *KM, *VM; const float* SSQKV;
    __device__ __forceinline__ void operator()(const f32x4 (&acc)[2][2][4][2], const pg8::Unit& u, int wr, int wc, int fr, int fq) const {
        const int pn = u.pn, b = u.pm >> 4, s0 = (u.pm & 15) * 256 + wr * 64 + fr, t0 = u.pm * 256 + wr * 64 + fr;
#pragma unroll
        for (int ai = 0; ai < 2; ++ai)
#pragma unroll
            for (int m = 0; m < 4; ++m) { const int ro = ai * 128 + m * 16; const float sc = __builtin_amdgcn_rsqf(SSQKV[t0 + ro] * (1.f / KVLORA) + RMS_EPS);
#pragma unroll
                for (int bj = 0; bj < 2; ++bj) { const int h = 2 * pn + bj; const size_t rowi = (size_t)(b * 8 + h) * SEQ + s0 + ro;
                    bf16_t* rp = (wc < 2) ? KM + rowi * 96 + 32 * wc + 8 * fq : VM + rowi * 64 + 32 * (wc - 2) + 8 * fq;
                    *(u32x4*)rp = pack8(acc[ai][bj][m][0] * sc, acc[ai][bj][m][1] * sc); }
                asm volatile("" ::: "memory"); }
    }
};
struct Epi3 {
    static constexpr bool PERM = true, AFTER_DRAIN = false;
    const float* x; float* out; bf16_t* HB;
    __device__ __forceinline__ void operator()(const f32x4 (&acc)[2][2][4][2], const pg8::Unit& u, int wr, int wc, int fr, int fq) const {
        const int t0 = u.pm * 256 + wr * 64 + fr, c0 = u.pn * 256 + 32 * wc + 8 * fq;
#pragma unroll
        for (int ai = 0; ai < 2; ++ai)
#pragma unroll
            for (int m = 0; m < 4; ++m) {
#pragma unroll
                for (int bj = 0; bj < 2; ++bj) { const size_t idx = (size_t)(t0 + ai * 128 + m * 16) * DM + c0 + 128 * bj;
                    const f32x4 h0 = *(const f32x4*)(x + idx) + acc[ai][bj][m][0], h1 = *(const f32x4*)(x + idx + 4) + acc[ai][bj][m][1];
                    *(f32x4*)(out + idx) = h0; *(f32x4*)(out + idx + 4) = h1; *(u32x4*)(HB + idx) = pack8(h0, h1); }
                asm volatile("" ::: "memory"); }
    }
};
struct Epi4 {
    static constexpr bool PERM = true, AFTER_DRAIN = false;
    float* out; const bf16_t* PLE; float* SSQF;
    __device__ __forceinline__ void operator()(const f32x4 (&acc)[2][2][4][2], const pg8::Unit& u, int wr, int wc, int fr, int fq) const {
        const int t0 = u.pm * 256 + wr * 64 + fr, c0 = u.pn * 256 + 32 * wc + 8 * fq;
#pragma unroll
        for (int ai = 0; ai < 2; ++ai)
#pragma unroll
            for (int m = 0; m < 4; ++m) { float q = 0.f;
#pragma unroll
                for (int bj = 0; bj < 2; ++bj) { const size_t idx = (size_t)(t0 + ai * 128 + m * 16) * DM + c0 + 128 * bj;
                    const u32x4 pw = *(const u32x4*)(PLE + idx); f32x4 h0 = *(const f32x4*)(out + idx), h1 = *(const f32x4*)(out + idx + 4);
                    const f32x4 a = acc[ai][bj][m][0], c = acc[ai][bj][m][1];
                    h0[0] += __uint_as_float(pw.x << 16) * sigmoid_f(a[0]); h0[1] += __uint_as_float(pw.x & 0xffff0000u) * sigmoid_f(a[1]);
                    h0[2] += __uint_as_float(pw.y << 16) * sigmoid_f(a[2]); h0[3] += __uint_as_float(pw.y & 0xffff0000u) * sigmoid_f(a[3]);
                    h1[0] += __uint_as_float(pw.z << 16) * sigmoid_f(c[0]); h1[1] += __uint_as_float(pw.z & 0xffff0000u) * sigmoid_f(c[1]);
                    h1[2] += __uint_as_float(pw.w << 16) * sigmoid_f(c[2]); h1[3] += __uint_as_float(pw.w & 0xffff0000u) * sigmoid_f(c[3]);
                    *(f32x4*)(out + idx) = h0; *(f32x4*)(out + idx + 4) = h1;
                    q += (h0[0] * h0[0] + h0[1] * h0[1]) + (h0[2] * h0[2] + h0[3] * h0[3]) + (h1[0] * h1[0] + h1[1] * h1[1]) + (h1[2] * h1[2] + h1[3] * h1[3]); }
                q += __shfl_xor(q, 16); q += __shfl_xor(q, 32);
                if (fq == 0) atomicAdd(SSQF + t0 + ai * 128 + m * 16, q);
                asm volatile("" ::: "memory"); }
    }
};

#ifndef PG8_SP2
#define PG8_SP2 true
#endif
#ifndef PG8_ALIGN
#define PG8_ALIGN true
#endif
__device__ __forceinline__ void phase1_gemm(const Params& P, LAS unsigned char* lds) {
    pg8::Gemm g{(const bf16_t*)(P.ws + WS_XN), (const bf16_t*)(P.ws + WS_WIN), T, NIN, DM, DM}; pg8::StaticOrder S; S.init(T, NIN, (int)gridDim.x, (int)blockIdx.x);
    Epi1 E{(bf16_t*)(P.ws + WS_QD), (bf16_t*)(P.ws + WS_KD), (bf16_t*)(P.ws + WS_VD), (bf16_t*)(P.ws + WS_G), (bf16_t*)(P.ws + WS_CQ), (bf16_t*)(P.ws + WS_KM),
           (float*)(P.ws + WS_SSQQ), (float*)(P.ws + WS_SSQKV), (const float2*)(P.ws + WS_CSA), (const float2*)(P.ws + WS_CSB)};
    pg8::gemm_phase<Epi1, pg8::StaticOrder, PG8_ALIGN, PG8_SP2>(lds, g, S, E);
}
__device__ __forceinline__ void phase15_gemm(const Params& P, LAS unsigned char* lds) {
    { pg8::Gemm g{(const bf16_t*)(P.ws + WS_CQ), (const bf16_t*)(P.ws + WS_WUQ), T, 768, QLORA, CQP}; pg8::StaticOrder S; S.init(T, 768, (int)gridDim.x, (int)blockIdx.x);
      EpiQ E{(bf16_t*)(P.ws + WS_QM), (const float*)(P.ws + WS_SSQQ), (const float2*)(P.ws + WS_CSB)};
      pg8::gemm_phase<EpiQ, pg8::StaticOrder, PG8_ALIGN, PG8_SP2>(lds, g, S, E); }
    { pg8::Gemm g{(const bf16_t*)(P.ws + WS_CQ) + 256, (const bf16_t*)(P.ws + WS_WUKV), T, 1024, 256, CQP}; pg8::StaticOrder S; S.init(T, 1024, (int)gridDim.x, (int)blockIdx.x);
      EpiKV E{(bf16_t*)(P.ws + WS_KM), (bf16_t*)(P.ws + WS_VM), (const float*)(P.ws + WS_SSQKV)};
      pg8::gemm_phase<EpiKV, pg8::StaticOrder, PG8_ALIGN, PG8_SP2>(lds, g, S, E); }
}
__device__ __forceinline__ void phase3_gemm(const Params& P, LAS unsigned char* lds) {
    { pg8::Gemm g{(const bf16_t*)(P.ws + WS_YCAT), (const bf16_t*)(P.ws + WS_WOUT), T, DM, DM, DM}; pg8::StaticOrder S; S.init(T, DM, (int)gridDim.x, (int)blockIdx.x);
      Epi3 E{P.x, P.out, (bf16_t*)(P.ws + WS_HB)};
      pg8::gemm_phase<Epi3, pg8::StaticOrder, PG8_ALIGN, PG8_SP2>(lds, g, S, E); }
    { pg8::Gemm g{(const bf16_t*)(P.ws + WS_PB), (const bf16_t*)(P.ws + WS_WPLE), T, DM, PLE_DIM, PLE_DIM}; pg8::StaticOrder S; S.init(T, DM, (int)gridDim.x, (int)blockIdx.x);
      EpiStore E{(bf16_t*)(P.ws + WS_PLE), DM};
      pg8::gemm_phase<EpiStore, pg8::StaticOrder, PG8_ALIGN, PG8_SP2>(lds, g, S, E); }
}
__device__ __forceinline__ void phase4_gemm(const Params& P, LAS unsigned char* lds) {
    pg8::Gemm g{(const bf16_t*)(P.ws + WS_HB), (const bf16_t*)(P.ws + WS_WG), T, DM, DM, DM}; pg8::StaticOrder S; S.init(T, DM, (int)gridDim.x, (int)blockIdx.x);
    Epi4 E{P.out, (const bf16_t*)(P.ws + WS_PLE), (float*)(P.ws + WS_SSQF)};
    pg8::gemm_phase<Epi4, pg8::StaticOrder, PG8_ALIGN, PG8_SP2>(lds, g, S, E);
}

namespace att {
typedef short bf16x8 __attribute__((ext_vector_type(8)));
typedef short s16x4 __attribute__((ext_vector_type(4)));
typedef float f32x16 __attribute__((ext_vector_type(16)));
#define SBAR() __builtin_amdgcn_sched_barrier(0)
constexpr float THR = 8.f;
constexpr int BUF_BYTES = 32768, K_OFF = 0, V_OFF = 16384;
constexpr int WS_OFF = 2 * BUF_BYTES;
constexpr int ATT_LDS_BYTES = WS_OFF + 8 * 64 * 4;
__device__ __forceinline__ int crow(int r, int hi) { return (r & 3) + 8 * (r >> 2) + 4 * hi; }
__device__ __forceinline__ unsigned cvtpk(float lo, float hi) { unsigned r; asm volatile("v_cvt_pk_bf16_f32 %0, %1, %2" : "=v"(r) : "v"(lo), "v"(hi)); return r; }

__device__ __forceinline__ void partialSM(f32x16& p0, f32x16& p1, float& m_reg, float& alpha) {
    float pmax = p0[0];
#pragma unroll
    for (int r = 1; r < 16; ++r) pmax = fmaxf(pmax, p0[r]);
#pragma unroll
    for (int r = 0; r < 16; ++r) pmax = fmaxf(pmax, p1[r]);
    { auto rr = __builtin_amdgcn_permlane32_swap(__float_as_uint(pmax), __float_as_uint(pmax), false, false); pmax = fmaxf(__uint_as_float(rr[0]), __uint_as_float(rr[1])); }
    float mn;
    if (__builtin_expect(__all(pmax - m_reg <= THR), 1)) { mn = m_reg; alpha = 1.f; }
    else { mn = fmaxf(m_reg, pmax); alpha = __builtin_amdgcn_exp2f(m_reg - mn); m_reg = mn; }
#pragma unroll
    for (int r = 0; r < 16; ++r) { p0[r] -= mn; p1[r] -= mn; }
#pragma unroll
    for (int r = 0; r < 16; ++r) p0[r] = __builtin_amdgcn_exp2f(p0[r]);
}
__device__ __forceinline__ void finishSM(f32x16& p0, f32x16& p1, float alpha, float& l_reg, bf16x8& pa0, bf16x8& pa1, bf16x8& pa2, bf16x8& pa3) {
#pragma unroll
    for (int r = 0; r < 16; ++r) p1[r] = __builtin_amdgcn_exp2f(p1[r]);
    float ps = 0.f;
#pragma unroll
    for (int r = 0; r < 16; ++r) ps += p0[r];
#pragma unroll
    for (int r = 0; r < 16; ++r) ps += p1[r];
    { auto rr = __builtin_amdgcn_permlane32_swap(__float_as_uint(ps), __float_as_uint(ps), false, false); ps = __uint_as_float(rr[0]) + __uint_as_float(rr[1]); }
    l_reg = l_reg * alpha + ps;
#define PK4(P, BASE, OUT) do { unsigned a0 = cvtpk(P[BASE + 0], P[BASE + 1]), a1 = cvtpk(P[BASE + 2], P[BASE + 3]);   \
    unsigned b0 = cvtpk(P[BASE + 4], P[BASE + 5]), b1 = cvtpk(P[BASE + 6], P[BASE + 7]);                              \
    auto r0 = __builtin_amdgcn_permlane32_swap(a0, b0, false, false); auto r1 = __builtin_amdgcn_permlane32_swap(a1, b1, false, false); \
    u32x4 w = {r0[0], r1[0], r0[1], r1[1]}; OUT = __builtin_bit_cast(bf16x8, w); } while (0)
    PK4(p0, 0, pa0); PK4(p0, 8, pa1); PK4(p1, 0, pa2); PK4(p1, 8, pa3);
#undef PK4
}
__device__ __forceinline__ void cmask(f32x16& p0, f32x16& p1, int jb, int qrel, int hi) {
    const int kb = 64 * jb + 4 * hi;
#pragma unroll
    for (int r = 0; r < 16; ++r) { const int kv = kb + (r & 3) + 8 * (r >> 2); if (kv > qrel) p0[r] = -INFINITY; if (kv + 32 > qrel) p1[r] = -INFINITY; }
}
template <int DQK> __device__ __forceinline__ void qkt(f32x16& p0, f32x16& p1, LAS const unsigned char* kp  , const bf16x8* qr) {
    constexpr int PITCH = 2 * DQK + 16;
    p0 = f32x16{}; p1 = f32x16{};
#pragma unroll
    for (int d0 = 0; d0 < DQK / 16; ++d0) {
        const bf16x8 b0 = *(LAS const bf16x8*)(kp + d0 * 32), b1 = *(LAS const bf16x8*)(kp + 32 * PITCH + d0 * 32);
        p0 = __builtin_amdgcn_mfma_f32_32x32x16_bf16(b0, qr[d0], p0, 0, 0, 0);
        p1 = __builtin_amdgcn_mfma_f32_32x32x16_bf16(b1, qr[d0], p1, 0, 0, 0); }
}
template <int NCB> __device__ __forceinline__ int v_st(int k, int c) { const int kk = (k & ~0xC) | ((k & 4) << 1) | ((k & 8) >> 1); return ((kk >> 3) * NCB + (c >> 5)) * 512 + ((kk & 7) * 32 + (c & 31)) * 2; }
__device__ __forceinline__ int v_rd_base(int lane) { return ((lane & 3) << 3) | (((lane >> 2) & 3) << 6) | (((lane >> 4) & 1) << 5) | (((lane >> 5) & 1) << 8); }
template <int OFF> __device__ __forceinline__ s16x4 tr_read(int vb) { s16x4 r; asm volatile("ds_read_b64_tr_b16 %0, %1 offset:%2" : "=&v"(r) : "v"(vb), "i"(OFF) : "memory"); return r; }
template <int NCB, int D0> __device__ __forceinline__ void pv_one(f32x16& od, int vb, bf16x8 pa0, bf16x8 pa1, bf16x8 pa2, bf16x8 pa3) {
    constexpr int KS = 2 * NCB * 512, HF = NCB * 512, B0 = D0 * 512;
    const s16x4 l0 = tr_read<B0>(vb), h0 = tr_read<B0 + HF>(vb), l1 = tr_read<B0 + KS>(vb), h1 = tr_read<B0 + KS + HF>(vb);
    const s16x4 l2 = tr_read<B0 + 2 * KS>(vb), h2 = tr_read<B0 + 2 * KS + HF>(vb), l3 = tr_read<B0 + 3 * KS>(vb), h3 = tr_read<B0 + 3 * KS + HF>(vb);
    asm volatile("s_waitcnt lgkmcnt(0)" ::: "memory"); SBAR();
#define PK(L, H) (bf16x8){L[0], L[1], L[2], L[3], H[0], H[1], H[2], H[3]}
    od = __builtin_amdgcn_mfma_f32_32x32x16_bf16(pa0, PK(l0, h0), od, 0, 0, 0);
    od = __builtin_amdgcn_mfma_f32_32x32x16_bf16(pa1, PK(l1, h1), od, 0, 0, 0);
    od = __builtin_amdgcn_mfma_f32_32x32x16_bf16(pa2, PK(l2, h2), od, 0, 0, 0);
    od = __builtin_amdgcn_mfma_f32_32x32x16_bf16(pa3, PK(l3, h3), od, 0, 0, 0);
#undef PK
}
template <int NCB> __device__ __forceinline__ void pv_all(f32x16* o, int vb, bf16x8 pa0, bf16x8 pa1, bf16x8 pa2, bf16x8 pa3) {
    pv_one<NCB, 0>(o[0], vb, pa0, pa1, pa2, pa3); pv_one<NCB, 1>(o[1], vb, pa0, pa1, pa2, pa3);
    if constexpr (NCB == 4) { pv_one<NCB, 2>(o[2], vb, pa0, pa1, pa2, pa3); pv_one<NCB, 3>(o[3], vb, pa0, pa1, pa2, pa3); }
}

template <int DQK, int DV, int VP, int KIND>
__device__ __forceinline__ void attn_unit(const bf16_t* Qh, const bf16_t* Kh, const bf16_t* Vh, int qb, bf16_t* OUT, const bf16_t* GATE, LAS unsigned char* lds) {
    constexpr int NCB = DV / 32, NKS = DQK / 16, PITCH = 2 * DQK + 16, NKCH = DQK / 8, KCHUNKS = 64 * NKCH, NKI = (KCHUNKS + NT - 1) / NT, NVI = (64 * DV / 8) / NT;
    const int tid = tid_op(), lane = tid & 63, r32 = lane & 31, hi = lane >> 5; const int wid = __builtin_amdgcn_readfirstlane(tid >> 6);
    LAS float* wsf = (LAS float*)(lds + WS_OFF) + wid * 64; LAS float* li_l = wsf; LAS float* al_l = wsf + 32;
    const int q0 = qb * 256, NTL = (q0 + 256) / 64;
    float m_reg = -1e30f, l_reg = 0.f; f32x16 o[NCB]; bf16x8 qr[NKS];
#pragma unroll
    for (int d = 0; d < NCB; ++d) o[d] = f32x16{};
    { const bf16_t* Qw = Qh + (size_t)(q0 + wid * 32 + r32) * DQK + hi * 8;
#pragma unroll
      for (int d0 = 0; d0 < NKS; ++d0) qr[d0] = *(const bf16x8*)(Qw + d0 * 16); }
    int kgo[NKI], klo[NKI];
#pragma unroll
    for (int i = 0; i < NKI; ++i) { const int id = (tid + i * NT < KCHUNKS) ? tid + i * NT : tid; const int row = id / NKCH, ch = id % NKCH; kgo[i] = row * DQK + ch * 8; klo[i] = K_OFF + row * PITCH + ch * 16; }
    int vgo[NVI], vlo[NVI];
#pragma unroll
    for (int i = 0; i < NVI; ++i) { const int id = tid + i * NT; const int key = id / (DV / 8), c = (id % (DV / 8)) * 8; vgo[i] = key * VP + c; vlo[i] = V_OFF + v_st<NCB>(key, c); }
    bf16x8 ks[2][NKI], vs[2][NVI];
#define SLOAD(sl, t) do { const bf16_t* kt_ = Kh + (size_t)(t) * 64 * DQK; const bf16_t* vt_ = Vh + (size_t)(t) * 64 * VP; \
    _Pragma("unroll") for (int i_ = 0; i_ < NKI; ++i_) ks[sl][i_] = *(const bf16x8*)(kt_ + kgo[i_]); \
    _Pragma("unroll") for (int i_ = 0; i_ < NVI; ++i_) vs[sl][i_] = *(const bf16x8*)(vt_ + vgo[i_]); } while (0)
#define SWRITE(b, sl) do { LAS unsigned char* bb_ = lds + (b) * BUF_BYTES; \
    _Pragma("unroll") for (int i_ = 0; i_ < NKI; ++i_) *(LAS bf16x8*)(bb_ + klo[i_]) = ks[sl][i_]; \
    _Pragma("unroll") for (int i_ = 0; i_ < NVI; ++i_) *(LAS bf16x8*)(bb_ + vlo[i_]) = vs[sl][i_]; } while (0)
#define RESC(a) do { if (__any((a) < 1.f)) { if (hi == 0) al_l[r32] = (a); asm volatile("s_waitcnt lgkmcnt(0)" ::: "memory"); \
    _Pragma("unroll") for (int d_ = 0; d_ < NCB; ++d_) _Pragma("unroll") for (int r_ = 0; r_ < 16; ++r_) o[d_][r_] *= al_l[crow(r_, hi)]; } } while (0)
#define CMASK(P0, P1, t) do { const int jb_ = (t) - (NTL - 4); if (jb_ >= 0) cmask(P0, P1, jb_, qrel, hi); } while (0)
    LAS const unsigned char* kp0 = lds + K_OFF + r32 * PITCH + hi * 16; LAS const unsigned char* kp1 = kp0 + BUF_BYTES;
    const int vb0 = (int)(uintptr_t)(lds + V_OFF) + v_rd_base(lane), vb1 = vb0 + BUF_BYTES;
    const int qrel = wid * 32 + r32;
    f32x16 pA0, pA1, pB0, pB1; float alA, alB; bf16x8 pa0, pa1, pa2, pa3;
    SLOAD(0, 0); SWRITE(0, 0); __syncthreads();
    qkt<DQK>(pA0, pA1, kp0, qr); CMASK(pA0, pA1, 0); partialSM(pA0, pA1, m_reg, alA);
    SLOAD(1, 1); SLOAD(0, 2);
    SWRITE(1, 1); __syncthreads();
#pragma unroll 1
    for (int j = 1; j + 1 < NTL; j += 2) {
        SBAR(); qkt<DQK>(pB0, pB1, kp1, qr);
        finishSM(pA0, pA1, alA, l_reg, pa0, pa1, pa2, pa3); SBAR();
        SLOAD(1, j + 2); SBAR();
        pv_all<NCB>(o, vb0, pa0, pa1, pa2, pa3); CMASK(pB0, pB1, j); partialSM(pB0, pB1, m_reg, alB);
        __syncthreads(); SWRITE(0, 0);
        RESC(alB); __syncthreads();
        SBAR(); qkt<DQK>(pA0, pA1, kp0, qr);
        finishSM(pB0, pB1, alB, l_reg, pa0, pa1, pa2, pa3); SBAR();
        if (j + 3 < NTL) SLOAD(0, j + 3); SBAR();
        pv_all<NCB>(o, vb1, pa0, pa1, pa2, pa3); CMASK(pA0, pA1, j + 1); partialSM(pA0, pA1, m_reg, alA);
        __syncthreads(); SWRITE(1, 1);
        RESC(alA); __syncthreads();
    }
    SBAR(); qkt<DQK>(pB0, pB1, kp1, qr);
    finishSM(pA0, pA1, alA, l_reg, pa0, pa1, pa2, pa3); SBAR();
    pv_all<NCB>(o, vb0, pa0, pa1, pa2, pa3); CMASK(pB0, pB1, NTL - 1); partialSM(pB0, pB1, m_reg, alB);
    RESC(alB);
    finishSM(pB0, pB1, alB, l_reg, pa0, pa1, pa2, pa3); SBAR();
    pv_all<NCB>(o, vb1, pa0, pa1, pa2, pa3);
    if (hi == 0) li_l[r32] = l_reg; asm volatile("s_waitcnt lgkmcnt(0)" ::: "memory");
    float rli[16];
#pragma unroll
    for (int r = 0; r < 16; ++r) rli[r] = __builtin_amdgcn_rcpf(li_l[crow(r, hi)]);
    __syncthreads();
    LAS bf16_t* stg = (LAS bf16_t*)(lds + wid * 8192);
#pragma unroll
    for (int r = 0; r < 16; ++r) { const int orow = crow(r, hi);
#pragma unroll
        for (int d0 = 0; d0 < NCB; ++d0) stg[orow * DV + d0 * 32 + r32] = (bf16_t)f2bf(o[d0][r] * rli[r]); }
    asm volatile("s_waitcnt lgkmcnt(0)" ::: "memory");
    constexpr int CPR = DV / 8;
#pragma unroll
    for (int i = 0; i < (32 * CPR) / 64; ++i) { const int id = i * 64 + lane, row = id / CPR, ch = id % CPR; u32x4 v = *(LAS const u32x4*)(stg + row * DV + ch * 8);
        const size_t ro = (size_t)(q0 + wid * 32 + row);
        if constexpr (KIND == 0) { *(u32x4*)(OUT + ro * 128 + ch * 8) = v; }
        else { const u32x4 g = *(const u32x4*)(GATE + ro * 1024 + ch * 8); u32x4 w;
            w.x = cvtpk(__uint_as_float(v.x << 16) * __uint_as_float(g.x << 16), __uint_as_float(v.x & 0xffff0000u) * __uint_as_float(g.x & 0xffff0000u));
            w.y = cvtpk(__uint_as_float(v.y << 16) * __uint_as_float(g.y << 16), __uint_as_float(v.y & 0xffff0000u) * __uint_as_float(g.y & 0xffff0000u));
            w.z = cvtpk(__uint_as_float(v.z << 16) * __uint_as_float(g.z << 16), __uint_as_float(v.z & 0xffff0000u) * __uint_as_float(g.z & 0xffff0000u));
            w.w = cvtpk(__uint_as_float(v.w << 16) * __uint_as_float(g.w << 16), __uint_as_float(v.w & 0xffff0000u) * __uint_as_float(g.w & 0xffff0000u));
            *(u32x4*)(OUT + ro * 1024 + ch * 8) = w; } }
    asm volatile("s_waitcnt lgkmcnt(0)" ::: "memory");
    __syncthreads();
#undef SLOAD
#undef SWRITE
#undef RESC
#undef CMASK
}
#undef SBAR
}

namespace att2 {
using att::bf16x8; using att::s16x4; using att::f32x16; using att::crow; using att::cvtpk; using att::cmask; using att::tr_read;
#define SBAR() __builtin_amdgcn_sched_barrier(0)
#define WAIT_BAR(N) asm volatile("s_waitcnt vmcnt(" #N ") lgkmcnt(0)\n\ts_barrier" ::: "memory")
constexpr float THR = 8.f;
__device__ __forceinline__ void glds16(const void* gsrc, unsigned lds_dst) { unsigned keep;
    asm volatile("s_mov_b32 %0, m0\n\ts_mov_b32 m0, %2\n\ts_nop 0\n\tglobal_load_lds_dwordx4 %1, off\n\ts_mov_b32 m0, %0" : "=&s"(keep) : "v"(gsrc), "s"(lds_dst) : "memory"); }
__device__ __forceinline__ void partialSM(f32x16& p0, f32x16& p1, float& m_reg, float& alpha) {
    float pmax = p0[0];
#pragma unroll
    for (int r = 1; r < 16; ++r) pmax = fmaxf(pmax, p0[r]);
#pragma unroll
    for (int r = 0; r < 16; ++r) pmax = fmaxf(pmax, p1[r]);
    { auto rr = __builtin_amdgcn_permlane32_swap(__float_as_uint(pmax), __float_as_uint(pmax), false, false); pmax = fmaxf(__uint_as_float(rr[0]), __uint_as_float(rr[1])); }
    float mn;
    if (__builtin_expect(__all(pmax - m_reg <= THR), 1)) { mn = m_reg; alpha = 1.f; }
    else { mn = fmaxf(m_reg, pmax); alpha = __builtin_amdgcn_exp2f(m_reg - mn); m_reg = mn; }
#pragma unroll
    for (int r = 0; r < 16; ++r) { p0[r] -= mn; p1[r] -= mn; }
#pragma unroll
    for (int r = 0; r < 16; ++r) p0[r] = __builtin_amdgcn_exp2f(p0[r]);
}
__device__ __forceinline__ void finishSM(f32x16& p0, f32x16& p1, float alpha, float& l_reg, bf16x8& pa0, bf16x8& pa1, bf16x8& pa2, bf16x8& pa3) {
#pragma unroll
    for (int r = 0; r < 16; ++r) p1[r] = __builtin_amdgcn_exp2f(p1[r]);
    float ps = 0.f;
#pragma unroll
    for (int r = 0; r < 16; ++r) ps += p0[r];
#pragma unroll
    for (int r = 0; r < 16; ++r) ps += p1[r];
    { auto rr = __builtin_amdgcn_permlane32_swap(__float_as_uint(ps), __float_as_uint(ps), false, false); ps = __uint_as_float(rr[0]) + __uint_as_float(rr[1]); }
    l_reg = l_reg * alpha + ps;
#define PK8(P, B) __builtin_bit_cast(bf16x8, (u32x4){cvtpk(P[B], P[B + 1]), cvtpk(P[B + 2], P[B + 3]), cvtpk(P[B + 4], P[B + 5]), cvtpk(P[B + 6], P[B + 7])})
    pa0 = PK8(p0, 0); pa1 = PK8(p0, 8); pa2 = PK8(p1, 0); pa3 = PK8(p1, 8);
#undef PK8
}
template <int NKS> __device__ __forceinline__ void qkt(f32x16& p0, f32x16& p1, LAS const unsigned char* kp  , const bf16x8* qr) {
    p0 = f32x16{}; p1 = f32x16{};
#pragma unroll
    for (int d0 = 0; d0 < NKS; ++d0) {
        const bf16x8 b0 = *(LAS const bf16x8*)(kp + d0 * 2048), b1 = *(LAS const bf16x8*)(kp + d0 * 2048 + 512);
        p0 = __builtin_amdgcn_mfma_f32_32x32x16_bf16(b0, qr[d0], p0, 0, 0, 0);
        p1 = __builtin_amdgcn_mfma_f32_32x32x16_bf16(b1, qr[d0], p1, 0, 0, 0); }
}
template <int D0> __device__ __forceinline__ void pv_one(f32x16& od, int vb, bf16x8 pa0, bf16x8 pa1, bf16x8 pa2, bf16x8 pa3) {
    constexpr int B0 = D0 * 4096;
    const s16x4 l0 = tr_read<B0>(vb), h0 = tr_read<B0 + 512>(vb), l1 = tr_read<B0 + 1024>(vb), h1 = tr_read<B0 + 1536>(vb);
    const s16x4 l2 = tr_read<B0 + 2048>(vb), h2 = tr_read<B0 + 2560>(vb), l3 = tr_read<B0 + 3072>(vb), h3 = tr_read<B0 + 3584>(vb);
    asm volatile("s_waitcnt lgkmcnt(0)" ::: "memory"); SBAR();
#define PK(L, H) (bf16x8){L[0], L[1], L[2], L[3], H[0], H[1], H[2], H[3]}
    od = __builtin_amdgcn_mfma_f32_32x32x16_bf16(pa0, PK(l0, h0), od, 0, 0, 0);
    od = __builtin_amdgcn_mfma_f32_32x32x16_bf16(pa1, PK(l1, h1), od, 0, 0, 0);
    od = __builtin_amdgcn_mfma_f32_32x32x16_bf16(pa2, PK(l2, h2), od, 0, 0, 0);
    od = __builtin_amdgcn_mfma_f32_32x32x16_bf16(pa3, PK(l3, h3), od, 0, 0, 0);
#undef PK
}
template <int NCB> __device__ __forceinline__ void pv_all(f32x16* o, int vb, bf16x8 pa0, bf16x8 pa1, bf16x8 pa2, bf16x8 pa3) {
    pv_one<0>(o[0], vb, pa0, pa1, pa2, pa3); pv_one<1>(o[1], vb, pa0, pa1, pa2, pa3);
    if constexpr (NCB == 4) { pv_one<2>(o[2], vb, pa0, pa1, pa2, pa3); pv_one<3>(o[3], vb, pa0, pa1, pa2, pa3); }
}
template <int DQK, int DV> struct Geo {
    static constexpr int NCB = DV / 32, NKS = DQK / 16, NKCH = DQK / 8, KSLOT = NKCH * 1024, VSLOT = NCB * 4096, K_OFF = 0, V_OFF = 3 * KSLOT, WS_OFF = V_OFF + 3 * VSLOT, STG_OFF = WS_OFF + 2048;
    static constexpr int NKI = (NKCH + 7) / 8, NVI = (NCB * 4) / 8, NDMA = NKI + NVI;
};
template <int DQK, int DV, int VP>
__device__ __forceinline__ void attn_pass(const bf16_t* Qh, const bf16_t* Kh, const bf16_t* Vh, int qb, LAS unsigned char* lds, f32x16 (&o)[DV / 32], float (&rli)[16]) {
    typedef Geo<DQK, DV> Gm; constexpr int NCB = Gm::NCB, NKS = Gm::NKS, NKI = Gm::NKI, NVI = Gm::NVI, KSLOT = Gm::KSLOT, VSLOT = Gm::VSLOT;
    static_assert(Gm::NDMA == 3, "the ring waits below count 3 LDS-DMA pieces per wave and step (NVI of them V pieces)");
    const int tid = tid_op(), lane = tid & 63, r32 = lane & 31, hi = lane >> 5; const int wid = __builtin_amdgcn_readfirstlane(tid >> 6);
    LAS float* wsf = (LAS float*)(lds + Gm::WS_OFF) + wid * 64; LAS float* li_l = wsf; LAS float* al_l = wsf + 32;
    const unsigned lds0 = (unsigned)(uintptr_t)lds;
    const int q0 = qb * 256, NTL = (q0 + 256) / 64;
    const bf16_t* ksrc[NKI]; unsigned kdst[NKI]; const bf16_t* vsrc[NVI]; unsigned vdst[NVI];
#pragma unroll
    for (int i = 0; i < NKI; ++i) { const int c = (wid + 8 * i < Gm::NKCH) ? wid + 8 * i : wid; ksrc[i] = Kh + (size_t)lane * DQK + c * 8; kdst[i] = lds0 + Gm::K_OFF + c * 1024; }
#pragma unroll
    for (int i = 0; i < NVI; ++i) { const int pi = wid + 8 * i, dblk = pi >> 2, kq = pi & 3; vsrc[i] = Vh + (size_t)(16 * kq + (lane >> 2)) * VP + dblk * 32 + (lane & 3) * 8; vdst[i] = lds0 + Gm::V_OFF + pi * 1024; }
#define DMA_K(t, so) do { _Pragma("unroll") for (int i_ = 0; i_ < NKI; ++i_) glds16(ksrc[i_] + (size_t)(t) * 64 * DQK, (unsigned)__builtin_amdgcn_readfirstlane(kdst[i_] + (so) * KSLOT)); } while (0)
#define DMA_V(t, so) do { _Pragma("unroll") for (int i_ = 0; i_ < NVI; ++i_) glds16(vsrc[i_] + (size_t)(t) * 64 * VP, (unsigned)__builtin_amdgcn_readfirstlane(vdst[i_] + (so) * VSLOT)); } while (0)
    DMA_K(0, 0); DMA_V(0, 0); DMA_K(1, 1);
    float m_reg = -1e30f, l_reg = 0.f; bf16x8 qr[NKS];
#pragma unroll
    for (int d = 0; d < NCB; ++d) o[d] = f32x16{};
    { const bf16_t* Qw = Qh + (size_t)(q0 + wid * 32 + r32) * DQK + hi * 8;
#pragma unroll
      for (int d0 = 0; d0 < NKS; ++d0) qr[d0] = *(const bf16x8*)(Qw + d0 * 16); }
    LAS const unsigned char* kp0 = lds + Gm::K_OFF + hi * 1024 + r32 * 16;
    const int vb0 = (int)lds0 + Gm::V_OFF + ((lane >> 4) & 1) * 32 + (lane & 3) * 8 + (4 * hi + ((lane & 15) >> 2)) * 64;
    const int qrel = wid * 32 + r32;
#define RESC(a) do { if (__any((a) < 1.f)) { if (hi == 0) al_l[r32] = (a); asm volatile("s_waitcnt lgkmcnt(0)" ::: "memory"); \
    _Pragma("unroll") for (int d_ = 0; d_ < NCB; ++d_) _Pragma("unroll") for (int r_ = 0; r_ < 16; ++r_) o[d_][r_] *= al_l[crow(r_, hi)]; } } while (0)
#define CMASK(P0, P1, t) do { const int jb_ = (t) - (NTL - 4); if (jb_ >= 0) cmask(P0, P1, jb_, qrel, hi); } while (0)
    int sp = 2, sc = 0, sn = 1;
#define ROT() do { const int t_ = sp; sp = sc; sc = sn; sn = t_; } while (0)
    f32x16 pA0, pA1, pB0, pB1; float alA, alB; bf16x8 pa0, pa1, pa2, pa3;
    asm volatile("s_waitcnt vmcnt(0)" ::: "memory"); __builtin_amdgcn_s_barrier();
    DMA_K(2, sp); DMA_V(1, sn);
    qkt<NKS>(pA0, pA1, kp0 + sc * KSLOT, qr); CMASK(pA0, pA1, 0); partialSM(pA0, pA1, m_reg, alA);
    WAIT_BAR(3); ROT();
#define STEP(C0, C1, alC, P0, P1, alP, t) do { \
    if ((t) + 2 < NTL) DMA_K((t) + 2, sp); if ((t) + 1 < NTL) DMA_V((t) + 1, sn); \
    SBAR(); qkt<NKS>(C0, C1, kp0 + sc * KSLOT, qr); \
    finishSM(P0, P1, alP, l_reg, pa0, pa1, pa2, pa3); SBAR(); \
    pv_all<NCB>(o, vb0 + sp * VSLOT, pa0, pa1, pa2, pa3); CMASK(C0, C1, t); partialSM(C0, C1, m_reg, alC); \
    RESC(alC); \
    if ((t) + 2 < NTL) { WAIT_BAR(3); } else if ((t) + 1 < NTL) { if (NVI == 2) { WAIT_BAR(2); } else { WAIT_BAR(1); } } else { WAIT_BAR(0); } \
    ROT(); } while (0)
#pragma unroll 1
    for (int t = 1; t + 1 < NTL; t += 2) { STEP(pB0, pB1, alB, pA0, pA1, alA, t); STEP(pA0, pA1, alA, pB0, pB1, alB, t + 1); }
    STEP(pB0, pB1, alB, pA0, pA1, alA, NTL - 1);
    finishSM(pB0, pB1, alB, l_reg, pa0, pa1, pa2, pa3); SBAR();
    pv_all<NCB>(o, vb0 + sp * VSLOT, pa0, pa1, pa2, pa3);
    if (hi == 0) li_l[r32] = l_reg; asm volatile("s_waitcnt lgkmcnt(0)" ::: "memory");
#pragma unroll
    for (int r = 0; r < 16; ++r) rli[r] = __builtin_amdgcn_rcpf(li_l[crow(r, hi)]);
    WAIT_BAR(0);
#undef DMA_K
#undef DMA_V
#undef RESC
#undef CMASK
#undef ROT
#undef STEP
}
typedef short v4i16_t __attribute__((ext_vector_type(4)));
__device__ __forceinline__ s16x4 vtr(LAS const unsigned char* p) { return __builtin_bit_cast(s16x4, __builtin_amdgcn_ds_read_tr16_b64_v4i16((LAS v4i16_t*)p)); }
#define PIN(x) asm volatile("" : "+v"(x))
#define PEL(P0, P1, e) ((e) < 16 ? P0[(e) & 15] : P1[(e) & 15])
template <int NKS, int NCB>
__device__ __forceinline__ void step3(f32x16& C0, f32x16& C1, f32x16& P0, f32x16& P1, float alP, float& alC, float& m_reg, float& l_reg, f32x16 (&o)[NCB], const bf16x8 (&qr)[NKS],
                                      LAS const unsigned char* kp, LAS const unsigned char* vp, bool band, int jb, int qrel, int hi) {
    constexpr int NQK = 2 * NKS, NPV = 4 * NCB, A_PER = (32 + NQK - 1) / NQK, C_PER = (16 + NQK - 1) / NQK, E_PER = 32 / NPV;
    bf16x8 kfr[NQK]; s16x4 vlo[NPV], vhi[NPV]; u32x4 pw[4]; float sacc = 0.f;
    kfr[0] = *(LAS const bf16x8*)(kp); kfr[1] = *(LAS const bf16x8*)(kp + 512);
#pragma unroll
    for (int f = 0; f < NQK; ++f) {
        if (f + 2 < NQK) kfr[f + 2] = *(LAS const bf16x8*)(kp + ((f + 2) >> 1) * 2048 + ((f + 2) & 1) * 512);
        if (f < 8) { const int ks = f / NCB, d0 = f % NCB; vlo[f] = vtr(vp + d0 * 4096 + ks * 1024); vhi[f] = vtr(vp + d0 * 4096 + ks * 1024 + 512); }
        SBAR();
        if (f & 1) C1 = __builtin_amdgcn_mfma_f32_32x32x16_bf16(kfr[f], qr[f >> 1], f < 2 ? f32x16{} : C1, 0, 0, 0);
        else       C0 = __builtin_amdgcn_mfma_f32_32x32x16_bf16(kfr[f], qr[f >> 1], f < 2 ? f32x16{} : C0, 0, 0, 0);
#pragma unroll
        for (int k = 0; k < A_PER; ++k) { const int e = f * A_PER + k; if (e < 32) sacc += PEL(P0, P1, e); }
        PIN(sacc);
#pragma unroll
        for (int k = 0; k < C_PER; ++k) { const int i2 = f * C_PER + k; if (i2 < 16) { pw[i2 >> 2][i2 & 3] = cvtpk(PEL(P0, P1, 2 * i2), PEL(P0, P1, 2 * i2 + 1)); PIN(pw[i2 >> 2]); } }
        SBAR();
    }
    l_reg = l_reg * alP + sacc;
    if (band) { asm volatile("; band tile" ::: "memory"); cmask(C0, C1, jb, qrel, hi); }
    float pmax = fmaxf(fmaxf(C0[0], C0[1]), C1[0]);
#pragma unroll
    for (int r = 1; r < 16; ++r) { pmax = fmaxf(pmax, C1[r]); if (r > 1) pmax = fmaxf(pmax, C0[r]); }
    { auto rr = __builtin_amdgcn_permlane32_swap(__float_as_uint(pmax), __float_as_uint(pmax), false, false); pmax = fmaxf(__uint_as_float(rr[0]), __uint_as_float(rr[1])); }
    float mn;
    if (__builtin_expect(__all(pmax - m_reg <= THR), 1)) { mn = m_reg; alC = 1.f; }
    else { mn = fmaxf(m_reg, pmax); alC = __builtin_amdgcn_exp2f(m_reg - mn); m_reg = mn; }
    SBAR();
#pragma unroll
    for (int g = 0; g < NPV; ++g) {
        if (NPV == 16 && g < 8) { const int g2 = g + 8, ks = g2 / NCB, d0 = g2 % NCB; vlo[g2] = vtr(vp + d0 * 4096 + ks * 1024); vhi[g2] = vtr(vp + d0 * 4096 + ks * 1024 + 512); }
        SBAR();
        { const int ks = g / NCB, d0 = g % NCB;
          const bf16x8 vf = (bf16x8){vlo[g][0], vlo[g][1], vlo[g][2], vlo[g][3], vhi[g][0], vhi[g][1], vhi[g][2], vhi[g][3]};
          o[d0] = __builtin_amdgcn_mfma_f32_32x32x16_bf16(__builtin_bit_cast(bf16x8, pw[ks]), vf, o[d0], 0, 0, 0); }
#pragma unroll
        for (int k = 0; k < E_PER; ++k) { const int e = g * E_PER + k;
            if (e < 16) C0[e & 15] = __builtin_amdgcn_exp2f(C0[e & 15] - mn); else C1[e & 15] = __builtin_amdgcn_exp2f(C1[e & 15] - mn); }
        if (g * E_PER < 16) PIN(C0); else PIN(C1);
        SBAR();
    }
}
template <int DQK, int DV, int VP>
__device__ __forceinline__ void attn_pass3(const bf16_t* Qh, const bf16_t* Kh, const bf16_t* Vh, int qb, LAS unsigned char* lds, f32x16 (&o)[DV / 32], float (&rli)[16]) {
    typedef Geo<DQK, DV> Gm; constexpr int NCB = Gm::NCB, NKS = Gm::NKS, NKI = Gm::NKI, NVI = Gm::NVI, KSLOT = Gm::KSLOT, VSLOT = Gm::VSLOT;
    static_assert(Gm::NDMA == 3, "the ring waits below count 3 LDS-DMA pieces per wave and step (NVI of them V pieces)");
    const int tid = tid_op(), lane = tid & 63, r32 = lane & 31, hi = lane >> 5; const int wid = __builtin_amdgcn_readfirstlane(tid >> 6);
    LAS float* wsf = (LAS float*)(lds + Gm::WS_OFF) + wid * 64; LAS float* li_l = wsf; LAS float* al_l = wsf + 32;
    const unsigned lds0 = (unsigned)(uintptr_t)lds;
    const int q0 = qb * 256, NTL = (q0 + 256) / 64;
    const bf16_t* ksrc[NKI]; unsigned kdst[NKI]; const bf16_t* vsrc[NVI]; unsigned vdst[NVI];
#pragma unroll
    for (int i = 0; i < NKI; ++i) { const int c = (wid + 8 * i < Gm::NKCH) ? wid + 8 * i : wid; ksrc[i] = Kh + (size_t)lane * DQK + c * 8; kdst[i] = lds0 + Gm::K_OFF + c * 1024; }
#pragma unroll
    for (int i = 0; i < NVI; ++i) { const int pi = wid + 8 * i, dblk = pi >> 2, kq = pi & 3; vsrc[i] = Vh + (size_t)(16 * kq + (lane >> 2)) * VP + dblk * 32 + (lane & 3) * 8; vdst[i] = lds0 + Gm::V_OFF + pi * 1024; }
#define DMA_K(t, so) do { _Pragma("unroll") for (int i_ = 0; i_ < NKI; ++i_) glds16(ksrc[i_] + (size_t)(t) * 64 * DQK, (unsigned)__builtin_amdgcn_readfirstlane(kdst[i_] + (so) * KSLOT)); } while (0)
#define DMA_V(t, so) do { _Pragma("unroll") for (int i_ = 0; i_ < NVI; ++i_) glds16(vsrc[i_] + (size_t)(t) * 64 * VP, (unsigned)__builtin_amdgcn_readfirstlane(vdst[i_] + (so) * VSLOT)); } while (0)
    DMA_K(0, 0); DMA_V(0, 0); DMA_K(1, 1);
    float m_reg = -1e30f, l_reg = 0.f; bf16x8 qr[NKS];
#pragma unroll
    for (int d = 0; d < NCB; ++d) o[d] = f32x16{};
    { const bf16_t* Qw = Qh + (size_t)(q0 + wid * 32 + r32) * DQK + hi * 8;
#pragma unroll
      for (int d0 = 0; d0 < NKS; ++d0) qr[d0] = *(const bf16x8*)(Qw + d0 * 16); }
    LAS const unsigned char* kp0 = lds + Gm::K_OFF + hi * 1024 + r32 * 16;
    LAS const unsigned char* vp0 = lds + Gm::V_OFF + ((lane >> 4) & 1) * 32 + (lane & 3) * 8 + (4 * hi + ((lane & 15) >> 2)) * 64;
    const int qrel = wid * 32 + r32;
#define RESC(a) do { if (__any((a) < 1.f)) { if (hi == 0) al_l[r32] = (a); asm volatile("s_waitcnt lgkmcnt(0)" ::: "memory"); \
    _Pragma("unroll") for (int d_ = 0; d_ < NCB; ++d_) _Pragma("unroll") for (int r_ = 0; r_ < 16; ++r_) o[d_][r_] *= al_l[crow(r_, hi)]; } } while (0)
    int sp = 2, sc = 0, sn = 1;
#define ROT() do { const int t_ = sp; sp = sc; sc = sn; sn = t_; } while (0)
    f32x16 pA0, pA1, pB0, pB1; float alA, alB;
    asm volatile("s_waitcnt vmcnt(0)" ::: "memory"); __builtin_amdgcn_s_barrier();
    DMA_K(2, sp); DMA_V(1, sn);
    att2::qkt<NKS>(pA0, pA1, kp0 + sc * KSLOT, qr); if (NTL == 4) cmask(pA0, pA1, 0, qrel, hi);
    { float pmax = pA0[0];
#pragma unroll
      for (int r = 1; r < 16; ++r) pmax = fmaxf(pmax, pA0[r]);
#pragma unroll
      for (int r = 0; r < 16; ++r) pmax = fmaxf(pmax, pA1[r]);
      { auto rr = __builtin_amdgcn_permlane32_swap(__float_as_uint(pmax), __float_as_uint(pmax), false, false); pmax = fmaxf(__uint_as_float(rr[0]), __uint_as_float(rr[1])); }
      m_reg = pmax; alA = 0.f;
#pragma unroll
      for (int r = 0; r < 16; ++r) { pA0[r] = __builtin_amdgcn_exp2f(pA0[r] - pmax); pA1[r] = __builtin_amdgcn_exp2f(pA1[r] - pmax); } }
    WAIT_BAR(3); ROT();
#define STEP(C0, C1, alC, P0, P1, alP, t) do { \
    if ((t) + 2 < NTL) DMA_K((t) + 2, sp); if ((t) + 1 < NTL) DMA_V((t) + 1, sn); \
    SBAR(); step3<NKS, NCB>(C0, C1, P0, P1, alP, alC, m_reg, l_reg, o, qr, kp0 + sc * KSLOT, vp0 + sp * VSLOT, (t) >= NTL - 4, (t) - (NTL - 4), qrel, hi); \
    RESC(alC); \
    if ((t) + 2 < NTL) { WAIT_BAR(3); } else if ((t) + 1 < NTL) { if (NVI == 2) { WAIT_BAR(2); } else { WAIT_BAR(1); } } else { WAIT_BAR(0); } \
    ROT(); } while (0)
#pragma unroll 1
    for (int t = 1; t + 1 < NTL; t += 2) { STEP(pB0, pB1, alB, pA0, pA1, alA, t); STEP(pA0, pA1, alA, pB0, pB1, alB, t + 1); }
    STEP(pB0, pB1, alB, pA0, pA1, alA, NTL - 1);
    { float ps = 0.f;
#pragma unroll
      for (int r = 0; r < 16; ++r) ps += pB0[r] + pB1[r];
      l_reg = l_reg * alB + ps;
#define PK8(P, B) __builtin_bit_cast(bf16x8, (u32x4){cvtpk(P[B], P[B + 1]), cvtpk(P[B + 2], P[B + 3]), cvtpk(P[B + 4], P[B + 5]), cvtpk(P[B + 6], P[B + 7])})
      const bf16x8 pa0 = PK8(pB0, 0), pa1 = PK8(pB0, 8), pa2 = PK8(pB1, 0), pa3 = PK8(pB1, 8);
#undef PK8
      SBAR(); att2::pv_all<NCB>(o, (int)lds0 + Gm::V_OFF + ((lane >> 4) & 1) * 32 + (lane & 3) * 8 + (4 * hi + ((lane & 15) >> 2)) * 64 + sp * VSLOT, pa0, pa1, pa2, pa3); }
    { auto rr = __builtin_amdgcn_permlane32_swap(__float_as_uint(l_reg), __float_as_uint(l_reg), false, false); l_reg = __uint_as_float(rr[0]) + __uint_as_float(rr[1]); }
    if (hi == 0) li_l[r32] = l_reg; asm volatile("s_waitcnt lgkmcnt(0)" ::: "memory");
#pragma unroll
    for (int r = 0; r < 16; ++r) rli[r] = __builtin_amdgcn_rcpf(li_l[crow(r, hi)]);
    WAIT_BAR(0);
#undef DMA_K
#undef DMA_V
#undef RESC
#undef ROT
#undef STEP
}
#undef PIN
#undef PEL
template <int DV, bool GATED>
__device__ __forceinline__ void store_rows(LAS const bf16_t* stg, bf16_t* out, const bf16_t* gate, int pitch, int lane) {
    constexpr int CPR = DV / 8;
#pragma unroll
    for (int i = 0; i < (32 * CPR) / 64; ++i) { const int id = i * 64 + lane, row = id / CPR, ch = id % CPR; const u32x4 v = *(LAS const u32x4*)(stg + row * DV + ch * 8);
        if constexpr (!GATED) { *(u32x4*)(out + (size_t)row * pitch + ch * 8) = v; }
        else { const u32x4 g = *(const u32x4*)(gate + (size_t)row * pitch + ch * 8); u32x4 w;
            w.x = cvtpk(__uint_as_float(v.x << 16) * __uint_as_float(g.x << 16), __uint_as_float(v.x & 0xffff0000u) * __uint_as_float(g.x & 0xffff0000u));
            w.y = cvtpk(__uint_as_float(v.y << 16) * __uint_as_float(g.y << 16), __uint_as_float(v.y & 0xffff0000u) * __uint_as_float(g.y & 0xffff0000u));
            w.z = cvtpk(__uint_as_float(v.z << 16) * __uint_as_float(g.z << 16), __uint_as_float(v.z & 0xffff0000u) * __uint_as_float(g.z & 0xffff0000u));
            w.w = cvtpk(__uint_as_float(v.w << 16) * __uint_as_float(g.w << 16), __uint_as_float(v.w & 0xffff0000u) * __uint_as_float(g.w & 0xffff0000u));
            *(u32x4*)(out + (size_t)row * pitch + ch * 8) = w; } }
}
#ifndef ATTN_PASS
#define ATTN_PASS attn_pass3
#endif
__device__ __forceinline__ void mla_unit(const bf16_t* Qh, const bf16_t* Kh, const bf16_t* Vh, int qb, bf16_t* YC, const bf16_t* G, LAS unsigned char* lds) {
    typedef Geo<96, 64> Gm; f32x16 o[2]; float rli[16];
    ATTN_PASS<96, 64, 64>(Qh, Kh, Vh, qb, lds, o, rli);
    const int tid = tid_op(), lane = tid & 63, r32 = lane & 31, hi = lane >> 5; const int wid = __builtin_amdgcn_readfirstlane(tid >> 6);
    LAS bf16_t* stg = (LAS bf16_t*)(lds + Gm::STG_OFF + wid * 4096);
#pragma unroll
    for (int r = 0; r < 16; ++r) { const int orow = crow(r, hi);
#pragma unroll
        for (int d0 = 0; d0 < 2; ++d0) stg[orow * 64 + d0 * 32 + r32] = (bf16_t)f2bf(o[d0][r] * rli[r]); }
    asm volatile("s_waitcnt lgkmcnt(0)" ::: "memory");
    const size_t ro = (size_t)(qb * 256 + wid * 32) * 1024;
    store_rows<64, true>(stg, YC + ro, G + ro, 1024, lane);
    asm volatile("s_waitcnt lgkmcnt(0)" ::: "memory");
    __syncthreads();
}
__device__ __forceinline__ void diff_unit(const bf16_t* Q0, const bf16_t* K0, const bf16_t* Vh, int qb, bf16_t* YC, const bf16_t* G, const float* subln_g, float lam, LAS unsigned char* lds) {
    typedef Geo<64, 128> Gm; f32x16 o[4]; float rli[16];
    const int tid = tid_op(), lane = tid & 63, r32 = lane & 31, hi = lane >> 5; const int wid = __builtin_amdgcn_readfirstlane(tid >> 6);
    LAS unsigned* park = (LAS unsigned*)(lds + Gm::STG_OFF + wid * 8192);
    ATTN_PASS<64, 128, 128>(Q0, K0, Vh, qb, lds, o, rli);
#pragma unroll
    for (int r = 0; r < 16; r += 2)
#pragma unroll
        for (int d0 = 0; d0 < 4; ++d0) park[((r >> 1) * 4 + d0) * 64 + lane] = cvtpk(o[d0][r] * rli[r], o[d0][r + 1] * rli[r + 1]);
    ATTN_PASS<64, 128, 128>(Q0 + (size_t)SEQ * 64, K0 + (size_t)SEQ * 64, Vh, qb, lds, o, rli);
    asm volatile("s_waitcnt lgkmcnt(0)" ::: "memory");
    float ss[16];
#pragma unroll
    for (int r = 0; r < 16; r += 2) { float s0 = 0.f, s1 = 0.f;
#pragma unroll
        for (int d0 = 0; d0 < 4; ++d0) { const unsigned w = park[((r >> 1) * 4 + d0) * 64 + lane];
            const float a = __uint_as_float(w << 16) - lam * (o[d0][r] * rli[r]), b = __uint_as_float(w & 0xffff0000u) - lam * (o[d0][r + 1] * rli[r + 1]);
            o[d0][r] = a; o[d0][r + 1] = b; s0 += a * a; s1 += b * b; }
        ss[r] = s0; ss[r + 1] = s1; }
#pragma unroll
    for (int r = 0; r < 16; ++r) { float v = ss[r];
        v += __shfl_xor(v, 1); v += __shfl_xor(v, 2); v += __shfl_xor(v, 4); v += __shfl_xor(v, 8); v += __shfl_xor(v, 16);
        ss[r] = __builtin_amdgcn_rsqf(v * (1.f / 128.f) + RMS_EPS) * (1.f - LAM_INIT); }
    float gcol[4];
#pragma unroll
    for (int d0 = 0; d0 < 4; ++d0) gcol[d0] = subln_g[d0 * 32 + r32];
    asm volatile("s_waitcnt lgkmcnt(0)" ::: "memory");
    LAS bf16_t* stg = (LAS bf16_t*)park;
#pragma unroll
    for (int r = 0; r < 16; ++r) { const int orow = crow(r, hi);
#pragma unroll
        for (int d0 = 0; d0 < 4; ++d0) stg[orow * 128 + d0 * 32 + r32] = (bf16_t)f2bf(o[d0][r] * ss[r] * gcol[d0]); }
    asm volatile("s_waitcnt lgkmcnt(0)" ::: "memory");
    const size_t ro = (size_t)(qb * 256 + wid * 32) * 1024;
    store_rows<128, true>(stg, YC + ro, G + ro, 1024, lane);
    asm volatile("s_waitcnt lgkmcnt(0)" ::: "memory");
    __syncthreads();
}
#undef SBAR
#undef WAIT_BAR
}

__device__ __forceinline__ void phase2_v2(const Params& P, LAS unsigned char* lds) {
    const bf16_t* QD = (const bf16_t*)(P.ws + WS_QD); const bf16_t* KD = (const bf16_t*)(P.ws + WS_KD); const bf16_t* VD = (const bf16_t*)(P.ws + WS_VD);
    const bf16_t* QM = (const bf16_t*)(P.ws + WS_QM); const bf16_t* KM = (const bf16_t*)(P.ws + WS_KM); const bf16_t* VM = (const bf16_t*)(P.ws + WS_VM);
    const bf16_t* G = (const bf16_t*)(P.ws + WS_G); bf16_t* YC = (bf16_t*)(P.ws + WS_YCAT);
    const float lam = ((const float*)(P.ws + WS_MISC))[0];
    const int Gn = (int)gridDim.x, bx = (int)blockIdx.x, vcu = (Gn % 8 == 0) ? (bx % 8) * (Gn / 8) + bx / 8 : bx;
#pragma unroll 1
    for (int it = vcu; it < 256 + 512; it += Gn) {
        if (it < 256) {
            const int bh4 = it >> 3, sidx = it & 7, b = bh4 >> 2, h = bh4 & 3;
#pragma unroll 1
            for (int half = 0; half < 2; ++half) { const int qb = half == 0 ? 15 - sidx : sidx;
                att2::diff_unit(QD + (size_t)(b * 8 + 2 * h) * SEQ * 64, KD + (size_t)(b * 8 + 2 * h) * SEQ * 64, VD + (size_t)(b * 4 + h) * SEQ * 128, qb,
                                YC + (size_t)b * SEQ * 1024 + h * 128, G + (size_t)b * SEQ * 1024 + h * 128, P.subln_g, lam, lds); }
        } else {
            const int rem = it - 256, bh = rem >> 3, sidx = rem & 7, b = bh >> 3, hh = bh & 7;
#pragma unroll 1
            for (int half = 0; half < 2; ++half) { const int qb = half == 0 ? 15 - sidx : sidx;
                att2::mla_unit(QM + (size_t)bh * SEQ * 96, KM + (size_t)bh * SEQ * 96, VM + (size_t)bh * SEQ * 64, qb, YC + (size_t)b * SEQ * 1024 + 512 + hh * 64, G + (size_t)b * SEQ * 1024 + 512 + hh * 64, lds); }
        }
    }
    __syncthreads();
}

__device__ __forceinline__ void phase2_mfma(const Params& P, LAS unsigned char* lds) {
    const bf16_t* QD = (const bf16_t*)(P.ws + WS_QD); const bf16_t* KD = (const bf16_t*)(P.ws + WS_KD); const bf16_t* VD = (const bf16_t*)(P.ws + WS_VD);
    const bf16_t* QM = (const bf16_t*)(P.ws + WS_QM); const bf16_t* KM = (const bf16_t*)(P.ws + WS_KM); const bf16_t* VM = (const bf16_t*)(P.ws + WS_VM);
    const bf16_t* G = (const bf16_t*)(P.ws + WS_G); bf16_t* OD = (bf16_t*)(P.ws + WS_OD); bf16_t* YC = (bf16_t*)(P.ws + WS_YCAT);
    const int Gn = (int)gridDim.x, bx = (int)blockIdx.x, vcu = (Gn % 8 == 0) ? (bx % 8) * (Gn / 8) + bx / 8 : bx;
#pragma unroll 1
    for (int pr = vcu; pr < 1024; pr += Gn) {
        const int kind = pr >> 9, rem = pr & 511, bh = rem >> 3, sidx = rem & 7, b = bh >> 3, hh = bh & 7;
#pragma unroll 1
        for (int half = 0; half < 2; ++half) {
            const int qb = half == 0 ? 15 - sidx : sidx;
            if (kind == 0) att::attn_unit<64, 128, 128, 0>(QD + (size_t)bh * SEQ * 64, KD + (size_t)bh * SEQ * 64, VD + (size_t)(b * 4 + (hh >> 1)) * SEQ * 128, qb, OD + (size_t)bh * SEQ * 128, nullptr, lds);
            else att::attn_unit<96, 64, 64, 1>(QM + (size_t)bh * SEQ * 96, KM + (size_t)bh * SEQ * 96, VM + (size_t)bh * SEQ * 64, qb, YC + (size_t)b * SEQ * 1024 + 512 + hh * 64, G + (size_t)b * SEQ * 1024 + 512 + hh * 64, lds);
        }
    }
}

#define GAS __attribute__((address_space(1)))
constexpr int CW_BAR = 4096;
constexpr int LDSCTL_OFF = 162816, MISC_OFF = LDSCTL_OFF + 320;
#define XB_TMO      128
#define XB_XCNT(j)  (256  + 64 * (j))
#define XB_XSUB(j)  (1280 + 64 * (j))
#define XB_XGEN(j)  (2304 + 64 * (j))
#define XB_TOP      3328
#define XB_TOPGEN   3392
#define XCD_BAR_WORDS 3456
#define XB_SPIN_CAP (1u << 18)

__device__ __forceinline__ unsigned xb_ld(unsigned* p)              { return __hip_atomic_load(p, __ATOMIC_RELAXED, __HIP_MEMORY_SCOPE_AGENT); }
__device__ __forceinline__ unsigned xb_add(unsigned* p, unsigned v) { return __hip_atomic_fetch_add(p, v, __ATOMIC_RELAXED, __HIP_MEMORY_SCOPE_AGENT); }
__device__ __forceinline__ unsigned xb_xcc_id() { return (unsigned)__builtin_amdgcn_s_getreg((3 << 11) | 20) & 0xFu; }
#define XB_SPIN(cond, bar) do { unsigned _sp = 0; while (cond) { __builtin_amdgcn_s_sleep(1); \
    if ((++_sp & 255u) == 0u) { if (xb_ld(&(bar)[XB_TMO])) break; if (_sp > XB_SPIN_CAP) { atomicAdd(&(bar)[XB_TMO], 1u); break; } } } } while (0)

struct XcdBarrier {
    unsigned* bar; unsigned x;
    volatile LAS unsigned* st;
};

__device__ __forceinline__ XcdBarrier xcd_barrier_post(unsigned* bar, volatile LAS unsigned* st) {
    XcdBarrier b; b.bar = bar; b.x = xb_xcc_id(); b.st = st;
    if (threadIdx.x == 0) (void)xb_add(&bar[XB_XCNT(b.x)], 1u);
    return b;
}
__device__ __forceinline__ void xcd_barrier_complete(unsigned* bar, unsigned x, unsigned& nloc, unsigned& nx) {
    const unsigned G = gridDim.x * gridDim.y * gridDim.z;
    unsigned sum, cnt, mine, sp = 0u;
    for (;;) {
        sum = 0u; cnt = 0u; mine = 0u;
#pragma unroll
        for (unsigned j = 0; j < 16; ++j) { const unsigned c = xb_ld(&bar[XB_XCNT(j)]); sum += c; cnt += (c > 0u) ? 1u : 0u; mine = (j == x) ? c : mine; }
        if (sum == G) break;
        __builtin_amdgcn_s_sleep(1);
        if ((++sp & 255u) == 0u) { if (xb_ld(&bar[XB_TMO])) break; if (sp > XB_SPIN_CAP) { atomicAdd(&bar[XB_TMO], 1u); break; } }
    }
    nloc = mine > 0u ? mine : 1u; nx = cnt > 0u ? cnt : 1u;
}

__device__ __forceinline__ void xcd_barrier(const XcdBarrier& b) {
    asm volatile("s_waitcnt vmcnt(0)" ::: "memory");
    __syncthreads();
    if (threadIdx.x == 0) {
        unsigned* bar = b.bar;
        __builtin_amdgcn_s_waitcnt(0);
        unsigned nloc = b.st[0], nx = b.st[1];
        if (nloc == 0u) { xcd_barrier_complete(bar, b.x, nloc, nx); b.st[0] = nloc; b.st[1] = nx; }
        const unsigned old = xb_add(&bar[XB_XSUB(b.x)], 1u);
        const unsigned gen = old / nloc;
        if (old + 1u == (gen + 1u) * nloc) {
            __builtin_amdgcn_fence(__ATOMIC_RELEASE, "agent");
            asm volatile("s_waitcnt vmcnt(0)" ::: "memory");
            const unsigned og = xb_add(&bar[XB_TOP], 1u);
            const unsigned tg = og / nx;
            if (og + 1u == (tg + 1u) * nx) xb_add(&bar[XB_TOPGEN], 1u);
            else XB_SPIN(xb_ld(&bar[XB_TOPGEN]) == tg, bar);
            __builtin_amdgcn_fence(__ATOMIC_ACQUIRE, "agent");
            xb_add(&bar[XB_XGEN(b.x)], 1u);
            asm volatile("s_waitcnt vmcnt(0)" ::: "memory");
        } else {
            XB_SPIN(xb_ld(&bar[XB_XGEN(b.x)]) == gen, bar);
            __builtin_amdgcn_fence(__ATOMIC_ACQUIRE, "agent");
            asm volatile("s_waitcnt vmcnt(0)" ::: "memory");
        }
    }
    __syncthreads();
}

#ifndef OPT_P1
#define OPT_P1 1
#endif
#ifndef OPT_P2
#define OPT_P2 2
#endif
#ifndef OPT_P15
#define OPT_P15 1
#endif
#ifndef OPT_P3
#define OPT_P3 1
#endif
#ifndef OPT_P4
#define OPT_P4 1
#endif
constexpr int LDS_BYTES = 163840;
__global__ void __launch_bounds__(NT, 2) fwd_megakernel(Params P) {
    extern __shared__ __attribute__((aligned(16))) unsigned char lds_raw[];
    LAS unsigned char* lds = (LAS unsigned char*)lds_raw;
    float* smem = (float*)lds_raw;
    const int bid = blockIdx.x, nb = gridDim.x;
    for (int u = threadIdx.x; u < (LDS_BYTES - LDSCTL_OFF) / 4; u += NT) ((LAS unsigned*)(lds + LDSCTL_OFF))[u] = 0u;
    __syncthreads();
    const XcdBarrier bar = xcd_barrier_post((unsigned*)(P.ws + WS_CTL) + CW_BAR, (volatile LAS unsigned*)(lds + MISC_OFF) + 8);
    phase0(P, bid, nb);
    phase0_weights(P, bid, nb, lds);
    xcd_barrier(bar);
#if OPT_P1
    phase1_gemm(P, lds);
#else
    phase1_naive(P, bid, nb, smem);
#endif
    xcd_barrier(bar);
#if OPT_P15
    phase15_gemm(P, lds);
#else
    phase15_naive(P, bid, nb, smem);
#endif
    xcd_barrier(bar);
#if OPT_P2 == 2
    phase2_v2(P, lds);
    xcd_barrier(bar);
#elif OPT_P2
    phase2_mfma(P, lds);
    xcd_barrier(bar);
    phase25_naive(P, bid, nb);
    xcd_barrier(bar);
#else
    phase2_naive(P, bid, nb, smem);
    xcd_barrier(bar);
    phase25_naive(P, bid, nb);
    xcd_barrier(bar);
#endif
#if OPT_P3
    phase3_gemm(P, lds);
#else
    phase3_naive(P, bid, nb, smem);
#endif
    xcd_barrier(bar);
#if OPT_P4
    phase4_gemm(P, lds);
#else
    phase4_naive(P, bid, nb, smem);
#endif
    xcd_barrier(bar);
    phase5(P, bid, nb);
}

extern "C" void kernel_launch(void* const* d_in, const int* in_sizes, int n_in, void* d_out, int out_size, void* d_ws, size_t ws_size, hipStream_t stream) {
    if (n_in != 15 || out_size != T * DM || ws_size < WS_END) { fprintf(stderr, "kernel_launch: unexpected shapes (n_in %d out %d ws %zu)\n", n_in, out_size, ws_size); return; }
    static int grid_blocks = 0;
    if (!grid_blocks) {
        int dev = 0, cus = 0, per_cu = 0;
        (void)hipGetDevice(&dev);
        (void)hipDeviceGetAttribute(&cus, hipDeviceAttributeMultiprocessorCount, dev);
        if (hipFuncSetAttribute((const void*)fwd_megakernel, hipFuncAttributeMaxDynamicSharedMemorySize, LDS_BYTES) != hipSuccess) { fprintf(stderr, "kernel_launch: hipFuncSetAttribute failed\n"); return; }
        if (hipOccupancyMaxActiveBlocksPerMultiprocessor(&per_cu, (const void*)fwd_megakernel, NT, LDS_BYTES) != hipSuccess || per_cu < 1) { fprintf(stderr, "kernel_launch: occupancy query says %d blocks/CU\n", per_cu); return; }
        grid_blocks = cus;
    }
    Params P{};
    P.x = (const float*)d_in[0]; P.p = (const float*)d_in[1]; P.pos = (const int*)d_in[2]; P.norm_g = (const float*)d_in[3]; P.w_in = (const float*)d_in[4];
    P.diff_lambda = (const float*)d_in[5]; P.subln_g = (const float*)d_in[6]; P.qn_g = (const float*)d_in[7]; P.w_uq = (const float*)d_in[8]; P.kvn_g = (const float*)d_in[9];
    P.w_ukv = (const float*)d_in[10]; P.w_out = (const float*)d_in[11]; P.w_ple = (const float*)d_in[12]; P.w_gate = (const float*)d_in[13]; P.final_g = (const float*)d_in[14];
    P.out = (float*)d_out; P.ws = (unsigned char*)d_ws;
    if (hipMemsetAsync((char*)d_ws + WS_CTL, 0, 65536, stream) != hipSuccess) { fprintf(stderr, "kernel_launch: memset failed\n"); return; }
    hipLaunchKernelGGL(fwd_megakernel, dim3(grid_blocks), dim3(NT), LDS_BYTES, stream, P);
    const hipError_t e = hipPeekAtLastError();
    if (e != hipSuccess) fprintf(stderr, "launch failed: %s (grid %d)\n", hipGetErrorString(e), grid_blocks);
}
```

```cpp
#include <hip/hip_runtime.h>
#include <hip/hip_cooperative_groups.h>
#include <cstdio>
#include <cstdint>

namespace cg = cooperative_groups;
typedef unsigned short bf16_t;

constexpr int BATCH = 8, SEQ = 4096, T = BATCH * SEQ, DM = 1024, DIN = 3104, PLE_DIM = 256;
constexpr int OFF_DQ = 0, OFF_DK = 512, OFF_DV = 1024, OFF_DG = 1536, OFF_CQ = 2048, OFF_CKV = 2432, OFF_KR = 2560, OFF_MG = 2592;
constexpr int QLORA = 384, KVLORA = 128, CQP = 512;
constexpr float RMS_EPS = 1e-6f;
constexpr float LOG2E = 1.4426950408889634f;
constexpr float C2D = 0.125f * LOG2E;
constexpr float C2M = 0.10206207261596575f * LOG2E;
constexpr float LAM_INIT = 0.2f;
constexpr int NT = 512;

constexpr size_t MiB = 1u << 20;
constexpr size_t WS_CTL = 0;
constexpr size_t WS_MISC = 1 * MiB;
constexpr size_t WS_SSQQ = 1 * MiB + 65536, WS_SSQKV = WS_SSQQ + 131072, WS_SSQF = WS_SSQKV + 131072;
constexpr size_t WS_CSA = 2 * MiB, WS_CSB = 10 * MiB;
constexpr size_t WS_WIN = 14 * MiB, WS_WPLE = 21 * MiB, WS_WUQ = 22 * MiB, WS_WUKV = 23 * MiB, WS_WOUT = 24 * MiB, WS_WG = 26 * MiB;
constexpr size_t WS_PB = 28 * MiB, WS_CQ = 44 * MiB  , WS_XN = 76 * MiB, WS_OD = WS_XN;
constexpr size_t WS_QD = 140 * MiB, WS_KD = 172 * MiB, WS_PLE = WS_QD, WS_VD = 204 * MiB, WS_G = 236 * MiB, WS_HB = WS_G;
constexpr size_t WS_QM = 300 * MiB, WS_KM = 348 * MiB, WS_VM = 396 * MiB, WS_YCAT = 428 * MiB, WS_END = 492 * MiB;

struct Params {
    const float* x; const float* p; const int* pos; const float* norm_g; const float* w_in; const float* diff_lambda;
    const float* subln_g; const float* qn_g; const float* w_uq; const float* kvn_g; const float* w_ukv; const float* w_out;
    const float* w_ple; const float* w_gate; const float* final_g; float* out; unsigned char* ws;
};

__device__ __forceinline__ unsigned f2bf(float f) { unsigned u = __float_as_uint(f); return (u + 0x7fffu + ((u >> 16) & 1u)) >> 16; }
__device__ __forceinline__ float bf2f(bf16_t h) { return __uint_as_float(((unsigned)h) << 16); }
__device__ __forceinline__ float wave_sum(float v) {
#pragma unroll
    for (int o = 1; o < 64; o <<= 1) v += __shfl_xor(v, o);
    return v;
}
__device__ __forceinline__ int tid_op() { int t = threadIdx.x; asm volatile("" : "+v"(t)); return t; }
__device__ __forceinline__ int sgpr_op(int v) { asm volatile("" : "+s"(v)); return v; }
__device__ __forceinline__ float silu_f(float v) { return v / (1.f + __expf(-v)); }
__device__ __forceinline__ float sigmoid_f(float v) { return 1.f / (1.f + __expf(-v)); }

__device__ __forceinline__ void phase0(const Params& P, int bid, int nb) {
    bid = sgpr_op(bid); nb = sgpr_op(nb);
    const int tid = tid_op(), lane = tid & 63, wave = tid >> 6;
    const int gw = bid * (NT / 64) + wave, ngw = nb * (NT / 64);
    const int gt = bid * NT + tid, ngt = nb * NT;
    bf16_t* XN = (bf16_t*)(P.ws + WS_XN);
    for (int t = gw; t < T; t += 2 * ngw) {
        const int t2 = t + ngw;
        const bool has2 = t2 < T;
        const float4* xr = (const float4*)(P.x + (size_t)t * DM); const float4* xr2 = (const float4*)(P.x + (size_t)(has2 ? t2 : t) * DM);
        float4 v[4], w[4]; float s = 0.f, s2 = 0.f;
#pragma unroll
        for (int j = 0; j < 4; ++j) { v[j] = xr[lane + 64 * j]; w[j] = xr2[lane + 64 * j]; }
#pragma unroll
        for (int j = 0; j < 4; ++j) { s += v[j].x * v[j].x + v[j].y * v[j].y + v[j].z * v[j].z + v[j].w * v[j].w; s2 += w[j].x * w[j].x + w[j].y * w[j].y + w[j].z * w[j].z + w[j].w * w[j].w; }
        s = wave_sum(s); s2 = wave_sum(s2);
        const float rstd = 1.0f / sqrtf(s * (1.f / DM) + RMS_EPS), rstd2 = 1.0f / sqrtf(s2 * (1.f / DM) + RMS_EPS);
#pragma unroll
        for (int j = 0; j < 4; ++j) {
            const float4 g = ((const float4*)P.norm_g)[lane + 64 * j];
            uint2 o; o.x = f2bf(v[j].x * rstd * g.x) | (f2bf(v[j].y * rstd * g.y) << 16); o.y = f2bf(v[j].z * rstd * g.z) | (f2bf(v[j].w * rstd * g.w) << 16);
            ((uint2*)(XN + (size_t)t * DM))[lane + 64 * j] = o;
            if (has2) { uint2 o2; o2.x = f2bf(w[j].x * rstd2 * g.x) | (f2bf(w[j].y * rstd2 * g.y) << 16); o2.y = f2bf(w[j].z * rstd2 * g.z) | (f2bf(w[j].w * rstd2 * g.w) << 16);
                ((uint2*)(XN + (size_t)t2 * DM))[lane + 64 * j] = o2; }
        }
    }
    bf16_t* PB = (bf16_t*)(P.ws + WS_PB);
    for (int i = gt; i < T * PLE_DIM / 4; i += ngt) {
        const float4 v = ((const float4*)P.p)[i];
        uint2 o; o.x = f2bf(v.x) | (f2bf(v.y) << 16); o.y = f2bf(v.z) | (f2bf(v.w) << 16);
        ((uint2*)PB)[i] = o;
    }
    float2* CSA = (float2*)(P.ws + WS_CSA); float2* CSB = (float2*)(P.ws + WS_CSB);
    {
        const double invA = pow(10000.0, -(double)(gt & 31) / 32.0) * 0.15915494309189535, invB = pow(10000.0, -(double)(gt & 15) / 16.0) * 0.15915494309189535;
        if ((ngt & 31) == 0) {
            for (int i = gt; i < T * 32; i += ngt) { double rev = (double)P.pos[i >> 5] * invA; rev -= floor(rev); const float rf = (float)rev; CSA[i] = make_float2(__builtin_amdgcn_cosf(rf), __builtin_amdgcn_sinf(rf)); }
            for (int i = gt; i < T * 16; i += ngt) { double rev = (double)P.pos[i >> 4] * invB; rev -= floor(rev); const float rf = (float)rev; CSB[i] = make_float2(__builtin_amdgcn_cosf(rf), __builtin_amdgcn_sinf(rf)); }
        } else {
            for (int i = gt; i < T * 32; i += ngt) { double rev = (double)P.pos[i >> 5] * pow(10000.0, -(double)(i & 31) / 32.0) * 0.15915494309189535; rev -= floor(rev); const float rf = (float)rev; CSA[i] = make_float2(__builtin_amdgcn_cosf(rf), __builtin_amdgcn_sinf(rf)); }
            for (int i = gt; i < T * 16; i += ngt) { double rev = (double)P.pos[i >> 4] * pow(10000.0, -(double)(i & 15) / 16.0) * 0.15915494309189535; rev -= floor(rev); const float rf = (float)rev; CSB[i] = make_float2(__builtin_amdgcn_cosf(rf), __builtin_amdgcn_sinf(rf)); }
        }
    }
    float* ssq = (float*)(P.ws + WS_SSQQ);
    for (int i = gt; i < 3 * T; i += ngt) ssq[i] = 0.f;
    if (bid == 0 && tid == 0) {
        float s1 = 0.f, s2 = 0.f;
        for (int i = 0; i < 64; ++i) { s1 += P.diff_lambda[i] * P.diff_lambda[64 + i]; s2 += P.diff_lambda[128 + i] * P.diff_lambda[192 + i]; }
        ((float*)(P.ws + WS_MISC))[0] = expf(s1) - expf(s2) + LAM_INIT;
    }
}

constexpr int NG_SMEM_FLOATS = 16 * 129 + 16 * 65 + 128 * 65;
__device__ __forceinline__ void ngemm_tile(const bf16_t* A, int lda, int row0, const float* W, int ldw, int col0, int ncol, int K, const float* kscale, float* smem) {
    float* As = smem; float* Bs = smem + 16 * 129; float* Cs = Bs + 16 * 65;
    const int tid = tid_op(), ty = tid >> 4, tx = tid & 15;
    float acc[4][4];
#pragma unroll
    for (int i = 0; i < 4; ++i)
#pragma unroll
        for (int j = 0; j < 4; ++j) acc[i][j] = 0.f;
#pragma unroll 1
    for (int k0 = 0; k0 < K; k0 += 16) {
        __syncthreads();
#pragma unroll
        for (int i = 0; i < 4; ++i) { const int idx = tid + i * NT, r = idx >> 4, kk = idx & 15; As[kk * 129 + r] = bf2f(A[(size_t)(row0 + r) * lda + k0 + kk]); }
#pragma unroll
        for (int i = 0; i < 2; ++i) { const int idx = tid + i * NT, kk = idx >> 6, c = idx & 63;
            float w = 0.f; if (c < ncol) { w = W[(size_t)(k0 + kk) * ldw + col0 + c]; if (kscale) w *= kscale[k0 + kk]; }
            Bs[kk * 65 + c] = w; }
        __syncthreads();
#pragma unroll
        for (int kk = 0; kk < 16; ++kk) {
            float a[4], b[4];
#pragma unroll
            for (int i = 0; i < 4; ++i) a[i] = As[kk * 129 + ty * 4 + i];
#pragma unroll
            for (int j = 0; j < 4; ++j) b[j] = Bs[kk * 65 + tx * 4 + j];
#pragma unroll
            for (int i = 0; i < 4; ++i)
#pragma unroll
                for (int j = 0; j < 4; ++j) acc[i][j] += a[i] * b[j];
        }
    }
    __syncthreads();
#pragma unroll
    for (int i = 0; i < 4; ++i)
#pragma unroll
        for (int j = 0; j < 4; ++j) Cs[(ty * 4 + i) * 65 + tx * 4 + j] = acc[i][j];
    __syncthreads();
}

__device__ __forceinline__ void phase1_naive(const Params& P, int bid, int nb, float* smem) {
    bid = sgpr_op(bid); nb = sgpr_op(nb);
    const int tid = tid_op();
    const bf16_t* XN = (const bf16_t*)(P.ws + WS_XN);
    bf16_t* QD = (bf16_t*)(P.ws + WS_QD); bf16_t* KD = (bf16_t*)(P.ws + WS_KD); bf16_t* VD = (bf16_t*)(P.ws + WS_VD); bf16_t* G = (bf16_t*)(P.ws + WS_G);
    bf16_t* CQ = (bf16_t*)(P.ws + WS_CQ); bf16_t* KM = (bf16_t*)(P.ws + WS_KM);
    float* SSQQ = (float*)(P.ws + WS_SSQQ); float* SSQKV = (float*)(P.ws + WS_SSQKV);
    const float2* CSA = (const float2*)(P.ws + WS_CSA); const float2* CSB = (const float2*)(P.ws + WS_CSB);
    float* Cs = smem + 16 * 129 + 16 * 65;
    constexpr int NCT = 49, NRT = T / 128;
    for (int item = bid; item < NCT * NRT; item += nb) {
        const int ct = item % NCT, rt = item / NCT, row0 = rt * 128;
        int col0, ncol = 64;
        if (ct < 40) col0 = ct * 64; else if (ct == 40) { col0 = OFF_KR; ncol = 32; } else col0 = OFF_MG + (ct - 41) * 64;
        ngemm_tile(XN, DM, row0, P.w_in, DIN, col0, ncol, DM, nullptr, smem);
        _Pragma("unroll 1") for (int e = tid; e < 128 * 64; e += NT) {
            const int r = e >> 6, c = e & 63, t = row0 + r, b = t / SEQ, s = t % SEQ;
            const float v = Cs[r * 65 + c];
            if (col0 < OFF_DV) {
                const int i = c & 31; const float x1 = Cs[r * 65 + i], x2 = Cs[r * 65 + i + 32]; const float2 cs = CSA[(size_t)t * 32 + i];
                const float o = (c < 32) ? (x1 * cs.x - x2 * cs.y) : (x2 * cs.x + x1 * cs.y);
                if (col0 < OFF_DK) { const int mh = col0 / 64; QD[((size_t)(b * 8 + mh) * SEQ + s) * 64 + c] = (bf16_t)f2bf(o * C2D); }
                else { const int mh = (col0 - OFF_DK) / 64; KD[((size_t)(b * 8 + mh) * SEQ + s) * 64 + c] = (bf16_t)f2bf(o); }
            } else if (col0 < OFF_DG) { const int col = col0 - OFF_DV + c, h = col >> 7, d = col & 127; VD[((size_t)(b * 4 + h) * SEQ + s) * 128 + d] = (bf16_t)f2bf(v); }
            else if (col0 < OFF_CQ) { const int col = col0 - OFF_DG + c; G[(size_t)t * 1024 + col] = (bf16_t)f2bf(silu_f(v)); }
            else if (col0 < OFF_CKV) { const int col = col0 - OFF_CQ + c; CQ[(size_t)t * CQP + col] = (bf16_t)f2bf(v); }
            else if (col0 < OFF_KR) { const int col = col0 - OFF_CKV + c; CQ[(size_t)t * CQP + QLORA + col] = (bf16_t)f2bf(v); }
            else if (col0 == OFF_KR) { if (c < 32) { const int i = c & 15; const float x1 = Cs[r * 65 + i], x2 = Cs[r * 65 + i + 16]; const float2 cs = CSB[(size_t)t * 16 + i];
                    const float o = (c < 16) ? (x1 * cs.x - x2 * cs.y) : (x2 * cs.x + x1 * cs.y);
                    for (int h = 0; h < 8; ++h) KM[((size_t)(b * 8 + h) * SEQ + s) * 96 + 64 + c] = (bf16_t)f2bf(o); } }
            else { const int col = col0 - OFF_MG + c; G[(size_t)t * 1024 + 512 + col] = (bf16_t)f2bf(silu_f(v)); }
        }
        if (col0 >= OFF_CQ && col0 < OFF_KR && tid < 128) {
            float s = 0.f; _Pragma("unroll 4") for (int c = 0; c < 64; ++c) { const float v = Cs[tid * 65 + c]; s += v * v; }
            atomicAdd((col0 < OFF_CKV ? SSQQ : SSQKV) + row0 + tid, s);
        }
    }
}

__device__ __forceinline__ void phase15_naive(const Params& P, int bid, int nb, float* smem) {
    bid = sgpr_op(bid); nb = sgpr_op(nb);
    const int tid = tid_op();
    const bf16_t* CQ = (const bf16_t*)(P.ws + WS_CQ); const bf16_t* CKV = CQ + QLORA;
    bf16_t* QM = (bf16_t*)(P.ws + WS_QM); bf16_t* KM = (bf16_t*)(P.ws + WS_KM); bf16_t* VM = (bf16_t*)(P.ws + WS_VM);
    const float* SSQQ = (const float*)(P.ws + WS_SSQQ); const float* SSQKV = (const float*)(P.ws + WS_SSQKV);
    const float2* CSB = (const float2*)(P.ws + WS_CSB);
    float* Cs = smem + 16 * 129 + 16 * 65;
    constexpr int NCT = 12 + 16, NRT = T / 128;
    for (int item = bid; item < NCT * NRT; item += nb) {
        const int ct = item % NCT, rt = item / NCT, row0 = rt * 128;
        if (ct < 12) {
            const int col0 = ct * 64;
            ngemm_tile(CQ, CQP, row0, P.w_uq, 768, col0, 64, QLORA, P.qn_g, smem);
            _Pragma("unroll 1") for (int e = tid; e < 128 * 64; e += NT) {
                const int r = e >> 6, c = e & 63, t = row0 + r, b = t / SEQ, s = t % SEQ, col = col0 + c, h = col / 96, j = col % 96;
                const float rstd = 1.0f / sqrtf(SSQQ[t] * (1.f / QLORA) + RMS_EPS);
                float o;
                if (j < 64) o = Cs[r * 65 + c];
                else { const int jj = j - 64, i = jj & 15, cb = c - jj; const float x1 = Cs[r * 65 + cb + i], x2 = Cs[r * 65 + cb + i + 16]; const float2 cs = CSB[(size_t)t * 16 + i];
                    o = (jj < 16) ? (x1 * cs.x - x2 * cs.y) : (x2 * cs.x + x1 * cs.y); }
                QM[((size_t)(b * 8 + h) * SEQ + s) * 96 + j] = (bf16_t)f2bf(o * rstd * C2M);
            }
        } else {
            const int col0 = (ct - 12) * 64;
            ngemm_tile(CKV, CQP, row0, P.w_ukv, 1024, col0, 64, KVLORA, P.kvn_g, smem);
            _Pragma("unroll 1") for (int e = tid; e < 128 * 64; e += NT) {
                const int r = e >> 6, c = e & 63, t = row0 + r, b = t / SEQ, s = t % SEQ, col = col0 + c, h = col >> 7, j = col & 127;
                const float rstd = 1.0f / sqrtf(SSQKV[t] * (1.f / KVLORA) + RMS_EPS);
                const float o = Cs[r * 65 + c] * rstd;
                if (j < 64) KM[((size_t)(b * 8 + h) * SEQ + s) * 96 + j] = (bf16_t)f2bf(o);
                else VM[((size_t)(b * 8 + h) * SEQ + s) * 64 + j - 64] = (bf16_t)f2bf(o);
            }
        }
    }
}

template <int DQK, int DV, int DVS>
__device__ __forceinline__ void nattn_rows(const bf16_t* Qh, const bf16_t* Kh, const bf16_t* Vh, int q0, float* o, float& l_out, unsigned* smem) {
    const int tid = tid_op(), i = q0 + tid;
    unsigned* Ks = smem; unsigned* Vs = smem + 32 * (DQK / 2);
    unsigned q2[DQK / 2];
#pragma unroll
    for (int d = 0; d < DQK / 2; ++d) q2[d] = ((const unsigned*)(Qh + (size_t)i * DQK))[d];
#pragma unroll
    for (int d = 0; d < DV; ++d) o[d] = 0.f;
    float m = -1e30f, l = 0.f;
    const int jend = q0 + NT;
#pragma unroll 1
    for (int j0 = 0; j0 < jend; j0 += 32) {
        __syncthreads();
        for (int idx = tid; idx < 32 * (DQK / 2); idx += NT) Ks[idx] = ((const unsigned*)(Kh + (size_t)j0 * DQK))[idx];
        for (int idx = tid; idx < 32 * (DV / 2); idx += NT) { const int r = idx / (DV / 2), c = idx % (DV / 2); Vs[idx] = ((const unsigned*)(Vh + (size_t)(j0 + r) * DVS))[c]; }
        __syncthreads();
#pragma unroll 1
        for (int jj = 0; jj < 32; jj += 2) {
            float sc[2];
#pragma unroll
            for (int k = 0; k < 2; ++k) {
                const unsigned* kr = Ks + (jj + k) * (DQK / 2); float s = 0.f;
#pragma unroll
                for (int d = 0; d < DQK / 2; ++d) { const unsigned kk = kr[d]; unsigned qq = q2[d]; asm volatile("" : "+v"(qq));
                    s += __uint_as_float(qq << 16) * __uint_as_float(kk << 16); s += __uint_as_float(qq & 0xffff0000u) * __uint_as_float(kk & 0xffff0000u); }
                sc[k] = (j0 + jj + k <= i) ? s : -1e30f;
                asm volatile("" : "+v"(sc[k]));
            }
            const float mn = fmaxf(fmaxf(sc[0], sc[1]), m);
            const float alpha = exp2f(m - mn);
            float pr[2];
#pragma unroll
            for (int k = 0; k < 2; ++k) pr[k] = (j0 + jj + k <= i) ? exp2f(sc[k] - mn) : 0.f;
            l = l * alpha + (pr[0] + pr[1]); m = mn;
#pragma unroll
            for (int d = 0; d < DV; ++d) o[d] *= alpha;
#pragma unroll
            for (int k = 0; k < 2; ++k) { const unsigned* vr = Vs + (jj + k) * (DV / 2);
#pragma unroll
                for (int d = 0; d < DV / 2; ++d) { const unsigned vv = vr[d]; o[2 * d] += pr[k] * __uint_as_float(vv << 16); o[2 * d + 1] += pr[k] * __uint_as_float(vv & 0xffff0000u); } }
        }
    }
    l_out = l;
}
__device__ __forceinline__ void phase2_naive(const Params& P, int bid, int nb, float* smemf) {
    bid = sgpr_op(bid); nb = sgpr_op(nb);
    unsigned* smem = (unsigned*)smemf;
    const bf16_t* QD = (const bf16_t*)(P.ws + WS_QD); const bf16_t* KD = (const bf16_t*)(P.ws + WS_KD); const bf16_t* VD = (const bf16_t*)(P.ws + WS_VD);
    const bf16_t* QM = (const bf16_t*)(P.ws + WS_QM); const bf16_t* KM = (const bf16_t*)(P.ws + WS_KM); const bf16_t* VM = (const bf16_t*)(P.ws + WS_VM);
    const bf16_t* G = (const bf16_t*)(P.ws + WS_G); bf16_t* OD = (bf16_t*)(P.ws + WS_OD); bf16_t* YC = (bf16_t*)(P.ws + WS_YCAT);
    constexpr int NCH = SEQ / NT;
    for (int item = bid; item < 2 * 64 * NCH; item += nb) {
        const int kind = item / (64 * NCH), rem = item % (64 * NCH), bh = rem / NCH, ch = NCH - 1 - rem % NCH, q0 = ch * NT, b = bh >> 3, hh = bh & 7;
        const int i = q0 + tid_op();
        if (kind == 0) {
#pragma unroll 1
            for (int half = 0; half < 2; ++half) {
                float o[64], l;
                nattn_rows<64, 64, 128>(QD + (size_t)bh * SEQ * 64, KD + (size_t)bh * SEQ * 64, VD + (size_t)(b * 4 + (hh >> 1)) * SEQ * 128 + half * 64, q0, o, l, smem);
                const float rl = 1.f / l;
#pragma unroll
                for (int d = 0; d < 64; ++d) OD[((size_t)bh * SEQ + i) * 128 + half * 64 + d] = (bf16_t)f2bf(o[d] * rl);
            }
        } else {
            float o[64], l;
            nattn_rows<96, 64, 64>(QM + (size_t)bh * SEQ * 96, KM + (size_t)bh * SEQ * 96, VM + (size_t)bh * SEQ * 64, q0, o, l, smem);
            const float rl = 1.f / l; const size_t t = (size_t)b * SEQ + i;
#pragma unroll
            for (int d = 0; d < 64; ++d) { const size_t idx = t * 1024 + 512 + hh * 64 + d; YC[idx] = (bf16_t)f2bf(o[d] * rl * bf2f(G[idx])); }
        }
    }
}

__device__ __forceinline__ void phase25_naive(const Params& P, int bid, int nb) {
    bid = sgpr_op(bid); nb = sgpr_op(nb);
    const bf16_t* OD = (const bf16_t*)(P.ws + WS_OD); const bf16_t* G = (const bf16_t*)(P.ws + WS_G); bf16_t* YC = (bf16_t*)(P.ws + WS_YCAT);
    const float lam = ((const float*)(P.ws + WS_MISC))[0];
    const int tid = tid_op(), lane = tid & 63, wave = tid >> 6;
    const int gw = bid * (NT / 64) + wave, ngw = nb * (NT / 64);
    for (int it = gw; it < T * 4; it += ngw) {
        const int t = it >> 2, h = it & 3, b = t / SEQ, s = t % SEQ;
        const bf16_t* o0 = OD + ((size_t)(b * 8 + 2 * h) * SEQ + s) * 128; const bf16_t* o1 = OD + ((size_t)(b * 8 + 2 * h + 1) * SEQ + s) * 128;
        const float d0 = bf2f(o0[lane]) - lam * bf2f(o1[lane]), d1 = bf2f(o0[lane + 64]) - lam * bf2f(o1[lane + 64]);
        const float ss = wave_sum(d0 * d0 + d1 * d1);
        const float rstd = 1.0f / sqrtf(ss * (1.f / 128.f) + RMS_EPS);
        const size_t base = (size_t)t * 1024 + h * 128;
        YC[base + lane] = (bf16_t)f2bf(d0 * rstd * P.subln_g[lane] * (1.f - LAM_INIT) * bf2f(G[base + lane]));
        YC[base + lane + 64] = (bf16_t)f2bf(d1 * rstd * P.subln_g[lane + 64] * (1.f - LAM_INIT) * bf2f(G[base + lane + 64]));
    }
}

__device__ __forceinline__ void phase3_naive(const Params& P, int bid, int nb, float* smem) {
    bid = sgpr_op(bid); nb = sgpr_op(nb);
    const int tid = tid_op();
    const bf16_t* YC = (const bf16_t*)(P.ws + WS_YCAT); const bf16_t* PB = (const bf16_t*)(P.ws + WS_PB);
    bf16_t* HB = (bf16_t*)(P.ws + WS_HB); bf16_t* PLE = (bf16_t*)(P.ws + WS_PLE);
    float* Cs = smem + 16 * 129 + 16 * 65;
    constexpr int NRT = T / 128;
    for (int item = bid; item < 32 * NRT; item += nb) {
        const int ct = item % 32, rt = item / 32, row0 = rt * 128, col0 = (ct & 15) * 64;
        if (ct < 16) {
            ngemm_tile(YC, DM, row0, P.w_out, DM, col0, 64, DM, nullptr, smem);
            _Pragma("unroll 1") for (int e = tid; e < 128 * 64; e += NT) { const int r = e >> 6, c = e & 63; const size_t idx = (size_t)(row0 + r) * DM + col0 + c;
                const float h = P.x[idx] + Cs[r * 65 + c]; P.out[idx] = h; HB[idx] = (bf16_t)f2bf(h); }
        } else {
            ngemm_tile(PB, PLE_DIM, row0, P.w_ple, DM, col0, 64, PLE_DIM, nullptr, smem);
            _Pragma("unroll 1") for (int e = tid; e < 128 * 64; e += NT) { const int r = e >> 6, c = e & 63; const size_t idx = (size_t)(row0 + r) * DM + col0 + c; PLE[idx] = (bf16_t)f2bf(Cs[r * 65 + c]); }
        }
    }
}
__device__ __forceinline__ void phase4_naive(const Params& P, int bid, int nb, float* smem) {
    bid = sgpr_op(bid); nb = sgpr_op(nb);
    const int tid = tid_op();
    const bf16_t* HB = (const bf16_t*)(P.ws + WS_HB); const bf16_t* PLE = (const bf16_t*)(P.ws + WS_PLE); float* SSQF = (float*)(P.ws + WS_SSQF);
    float* Cs = smem + 16 * 129 + 16 * 65;
    constexpr int NRT = T / 128;
    for (int item = bid; item < 16 * NRT; item += nb) {
        const int ct = item % 16, rt = item / 16, row0 = rt * 128, col0 = ct * 64;
        ngemm_tile(HB, DM, row0, P.w_gate, DM, col0, 64, DM, nullptr, smem);
        _Pragma("unroll 1") for (int e = tid; e < 128 * 64; e += NT) { const int r = e >> 6, c = e & 63; const size_t idx = (size_t)(row0 + r) * DM + col0 + c;
            const float h2 = P.out[idx] + bf2f(PLE[idx]) * sigmoid_f(Cs[r * 65 + c]); P.out[idx] = h2; Cs[r * 65 + c] = h2; }
        __syncthreads();
        if (tid < 128) { float s = 0.f; _Pragma("unroll 4") for (int c = 0; c < 64; ++c) { const float v = Cs[tid * 65 + c]; s += v * v; } atomicAdd(SSQF + row0 + tid, s); }
    }
}
__device__ __forceinline__ void phase5(const Params& P, int bid, int nb) {
    bid = sgpr_op(bid); nb = sgpr_op(nb);
    const float* SSQF = (const float*)(P.ws + WS_SSQF);
    const int tid = tid_op(), lane = tid & 63, wave = tid >> 6;
    const int gw = bid * (NT / 64) + wave, ngw = nb * (NT / 64);
    for (int t = gw; t < T; t += ngw) {
        const float rstd = 1.0f / sqrtf(SSQF[t] * (1.f / DM) + RMS_EPS);
        float4* o = (float4*)(P.out + (size_t)t * DM);
#pragma unroll
        for (int j = 0; j < 4; ++j) { float4 v = o[lane + 64 * j]; const float4 g = ((const float4*)P.final_g)[lane + 64 * j];
            v.x *= rstd * g.x; v.y *= rstd * g.y; v.z *= rstd * g.z; v.w *= rstd * g.w; o[lane + 64 * j] = v; }
    }
}

namespace pg8 {
#define PG8_LAS __attribute__((address_space(3)))
typedef unsigned short bf16_t;
typedef short bf16x8 __attribute__((ext_vector_type(8)));
typedef float f32x4 __attribute__((ext_vector_type(4)));
typedef unsigned u32x4 __attribute__((ext_vector_type(4)));
constexpr int BM = 256, BK = 64, HALF = 128, HTB = HALF * BK * 2  , STAGE_BYTES = 8 * HTB, NXCD = 8, WGM = 8;

__host__ __device__ __forceinline__ int lds_byte(int r, int c) { const int st = (r >> 4) * 2 + (c >> 5), rr = r & 15, cc = c & 31, ob = rr * 64 + cc * 2; return st * 1024 + (ob ^ (((ob >> 9) & 1) << 5)); }
__host__ __device__ __forceinline__ void stage_rc(int b, int& R, int& C) { const int st = b / 1024, sb = b % 1024, swz = sb ^ (((sb >> 9) & 1) << 5); R = (st >> 1) * 16 + swz / 64; C = (st & 1) * 32 + (swz % 64) / 2; }
__host__ __device__ __forceinline__ int perm32(int rho) { const int n = rho >> 4, i = rho & 15; return 8 * (i >> 2) + 4 * n + (i & 3); }

struct Unit { int pm, pn; };
struct Gemm { const bf16_t* A; const bf16_t* Bt; int M, N, K, lda; };

struct StaticOrder {
    int nM, nN, nwg, G, c;
    __host__ __device__ void init(int M, int N, int G_, int c_) { nM = M / BM; nN = N / BM; nwg = nM * nN; G = G_; c = c_; }
    __host__ __device__ bool next(int i, Unit& u) const {
        const long L = (long)i * G + c; if (L >= nwg) return false;
        int wgid = (int)L; { const int q = nwg / NXCD, r = nwg % NXCD, xcd = wgid % NXCD, off = wgid / NXCD; wgid = (xcd < r ? xcd * (q + 1) : r * (q + 1) + (xcd - r) * q) + off; }
        const int nig = WGM * nN, gid = wgid / nig, fm = gid * WGM, gsz = (nM - fm) < WGM ? (nM - fm) : WGM;
        u.pm = fm + ((wgid % nig) % gsz); u.pn = (wgid % nig) / gsz; return true;
    }
    __device__ __forceinline__ void a_ready(const Unit&) const {}
    __device__ __forceinline__ void done(const Unit&) const {}
};

__device__ __forceinline__ unsigned cvt_pk_bf16(float lo, float hi) { unsigned r; asm volatile("v_cvt_pk_bf16_f32 %0, %1, %2" : "=v"(r) : "v"(lo), "v"(hi)); return r; }
template <class Epi, class Sched, bool ALIGN_EPI = false, bool SP2 = false>
__device__ __forceinline__ void gemm_phase(PG8_LAS unsigned char* lds, const Gemm g, const Sched& S, const Epi& E) {
    const int tid = tid_op(), wid = __builtin_amdgcn_readfirstlane(tid >> 6), lane = tid & 63, wr = wid >> 2, wc = wid & 3, fr = lane & 15, fq = lane >> 4;
    const int K = g.K, nt = K / BK;
    unsigned voffA[2], voffB[2];
#pragma unroll
    for (int i = 0; i < 2; ++i) { int R, C; stage_rc(tid * 16 + i * 8192, R, C); const int Rb = Epi::PERM ? ((R & ~31) + perm32(R & 31)) : R;
        voffA[i] = (unsigned)(R * g.lda + C) * 2u; voffB[i] = (unsigned)(Rb * K + C) * 2u; }
    const size_t kstep = (size_t)(BK * 2);
    const size_t hstepA = (size_t)HALF * g.lda * 2, hstepB = (size_t)HALF * K * 2;
    const size_t tstepA = 2 * hstepA, tstepB = 2 * hstepB;
    const unsigned ldsw = (unsigned)wid * 1024u;
    const int aoff = lds_byte(wr * 64 + fr, fq * 8), boff = lds_byte(wc * 32 + fr, fq * 8);
#define PG8_SA(b, h) (((b) * 2 + (h)) * HTB)
#define PG8_SB(b, h) ((4 + (b) * 2 + (h)) * HTB)
#define PG8_STAGE(bufoff, gbase, voff) do { _Pragma("unroll") for (int _i = 0; _i < 2; ++_i) \
        __builtin_amdgcn_global_load_lds((const unsigned*)((const char*)(gbase) + (voff)[_i]), (PG8_LAS unsigned*)(lds + (bufoff) + ldsw + _i * 8192), 16, 0, 0); } while (0)
#define PG8_LDA(dst, b, h) do { _Pragma("unroll") for (int m = 0; m < 4; ++m) _Pragma("unroll") for (int k = 0; k < 2; ++k) dst[m][k] = *(const PG8_LAS bf16x8*)(lds + PG8_SA(b, h) + aoff + m * 2048 + k * 1024); } while (0)
#define PG8_LDB(dst, b, h) do { _Pragma("unroll") for (int n = 0; n < 2; ++n) _Pragma("unroll") for (int k = 0; k < 2; ++k) dst[n][k] = *(const PG8_LAS bf16x8*)(lds + PG8_SB(b, h) + boff + n * 2048 + k * 1024); } while (0)
#define PG8_MMA(ai, bj, At, Bt) do { __builtin_amdgcn_s_setprio(1); _Pragma("unroll") for (int m = 0; m < 4; ++m) _Pragma("unroll") for (int n = 0; n < 2; ++n) _Pragma("unroll") for (int k = 0; k < 2; ++k) \
        acc[ai][bj][m][n] = __builtin_amdgcn_mfma_f32_16x16x32_bf16(Bt[n][k], At[m][k], acc[ai][bj][m][n], 0, 0, 0); __builtin_amdgcn_s_setprio(0); } while (0)
#define PG8_WAIT_V(n) asm volatile("s_waitcnt vmcnt(" #n ")" ::: "memory")
#define PG8_WAIT_L(n) asm volatile("s_waitcnt lgkmcnt(" #n ")" ::: "memory")
#define PG8_BAR __builtin_amdgcn_s_barrier()
#define PG8_SCHED __builtin_amdgcn_sched_barrier(0)
    Unit cur, nxt; int ui = 0;
    if (!S.next(0, cur)) return;
    f32x4 acc[2][2][4][2];
#pragma unroll
    for (int a = 0; a < 2; ++a)
#pragma unroll
        for (int b = 0; b < 2; ++b)
#pragma unroll
            for (int m = 0; m < 4; ++m)
#pragma unroll
                for (int n = 0; n < 2; ++n) acc[a][b][m][n] = (f32x4){0.f, 0.f, 0.f, 0.f};
    bf16x8 At[4][2], B0[2][2], B1[2][2];
    const char* cA = (const char*)g.A + (size_t)cur.pm * tstepA; const char* cB = (const char*)g.Bt + (size_t)cur.pn * tstepB;
    S.a_ready(cur);
    if constexpr (SP2) {
        PG8_STAGE(PG8_SB(0, 0), cB, voffB); PG8_STAGE(PG8_SB(0, 1), cB + hstepB, voffB); PG8_STAGE(PG8_SA(0, 0), cA, voffA); PG8_STAGE(PG8_SA(0, 1), cA + hstepA, voffA);
        if (wr == 1) PG8_BAR;
        PG8_WAIT_V(2); PG8_BAR;
        PG8_STAGE(PG8_SB(1, 0), cB + kstep, voffB); PG8_STAGE(PG8_SA(1, 0), cA + kstep, voffA); PG8_STAGE(PG8_SB(1, 1), cB + hstepB + kstep, voffB);
        PG8_WAIT_V(6); PG8_BAR;
    } else {
        PG8_STAGE(PG8_SB(0, 0), cB, voffB); PG8_STAGE(PG8_SA(0, 0), cA, voffA); PG8_STAGE(PG8_SB(0, 1), cB + hstepB, voffB); PG8_STAGE(PG8_SA(0, 1), cA + hstepA, voffA);
        if (wr == 1) PG8_BAR;
        PG8_WAIT_V(4); PG8_BAR;
        PG8_STAGE(PG8_SB(1, 0), cB + kstep, voffB); PG8_STAGE(PG8_SA(1, 0), cA + kstep, voffA); PG8_STAGE(PG8_SB(1, 1), cB + hstepB + kstep, voffB);
        PG8_WAIT_V(6); PG8_BAR;
    }
    for (;;) {
        const bool has_next = S.next(ui + 1, nxt);
        const char* nA = has_next ? (const char*)g.A + (size_t)nxt.pm * tstepA : cA; const char* nB = has_next ? (const char*)g.Bt + (size_t)nxt.pn * tstepB : cB;
#pragma unroll 1
        for (int t = 0; t < nt; t += 2) {
            const bool last = (t == nt - 2);
            const char* a1 = cA + (size_t)(t + 1) * kstep;
            const char* a2 = last ? nA : cA + (size_t)(t + 2) * kstep; const char* b2 = last ? nB : cB + (size_t)(t + 2) * kstep;
            const char* a3 = a2 + kstep; const char* b3 = b2 + kstep;
            if (last && has_next) S.a_ready(nxt);
            if constexpr (SP2) {
            PG8_LDB(B0, 0, 0); PG8_LDB(B1, 0, 1); PG8_SCHED; PG8_LDA(At, 0, 0); PG8_STAGE(PG8_SA(1, 1), a1 + hstepA, voffA);
            PG8_WAIT_V(8); PG8_WAIT_L(0); PG8_BAR; PG8_MMA(0, 0, At, B0); PG8_MMA(0, 1, At, B1); PG8_BAR; PG8_SCHED;
            PG8_LDA(At, 0, 1); PG8_STAGE(PG8_SB(0, 0), b2, voffB); PG8_STAGE(PG8_SB(0, 1), b2 + hstepB, voffB); PG8_STAGE(PG8_SA(0, 0), a2, voffA);
            PG8_WAIT_V(8); PG8_WAIT_L(0); PG8_BAR; PG8_MMA(1, 0, At, B0); PG8_MMA(1, 1, At, B1); PG8_BAR; PG8_SCHED;
            PG8_LDB(B0, 1, 0); PG8_LDB(B1, 1, 1); PG8_SCHED; PG8_LDA(At, 1, 0); PG8_STAGE(PG8_SA(0, 1), a2 + hstepA, voffA);
            PG8_WAIT_V(8); PG8_WAIT_L(0); PG8_BAR; PG8_MMA(0, 0, At, B0); PG8_MMA(0, 1, At, B1); PG8_BAR; PG8_SCHED;
            PG8_LDA(At, 1, 1); PG8_STAGE(PG8_SB(1, 0), b3, voffB); PG8_STAGE(PG8_SB(1, 1), b3 + hstepB, voffB); PG8_STAGE(PG8_SA(1, 0), a3, voffA);
            PG8_WAIT_V(8); PG8_WAIT_L(0); PG8_BAR; PG8_MMA(1, 0, At, B0); PG8_MMA(1, 1, At, B1); PG8_BAR; PG8_SCHED;
            } else {
            PG8_LDB(B0, 0, 0); PG8_SCHED; PG8_LDA(At, 0, 0); PG8_STAGE(PG8_SA(1, 1), a1 + hstepA, voffA);
            PG8_WAIT_L(8); PG8_BAR; PG8_WAIT_L(0); PG8_MMA(0, 0, At, B0); PG8_BAR; PG8_SCHED;
            PG8_LDB(B1, 0, 1); PG8_STAGE(PG8_SB(0, 0), b2, voffB);
            PG8_BAR; PG8_WAIT_L(0); PG8_MMA(0, 1, At, B1); PG8_BAR;
            PG8_LDA(At, 0, 1); PG8_STAGE(PG8_SA(0, 0), a2, voffA);
            PG8_BAR; PG8_WAIT_L(0); PG8_MMA(1, 0, At, B0); PG8_BAR; PG8_SCHED;
            PG8_STAGE(PG8_SB(0, 1), b2 + hstepB, voffB);
            PG8_WAIT_V(6); PG8_BAR; PG8_MMA(1, 1, At, B1); PG8_BAR;
            PG8_LDB(B0, 1, 0); PG8_SCHED; PG8_LDA(At, 1, 0); PG8_STAGE(PG8_SA(0, 1), a2 + hstepA, voffA);
            PG8_WAIT_L(8); PG8_BAR; PG8_WAIT_L(0); PG8_MMA(0, 0, At, B0); PG8_BAR; PG8_SCHED;
            PG8_LDB(B1, 1, 1); PG8_STAGE(PG8_SB(1, 0), b3, voffB);
            PG8_BAR; PG8_WAIT_L(0); PG8_MMA(0, 1, At, B1); PG8_BAR;
            PG8_LDA(At, 1, 1); PG8_STAGE(PG8_SA(1, 0), a3, voffA);
            PG8_BAR; PG8_WAIT_L(0); PG8_MMA(1, 0, At, B0); PG8_BAR; PG8_SCHED;
            PG8_STAGE(PG8_SB(1, 1), b3 + hstepB, voffB);
            PG8_WAIT_V(6); PG8_BAR; PG8_MMA(1, 1, At, B1); PG8_BAR;
            }
        }
        if constexpr (ALIGN_EPI) { if (wr == 0) PG8_BAR; }
        if constexpr (!Epi::AFTER_DRAIN) { E(acc, cur, wr, wc, fr, fq); S.done(cur); }
        if (!has_next) break;
#pragma unroll
        for (int a = 0; a < 2; ++a)
#pragma unroll
            for (int b = 0; b < 2; ++b)
#pragma unroll
                for (int m = 0; m < 4; ++m)
#pragma unroll
                    for (int n = 0; n < 2; ++n) acc[a][b][m][n] = (f32x4){0.f, 0.f, 0.f, 0.f};
        cur = nxt; cA = nA; cB = nB; ++ui;
        if constexpr (ALIGN_EPI) { if (wr == 1) PG8_BAR; }
    }
    PG8_WAIT_V(0);
    if constexpr (!ALIGN_EPI) { if (wr == 0) PG8_BAR; }
    PG8_BAR;
    if constexpr (Epi::AFTER_DRAIN) { E.fused(acc, cur, wr, wc, fr, fq, lds, wid, lane); S.done(cur); }
#undef PG8_SA
#undef PG8_SB
#undef PG8_STAGE
#undef PG8_LDA
#undef PG8_LDB
#undef PG8_MMA
#undef PG8_WAIT_V
#undef PG8_WAIT_L
#undef PG8_BAR
#undef PG8_SCHED
}
}

#define LAS __attribute__((address_space(3)))
typedef float f32x4 __attribute__((ext_vector_type(4)));
typedef unsigned u32x4 __attribute__((ext_vector_type(4)));
using pg8::cvt_pk_bf16;
__device__ __forceinline__ u32x4 pack8(const f32x4 a, const f32x4 b) { u32x4 w; w.x = cvt_pk_bf16(a[0], a[1]); w.y = cvt_pk_bf16(a[2], a[3]); w.z = cvt_pk_bf16(b[0], b[1]); w.w = cvt_pk_bf16(b[2], b[3]); return w; }

struct MapIn {
    __device__ __forceinline__ int operator()(int g) const { const int pn = g >> 8, cc = g & 255, bj = cc >> 7, w = cc & 127;
        if (pn < 2) return OFF_DQ + (4 * pn + (w >> 5)) * 64 + bj * 32 + (w & 31);
        if (pn < 4) return OFF_DK + (4 * (pn - 2) + (w >> 5)) * 64 + bj * 32 + (w & 31);
        if (pn < 6) return OFF_DV + (pn - 4) * 256 + cc;
        if (pn < 8) return OFF_DG + (pn - 6) * 256 + cc;
        if (pn == 8) return OFF_CQ + cc;
        if (pn == 9) return bj == 0 ? OFF_CQ + 256 + w : OFF_CKV + w;
        if (pn < 12) return OFF_MG + (pn - 10) * 256 + cc;
        return w < 16 ? OFF_KR + bj * 16 + w : -1; } };
struct MapUq {
    __device__ __forceinline__ int operator()(int g) const { const int pn = g >> 8, cc = g & 255;
        if (pn == 0) { const int bj = cc >> 7, w = cc & 127; return (w >> 4) * 96 + 64 + bj * 16 + (w & 15); }
        const int gp = g - 256; return (gp >> 6) * 96 + (gp & 63); } };
struct MapId { __device__ __forceinline__ int operator()(int g) const { return g; } };
template <class Map>
__device__ __forceinline__ void wconv(const float* W, int K, int ldw, const float* kscale, bf16_t* Wt, int ldwt, int kdst_off, int Ng, Map map, LAS float* scr, int gw, int ngw, int lane) {
    const int nblk = Ng / 32, items = (K / 64) * nblk;
    for (int it = gw; it < items; it += ngw) {
        const int kb = it / nblk, nbk = it % nblk, k0 = 64 * kb, n0 = 32 * nbk;
        const int src = map(n0 + (lane & 31));
#pragma unroll 8
        for (int i = 0; i < 32; ++i) { const int kk = 2 * i + (lane >> 5);
            float v = 0.f; if (src >= 0) { v = W[(size_t)(k0 + kk) * ldw + src]; if (kscale) v *= kscale[k0 + kk]; }
            scr[kk * 33 + (lane & 31)] = v; }
        asm volatile("s_waitcnt lgkmcnt(0)" ::: "memory");
        const int c = lane & 7;
#pragma unroll
        for (int j = 0; j < 4; ++j) { const int n = (lane >> 3) + 8 * j; const LAS float* sp = scr + (8 * c) * 33 + n;
            u32x4 o; o.x = f2bf(sp[0]) | (f2bf(sp[33]) << 16); o.y = f2bf(sp[2 * 33]) | (f2bf(sp[3 * 33]) << 16); o.z = f2bf(sp[4 * 33]) | (f2bf(sp[5 * 33]) << 16); o.w = f2bf(sp[6 * 33]) | (f2bf(sp[7 * 33]) << 16);
            *(u32x4*)(Wt + (size_t)(n0 + n) * ldwt + kdst_off + k0 + 8 * c) = o; }
        asm volatile("s_waitcnt lgkmcnt(0)" ::: "memory");
    }
}
constexpr int NIN = 13 * 256;
__device__ __forceinline__ void phase0_weights(const Params& P, int bid, int nb, LAS unsigned char* lds) {
    const int tid = tid_op(), lane = tid & 63, wave = tid >> 6;
    const int gw = bid * (NT / 64) + wave, ngw = nb * (NT / 64);
    LAS float* scr = (LAS float*)(lds + wave * 16384);
    wconv(P.w_in, DM, DIN, nullptr, (bf16_t*)(P.ws + WS_WIN), DM, 0, NIN, MapIn(), scr, gw, ngw, lane);
    wconv(P.w_ple, PLE_DIM, DM, nullptr, (bf16_t*)(P.ws + WS_WPLE), PLE_DIM, 0, DM, MapId(), scr, gw, ngw, lane);
    wconv(P.w_uq, QLORA, 768, P.qn_g, (bf16_t*)(P.ws + WS_WUQ), QLORA, 0, 768, MapUq(), scr, gw, ngw, lane);
    wconv(P.w_ukv, KVLORA, 1024, P.kvn_g, (bf16_t*)(P.ws + WS_WUKV), 256, 128, 1024, MapId(), scr, gw, ngw, lane);
    wconv(P.w_out, DM, DM, nullptr, (bf16_t*)(P.ws + WS_WOUT), DM, 0, DM, MapId(), scr, gw, ngw, lane);
    wconv(P.w_gate, DM, DM, nullptr, (bf16_t*)(P.ws + WS_WG), DM, 0, DM, MapId(), scr, gw, ngw, lane);
    u32x4* z = (u32x4*)(P.ws + WS_WUKV);
    for (int i = bid * NT + tid; i < 1024 * 16; i += nb * NT) { const int g = i >> 4, c = i & 15; z[g * 32 + c] = (u32x4){0u, 0u, 0u, 0u}; }
}

struct Epi1 {
    static constexpr bool PERM = true, AFTER_DRAIN = false;
    bf16_t *QD, *KD, *VD, *G, *CQ, *KM; float *SSQQ, *SSQKV; const float2 *CSA, *CSB;
    __device__ __forceinline__ void operator()(const f32x4 (&acc)[2][2][4][2], const pg8::Unit& u, int wr, int wc, int fr, int fq) const {
        const int pn = u.pn, b = u.pm >> 4, s0 = (u.pm & 15) * 256 + wr * 64 + fr, t0 = u.pm * 256 + wr * 64 + fr;
        if (pn < 4) {
            bf16_t* dst = pn < 2 ? QD : KD; const float sc = pn < 2 ? C2D : 1.f; const int mh = 4 * (pn & 1) + wc;
            f32x4 csb[2][4];
            { const f32x4* cs = (const f32x4*)(CSA + (size_t)t0 * 32 + 8 * fq);
#pragma unroll
              for (int k = 0; k < 4; ++k) csb[0][k] = cs[k]; }
#pragma unroll
            for (int g = 0; g < 8; ++g) { const int ai = g >> 2, m = g & 3, ro = ai * 128 + m * 16;
                if (g + 1 < 8) { const int ro2 = ((g + 1) >> 2) * 128 + ((g + 1) & 3) * 16; const f32x4* cs = (const f32x4*)(CSA + (size_t)(t0 + ro2) * 32 + 8 * fq);
#pragma unroll
                    for (int k = 0; k < 4; ++k) csb[(g + 1) & 1][k] = cs[k]; }
                asm volatile("" ::: "memory");
                f32x4 o1[2], o2[2];
#pragma unroll
                for (int n = 0; n < 2; ++n) { const f32x4 ca = csb[g & 1][2 * n], cb = csb[g & 1][2 * n + 1]; const f32x4 x1 = acc[ai][0][m][n], x2 = acc[ai][1][m][n];
                    o1[n] = (f32x4){x1[0] * ca[0] - x2[0] * ca[1], x1[1] * ca[2] - x2[1] * ca[3], x1[2] * cb[0] - x2[2] * cb[1], x1[3] * cb[2] - x2[3] * cb[3]} * sc;
                    o2[n] = (f32x4){x2[0] * ca[0] + x1[0] * ca[1], x2[1] * ca[2] + x1[1] * ca[3], x2[2] * cb[0] + x1[2] * cb[1], x2[3] * cb[2] + x1[3] * cb[3]} * sc; }
                bf16_t* rp = dst + ((size_t)(b * 8 + mh) * SEQ + s0 + ro) * 64 + 8 * fq;
                *(u32x4*)rp = pack8(o1[0], o1[1]); *(u32x4*)(rp + 32) = pack8(o2[0], o2[1]); asm volatile("" ::: "memory"); }
        } else if (pn < 6) {
#pragma unroll
            for (int ai = 0; ai < 2; ++ai)
#pragma unroll
                for (int m = 0; m < 4; ++m)
#pragma unroll
                    for (int bj = 0; bj < 2; ++bj) { const int ro = ai * 128 + m * 16, h = 2 * (pn - 4) + bj;
                        *(u32x4*)(VD + ((size_t)(b * 4 + h) * SEQ + s0 + ro) * 128 + 32 * wc + 8 * fq) = pack8(acc[ai][bj][m][0], acc[ai][bj][m][1]); }
        } else if (pn < 8 || pn == 10 || pn == 11) {
            const int cb = (pn < 8 ? (pn - 6) * 256 : 512 + (pn - 10) * 256) + 32 * wc + 8 * fq;
#pragma unroll
            for (int ai = 0; ai < 2; ++ai)
#pragma unroll
                for (int m = 0; m < 4; ++m)
#pragma unroll
                    for (int bj = 0; bj < 2; ++bj) { const int ro = ai * 128 + m * 16; f32x4 a = acc[ai][bj][m][0], c = acc[ai][bj][m][1];
#pragma unroll
                        for (int j = 0; j < 4; ++j) { a[j] = silu_f(a[j]); c[j] = silu_f(c[j]); }
                        *(u32x4*)(G + (size_t)(t0 + ro) * 1024 + cb + 128 * bj) = pack8(a, c); }
        } else if (pn < 10) {
#pragma unroll
            for (int ai = 0; ai < 2; ++ai)
#pragma unroll
                for (int m = 0; m < 4; ++m) { const int ro = ai * 128 + m * 16; float ss[2];
#pragma unroll
                    for (int bj = 0; bj < 2; ++bj) { const f32x4 a = acc[ai][bj][m][0], c = acc[ai][bj][m][1];
                        *(u32x4*)(CQ + (size_t)(t0 + ro) * CQP + (pn - 8) * 256 + 128 * bj + 32 * wc + 8 * fq) = pack8(a, c);
                        float q = (a[0] * a[0] + a[1] * a[1]) + (a[2] * a[2] + a[3] * a[3]) + (c[0] * c[0] + c[1] * c[1]) + (c[2] * c[2] + c[3] * c[3]);
                        q += __shfl_xor(q, 16); q += __shfl_xor(q, 32); ss[bj] = q; }
                    if (fq == 0) { if (pn == 8) atomicAdd(SSQQ + t0 + ro, ss[0] + ss[1]); else { atomicAdd(SSQQ + t0 + ro, ss[0]); atomicAdd(SSQKV + t0 + ro, ss[1]); } } }
        } else {
            if (wc == 0 && fq < 2) {
#pragma unroll
                for (int ai = 0; ai < 2; ++ai)
#pragma unroll
                    for (int m = 0; m < 4; ++m) { const int ro = ai * 128 + m * 16; const f32x4* cs = (const f32x4*)(CSB + (size_t)(t0 + ro) * 16 + 8 * fq);
                        f32x4 o1[2], o2[2];
#pragma unroll
                        for (int n = 0; n < 2; ++n) { const f32x4 ca = cs[2 * n], cb = cs[2 * n + 1]; const f32x4 x1 = acc[ai][0][m][n], x2 = acc[ai][1][m][n];
                            o1[n] = (f32x4){x1[0] * ca[0] - x2[0] * ca[1], x1[1] * ca[2] - x2[1] * ca[3], x1[2] * cb[0] - x2[2] * cb[1], x1[3] * cb[2] - x2[3] * cb[3]};
                            o2[n] = (f32x4){x2[0] * ca[0] + x1[0] * ca[1], x2[1] * ca[2] + x1[1] * ca[3], x2[2] * cb[0] + x1[2] * cb[1], x2[3] * cb[2] + x1[3] * cb[3]}; }
                        const u32x4 w1 = pack8(o1[0], o1[1]), w2 = pack8(o2[0], o2[1]);
#pragma unroll
                        for (int h = 0; h < 8; ++h) { bf16_t* rp = KM + ((size_t)(b * 8 + h) * SEQ + s0 + ro) * 96 + 64 + 8 * fq; *(u32x4*)rp = w1; *(u32x4*)(rp + 16) = w2; } }
            }
        }
    }
};
struct EpiStore {
    static constexpr bool PERM = true, AFTER_DRAIN = false;
    bf16_t* O; int ldc;
    __device__ __forceinline__ void operator()(const f32x4 (&acc)[2][2][4][2], const pg8::Unit& u, int wr, int wc, int fr, int fq) const {
        const int t0 = u.pm * 256 + wr * 64 + fr, c0 = u.pn * 256 + 32 * wc + 8 * fq;
#pragma unroll
        for (int ai = 0; ai < 2; ++ai)
#pragma unroll
            for (int m = 0; m < 4; ++m)
#pragma unroll
                for (int bj = 0; bj < 2; ++bj) *(u32x4*)(O + (size_t)(t0 + ai * 128 + m * 16) * ldc + c0 + 128 * bj) = pack8(acc[ai][bj][m][0], acc[ai][bj][m][1]);
    }
};
struct EpiQ {
    static constexpr bool PERM = true, AFTER_DRAIN = false;
    bf16_t* QM; const float* SSQQ; const float2* CSB;
    __device__ __forceinline__ void operator()(const f32x4 (&acc)[2][2][4][2], const pg8::Unit& u, int wr, int wc, int fr, int fq) const {
        const int pn = u.pn, b = u.pm >> 4, s0 = (u.pm & 15) * 256 + wr * 64 + fr, t0 = u.pm * 256 + wr * 64 + fr;
        float ssq[8];
#pragma unroll
        for (int g = 0; g < 8; ++g) ssq[g] = SSQQ[t0 + (g >> 2) * 128 + (g & 3) * 16];
        if (pn == 0) { const int h = 2 * wc + (fq >> 1), i0 = 8 * (fq & 1);
            f32x4 csb[2][4];
            { const f32x4* cs = (const f32x4*)(CSB + (size_t)t0 * 16 + i0);
#pragma unroll
              for (int k = 0; k < 4; ++k) csb[0][k] = cs[k]; }
#pragma unroll
            for (int g = 0; g < 8; ++g) { const int ai = g >> 2, m = g & 3, ro = ai * 128 + m * 16; const float sc = C2M * __builtin_amdgcn_rsqf(ssq[g] * (1.f / QLORA) + RMS_EPS);
                if (g + 1 < 8) { const int ro2 = ((g + 1) >> 2) * 128 + ((g + 1) & 3) * 16; const f32x4* cs = (const f32x4*)(CSB + (size_t)(t0 + ro2) * 16 + i0);
#pragma unroll
                    for (int k = 0; k < 4; ++k) csb[(g + 1) & 1][k] = cs[k]; }
                asm volatile("" ::: "memory");
                f32x4 o1[2], o2[2];
#pragma unroll
                for (int n = 0; n < 2; ++n) { const f32x4 ca = csb[g & 1][2 * n], cb = csb[g & 1][2 * n + 1]; const f32x4 x1 = acc[ai][0][m][n], x2 = acc[ai][1][m][n];
                    o1[n] = (f32x4){x1[0] * ca[0] - x2[0] * ca[1], x1[1] * ca[2] - x2[1] * ca[3], x1[2] * cb[0] - x2[2] * cb[1], x1[3] * cb[2] - x2[3] * cb[3]} * sc;
                    o2[n] = (f32x4){x2[0] * ca[0] + x1[0] * ca[1], x2[1] * ca[2] + x1[1] * ca[3], x2[2] * cb[0] + x1[2] * cb[1], x2[3] * cb[2] + x1[3] * cb[3]} * sc; }
                bf16_t* rp = QM + ((size_t)(b * 8 + h) * SEQ + s0 + ro) * 96 + 64 + i0;
                *(u32x4*)rp = pack8(o1[0], o1[1]); *(u32x4*)(rp + 16) = pack8(o2[0], o2[1]); asm volatile("" ::: "memory"); }
        } else {
#pragma unroll
            for (int g = 0; g < 8; ++g) { const int ai = g >> 2, m = g & 3, ro = ai * 128 + m * 16; const float sc = C2M * __builtin_amdgcn_rsqf(ssq[g] * (1.f / QLORA) + RMS_EPS);
#pragma unroll
                for (int bj = 0; bj < 2; ++bj) { const int h = 4 * (pn - 1) + 2 * bj + (wc >> 1), d = 32 * (wc & 1) + 8 * fq;
                    *(u32x4*)(QM + ((size_t)(b * 8 + h) * SEQ + s0 + ro) * 96 + d) = pack8(acc[ai][bj][m][0] * sc, acc[ai][bj][m][1] * sc); } }
        }
    }
};
struct EpiKV {
    static constexpr bool PERM = true, AFTER_DRAIN = false;
    bf16_t *KM, *VM; const float* SSQKV;
    __device__ __forceinline__ void operator()(const f32x4 (&acc)[2][2][4][2], const pg8::Unit& u, int wr, int wc, int fr, int fq) const {
        const int pn = u.pn, b = u.pm >> 4, s0 = (u.pm & 15) * 256 + wr * 64 + fr, t0 = u.pm * 256 + wr * 64 + fr;
        float ssq[8];
#pragma unroll
        for (int g = 0; g < 8; ++g) ssq[g] = SSQKV[t0 + (g >> 2) * 128 + (g & 3) * 16];
#pragma unroll
        for (int g = 0; g < 8; ++g) { const int ai = g >> 2, m = g & 3, ro = ai * 128 + m * 16; const float sc = __builtin_amdgcn_rsqf(ssq[g] * (1.f / KVLORA) + RMS_EPS);
#pragma unroll
            for (int bj = 0; bj < 2; ++bj) { const int h = 2 * pn + bj; const size_t rowi = (size_t)(b * 8 + h) * SEQ + s0 + ro;
                bf16_t* rp = (wc < 2) ? KM + rowi * 96 + 32 * wc + 8 * fq : VM + rowi * 64 + 32 * (wc - 2) + 8 * fq;
                *(u32x4*)rp = pack8(acc[ai][bj][m][0] * sc, acc[ai][bj][m][1] * sc); } }
    }
};
struct Epi3 {
    static constexpr bool PERM = true, AFTER_DRAIN = false;
    const float* x; bf16_t* HB;
    __device__ __forceinline__ void operator()(const f32x4 (&acc)[2][2][4][2], const pg8::Unit& u, int wr, int wc, int fr, int fq) const {
        const int t0 = u.pm * 256 + wr * 64 + fr, c0 = u.pn * 256 + 32 * wc + 8 * fq;
        f32x4 xb[2][4];
#pragma unroll
        for (int bj = 0; bj < 2; ++bj) { const size_t idx = (size_t)t0 * DM + c0 + 128 * bj; xb[0][2 * bj] = *(const f32x4*)(x + idx); xb[0][2 * bj + 1] = *(const f32x4*)(x + idx + 4); }
#pragma unroll
        for (int g = 0; g < 8; ++g) { const int ai = g >> 2, m = g & 3;
            if (g + 1 < 8) { const int r2 = ((g + 1) >> 2) * 128 + ((g + 1) & 3) * 16;
#pragma unroll
                for (int bj = 0; bj < 2; ++bj) { const size_t idx = (size_t)(t0 + r2) * DM + c0 + 128 * bj; xb[(g + 1) & 1][2 * bj] = *(const f32x4*)(x + idx); xb[(g + 1) & 1][2 * bj + 1] = *(const f32x4*)(x + idx + 4); } }
            asm volatile("" ::: "memory");
#pragma unroll
            for (int bj = 0; bj < 2; ++bj) { const size_t idx = (size_t)(t0 + ai * 128 + m * 16) * DM + c0 + 128 * bj;
                *(u32x4*)(HB + idx) = pack8(xb[g & 1][2 * bj] + acc[ai][bj][m][0], xb[g & 1][2 * bj + 1] + acc[ai][bj][m][1]); }
            asm volatile("" ::: "memory"); }
    }
};
struct Epi4 {
    static constexpr bool PERM = true, AFTER_DRAIN = false;
    float* out; const bf16_t* HB; const bf16_t* PLE; float* SSQF;
    __device__ __forceinline__ void operator()(const f32x4 (&acc)[2][2][4][2], const pg8::Unit& u, int wr, int wc, int fr, int fq) const {
        const int t0 = u.pm * 256 + wr * 64 + fr, c0 = u.pn * 256 + 32 * wc + 8 * fq;
        u32x4 hb[2][2], pb[2][2];
#pragma unroll
        for (int bj = 0; bj < 2; ++bj) { const size_t idx = (size_t)t0 * DM + c0 + 128 * bj; hb[0][bj] = *(const u32x4*)(HB + idx); pb[0][bj] = *(const u32x4*)(PLE + idx); }
#pragma unroll
        for (int g = 0; g < 8; ++g) { const int ai = g >> 2, m = g & 3;
            if (g + 1 < 8) { const int r2 = ((g + 1) >> 2) * 128 + ((g + 1) & 3) * 16;
#pragma unroll
                for (int bj = 0; bj < 2; ++bj) { const size_t idx = (size_t)(t0 + r2) * DM + c0 + 128 * bj; hb[(g + 1) & 1][bj] = *(const u32x4*)(HB + idx); pb[(g + 1) & 1][bj] = *(const u32x4*)(PLE + idx); } }
            asm volatile("" ::: "memory");
            float q = 0.f;
#pragma unroll
            for (int bj = 0; bj < 2; ++bj) { const size_t idx = (size_t)(t0 + ai * 128 + m * 16) * DM + c0 + 128 * bj;
                const u32x4 hw = hb[g & 1][bj], pw = pb[g & 1][bj]; const f32x4 a = acc[ai][bj][m][0], c = acc[ai][bj][m][1]; f32x4 h0, h1;
                h0[0] = __uint_as_float(hw.x << 16) + __uint_as_float(pw.x << 16) * sigmoid_f(a[0]); h0[1] = __uint_as_float(hw.x & 0xffff0000u) + __uint_as_float(pw.x & 0xffff0000u) * sigmoid_f(a[1]);
                h0[2] = __uint_as_float(hw.y << 16) + __uint_as_float(pw.y << 16) * sigmoid_f(a[2]); h0[3] = __uint_as_float(hw.y & 0xffff0000u) + __uint_as_float(pw.y & 0xffff0000u) * sigmoid_f(a[3]);
                h1[0] = __uint_as_float(hw.z << 16) + __uint_as_float(pw.z << 16) * sigmoid_f(c[0]); h1[1] = __uint_as_float(hw.z & 0xffff0000u) + __uint_as_float(pw.z & 0xffff0000u) * sigmoid_f(c[1]);
                h1[2] = __uint_as_float(hw.w << 16) + __uint_as_float(pw.w << 16) * sigmoid_f(c[2]); h1[3] = __uint_as_float(hw.w & 0xffff0000u) + __uint_as_float(pw.w & 0xffff0000u) * sigmoid_f(c[3]);
                *(f32x4*)(out + idx) = h0; *(f32x4*)(out + idx + 4) = h1;
                q += (h0[0] * h0[0] + h0[1] * h0[1]) + (h0[2] * h0[2] + h0[3] * h0[3]) + (h1[0] * h1[0] + h1[1] * h1[1]) + (h1[2] * h1[2] + h1[3] * h1[3]); }
            q += __shfl_xor(q, 16); q += __shfl_xor(q, 32);
            if (fq == 0) atomicAdd(SSQF + t0 + ai * 128 + m * 16, q);
            asm volatile("" ::: "memory"); }
    }
};

#ifndef PG8_SP2
#define PG8_SP2 true
#endif
#ifndef PG8_ALIGN
#define PG8_ALIGN true
#endif
__device__ __forceinline__ void phase1_gemm(const Params& P, LAS unsigned char* lds) {
    pg8::Gemm g{(const bf16_t*)(P.ws + WS_XN), (const bf16_t*)(P.ws + WS_WIN), T, NIN, DM, DM}; pg8::StaticOrder S; S.init(T, NIN, (int)gridDim.x, (int)blockIdx.x);
    Epi1 E{(bf16_t*)(P.ws + WS_QD), (bf16_t*)(P.ws + WS_KD), (bf16_t*)(P.ws + WS_VD), (bf16_t*)(P.ws + WS_G), (bf16_t*)(P.ws + WS_CQ), (bf16_t*)(P.ws + WS_KM),
           (float*)(P.ws + WS_SSQQ), (float*)(P.ws + WS_SSQKV), (const float2*)(P.ws + WS_CSA), (const float2*)(P.ws + WS_CSB)};
    pg8::gemm_phase<Epi1, pg8::StaticOrder, PG8_ALIGN, PG8_SP2>(lds, g, S, E);
}
__device__ __forceinline__ void phase15_gemm(const Params& P, LAS unsigned char* lds) {
    { pg8::Gemm g{(const bf16_t*)(P.ws + WS_CQ), (const bf16_t*)(P.ws + WS_WUQ), T, 768, QLORA, CQP}; pg8::StaticOrder S; S.init(T, 768, (int)gridDim.x, (int)blockIdx.x);
      EpiQ E{(bf16_t*)(P.ws + WS_QM), (const float*)(P.ws + WS_SSQQ), (const float2*)(P.ws + WS_CSB)};
      pg8::gemm_phase<EpiQ, pg8::StaticOrder, PG8_ALIGN, PG8_SP2>(lds, g, S, E); }
    { pg8::Gemm g{(const bf16_t*)(P.ws + WS_CQ) + 256, (const bf16_t*)(P.ws + WS_WUKV), T, 1024, 256, CQP}; pg8::StaticOrder S; S.init(T, 1024, (int)gridDim.x, (int)blockIdx.x);
      EpiKV E{(bf16_t*)(P.ws + WS_KM), (bf16_t*)(P.ws + WS_VM), (const float*)(P.ws + WS_SSQKV)};
      pg8::gemm_phase<EpiKV, pg8::StaticOrder, PG8_ALIGN, PG8_SP2>(lds, g, S, E); }
}
__device__ __forceinline__ void phase3_gemm(const Params& P, LAS unsigned char* lds) {
    { pg8::Gemm g{(const bf16_t*)(P.ws + WS_YCAT), (const bf16_t*)(P.ws + WS_WOUT), T, DM, DM, DM}; pg8::StaticOrder S; S.init(T, DM, (int)gridDim.x, (int)blockIdx.x);
      Epi3 E{P.x, (bf16_t*)(P.ws + WS_HB)};
      pg8::gemm_phase<Epi3, pg8::StaticOrder, PG8_ALIGN, PG8_SP2>(lds, g, S, E); }
    { pg8::Gemm g{(const bf16_t*)(P.ws + WS_PB), (const bf16_t*)(P.ws + WS_WPLE), T, DM, PLE_DIM, PLE_DIM}; pg8::StaticOrder S; S.init(T, DM, (int)gridDim.x, (int)blockIdx.x);
      EpiStore E{(bf16_t*)(P.ws + WS_PLE), DM};
      pg8::gemm_phase<EpiStore, pg8::StaticOrder, PG8_ALIGN, PG8_SP2>(lds, g, S, E); }
}
__device__ __forceinline__ void phase4_gemm(const Params& P, LAS unsigned char* lds) {
    pg8::Gemm g{(const bf16_t*)(P.ws + WS_HB), (const bf16_t*)(P.ws + WS_WG), T, DM, DM, DM}; pg8::StaticOrder S; S.init(T, DM, (int)gridDim.x, (int)blockIdx.x);
    Epi4 E{P.out, (const bf16_t*)(P.ws + WS_HB), (const bf16_t*)(P.ws + WS_PLE), (float*)(P.ws + WS_SSQF)};
    pg8::gemm_phase<Epi4, pg8::StaticOrder, PG8_ALIGN, PG8_SP2>(lds, g, S, E);
}

namespace att {
typedef short bf16x8 __attribute__((ext_vector_type(8)));
typedef short s16x4 __attribute__((ext_vector_type(4)));
typedef float f32x16 __attribute__((ext_vector_type(16)));
#define SBAR() __builtin_amdgcn_sched_barrier(0)
constexpr float THR = 8.f;
constexpr int BUF_BYTES = 32768, K_OFF = 0, V_OFF = 16384;
constexpr int WS_OFF = 2 * BUF_BYTES;
constexpr int ATT_LDS_BYTES = WS_OFF + 8 * 64 * 4;
__device__ __forceinline__ int crow(int r, int hi) { return (r & 3) + 8 * (r >> 2) + 4 * hi; }
__device__ __forceinline__ unsigned cvtpk(float lo, float hi) { unsigned r; asm volatile("v_cvt_pk_bf16_f32 %0, %1, %2" : "=v"(r) : "v"(lo), "v"(hi)); return r; }

__device__ __forceinline__ void partialSM(f32x16& p0, f32x16& p1, float& m_reg, float& alpha) {
    float pmax = p0[0];
#pragma unroll
    for (int r = 1; r < 16; ++r) pmax = fmaxf(pmax, p0[r]);
#pragma unroll
    for (int r = 0; r < 16; ++r) pmax = fmaxf(pmax, p1[r]);
    { auto rr = __builtin_amdgcn_permlane32_swap(__float_as_uint(pmax), __float_as_uint(pmax), false, false); pmax = fmaxf(__uint_as_float(rr[0]), __uint_as_float(rr[1])); }
    float mn;
    if (__builtin_expect(__all(pmax - m_reg <= THR), 1)) { mn = m_reg; alpha = 1.f; }
    else { mn = fmaxf(m_reg, pmax); alpha = __builtin_amdgcn_exp2f(m_reg - mn); m_reg = mn; }
#pragma unroll
    for (int r = 0; r < 16; ++r) { p0[r] -= mn; p1[r] -= mn; }
#pragma unroll
    for (int r = 0; r < 16; ++r) p0[r] = __builtin_amdgcn_exp2f(p0[r]);
}
__device__ __forceinline__ void finishSM(f32x16& p0, f32x16& p1, float alpha, float& l_reg, bf16x8& pa0, bf16x8& pa1, bf16x8& pa2, bf16x8& pa3) {
#pragma unroll
    for (int r = 0; r < 16; ++r) p1[r] = __builtin_amdgcn_exp2f(p1[r]);
    float ps = 0.f;
#pragma unroll
    for (int r = 0; r < 16; ++r) ps += p0[r];
#pragma unroll
    for (int r = 0; r < 16; ++r) ps += p1[r];
    { auto rr = __builtin_amdgcn_permlane32_swap(__float_as_uint(ps), __float_as_uint(ps), false, false); ps = __uint_as_float(rr[0]) + __uint_as_float(rr[1]); }
    l_reg = l_reg * alpha + ps;
#define PK4(P, BASE, OUT) do { unsigned a0 = cvtpk(P[BASE + 0], P[BASE + 1]), a1 = cvtpk(P[BASE + 2], P[BASE + 3]);   \
    unsigned b0 = cvtpk(P[BASE + 4], P[BASE + 5]), b1 = cvtpk(P[BASE + 6], P[BASE + 7]);                              \
    auto r0 = __builtin_amdgcn_permlane32_swap(a0, b0, false, false); auto r1 = __builtin_amdgcn_permlane32_swap(a1, b1, false, false); \
    u32x4 w = {r0[0], r1[0], r0[1], r1[1]}; OUT = __builtin_bit_cast(bf16x8, w); } while (0)
    PK4(p0, 0, pa0); PK4(p0, 8, pa1); PK4(p1, 0, pa2); PK4(p1, 8, pa3);
#undef PK4
}
__device__ __forceinline__ void cmask(f32x16& p0, f32x16& p1, int jb, int qrel, int hi) {
    const int kb = 64 * jb + 4 * hi;
#pragma unroll
    for (int r = 0; r < 16; ++r) { const int kv = kb + (r & 3) + 8 * (r >> 2); if (kv > qrel) p0[r] = -INFINITY; if (kv + 32 > qrel) p1[r] = -INFINITY; }
}
template <int DQK> __device__ __forceinline__ void qkt(f32x16& p0, f32x16& p1, LAS const unsigned char* kp  , const bf16x8* qr) {
    constexpr int PITCH = 2 * DQK + 16;
    p0 = f32x16{}; p1 = f32x16{};
#pragma unroll
    for (int d0 = 0; d0 < DQK / 16; ++d0) {
        const bf16x8 b0 = *(LAS const bf16x8*)(kp + d0 * 32), b1 = *(LAS const bf16x8*)(kp + 32 * PITCH + d0 * 32);
        p0 = __builtin_amdgcn_mfma_f32_32x32x16_bf16(b0, qr[d0], p0, 0, 0, 0);
        p1 = __builtin_amdgcn_mfma_f32_32x32x16_bf16(b1, qr[d0], p1, 0, 0, 0); }
}
template <int NCB> __device__ __forceinline__ int v_st(int k, int c) { const int kk = (k & ~0xC) | ((k & 4) << 1) | ((k & 8) >> 1); return ((kk >> 3) * NCB + (c >> 5)) * 512 + ((kk & 7) * 32 + (c & 31)) * 2; }
__device__ __forceinline__ int v_rd_base(int lane) { return ((lane & 3) << 3) | (((lane >> 2) & 3) << 6) | (((lane >> 4) & 1) << 5) | (((lane >> 5) & 1) << 8); }
template <int OFF> __device__ __forceinline__ s16x4 tr_read(int vb) { s16x4 r; asm volatile("ds_read_b64_tr_b16 %0, %1 offset:%2" : "=&v"(r) : "v"(vb), "i"(OFF) : "memory"); return r; }
template <int NCB, int D0> __device__ __forceinline__ void pv_one(f32x16& od, int vb, bf16x8 pa0, bf16x8 pa1, bf16x8 pa2, bf16x8 pa3) {
    constexpr int KS = 2 * NCB * 512, HF = NCB * 512, B0 = D0 * 512;
    const s16x4 l0 = tr_read<B0>(vb), h0 = tr_read<B0 + HF>(vb), l1 = tr_read<B0 + KS>(vb), h1 = tr_read<B0 + KS + HF>(vb);
    const s16x4 l2 = tr_read<B0 + 2 * KS>(vb), h2 = tr_read<B0 + 2 * KS + HF>(vb), l3 = tr_read<B0 + 3 * KS>(vb), h3 = tr_read<B0 + 3 * KS + HF>(vb);
    asm volatile("s_waitcnt lgkmcnt(0)" ::: "memory"); SBAR();
#define PK(L, H) (bf16x8){L[0], L[1], L[2], L[3], H[0], H[1], H[2], H[3]}
    od = __builtin_amdgcn_mfma_f32_32x32x16_bf16(pa0, PK(l0, h0), od, 0, 0, 0);
    od = __builtin_amdgcn_mfma_f32_32x32x16_bf16(pa1, PK(l1, h1), od, 0, 0, 0);
    od = __builtin_amdgcn_mfma_f32_32x32x16_bf16(pa2, PK(l2, h2), od, 0, 0, 0);
    od = __builtin_amdgcn_mfma_f32_32x32x16_bf16(pa3, PK(l3, h3), od, 0, 0, 0);
#undef PK
}
template <int NCB> __device__ __forceinline__ void pv_all(f32x16* o, int vb, bf16x8 pa0, bf16x8 pa1, bf16x8 pa2, bf16x8 pa3) {
    pv_one<NCB, 0>(o[0], vb, pa0, pa1, pa2, pa3); pv_one<NCB, 1>(o[1], vb, pa0, pa1, pa2, pa3);
    if constexpr (NCB == 4) { pv_one<NCB, 2>(o[2], vb, pa0, pa1, pa2, pa3); pv_one<NCB, 3>(o[3], vb, pa0, pa1, pa2, pa3); }
}

template <int DQK, int DV, int VP, int KIND>
__device__ __forceinline__ void attn_unit(const bf16_t* Qh, const bf16_t* Kh, const bf16_t* Vh, int qb, bf16_t* OUT, const bf16_t* GATE, LAS unsigned char* lds) {
    constexpr int NCB = DV / 32, NKS = DQK / 16, PITCH = 2 * DQK + 16, NKCH = DQK / 8, KCHUNKS = 64 * NKCH, NKI = (KCHUNKS + NT - 1) / NT, NVI = (64 * DV / 8) / NT;
    const int tid = tid_op(), lane = tid & 63, r32 = lane & 31, hi = lane >> 5; const int wid = __builtin_amdgcn_readfirstlane(tid >> 6);
    LAS float* wsf = (LAS float*)(lds + WS_OFF) + wid * 64; LAS float* li_l = wsf; LAS float* al_l = wsf + 32;
    const int q0 = qb * 256, NTL = (q0 + 256) / 64;
    float m_reg = -1e30f, l_reg = 0.f; f32x16 o[NCB]; bf16x8 qr[NKS];
#pragma unroll
    for (int d = 0; d < NCB; ++d) o[d] = f32x16{};
    { const bf16_t* Qw = Qh + (size_t)(q0 + wid * 32 + r32) * DQK + hi * 8;
#pragma unroll
      for (int d0 = 0; d0 < NKS; ++d0) qr[d0] = *(const bf16x8*)(Qw + d0 * 16); }
    int kgo[NKI], klo[NKI];
#pragma unroll
    for (int i = 0; i < NKI; ++i) { const int id = (tid + i * NT < KCHUNKS) ? tid + i * NT : tid; const int row = id / NKCH, ch = id % NKCH; kgo[i] = row * DQK + ch * 8; klo[i] = K_OFF + row * PITCH + ch * 16; }
    int vgo[NVI], vlo[NVI];
#pragma unroll
    for (int i = 0; i < NVI; ++i) { const int id = tid + i * NT; const int key = id / (DV / 8), c = (id % (DV / 8)) * 8; vgo[i] = key * VP + c; vlo[i] = V_OFF + v_st<NCB>(key, c); }
    bf16x8 ks[2][NKI], vs[2][NVI];
#define SLOAD(sl, t) do { const bf16_t* kt_ = Kh + (size_t)(t) * 64 * DQK; const bf16_t* vt_ = Vh + (size_t)(t) * 64 * VP; \
    _Pragma("unroll") for (int i_ = 0; i_ < NKI; ++i_) ks[sl][i_] = *(const bf16x8*)(kt_ + kgo[i_]); \
    _Pragma("unroll") for (int i_ = 0; i_ < NVI; ++i_) vs[sl][i_] = *(const bf16x8*)(vt_ + vgo[i_]); } while (0)
#define SWRITE(b, sl) do { LAS unsigned char* bb_ = lds + (b) * BUF_BYTES; \
    _Pragma("unroll") for (int i_ = 0; i_ < NKI; ++i_) *(LAS bf16x8*)(bb_ + klo[i_]) = ks[sl][i_]; \
    _Pragma("unroll") for (int i_ = 0; i_ < NVI; ++i_) *(LAS bf16x8*)(bb_ + vlo[i_]) = vs[sl][i_]; } while (0)
#define RESC(a) do { if (__any((a) < 1.f)) { if (hi == 0) al_l[r32] = (a); asm volatile("s_waitcnt lgkmcnt(0)" ::: "memory"); \
    _Pragma("unroll") for (int d_ = 0; d_ < NCB; ++d_) _Pragma("unroll") for (int r_ = 0; r_ < 16; ++r_) o[d_][r_] *= al_l[crow(r_, hi)]; } } while (0)
#define CMASK(P0, P1, t) do { const int jb_ = (t) - (NTL - 4); if (jb_ >= 0) cmask(P0, P1, jb_, qrel, hi); } while (0)
    LAS const unsigned char* kp0 = lds + K_OFF + r32 * PITCH + hi * 16; LAS const unsigned char* kp1 = kp0 + BUF_BYTES;
    const int vb0 = (int)(uintptr_t)(lds + V_OFF) + v_rd_base(lane), vb1 = vb0 + BUF_BYTES;
    const int qrel = wid * 32 + r32;
    f32x16 pA0, pA1, pB0, pB1; float alA, alB; bf16x8 pa0, pa1, pa2, pa3;
    SLOAD(0, 0); SWRITE(0, 0); __syncthreads();
    qkt<DQK>(pA0, pA1, kp0, qr); CMASK(pA0, pA1, 0); partialSM(pA0, pA1, m_reg, alA);
    SLOAD(1, 1); SLOAD(0, 2);
    SWRITE(1, 1); __syncthreads();
#pragma unroll 1
    for (int j = 1; j + 1 < NTL; j += 2) {
        SBAR(); qkt<DQK>(pB0, pB1, kp1, qr);
        finishSM(pA0, pA1, alA, l_reg, pa0, pa1, pa2, pa3); SBAR();
        SLOAD(1, j + 2); SBAR();
        pv_all<NCB>(o, vb0, pa0, pa1, pa2, pa3); CMASK(pB0, pB1, j); partialSM(pB0, pB1, m_reg, alB);
        __syncthreads(); SWRITE(0, 0);
        RESC(alB); __syncthreads();
        SBAR(); qkt<DQK>(pA0, pA1, kp0, qr);
        finishSM(pB0, pB1, alB, l_reg, pa0, pa1, pa2, pa3); SBAR();
        if (j + 3 < NTL) SLOAD(0, j + 3); SBAR();
        pv_all<NCB>(o, vb1, pa0, pa1, pa2, pa3); CMASK(pA0, pA1, j + 1); partialSM(pA0, pA1, m_reg, alA);
        __syncthreads(); SWRITE(1, 1);
        RESC(alA); __syncthreads();
    }
    SBAR(); qkt<DQK>(pB0, pB1, kp1, qr);
    finishSM(pA0, pA1, alA, l_reg, pa0, pa1, pa2, pa3); SBAR();
    pv_all<NCB>(o, vb0, pa0, pa1, pa2, pa3); CMASK(pB0, pB1, NTL - 1); partialSM(pB0, pB1, m_reg, alB);
    RESC(alB);
    finishSM(pB0, pB1, alB, l_reg, pa0, pa1, pa2, pa3); SBAR();
    pv_all<NCB>(o, vb1, pa0, pa1, pa2, pa3);
    if (hi == 0) li_l[r32] = l_reg; asm volatile("s_waitcnt lgkmcnt(0)" ::: "memory");
    float rli[16];
#pragma unroll
    for (int r = 0; r < 16; ++r) rli[r] = __builtin_amdgcn_rcpf(li_l[crow(r, hi)]);
    __syncthreads();
    LAS bf16_t* stg = (LAS bf16_t*)(lds + wid * 8192);
#pragma unroll
    for (int r = 0; r < 16; ++r) { const int orow = crow(r, hi);
#pragma unroll
        for (int d0 = 0; d0 < NCB; ++d0) stg[orow * DV + d0 * 32 + r32] = (bf16_t)f2bf(o[d0][r] * rli[r]); }
    asm volatile("s_waitcnt lgkmcnt(0)" ::: "memory");
    constexpr int CPR = DV / 8;
#pragma unroll
    for (int i = 0; i < (32 * CPR) / 64; ++i) { const int id = i * 64 + lane, row = id / CPR, ch = id % CPR; u32x4 v = *(LAS const u32x4*)(stg + row * DV + ch * 8);
        const size_t ro = (size_t)(q0 + wid * 32 + row);
        if constexpr (KIND == 0) { *(u32x4*)(OUT + ro * 128 + ch * 8) = v; }
        else { const u32x4 g = *(const u32x4*)(GATE + ro * 1024 + ch * 8); u32x4 w;
            w.x = cvtpk(__uint_as_float(v.x << 16) * __uint_as_float(g.x << 16), __uint_as_float(v.x & 0xffff0000u) * __uint_as_float(g.x & 0xffff0000u));
            w.y = cvtpk(__uint_as_float(v.y << 16) * __uint_as_float(g.y << 16), __uint_as_float(v.y & 0xffff0000u) * __uint_as_float(g.y & 0xffff0000u));
            w.z = cvtpk(__uint_as_float(v.z << 16) * __uint_as_float(g.z << 16), __uint_as_float(v.z & 0xffff0000u) * __uint_as_float(g.z & 0xffff0000u));
            w.w = cvtpk(__uint_as_float(v.w << 16) * __uint_as_float(g.w << 16), __uint_as_float(v.w & 0xffff0000u) * __uint_as_float(g.w & 0xffff0000u));
            *(u32x4*)(OUT + ro * 1024 + ch * 8) = w; } }
    asm volatile("s_waitcnt lgkmcnt(0)" ::: "memory");
    __syncthreads();
#undef SLOAD
#undef SWRITE
#undef RESC
#undef CMASK
}
#undef SBAR
}

namespace att2 {
using att::bf16x8; using att::s16x4; using att::f32x16; using att::crow; using att::cvtpk; using att::cmask; using att::tr_read;
#define SBAR() __builtin_amdgcn_sched_barrier(0)
#define WAIT_BAR(N) asm volatile("s_waitcnt vmcnt(" #N ") lgkmcnt(0)\n\ts_barrier" ::: "memory")
constexpr float THR = 8.f;
__device__ __forceinline__ void glds16(const void* gsrc, unsigned lds_dst) { unsigned keep;
    asm volatile("s_mov_b32 %0, m0\n\ts_mov_b32 m0, %2\n\ts_nop 0\n\tglobal_load_lds_dwordx4 %1, off\n\ts_mov_b32 m0, %0" : "=&s"(keep) : "v"(gsrc), "s"(lds_dst) : "memory"); }
__device__ __forceinline__ void partialSM(f32x16& p0, f32x16& p1, float& m_reg, float& alpha) {
    float pmax = p0[0];
#pragma unroll
    for (int r = 1; r < 16; ++r) pmax = fmaxf(pmax, p0[r]);
#pragma unroll
    for (int r = 0; r < 16; ++r) pmax = fmaxf(pmax, p1[r]);
    { auto rr = __builtin_amdgcn_permlane32_swap(__float_as_uint(pmax), __float_as_uint(pmax), false, false); pmax = fmaxf(__uint_as_float(rr[0]), __uint_as_float(rr[1])); }
    float mn;
    if (__builtin_expect(__all(pmax - m_reg <= THR), 1)) { mn = m_reg; alpha = 1.f; }
    else { mn = fmaxf(m_reg, pmax); alpha = __builtin_amdgcn_exp2f(m_reg - mn); m_reg = mn; }
#pragma unroll
    for (int r = 0; r < 16; ++r) { p0[r] -= mn; p1[r] -= mn; }
#pragma unroll
    for (int r = 0; r < 16; ++r) p0[r] = __builtin_amdgcn_exp2f(p0[r]);
}
__device__ __forceinline__ void finishSM(f32x16& p0, f32x16& p1, float alpha, float& l_reg, bf16x8& pa0, bf16x8& pa1, bf16x8& pa2, bf16x8& pa3) {
#pragma unroll
    for (int r = 0; r < 16; ++r) p1[r] = __builtin_amdgcn_exp2f(p1[r]);
    float ps = 0.f;
#pragma unroll
    for (int r = 0; r < 16; ++r) ps += p0[r];
#pragma unroll
    for (int r = 0; r < 16; ++r) ps += p1[r];
    { auto rr = __builtin_amdgcn_permlane32_swap(__float_as_uint(ps), __float_as_uint(ps), false, false); ps = __uint_as_float(rr[0]) + __uint_as_float(rr[1]); }
    l_reg = l_reg * alpha + ps;
#define PK8(P, B) __builtin_bit_cast(bf16x8, (u32x4){cvtpk(P[B], P[B + 1]), cvtpk(P[B + 2], P[B + 3]), cvtpk(P[B + 4], P[B + 5]), cvtpk(P[B + 6], P[B + 7])})
    pa0 = PK8(p0, 0); pa1 = PK8(p0, 8); pa2 = PK8(p1, 0); pa3 = PK8(p1, 8);
#undef PK8
}
template <int NKS> __device__ __forceinline__ void qkt(f32x16& p0, f32x16& p1, LAS const unsigned char* kp  , const bf16x8* qr) {
    p0 = f32x16{}; p1 = f32x16{};
#pragma unroll
    for (int d0 = 0; d0 < NKS; ++d0) {
        const bf16x8 b0 = *(LAS const bf16x8*)(kp + d0 * 2048), b1 = *(LAS const bf16x8*)(kp + d0 * 2048 + 512);
        p0 = __builtin_amdgcn_mfma_f32_32x32x16_bf16(b0, qr[d0], p0, 0, 0, 0);
        p1 = __builtin_amdgcn_mfma_f32_32x32x16_bf16(b1, qr[d0], p1, 0, 0, 0); }
}
template <int D0> __device__ __forceinline__ void pv_one(f32x16& od, int vb, bf16x8 pa0, bf16x8 pa1, bf16x8 pa2, bf16x8 pa3) {
    constexpr int B0 = D0 * 4096;
    const s16x4 l0 = tr_read<B0>(vb), h0 = tr_read<B0 + 512>(vb), l1 = tr_read<B0 + 1024>(vb), h1 = tr_read<B0 + 1536>(vb);
    const s16x4 l2 = tr_read<B0 + 2048>(vb), h2 = tr_read<B0 + 2560>(vb), l3 = tr_read<B0 + 3072>(vb), h3 = tr_read<B0 + 3584>(vb);
    asm volatile("s_waitcnt lgkmcnt(0)" ::: "memory"); SBAR();
#define PK(L, H) (bf16x8){L[0], L[1], L[2], L[3], H[0], H[1], H[2], H[3]}
    od = __builtin_amdgcn_mfma_f32_32x32x16_bf16(pa0, PK(l0, h0), od, 0, 0, 0);
    od = __builtin_amdgcn_mfma_f32_32x32x16_bf16(pa1, PK(l1, h1), od, 0, 0, 0);
    od = __builtin_amdgcn_mfma_f32_32x32x16_bf16(pa2, PK(l2, h2), od, 0, 0, 0);
    od = __builtin_amdgcn_mfma_f32_32x32x16_bf16(pa3, PK(l3, h3), od, 0, 0, 0);
#undef PK
}
template <int NCB> __device__ __forceinline__ void pv_all(f32x16* o, int vb, bf16x8 pa0, bf16x8 pa1, bf16x8 pa2, bf16x8 pa3) {
    pv_one<0>(o[0], vb, pa0, pa1, pa2, pa3); pv_one<1>(o[1], vb, pa0, pa1, pa2, pa3);
    if constexpr (NCB == 4) { pv_one<2>(o[2], vb, pa0, pa1, pa2, pa3); pv_one<3>(o[3], vb, pa0, pa1, pa2, pa3); }
}
template <int DQK, int DV> struct Geo {
    static constexpr int NCB = DV / 32, NKS = DQK / 16, NKCH = DQK / 8, KSLOT = NKCH * 1024, VSLOT = NCB * 4096, K_OFF = 0, V_OFF = 3 * KSLOT, WS_OFF = V_OFF + 3 * VSLOT, STG_OFF = WS_OFF + 2048;
    static constexpr int NKI = (NKCH + 7) / 8, NVI = (NCB * 4) / 8, NDMA = NKI + NVI;
};
template <int DQK, int DV, int VP>
__device__ __forceinline__ void attn_pass(const bf16_t* Qh, const bf16_t* Kh, const bf16_t* Vh, int qb, LAS unsigned char* lds, f32x16 (&o)[DV / 32], float (&rli)[16]) {
    typedef Geo<DQK, DV> Gm; constexpr int NCB = Gm::NCB, NKS = Gm::NKS, NKI = Gm::NKI, NVI = Gm::NVI, KSLOT = Gm::KSLOT, VSLOT = Gm::VSLOT;
    static_assert(Gm::NDMA == 3, "the ring waits below count 3 LDS-DMA pieces per wave and step (NVI of them V pieces)");
    const int tid = tid_op(), lane = tid & 63, r32 = lane & 31, hi = lane >> 5; const int wid = __builtin_amdgcn_readfirstlane(tid >> 6);
    LAS float* wsf = (LAS float*)(lds + Gm::WS_OFF) + wid * 64; LAS float* li_l = wsf; LAS float* al_l = wsf + 32;
    const unsigned lds0 = (unsigned)(uintptr_t)lds;
    const int q0 = qb * 256, NTL = (q0 + 256) / 64;
    const bf16_t* ksrc[NKI]; unsigned kdst[NKI]; const bf16_t* vsrc[NVI]; unsigned vdst[NVI];
#pragma unroll
    for (int i = 0; i < NKI; ++i) { const int c = (wid + 8 * i < Gm::NKCH) ? wid + 8 * i : wid; ksrc[i] = Kh + (size_t)lane * DQK + c * 8; kdst[i] = lds0 + Gm::K_OFF + c * 1024; }
#pragma unroll
    for (int i = 0; i < NVI; ++i) { const int pi = wid + 8 * i, dblk = pi >> 2, kq = pi & 3; vsrc[i] = Vh + (size_t)(16 * kq + (lane >> 2)) * VP + dblk * 32 + (lane & 3) * 8; vdst[i] = lds0 + Gm::V_OFF + pi * 1024; }
#define DMA_K(t, so) do { _Pragma("unroll") for (int i_ = 0; i_ < NKI; ++i_) glds16(ksrc[i_] + (size_t)(t) * 64 * DQK, (unsigned)__builtin_amdgcn_readfirstlane(kdst[i_] + (so) * KSLOT)); } while (0)
#define DMA_V(t, so) do { _Pragma("unroll") for (int i_ = 0; i_ < NVI; ++i_) glds16(vsrc[i_] + (size_t)(t) * 64 * VP, (unsigned)__builtin_amdgcn_readfirstlane(vdst[i_] + (so) * VSLOT)); } while (0)
    DMA_K(0, 0); DMA_V(0, 0); DMA_K(1, 1);
    float m_reg = -1e30f, l_reg = 0.f; bf16x8 qr[NKS];
#pragma unroll
    for (int d = 0; d < NCB; ++d) o[d] = f32x16{};
    { const bf16_t* Qw = Qh + (size_t)(q0 + wid * 32 + r32) * DQK + hi * 8;
#pragma unroll
      for (int d0 = 0; d0 < NKS; ++d0) qr[d0] = *(const bf16x8*)(Qw + d0 * 16); }
    LAS const unsigned char* kp0 = lds + Gm::K_OFF + hi * 1024 + r32 * 16;
    const int vb0 = (int)lds0 + Gm::V_OFF + ((lane >> 4) & 1) * 32 + (lane & 3) * 8 + (4 * hi + ((lane & 15) >> 2)) * 64;
    const int qrel = wid * 32 + r32;
#define RESC(a) do { if (__any((a) < 1.f)) { if (hi == 0) al_l[r32] = (a); asm volatile("s_waitcnt lgkmcnt(0)" ::: "memory"); \
    _Pragma("unroll") for (int d_ = 0; d_ < NCB; ++d_) _Pragma("unroll") for (int r_ = 0; r_ < 16; ++r_) o[d_][r_] *= al_l[crow(r_, hi)]; } } while (0)
#define CMASK(P0, P1, t) do { const int jb_ = (t) - (NTL - 4); if (jb_ >= 0) cmask(P0, P1, jb_, qrel, hi); } while (0)
    int sp = 2, sc = 0, sn = 1;
#define ROT() do { const int t_ = sp; sp = sc; sc = sn; sn = t_; } while (0)
    f32x16 pA0, pA1, pB0, pB1; float alA, alB; bf16x8 pa0, pa1, pa2, pa3;
    asm volatile("s_waitcnt vmcnt(0)" ::: "memory"); __builtin_amdgcn_s_barrier();
    DMA_K(2, sp); DMA_V(1, sn);
    qkt<NKS>(pA0, pA1, kp0 + sc * KSLOT, qr); CMASK(pA0, pA1, 0); partialSM(pA0, pA1, m_reg, alA);
    WAIT_BAR(3); ROT();
#define STEP(C0, C1, alC, P0, P1, alP, t) do { \
    if ((t) + 2 < NTL) DMA_K((t) + 2, sp); if ((t) + 1 < NTL) DMA_V((t) + 1, sn); \
    SBAR(); qkt<NKS>(C0, C1, kp0 + sc * KSLOT, qr); \
    finishSM(P0, P1, alP, l_reg, pa0, pa1, pa2, pa3); SBAR(); \
    pv_all<NCB>(o, vb0 + sp * VSLOT, pa0, pa1, pa2, pa3); CMASK(C0, C1, t); partialSM(C0, C1, m_reg, alC); \
    RESC(alC); \
    if ((t) + 2 < NTL) { WAIT_BAR(3); } else if ((t) + 1 < NTL) { if (NVI == 2) { WAIT_BAR(2); } else { WAIT_BAR(1); } } else { WAIT_BAR(0); } \
    ROT(); } while (0)
#pragma unroll 1
    for (int t = 1; t + 1 < NTL; t += 2) { STEP(pB0, pB1, alB, pA0, pA1, alA, t); STEP(pA0, pA1, alA, pB0, pB1, alB, t + 1); }
    STEP(pB0, pB1, alB, pA0, pA1, alA, NTL - 1);
    finishSM(pB0, pB1, alB, l_reg, pa0, pa1, pa2, pa3); SBAR();
    pv_all<NCB>(o, vb0 + sp * VSLOT, pa0, pa1, pa2, pa3);
    if (hi == 0) li_l[r32] = l_reg; asm volatile("s_waitcnt lgkmcnt(0)" ::: "memory");
#pragma unroll
    for (int r = 0; r < 16; ++r) rli[r] = __builtin_amdgcn_rcpf(li_l[crow(r, hi)]);
    WAIT_BAR(0);
#undef DMA_K
#undef DMA_V
#undef RESC
#undef CMASK
#undef ROT
#undef STEP
}
typedef short v4i16_t __attribute__((ext_vector_type(4)));
__device__ __forceinline__ s16x4 vtr(LAS const unsigned char* p) { return __builtin_bit_cast(s16x4, __builtin_amdgcn_ds_read_tr16_b64_v4i16((LAS v4i16_t*)p)); }
#define PIN(x) asm volatile("" : "+v"(x))
#define PEL(P0, P1, e) ((e) < 16 ? P0[(e) & 15] : P1[(e) & 15])
template <int NKS, int NCB>
__device__ __forceinline__ void step3(f32x16& C0, f32x16& C1, f32x16& P0, f32x16& P1, float alP, float& alC, float& m_reg, float& l_reg, f32x16 (&o)[NCB], const bf16x8 (&qr)[NKS],
                                      LAS const unsigned char* kp, LAS const unsigned char* vp, bool band, int jb, int qrel, int hi) {
    constexpr int NQK = 2 * NKS, NPV = 4 * NCB, A_PER = (32 + NQK - 1) / NQK, C_PER = (16 + NQK - 1) / NQK, E_PER = 32 / NPV;
    bf16x8 kfr[NQK]; s16x4 vlo[NPV], vhi[NPV]; u32x4 pw[4]; float sacc = 0.f;
    kfr[0] = *(LAS const bf16x8*)(kp); kfr[1] = *(LAS const bf16x8*)(kp + 512);
#pragma unroll
    for (int f = 0; f < NQK; ++f) {
        if (f + 2 < NQK) kfr[f + 2] = *(LAS const bf16x8*)(kp + ((f + 2) >> 1) * 2048 + ((f + 2) & 1) * 512);
        if (f < 8) { const int ks = f / NCB, d0 = f % NCB; vlo[f] = vtr(vp + d0 * 4096 + ks * 1024); vhi[f] = vtr(vp + d0 * 4096 + ks * 1024 + 512); }
        SBAR();
        if (f & 1) C1 = __builtin_amdgcn_mfma_f32_32x32x16_bf16(kfr[f], qr[f >> 1], f < 2 ? f32x16{} : C1, 0, 0, 0);
        else       C0 = __builtin_amdgcn_mfma_f32_32x32x16_bf16(kfr[f], qr[f >> 1], f < 2 ? f32x16{} : C0, 0, 0, 0);
#pragma unroll
        for (int k = 0; k < A_PER; ++k) { const int e = f * A_PER + k; if (e < 32) sacc += PEL(P0, P1, e); }
        PIN(sacc);
#pragma unroll
        for (int k = 0; k < C_PER; ++k) { const int i2 = f * C_PER + k; if (i2 < 16) { pw[i2 >> 2][i2 & 3] = cvtpk(PEL(P0, P1, 2 * i2), PEL(P0, P1, 2 * i2 + 1)); PIN(pw[i2 >> 2]); } }
        SBAR();
    }
    l_reg = l_reg * alP + sacc;
    if (band) { asm volatile("; band tile" ::: "memory"); cmask(C0, C1, jb, qrel, hi); }
    float pmax = fmaxf(fmaxf(C0[0], C0[1]), C1[0]);
#pragma unroll
    for (int r = 1; r < 16; ++r) { pmax = fmaxf(pmax, C1[r]); if (r > 1) pmax = fmaxf(pmax, C0[r]); }
    { auto rr = __builtin_amdgcn_permlane32_swap(__float_as_uint(pmax), __float_as_uint(pmax), false, false); pmax = fmaxf(__uint_as_float(rr[0]), __uint_as_float(rr[1])); }
    float mn;
    if (__builtin_expect(__all(pmax - m_reg <= THR), 1)) { mn = m_reg; alC = 1.f; }
    else { mn = fmaxf(m_reg, pmax); alC = __builtin_amdgcn_exp2f(m_reg - mn); m_reg = mn; }
    SBAR();
#pragma unroll
    for (int g = 0; g < NPV; ++g) {
        if (NPV == 16 && g < 8) { const int g2 = g + 8, ks = g2 / NCB, d0 = g2 % NCB; vlo[g2] = vtr(vp + d0 * 4096 + ks * 1024); vhi[g2] = vtr(vp + d0 * 4096 + ks * 1024 + 512); }
        SBAR();
        { const int ks = g / NCB, d0 = g % NCB;
          const bf16x8 vf = (bf16x8){vlo[g][0], vlo[g][1], vlo[g][2], vlo[g][3], vhi[g][0], vhi[g][1], vhi[g][2], vhi[g][3]};
          o[d0] = __builtin_amdgcn_mfma_f32_32x32x16_bf16(__builtin_bit_cast(bf16x8, pw[ks]), vf, o[d0], 0, 0, 0); }
#pragma unroll
        for (int k = 0; k < E_PER; ++k) { const int e = g * E_PER + k;
            if (e < 16) C0[e & 15] = __builtin_amdgcn_exp2f(C0[e & 15] - mn); else C1[e & 15] = __builtin_amdgcn_exp2f(C1[e & 15] - mn); }
        if (g * E_PER < 16) PIN(C0); else PIN(C1);
        SBAR();
    }
}
template <int DQK, int DV, int VP>
__device__ __forceinline__ void attn_pass3(const bf16_t* Qh, const bf16_t* Kh, const bf16_t* Vh, int qb, LAS unsigned char* lds, f32x16 (&o)[DV / 32], float (&rli)[16]) {
    typedef Geo<DQK, DV> Gm; constexpr int NCB = Gm::NCB, NKS = Gm::NKS, NKI = Gm::NKI, NVI = Gm::NVI, KSLOT = Gm::KSLOT, VSLOT = Gm::VSLOT;
    static_assert(Gm::NDMA == 3, "the ring waits below count 3 LDS-DMA pieces per wave and step (NVI of them V pieces)");
    const int tid = tid_op(), lane = tid & 63, r32 = lane & 31, hi = lane >> 5; const int wid = __builtin_amdgcn_readfirstlane(tid >> 6);
    LAS float* wsf = (LAS float*)(lds + Gm::WS_OFF) + wid * 64; LAS float* li_l = wsf; LAS float* al_l = wsf + 32;
    const unsigned lds0 = (unsigned)(uintptr_t)lds;
    const int q0 = qb * 256, NTL = (q0 + 256) / 64;
    const bf16_t* ksrc[NKI]; unsigned kdst[NKI]; const bf16_t* vsrc[NVI]; unsigned vdst[NVI];
#pragma unroll
    for (int i = 0; i < NKI; ++i) { const int c = (wid + 8 * i < Gm::NKCH) ? wid + 8 * i : wid; ksrc[i] = Kh + (size_t)lane * DQK + c * 8; kdst[i] = lds0 + Gm::K_OFF + c * 1024; }
#pragma unroll
    for (int i = 0; i < NVI; ++i) { const int pi = wid + 8 * i, dblk = pi >> 2, kq = pi & 3; vsrc[i] = Vh + (size_t)(16 * kq + (lane >> 2)) * VP + dblk * 32 + (lane & 3) * 8; vdst[i] = lds0 + Gm::V_OFF + pi * 1024; }
#define DMA_K(t, so) do { _Pragma("unroll") for (int i_ = 0; i_ < NKI; ++i_) glds16(ksrc[i_] + (size_t)(t) * 64 * DQK, (unsigned)__builtin_amdgcn_readfirstlane(kdst[i_] + (so) * KSLOT)); } while (0)
#define DMA_V(t, so) do { _Pragma("unroll") for (int i_ = 0; i_ < NVI; ++i_) glds16(vsrc[i_] + (size_t)(t) * 64 * VP, (unsigned)__builtin_amdgcn_readfirstlane(vdst[i_] + (so) * VSLOT)); } while (0)
    DMA_K(0, 0); DMA_V(0, 0); DMA_K(1, 1);
    float m_reg = -1e30f, l_reg = 0.f; bf16x8 qr[NKS];
#pragma unroll
    for (int d = 0; d < NCB; ++d) o[d] = f32x16{};
    { const bf16_t* Qw = Qh + (size_t)(q0 + wid * 32 + r32) * DQK + hi * 8;
#pragma unroll
      for (int d0 = 0; d0 < NKS; ++d0) qr[d0] = *(const bf16x8*)(Qw + d0 * 16); }
    LAS const unsigned char* kp0 = lds + Gm::K_OFF + hi * 1024 + r32 * 16;
    LAS const unsigned char* vp0 = lds + Gm::V_OFF + ((lane >> 4) & 1) * 32 + (lane & 3) * 8 + (4 * hi + ((lane & 15) >> 2)) * 64;
    const int qrel = wid * 32 + r32;
#define RESC(a) do { if (__any((a) < 1.f)) { if (hi == 0) al_l[r32] = (a); asm volatile("s_waitcnt lgkmcnt(0)" ::: "memory"); \
    _Pragma("unroll") for (int d_ = 0; d_ < NCB; ++d_) _Pragma("unroll") for (int r_ = 0; r_ < 16; ++r_) o[d_][r_] *= al_l[crow(r_, hi)]; } } while (0)
    int sp = 2, sc = 0, sn = 1;
#define ROT() do { const int t_ = sp; sp = sc; sc = sn; sn = t_; } while (0)
    f32x16 pA0, pA1, pB0, pB1; float alA, alB;
    asm volatile("s_waitcnt vmcnt(0)" ::: "memory"); __builtin_amdgcn_s_barrier();
    DMA_K(2, sp); DMA_V(1, sn);
    att2::qkt<NKS>(pA0, pA1, kp0 + sc * KSLOT, qr); if (NTL == 4) cmask(pA0, pA1, 0, qrel, hi);
    { float pmax = pA0[0];
#pragma unroll
      for (int r = 1; r < 16; ++r) pmax = fmaxf(pmax, pA0[r]);
#pragma unroll
      for (int r = 0; r < 16; ++r) pmax = fmaxf(pmax, pA1[r]);
      { auto rr = __builtin_amdgcn_permlane32_swap(__float_as_uint(pmax), __float_as_uint(pmax), false, false); pmax = fmaxf(__uint_as_float(rr[0]), __uint_as_float(rr[1])); }
      m_reg = pmax; alA = 0.f;
#pragma unroll
      for (int r = 0; r < 16; ++r) { pA0[r] = __builtin_amdgcn_exp2f(pA0[r] - pmax); pA1[r] = __builtin_amdgcn_exp2f(pA1[r] - pmax); } }
    WAIT_BAR(3); ROT();
#define STEP(C0, C1, alC, P0, P1, alP, t) do { \
    if ((t) + 2 < NTL) DMA_K((t) + 2, sp); if ((t) + 1 < NTL) DMA_V((t) + 1, sn); \
    SBAR(); step3<NKS, NCB>(C0, C1, P0, P1, alP, alC, m_reg, l_reg, o, qr, kp0 + sc * KSLOT, vp0 + sp * VSLOT, (t) >= NTL - 4, (t) - (NTL - 4), qrel, hi); \
    RESC(alC); \
    if ((t) + 2 < NTL) { WAIT_BAR(3); } else if ((t) + 1 < NTL) { if (NVI == 2) { WAIT_BAR(2); } else { WAIT_BAR(1); } } else { WAIT_BAR(0); } \
    ROT(); } while (0)
#pragma unroll 1
    for (int t = 1; t + 1 < NTL; t += 2) { STEP(pB0, pB1, alB, pA0, pA1, alA, t); STEP(pA0, pA1, alA, pB0, pB1, alB, t + 1); }
    STEP(pB0, pB1, alB, pA0, pA1, alA, NTL - 1);
    { float ps = 0.f;
#pragma unroll
      for (int r = 0; r < 16; ++r) ps += pB0[r] + pB1[r];
      l_reg = l_reg * alB + ps;
#define PK8(P, B) __builtin_bit_cast(bf16x8, (u32x4){cvtpk(P[B], P[B + 1]), cvtpk(P[B + 2], P[B + 3]), cvtpk(P[B + 4], P[B + 5]), cvtpk(P[B + 6], P[B + 7])})
      const bf16x8 pa0 = PK8(pB0, 0), pa1 = PK8(pB0, 8), pa2 = PK8(pB1, 0), pa3 = PK8(pB1, 8);
#undef PK8
      SBAR(); att2::pv_all<NCB>(o, (int)lds0 + Gm::V_OFF + ((lane >> 4) & 1) * 32 + (lane & 3) * 8 + (4 * hi + ((lane & 15) >> 2)) * 64 + sp * VSLOT, pa0, pa1, pa2, pa3); }
    { auto rr = __builtin_amdgcn_permlane32_swap(__float_as_uint(l_reg), __float_as_uint(l_reg), false, false); l_reg = __uint_as_float(rr[0]) + __uint_as_float(rr[1]); }
    if (hi == 0) li_l[r32] = l_reg; asm volatile("s_waitcnt lgkmcnt(0)" ::: "memory");
#pragma unroll
    for (int r = 0; r < 16; ++r) rli[r] = __builtin_amdgcn_rcpf(li_l[crow(r, hi)]);
    WAIT_BAR(0);
#undef DMA_K
#undef DMA_V
#undef RESC
#undef ROT
#undef STEP
}
#undef PIN
#undef PEL
template <int DV, bool GATED>
__device__ __forceinline__ void store_rows(LAS const bf16_t* stg, bf16_t* out, const bf16_t* gate, int pitch, int lane) {
    constexpr int CPR = DV / 8;
#pragma unroll
    for (int i = 0; i < (32 * CPR) / 64; ++i) { const int id = i * 64 + lane, row = id / CPR, ch = id % CPR; const u32x4 v = *(LAS const u32x4*)(stg + row * DV + ch * 8);
        if constexpr (!GATED) { *(u32x4*)(out + (size_t)row * pitch + ch * 8) = v; }
        else { const u32x4 g = *(const u32x4*)(gate + (size_t)row * pitch + ch * 8); u32x4 w;
            w.x = cvtpk(__uint_as_float(v.x << 16) * __uint_as_float(g.x << 16), __uint_as_float(v.x & 0xffff0000u) * __uint_as_float(g.x & 0xffff0000u));
            w.y = cvtpk(__uint_as_float(v.y << 16) * __uint_as_float(g.y << 16), __uint_as_float(v.y & 0xffff0000u) * __uint_as_float(g.y & 0xffff0000u));
            w.z = cvtpk(__uint_as_float(v.z << 16) * __uint_as_float(g.z << 16), __uint_as_float(v.z & 0xffff0000u) * __uint_as_float(g.z & 0xffff0000u));
            w.w = cvtpk(__uint_as_float(v.w << 16) * __uint_as_float(g.w << 16), __uint_as_float(v.w & 0xffff0000u) * __uint_as_float(g.w & 0xffff0000u));
            *(u32x4*)(out + (size_t)row * pitch + ch * 8) = w; } }
}
#ifndef ATTN_PASS
#define ATTN_PASS attn_pass3
#endif
__device__ __forceinline__ void mla_unit(const bf16_t* Qh, const bf16_t* Kh, const bf16_t* Vh, int qb, bf16_t* YC, const bf16_t* G, LAS unsigned char* lds) {
    typedef Geo<96, 64> Gm; f32x16 o[2]; float rli[16];
    ATTN_PASS<96, 64, 64>(Qh, Kh, Vh, qb, lds, o, rli);
    const int tid = tid_op(), lane = tid & 63, r32 = lane & 31, hi = lane >> 5; const int wid = __builtin_amdgcn_readfirstlane(tid >> 6);
    LAS bf16_t* stg = (LAS bf16_t*)(lds + Gm::STG_OFF + wid * 4096);
#pragma unroll
    for (int r = 0; r < 16; ++r) { const int orow = crow(r, hi);
#pragma unroll
        for (int d0 = 0; d0 < 2; ++d0) stg[orow * 64 + d0 * 32 + r32] = (bf16_t)f2bf(o[d0][r] * rli[r]); }
    asm volatile("s_waitcnt lgkmcnt(0)" ::: "memory");
    const size_t ro = (size_t)(qb * 256 + wid * 32) * 1024;
    store_rows<64, true>(stg, YC + ro, G + ro, 1024, lane);
    asm volatile("s_waitcnt lgkmcnt(0)" ::: "memory");
    __syncthreads();
}
__device__ __forceinline__ void diff_unit(const bf16_t* Q0, const bf16_t* K0, const bf16_t* Vh, int qb, bf16_t* YC, const bf16_t* G, const float* subln_g, float lam, LAS unsigned char* lds) {
    typedef Geo<64, 128> Gm; f32x16 o[4]; float rli[16];
    const int tid = tid_op(), lane = tid & 63, r32 = lane & 31, hi = lane >> 5; const int wid = __builtin_amdgcn_readfirstlane(tid >> 6);
    LAS unsigned* park = (LAS unsigned*)(lds + Gm::STG_OFF + wid * 8192);
    ATTN_PASS<64, 128, 128>(Q0, K0, Vh, qb, lds, o, rli);
#pragma unroll
    for (int r = 0; r < 16; r += 2)
#pragma unroll
        for (int d0 = 0; d0 < 4; ++d0) park[((r >> 1) * 4 + d0) * 64 + lane] = cvtpk(o[d0][r] * rli[r], o[d0][r + 1] * rli[r + 1]);
    ATTN_PASS<64, 128, 128>(Q0 + (size_t)SEQ * 64, K0 + (size_t)SEQ * 64, Vh, qb, lds, o, rli);
    asm volatile("s_waitcnt lgkmcnt(0)" ::: "memory");
    float ss[16];
#pragma unroll
    for (int r = 0; r < 16; r += 2) { float s0 = 0.f, s1 = 0.f;
#pragma unroll
        for (int d0 = 0; d0 < 4; ++d0) { const unsigned w = park[((r >> 1) * 4 + d0) * 64 + lane];
            const float a = __uint_as_float(w << 16) - lam * (o[d0][r] * rli[r]), b = __uint_as_float(w & 0xffff0000u) - lam * (o[d0][r + 1] * rli[r + 1]);
            o[d0][r] = a; o[d0][r + 1] = b; s0 += a * a; s1 += b * b; }
        ss[r] = s0; ss[r + 1] = s1; }
#pragma unroll
    for (int r = 0; r < 16; ++r) { float v = ss[r];
        v += __shfl_xor(v, 1); v += __shfl_xor(v, 2); v += __shfl_xor(v, 4); v += __shfl_xor(v, 8); v += __shfl_xor(v, 16);
        ss[r] = __builtin_amdgcn_rsqf(v * (1.f / 128.f) + RMS_EPS) * (1.f - LAM_INIT); }
    float gcol[4];
#pragma unroll
    for (int d0 = 0; d0 < 4; ++d0) gcol[d0] = subln_g[d0 * 32 + r32];
    asm volatile("s_waitcnt lgkmcnt(0)" ::: "memory");
    LAS bf16_t* stg = (LAS bf16_t*)park;
#pragma unroll
    for (int r = 0; r < 16; ++r) { const int orow = crow(r, hi);
#pragma unroll
        for (int d0 = 0; d0 < 4; ++d0) stg[orow * 128 + d0 * 32 + r32] = (bf16_t)f2bf(o[d0][r] * ss[r] * gcol[d0]); }
    asm volatile("s_waitcnt lgkmcnt(0)" ::: "memory");
    const size_t ro = (size_t)(qb * 256 + wid * 32) * 1024;
    store_rows<128, true>(stg, YC + ro, G + ro, 1024, lane);
    asm volatile("s_waitcnt lgkmcnt(0)" ::: "memory");
    __syncthreads();
}
#undef SBAR
#undef WAIT_BAR
}

__device__ __forceinline__ void phase2_v2(const Params& P, LAS unsigned char* lds) {
    const bf16_t* QD = (const bf16_t*)(P.ws + WS_QD); const bf16_t* KD = (const bf16_t*)(P.ws + WS_KD); const bf16_t* VD = (const bf16_t*)(P.ws + WS_VD);
    const bf16_t* QM = (const bf16_t*)(P.ws + WS_QM); const bf16_t* KM = (const bf16_t*)(P.ws + WS_KM); const bf16_t* VM = (const bf16_t*)(P.ws + WS_VM);
    const bf16_t* G = (const bf16_t*)(P.ws + WS_G); bf16_t* YC = (bf16_t*)(P.ws + WS_YCAT);
    const float lam = ((const float*)(P.ws + WS_MISC))[0];
    const int Gn = (int)gridDim.x, bx = (int)blockIdx.x, vcu = (Gn % 8 == 0) ? (bx % 8) * (Gn / 8) + bx / 8 : bx;
#pragma unroll 1
    for (int it = vcu; it < 256 + 512; it += Gn) {
        if (it < 256) {
            const int bh4 = it >> 3, sidx = it & 7, b = bh4 >> 2, h = bh4 & 3;
#pragma unroll 1
            for (int half = 0; half < 2; ++half) { const int qb = half == 0 ? 15 - sidx : sidx;
                att2::diff_unit(QD + (size_t)(b * 8 + 2 * h) * SEQ * 64, KD + (size_t)(b * 8 + 2 * h) * SEQ * 64, VD + (size_t)(b * 4 + h) * SEQ * 128, qb,
                                YC + (size_t)b * SEQ * 1024 + h * 128, G + (size_t)b * SEQ * 1024 + h * 128, P.subln_g, lam, lds); }
        } else {
            const int rem = it - 256, bh = rem >> 3, sidx = rem & 7, b = bh >> 3, hh = bh & 7;
#pragma unroll 1
            for (int half = 0; half < 2; ++half) { const int qb = half == 0 ? 15 - sidx : sidx;
                att2::mla_unit(QM + (size_t)bh * SEQ * 96, KM + (size_t)bh * SEQ * 96, VM + (size_t)bh * SEQ * 64, qb, YC + (size_t)b * SEQ * 1024 + 512 + hh * 64, G + (size_t)b * SEQ * 1024 + 512 + hh * 64, lds); }
        }
    }
    __syncthreads();
}

__device__ __forceinline__ void phase2_mfma(const Params& P, LAS unsigned char* lds) {
    const bf16_t* QD = (const bf16_t*)(P.ws + WS_QD); const bf16_t* KD = (const bf16_t*)(P.ws + WS_KD); const bf16_t* VD = (const bf16_t*)(P.ws + WS_VD);
    const bf16_t* QM = (const bf16_t*)(P.ws + WS_QM); const bf16_t* KM = (const bf16_t*)(P.ws + WS_KM); const bf16_t* VM = (const bf16_t*)(P.ws + WS_VM);
    const bf16_t* G = (const bf16_t*)(P.ws + WS_G); bf16_t* OD = (bf16_t*)(P.ws + WS_OD); bf16_t* YC = (bf16_t*)(P.ws + WS_YCAT);
    const int Gn = (int)gridDim.x, bx = (int)blockIdx.x, vcu = (Gn % 8 == 0) ? (bx % 8) * (Gn / 8) + bx / 8 : bx;
#pragma unroll 1
    for (int pr = vcu; pr < 1024; pr += Gn) {
        const int kind = pr >> 9, rem = pr & 511, bh = rem >> 3, sidx = rem & 7, b = bh >> 3, hh = bh & 7;
#pragma unroll 1
        for (int half = 0; half < 2; ++half) {
            const int qb = half == 0 ? 15 - sidx : sidx;
            if (kind == 0) att::attn_unit<64, 128, 128, 0>(QD + (size_t)bh * SEQ * 64, KD + (size_t)bh * SEQ * 64, VD + (size_t)(b * 4 + (hh >> 1)) * SEQ * 128, qb, OD + (size_t)bh * SEQ * 128, nullptr, lds);
            else att::attn_unit<96, 64, 64, 1>(QM + (size_t)bh * SEQ * 96, KM + (size_t)bh * SEQ * 96, VM + (size_t)bh * SEQ * 64, qb, YC + (size_t)b * SEQ * 1024 + 512 + hh * 64, G + (size_t)b * SEQ * 1024 + 512 + hh * 64, lds);
        }
    }
}

#define GAS __attribute__((address_space(1)))
constexpr int CW_BAR = 4096;
constexpr int LDSCTL_OFF = 162816, MISC_OFF = LDSCTL_OFF + 320;
#define XB_TMO      128
#define XB_XCNT(j)  (256  + 64 * (j))
#define XB_XSUB(j)  (1280 + 64 * (j))
#define XB_XGEN(j)  (2304 + 64 * (j))
#define XB_TOP      3328
#define XB_TOPGEN   3392
#define XCD_BAR_WORDS 3456
#define XB_SPIN_CAP (1u << 18)

__device__ __forceinline__ unsigned xb_ld(unsigned* p)              { return __hip_atomic_load(p, __ATOMIC_RELAXED, __HIP_MEMORY_SCOPE_AGENT); }
__device__ __forceinline__ unsigned xb_add(unsigned* p, unsigned v) { return __hip_atomic_fetch_add(p, v, __ATOMIC_RELAXED, __HIP_MEMORY_SCOPE_AGENT); }
__device__ __forceinline__ unsigned xb_xcc_id() { return (unsigned)__builtin_amdgcn_s_getreg((3 << 11) | 20) & 0xFu; }
#define XB_SPIN(cond, bar) do { unsigned _sp = 0; while (cond) { __builtin_amdgcn_s_sleep(1); \
    if ((++_sp & 255u) == 0u) { if (xb_ld(&(bar)[XB_TMO])) break; if (_sp > XB_SPIN_CAP) { atomicAdd(&(bar)[XB_TMO], 1u); break; } } } } while (0)

struct XcdBarrier {
    unsigned* bar; unsigned x;
    volatile LAS unsigned* st;
};

__device__ __forceinline__ XcdBarrier xcd_barrier_post(unsigned* bar, volatile LAS unsigned* st) {
    XcdBarrier b; b.bar = bar; b.x = xb_xcc_id(); b.st = st;
    if (threadIdx.x == 0) (void)xb_add(&bar[XB_XCNT(b.x)], 1u);
    return b;
}
__device__ __forceinline__ void xcd_barrier_complete(unsigned* bar, unsigned x, unsigned& nloc, unsigned& nx) {
    const unsigned G = gridDim.x * gridDim.y * gridDim.z;
    unsigned sum, cnt, mine, sp = 0u;
    for (;;) {
        sum = 0u; cnt = 0u; mine = 0u;
#pragma unroll
        for (unsigned j = 0; j < 16; ++j) { const unsigned c = xb_ld(&bar[XB_XCNT(j)]); sum += c; cnt += (c > 0u) ? 1u : 0u; mine = (j == x) ? c : mine; }
        if (sum == G) break;
        __builtin_amdgcn_s_sleep(1);
        if ((++sp & 255u) == 0u) { if (xb_ld(&bar[XB_TMO])) break; if (sp > XB_SPIN_CAP) { atomicAdd(&bar[XB_TMO], 1u); break; } }
    }
    nloc = mine > 0u ? mine : 1u; nx = cnt > 0u ? cnt : 1u;
}

__device__ __forceinline__ void xcd_barrier(const XcdBarrier& b) {
    asm volatile("s_waitcnt vmcnt(0)" ::: "memory");
    __syncthreads();
    if (threadIdx.x == 0) {
        unsigned* bar = b.bar;
        __builtin_amdgcn_s_waitcnt(0);
        unsigned nloc = b.st[0], nx = b.st[1];
        if (nloc == 0u) { xcd_barrier_complete(bar, b.x, nloc, nx); b.st[0] = nloc; b.st[1] = nx; }
        const unsigned old = xb_add(&bar[XB_XSUB(b.x)], 1u);
        const unsigned gen = old / nloc;
        if (old + 1u == (gen + 1u) * nloc) {
            __builtin_amdgcn_fence(__ATOMIC_RELEASE, "agent");
            asm volatile("s_waitcnt vmcnt(0)" ::: "memory");
            const unsigned og = xb_add(&bar[XB_TOP], 1u);
            const unsigned tg = og / nx;
            if (og + 1u == (tg + 1u) * nx) xb_add(&bar[XB_TOPGEN], 1u);
            else XB_SPIN(xb_ld(&bar[XB_TOPGEN]) == tg, bar);
            __builtin_amdgcn_fence(__ATOMIC_ACQUIRE, "agent");
            xb_add(&bar[XB_XGEN(b.x)], 1u);
            asm volatile("s_waitcnt vmcnt(0)" ::: "memory");
        } else {
            XB_SPIN(xb_ld(&bar[XB_XGEN(b.x)]) == gen, bar);
            __builtin_amdgcn_fence(__ATOMIC_ACQUIRE, "agent");
            asm volatile("s_waitcnt vmcnt(0)" ::: "memory");
        }
    }
    __syncthreads();
}

#ifndef OPT_P1
#define OPT_P1 1
#endif
#ifndef OPT_P2
#define OPT_P2 2
#endif
#ifndef OPT_P15
#define OPT_P15 1
#endif
#ifndef OPT_P3
#define OPT_P3 1
#endif
#ifndef OPT_P4
#define OPT_P4 1
#endif
constexpr int LDS_BYTES = 163840;
__global__ void __launch_bounds__(NT, 2) fwd_megakernel(Params P) {
    extern __shared__ __attribute__((aligned(16))) unsigned char lds_raw[];
    LAS unsigned char* lds = (LAS unsigned char*)lds_raw;
    float* smem = (float*)lds_raw;
    const int bid = blockIdx.x, nb = gridDim.x;
    for (int u = threadIdx.x; u < (LDS_BYTES - LDSCTL_OFF) / 4; u += NT) ((LAS unsigned*)(lds + LDSCTL_OFF))[u] = 0u;
    __syncthreads();
    const XcdBarrier bar = xcd_barrier_post((unsigned*)(P.ws + WS_CTL) + CW_BAR, (volatile LAS unsigned*)(lds + MISC_OFF) + 8);
    phase0(P, bid, nb);
    phase0_weights(P, bid, nb, lds);
    xcd_barrier(bar);
#if OPT_P1
    phase1_gemm(P, lds);
#else
    phase1_naive(P, bid, nb, smem);
#endif
    xcd_barrier(bar);
#if OPT_P15
    phase15_gemm(P, lds);
#else
    phase15_naive(P, bid, nb, smem);
#endif
    xcd_barrier(bar);
#if OPT_P2 == 2
    phase2_v2(P, lds);
    xcd_barrier(bar);
#elif OPT_P2
    phase2_mfma(P, lds);
    xcd_barrier(bar);
    phase25_naive(P, bid, nb);
    xcd_barrier(bar);
#else
    phase2_naive(P, bid, nb, smem);
    xcd_barrier(bar);
    phase25_naive(P, bid, nb);
    xcd_barrier(bar);
#endif
#if OPT_P3
    phase3_gemm(P, lds);
#else
    phase3_naive(P, bid, nb, smem);
#endif
    xcd_barrier(bar);
#if OPT_P4
    phase4_gemm(P, lds);
#else
    phase4_naive(P, bid, nb, smem);
#endif
    xcd_barrier(bar);
    phase5(P, bid, nb);
}

extern "C" void kernel_launch(void* const* d_in, const int* in_sizes, int n_in, void* d_out, int out_size, void* d_ws, size_t ws_size, hipStream_t stream) {
    if (n_in != 15 || out_size != T * DM || ws_size < WS_END) { fprintf(stderr, "kernel_launch: unexpected shapes (n_in %d out %d ws %zu)\n", n_in, out_size, ws_size); return; }
    static int grid_blocks = 0;
    if (!grid_blocks) {
        int dev = 0, cus = 0, per_cu = 0;
        (void)hipGetDevice(&dev);
        (void)hipDeviceGetAttribute(&cus, hipDeviceAttributeMultiprocessorCount, dev);
        if (hipFuncSetAttribute((const void*)fwd_megakernel, hipFuncAttributeMaxDynamicSharedMemorySize, LDS_BYTES) != hipSuccess) { fprintf(stderr, "kernel_launch: hipFuncSetAttribute failed\n"); return; }
        if (hipOccupancyMaxActiveBlocksPerMultiprocessor(&per_cu, (const void*)fwd_megakernel, NT, LDS_BYTES) != hipSuccess || per_cu < 1) { fprintf(stderr, "kernel_launch: occupancy query says %d blocks/CU\n", per_cu); return; }
        grid_blocks = cus;
    }
    Params P{};
    P.x = (const float*)d_in[0]; P.p = (const float*)d_in[1]; P.pos = (const int*)d_in[2]; P.norm_g = (const float*)d_in[3]; P.w_in = (const float*)d_in[4];
    P.diff_lambda = (const float*)d_in[5]; P.subln_g = (const float*)d_in[6]; P.qn_g = (const float*)d_in[7]; P.w_uq = (const float*)d_in[8]; P.kvn_g = (const float*)d_in[9];
    P.w_ukv = (const float*)d_in[10]; P.w_out = (const float*)d_in[11]; P.w_ple = (const float*)d_in[12]; P.w_gate = (const float*)d_in[13]; P.final_g = (const float*)d_in[14];
    P.out = (float*)d_out; P.ws = (unsigned char*)d_ws;
    if (hipMemsetAsync((char*)d_ws + WS_CTL, 0, 65536, stream) != hipSuccess) { fprintf(stderr, "kernel_launch: memset failed\n"); return; }
    hipLaunchKernelGGL(fwd_megakernel, dim3(grid_blocks), dim3(NT), LDS_BYTES, stream, P);
    const hipError_t e = hipPeekAtLastError();
    if (e != hipSuccess) fprintf(stderr, "launch failed: %s (grid %d)\n", hipGetErrorString(e), grid_blocks);
}
```

```cpp
#include <hip/hip_runtime.h>
#include <hip/hip_cooperative_groups.h>
#include <cstdio>
#include <cstdint>

namespace cg = cooperative_groups;
typedef unsigned short bf16_t;

constexpr int BATCH = 8, SEQ = 4096, T = BATCH * SEQ, DM = 1024, DIN = 3104, PLE_DIM = 256;
constexpr int OFF_DQ = 0, OFF_DK = 512, OFF_DV = 1024, OFF_DG = 1536, OFF_CQ = 2048, OFF_CKV = 2432, OFF_KR = 2560, OFF_MG = 2592;
constexpr int QLORA = 384, KVLORA = 128, CQP = 512;
constexpr float RMS_EPS = 1e-6f;
constexpr float LOG2E = 1.4426950408889634f;
constexpr float C2D = 0.125f * LOG2E;
constexpr float C2M = 0.10206207261596575f * LOG2E;
constexpr float LAM_INIT = 0.2f;
constexpr int NT = 512;

constexpr size_t MiB = 1u << 20;
constexpr size_t WS_CTL = 0;
constexpr size_t WS_MISC = 1 * MiB;
constexpr size_t WS_SSQQ = 1 * MiB + 65536, WS_SSQKV = WS_SSQQ + 131072, WS_SSQF = WS_SSQKV + 131072;
constexpr size_t WS_CSA = 2 * MiB, WS_CSB = 10 * MiB;
constexpr size_t WS_WIN = 14 * MiB, WS_WPLE = 21 * MiB, WS_WUQ = 22 * MiB, WS_WUKV = 23 * MiB, WS_WOUT = 24 * MiB, WS_WG = 26 * MiB;
constexpr size_t WS_PB = 28 * MiB, WS_CQ = 44 * MiB  , WS_XN = 76 * MiB, WS_OD = WS_XN;
constexpr size_t WS_QD = 140 * MiB, WS_KD = 172 * MiB, WS_PLE = WS_QD, WS_VD = 204 * MiB, WS_G = 236 * MiB, WS_HB = WS_G;
constexpr size_t WS_QM = 300 * MiB, WS_KM = 348 * MiB, WS_VM = 396 * MiB, WS_YCAT = 428 * MiB, WS_END = 492 * MiB;

struct Params {
    const float* x; const float* p; const int* pos; const float* norm_g; const float* w_in; const float* diff_lambda;
    const float* subln_g; const float* qn_g; const float* w_uq; const float* kvn_g; const float* w_ukv; const float* w_out;
    const float* w_ple; const float* w_gate; const float* final_g; float* out; unsigned char* ws;
};

__device__ __forceinline__ unsigned f2bf(float f) { unsigned u = __float_as_uint(f); return (u + 0x7fffu + ((u >> 16) & 1u)) >> 16; }
__device__ __forceinline__ float bf2f(bf16_t h) { return __uint_as_float(((unsigned)h) << 16); }
__device__ __forceinline__ float wave_sum(float v) {
#pragma unroll
    for (int o = 1; o < 64; o <<= 1) v += __shfl_xor(v, o);
    return v;
}
__device__ __forceinline__ int tid_op() { int t = threadIdx.x; asm volatile("" : "+v"(t)); return t; }
__device__ __forceinline__ int sgpr_op(int v) { asm volatile("" : "+s"(v)); return v; }
__device__ __forceinline__ float silu_f(float v) { return v / (1.f + __expf(-v)); }
__device__ __forceinline__ float sigmoid_f(float v) { return 1.f / (1.f + __expf(-v)); }

__device__ __forceinline__ void phase0(const Params& P, int bid, int nb, int gw, int ngw) {
    bid = sgpr_op(bid); nb = sgpr_op(nb);
    const int tid = tid_op(), lane = tid & 63;
    const int gt = gw * 64 + lane, ngt = ngw * 64;
    bf16_t* XN = (bf16_t*)(P.ws + WS_XN);
    for (int t = gw; t < T; t += 2 * ngw) {
        const int t2 = t + ngw;
        const bool has2 = t2 < T;
        const float4* xr = (const float4*)(P.x + (size_t)t * DM); const float4* xr2 = (const float4*)(P.x + (size_t)(has2 ? t2 : t) * DM);
        float4 v[4], w[4]; float s = 0.f, s2 = 0.f;
#pragma unroll
        for (int j = 0; j < 4; ++j) { v[j] = xr[lane + 64 * j]; w[j] = xr2[lane + 64 * j]; }
#pragma unroll
        for (int j = 0; j < 4; ++j) { s += v[j].x * v[j].x + v[j].y * v[j].y + v[j].z * v[j].z + v[j].w * v[j].w; s2 += w[j].x * w[j].x + w[j].y * w[j].y + w[j].z * w[j].z + w[j].w * w[j].w; }
        s = wave_sum(s); s2 = wave_sum(s2);
        const float rstd = 1.0f / sqrtf(s * (1.f / DM) + RMS_EPS), rstd2 = 1.0f / sqrtf(s2 * (1.f / DM) + RMS_EPS);
#pragma unroll
        for (int j = 0; j < 4; ++j) {
            const float4 g = ((const float4*)P.norm_g)[lane + 64 * j];
            uint2 o; o.x = f2bf(v[j].x * rstd * g.x) | (f2bf(v[j].y * rstd * g.y) << 16); o.y = f2bf(v[j].z * rstd * g.z) | (f2bf(v[j].w * rstd * g.w) << 16);
            ((uint2*)(XN + (size_t)t * DM))[lane + 64 * j] = o;
            if (has2) { uint2 o2; o2.x = f2bf(w[j].x * rstd2 * g.x) | (f2bf(w[j].y * rstd2 * g.y) << 16); o2.y = f2bf(w[j].z * rstd2 * g.z) | (f2bf(w[j].w * rstd2 * g.w) << 16);
                ((uint2*)(XN + (size_t)t2 * DM))[lane + 64 * j] = o2; }
        }
    }
    bf16_t* PB = (bf16_t*)(P.ws + WS_PB);
    for (int i = gt; i < T * PLE_DIM / 4; i += ngt) {
        const float4 v = ((const float4*)P.p)[i];
        uint2 o; o.x = f2bf(v.x) | (f2bf(v.y) << 16); o.y = f2bf(v.z) | (f2bf(v.w) << 16);
        ((uint2*)PB)[i] = o;
    }
    float2* CSA = (float2*)(P.ws + WS_CSA); float2* CSB = (float2*)(P.ws + WS_CSB);
    {
        const double invA = pow(10000.0, -(double)(gt & 31) / 32.0) * 0.15915494309189535, invB = pow(10000.0, -(double)(gt & 15) / 16.0) * 0.15915494309189535;
        if ((ngt & 31) == 0) {
            for (int i = gt; i < T * 32; i += ngt) { double rev = (double)P.pos[i >> 5] * invA; rev -= floor(rev); const float rf = (float)rev; CSA[i] = make_float2(__builtin_amdgcn_cosf(rf), __builtin_amdgcn_sinf(rf)); }
            for (int i = gt; i < T * 16; i += ngt) { double rev = (double)P.pos[i >> 4] * invB; rev -= floor(rev); const float rf = (float)rev; CSB[i] = make_float2(__builtin_amdgcn_cosf(rf), __builtin_amdgcn_sinf(rf)); }
        } else {
            for (int i = gt; i < T * 32; i += ngt) { double rev = (double)P.pos[i >> 5] * pow(10000.0, -(double)(i & 31) / 32.0) * 0.15915494309189535; rev -= floor(rev); const float rf = (float)rev; CSA[i] = make_float2(__builtin_amdgcn_cosf(rf), __builtin_amdgcn_sinf(rf)); }
            for (int i = gt; i < T * 16; i += ngt) { double rev = (double)P.pos[i >> 4] * pow(10000.0, -(double)(i & 15) / 16.0) * 0.15915494309189535; rev -= floor(rev); const float rf = (float)rev; CSB[i] = make_float2(__builtin_amdgcn_cosf(rf), __builtin_amdgcn_sinf(rf)); }
        }
    }
    float* ssq = (float*)(P.ws + WS_SSQQ);
    for (int i = gt; i < 3 * T; i += ngt) ssq[i] = 0.f;
    if (bid == 0 && tid == 0) {
        float s1 = 0.f, s2 = 0.f;
        for (int i = 0; i < 64; ++i) { s1 += P.diff_lambda[i] * P.diff_lambda[64 + i]; s2 += P.diff_lambda[128 + i] * P.diff_lambda[192 + i]; }
        ((float*)(P.ws + WS_MISC))[0] = expf(s1) - expf(s2) + LAM_INIT;
    }
}

constexpr int NG_SMEM_FLOATS = 16 * 129 + 16 * 65 + 128 * 65;
__device__ __forceinline__ void ngemm_tile(const bf16_t* A, int lda, int row0, const float* W, int ldw, int col0, int ncol, int K, const float* kscale, float* smem) {
    float* As = smem; float* Bs = smem + 16 * 129; float* Cs = Bs + 16 * 65;
    const int tid = tid_op(), ty = tid >> 4, tx = tid & 15;
    float acc[4][4];
#pragma unroll
    for (int i = 0; i < 4; ++i)
#pragma unroll
        for (int j = 0; j < 4; ++j) acc[i][j] = 0.f;
#pragma unroll 1
    for (int k0 = 0; k0 < K; k0 += 16) {
        __syncthreads();
#pragma unroll
        for (int i = 0; i < 4; ++i) { const int idx = tid + i * NT, r = idx >> 4, kk = idx & 15; As[kk * 129 + r] = bf2f(A[(size_t)(row0 + r) * lda + k0 + kk]); }
#pragma unroll
        for (int i = 0; i < 2; ++i) { const int idx = tid + i * NT, kk = idx >> 6, c = idx & 63;
            float w = 0.f; if (c < ncol) { w = W[(size_t)(k0 + kk) * ldw + col0 + c]; if (kscale) w *= kscale[k0 + kk]; }
            Bs[kk * 65 + c] = w; }
        __syncthreads();
#pragma unroll
        for (int kk = 0; kk < 16; ++kk) {
            float a[4], b[4];
#pragma unroll
            for (int i = 0; i < 4; ++i) a[i] = As[kk * 129 + ty * 4 + i];
#pragma unroll
            for (int j = 0; j < 4; ++j) b[j] = Bs[kk * 65 + tx * 4 + j];
#pragma unroll
            for (int i = 0; i < 4; ++i)
#pragma unroll
                for (int j = 0; j < 4; ++j) acc[i][j] += a[i] * b[j];
        }
    }
    __syncthreads();
#pragma unroll
    for (int i = 0; i < 4; ++i)
#pragma unroll
        for (int j = 0; j < 4; ++j) Cs[(ty * 4 + i) * 65 + tx * 4 + j] = acc[i][j];
    __syncthreads();
}

__device__ __forceinline__ void phase1_naive(const Params& P, int bid, int nb, float* smem) {
    bid = sgpr_op(bid); nb = sgpr_op(nb);
    const int tid = tid_op();
    const bf16_t* XN = (const bf16_t*)(P.ws + WS_XN);
    bf16_t* QD = (bf16_t*)(P.ws + WS_QD); bf16_t* KD = (bf16_t*)(P.ws + WS_KD); bf16_t* VD = (bf16_t*)(P.ws + WS_VD); bf16_t* G = (bf16_t*)(P.ws + WS_G);
    bf16_t* CQ = (bf16_t*)(P.ws + WS_CQ); bf16_t* KM = (bf16_t*)(P.ws + WS_KM);
    float* SSQQ = (float*)(P.ws + WS_SSQQ); float* SSQKV = (float*)(P.ws + WS_SSQKV);
    const float2* CSA = (const float2*)(P.ws + WS_CSA); const float2* CSB = (const float2*)(P.ws + WS_CSB);
    float* Cs = smem + 16 * 129 + 16 * 65;
    constexpr int NCT = 49, NRT = T / 128;
    for (int item = bid; item < NCT * NRT; item += nb) {
        const int ct = item % NCT, rt = item / NCT, row0 = rt * 128;
        int col0, ncol = 64;
        if (ct < 40) col0 = ct * 64; else if (ct == 40) { col0 = OFF_KR; ncol = 32; } else col0 = OFF_MG + (ct - 41) * 64;
        ngemm_tile(XN, DM, row0, P.w_in, DIN, col0, ncol, DM, nullptr, smem);
        _Pragma("unroll 1") for (int e = tid; e < 128 * 64; e += NT) {
            const int r = e >> 6, c = e & 63, t = row0 + r, b = t / SEQ, s = t % SEQ;
            const float v = Cs[r * 65 + c];
            if (col0 < OFF_DV) {
                const int i = c & 31; const float x1 = Cs[r * 65 + i], x2 = Cs[r * 65 + i + 32]; const float2 cs = CSA[(size_t)t * 32 + i];
                const float o = (c < 32) ? (x1 * cs.x - x2 * cs.y) : (x2 * cs.x + x1 * cs.y);
                if (col0 < OFF_DK) { const int mh = col0 / 64; QD[((size_t)(b * 8 + mh) * SEQ + s) * 64 + c] = (bf16_t)f2bf(o * C2D); }
                else { const int mh = (col0 - OFF_DK) / 64; KD[((size_t)(b * 8 + mh) * SEQ + s) * 64 + c] = (bf16_t)f2bf(o); }
            } else if (col0 < OFF_DG) { const int col = col0 - OFF_DV + c, h = col >> 7, d = col & 127; VD[((size_t)(b * 4 + h) * SEQ + s) * 128 + d] = (bf16_t)f2bf(v); }
            else if (col0 < OFF_CQ) { const int col = col0 - OFF_DG + c; G[(size_t)t * 1024 + col] = (bf16_t)f2bf(silu_f(v)); }
            else if (col0 < OFF_CKV) { const int col = col0 - OFF_CQ + c; CQ[(size_t)t * CQP + col] = (bf16_t)f2bf(v); }
            else if (col0 < OFF_KR) { const int col = col0 - OFF_CKV + c; CQ[(size_t)t * CQP + QLORA + col] = (bf16_t)f2bf(v); }
            else if (col0 == OFF_KR) { if (c < 32) { const int i = c & 15; const float x1 = Cs[r * 65 + i], x2 = Cs[r * 65 + i + 16]; const float2 cs = CSB[(size_t)t * 16 + i];
                    const float o = (c < 16) ? (x1 * cs.x - x2 * cs.y) : (x2 * cs.x + x1 * cs.y);
                    for (int h = 0; h < 8; ++h) KM[((size_t)(b * 8 + h) * SEQ + s) * 96 + 64 + c] = (bf16_t)f2bf(o); } }
            else { const int col = col0 - OFF_MG + c; G[(size_t)t * 1024 + 512 + col] = (bf16_t)f2bf(silu_f(v)); }
        }
        if (col0 >= OFF_CQ && col0 < OFF_KR && tid < 128) {
            float s = 0.f; _Pragma("unroll 4") for (int c = 0; c < 64; ++c) { const float v = Cs[tid * 65 + c]; s += v * v; }
            atomicAdd((col0 < OFF_CKV ? SSQQ : SSQKV) + row0 + tid, s);
        }
    }
}

__device__ __forceinline__ void phase15_naive(const Params& P, int bid, int nb, float* smem) {
    bid = sgpr_op(bid); nb = sgpr_op(nb);
    const int tid = tid_op();
    const bf16_t* CQ = (const bf16_t*)(P.ws + WS_CQ); const bf16_t* CKV = CQ + QLORA;
    bf16_t* QM = (bf16_t*)(P.ws + WS_QM); bf16_t* KM = (bf16_t*)(P.ws + WS_KM); bf16_t* VM = (bf16_t*)(P.ws + WS_VM);
    const float* SSQQ = (const float*)(P.ws + WS_SSQQ); const float* SSQKV = (const float*)(P.ws + WS_SSQKV);
    const float2* CSB = (const float2*)(P.ws + WS_CSB);
    float* Cs = smem + 16 * 129 + 16 * 65;
    constexpr int NCT = 12 + 16, NRT = T / 128;
    for (int item = bid; item < NCT * NRT; item += nb) {
        const int ct = item % NCT, rt = item / NCT, row0 = rt * 128;
        if (ct < 12) {
            const int col0 = ct * 64;
            ngemm_tile(CQ, CQP, row0, P.w_uq, 768, col0, 64, QLORA, P.qn_g, smem);
            _Pragma("unroll 1") for (int e = tid; e < 128 * 64; e += NT) {
                const int r = e >> 6, c = e & 63, t = row0 + r, b = t / SEQ, s = t % SEQ, col = col0 + c, h = col / 96, j = col % 96;
                const float rstd = 1.0f / sqrtf(SSQQ[t] * (1.f / QLORA) + RMS_EPS);
                float o;
                if (j < 64) o = Cs[r * 65 + c];
                else { const int jj = j - 64, i = jj & 15, cb = c - jj; const float x1 = Cs[r * 65 + cb + i], x2 = Cs[r * 65 + cb + i + 16]; const float2 cs = CSB[(size_t)t * 16 + i];
                    o = (jj < 16) ? (x1 * cs.x - x2 * cs.y) : (x2 * cs.x + x1 * cs.y); }
                QM[((size_t)(b * 8 + h) * SEQ + s) * 96 + j] = (bf16_t)f2bf(o * rstd * C2M);
            }
        } else {
            const int col0 = (ct - 12) * 64;
            ngemm_tile(CKV, CQP, row0, P.w_ukv, 1024, col0, 64, KVLORA, P.kvn_g, smem);
            _Pragma("unroll 1") for (int e = tid; e < 128 * 64; e += NT) {
                const int r = e >> 6, c = e & 63, t = row0 + r, b = t / SEQ, s = t % SEQ, col = col0 + c, h = col >> 7, j = col & 127;
                const float rstd = 1.0f / sqrtf(SSQKV[t] * (1.f / KVLORA) + RMS_EPS);
                const float o = Cs[r * 65 + c] * rstd;
                if (j < 64) KM[((size_t)(b * 8 + h) * SEQ + s) * 96 + j] = (bf16_t)f2bf(o);
                else VM[((size_t)(b * 8 + h) * SEQ + s) * 64 + j - 64] = (bf16_t)f2bf(o);
            }
        }
    }
}

template <int DQK, int DV, int DVS>
__device__ __forceinline__ void nattn_rows(const bf16_t* Qh, const bf16_t* Kh, const bf16_t* Vh, int q0, float* o, float& l_out, unsigned* smem) {
    const int tid = tid_op(), i = q0 + tid;
    unsigned* Ks = smem; unsigned* Vs = smem + 32 * (DQK / 2);
    unsigned q2[DQK / 2];
#pragma unroll
    for (int d = 0; d < DQK / 2; ++d) q2[d] = ((const unsigned*)(Qh + (size_t)i * DQK))[d];
#pragma unroll
    for (int d = 0; d < DV; ++d) o[d] = 0.f;
    float m = -1e30f, l = 0.f;
    const int jend = q0 + NT;
#pragma unroll 1
    for (int j0 = 0; j0 < jend; j0 += 32) {
        __syncthreads();
        for (int idx = tid; idx < 32 * (DQK / 2); idx += NT) Ks[idx] = ((const unsigned*)(Kh + (size_t)j0 * DQK))[idx];
        for (int idx = tid; idx < 32 * (DV / 2); idx += NT) { const int r = idx / (DV / 2), c = idx % (DV / 2); Vs[idx] = ((const unsigned*)(Vh + (size_t)(j0 + r) * DVS))[c]; }
        __syncthreads();
#pragma unroll 1
        for (int jj = 0; jj < 32; jj += 2) {
            float sc[2];
#pragma unroll
            for (int k = 0; k < 2; ++k) {
                const unsigned* kr = Ks + (jj + k) * (DQK / 2); float s = 0.f;
#pragma unroll
                for (int d = 0; d < DQK / 2; ++d) { const unsigned kk = kr[d]; unsigned qq = q2[d]; asm volatile("" : "+v"(qq));
                    s += __uint_as_float(qq << 16) * __uint_as_float(kk << 16); s += __uint_as_float(qq & 0xffff0000u) * __uint_as_float(kk & 0xffff0000u); }
                sc[k] = (j0 + jj + k <= i) ? s : -1e30f;
                asm volatile("" : "+v"(sc[k]));
            }
            const float mn = fmaxf(fmaxf(sc[0], sc[1]), m);
            const float alpha = exp2f(m - mn);
            float pr[2];
#pragma unroll
            for (int k = 0; k < 2; ++k) pr[k] = (j0 + jj + k <= i) ? exp2f(sc[k] - mn) : 0.f;
            l = l * alpha + (pr[0] + pr[1]); m = mn;
#pragma unroll
            for (int d = 0; d < DV; ++d) o[d] *= alpha;
#pragma unroll
            for (int k = 0; k < 2; ++k) { const unsigned* vr = Vs + (jj + k) * (DV / 2);
#pragma unroll
                for (int d = 0; d < DV / 2; ++d) { const unsigned vv = vr[d]; o[2 * d] += pr[k] * __uint_as_float(vv << 16); o[2 * d + 1] += pr[k] * __uint_as_float(vv & 0xffff0000u); } }
        }
    }
    l_out = l;
}
__device__ __forceinline__ void phase2_naive(const Params& P, int bid, int nb, float* smemf) {
    bid = sgpr_op(bid); nb = sgpr_op(nb);
    unsigned* smem = (unsigned*)smemf;
    const bf16_t* QD = (const bf16_t*)(P.ws + WS_QD); const bf16_t* KD = (const bf16_t*)(P.ws + WS_KD); const bf16_t* VD = (const bf16_t*)(P.ws + WS_VD);
    const bf16_t* QM = (const bf16_t*)(P.ws + WS_QM); const bf16_t* KM = (const bf16_t*)(P.ws + WS_KM); const bf16_t* VM = (const bf16_t*)(P.ws + WS_VM);
    const bf16_t* G = (const bf16_t*)(P.ws + WS_G); bf16_t* OD = (bf16_t*)(P.ws + WS_OD); bf16_t* YC = (bf16_t*)(P.ws + WS_YCAT);
    constexpr int NCH = SEQ / NT;
    for (int item = bid; item < 2 * 64 * NCH; item += nb) {
        const int kind = item / (64 * NCH), rem = item % (64 * NCH), bh = rem / NCH, ch = NCH - 1 - rem % NCH, q0 = ch * NT, b = bh >> 3, hh = bh & 7;
        const int i = q0 + tid_op();
        if (kind == 0) {
#pragma unroll 1
            for (int half = 0; half < 2; ++half) {
                float o[64], l;
                nattn_rows<64, 64, 128>(QD + (size_t)bh * SEQ * 64, KD + (size_t)bh * SEQ * 64, VD + (size_t)(b * 4 + (hh >> 1)) * SEQ * 128 + half * 64, q0, o, l, smem);
                const float rl = 1.f / l;
#pragma unroll
                for (int d = 0; d < 64; ++d) OD[((size_t)bh * SEQ + i) * 128 + half * 64 + d] = (bf16_t)f2bf(o[d] * rl);
            }
        } else {
            float o[64], l;
            nattn_rows<96, 64, 64>(QM + (size_t)bh * SEQ * 96, KM + (size_t)bh * SEQ * 96, VM + (size_t)bh * SEQ * 64, q0, o, l, smem);
            const float rl = 1.f / l; const size_t t = (size_t)b * SEQ + i;
#pragma unroll
            for (int d = 0; d < 64; ++d) { const size_t idx = t * 1024 + 512 + hh * 64 + d; YC[idx] = (bf16_t)f2bf(o[d] * rl * bf2f(G[idx])); }
        }
    }
}

__device__ __forceinline__ void phase25_naive(const Params& P, int bid, int nb) {
    bid = sgpr_op(bid); nb = sgpr_op(nb);
    const bf16_t* OD = (const bf16_t*)(P.ws + WS_OD); const bf16_t* G = (const bf16_t*)(P.ws + WS_G); bf16_t* YC = (bf16_t*)(P.ws + WS_YCAT);
    const float lam = ((const float*)(P.ws + WS_MISC))[0];
    const int tid = tid_op(), lane = tid & 63, wave = tid >> 6;
    const int gw = bid * (NT / 64) + wave, ngw = nb * (NT / 64);
    for (int it = gw; it < T * 4; it += ngw) {
        const int t = it >> 2, h = it & 3, b = t / SEQ, s = t % SEQ;
        const bf16_t* o0 = OD + ((size_t)(b * 8 + 2 * h) * SEQ + s) * 128; const bf16_t* o1 = OD + ((size_t)(b * 8 + 2 * h + 1) * SEQ + s) * 128;
        const float d0 = bf2f(o0[lane]) - lam * bf2f(o1[lane]), d1 = bf2f(o0[lane + 64]) - lam * bf2f(o1[lane + 64]);
        const float ss = wave_sum(d0 * d0 + d1 * d1);
        const float rstd = 1.0f / sqrtf(ss * (1.f / 128.f) + RMS_EPS);
        const size_t base = (size_t)t * 1024 + h * 128;
        YC[base + lane] = (bf16_t)f2bf(d0 * rstd * P.subln_g[lane] * (1.f - LAM_INIT) * bf2f(G[base + lane]));
        YC[base + lane + 64] = (bf16_t)f2bf(d1 * rstd * P.subln_g[lane + 64] * (1.f - LAM_INIT) * bf2f(G[base + lane + 64]));
    }
}

__device__ __forceinline__ void phase3_naive(const Params& P, int bid, int nb, float* smem) {
    bid = sgpr_op(bid); nb = sgpr_op(nb);
    const int tid = tid_op();
    const bf16_t* YC = (const bf16_t*)(P.ws + WS_YCAT); const bf16_t* PB = (const bf16_t*)(P.ws + WS_PB);
    bf16_t* HB = (bf16_t*)(P.ws + WS_HB); bf16_t* PLE = (bf16_t*)(P.ws + WS_PLE);
    float* Cs = smem + 16 * 129 + 16 * 65;
    constexpr int NRT = T / 128;
    for (int item = bid; item < 32 * NRT; item += nb) {
        const int ct = item % 32, rt = item / 32, row0 = rt * 128, col0 = (ct & 15) * 64;
        if (ct < 16) {
            ngemm_tile(YC, DM, row0, P.w_out, DM, col0, 64, DM, nullptr, smem);
            _Pragma("unroll 1") for (int e = tid; e < 128 * 64; e += NT) { const int r = e >> 6, c = e & 63; const size_t idx = (size_t)(row0 + r) * DM + col0 + c;
                const float h = P.x[idx] + Cs[r * 65 + c]; P.out[idx] = h; HB[idx] = (bf16_t)f2bf(h); }
        } else {
            ngemm_tile(PB, PLE_DIM, row0, P.w_ple, DM, col0, 64, PLE_DIM, nullptr, smem);
            _Pragma("unroll 1") for (int e = tid; e < 128 * 64; e += NT) { const int r = e >> 6, c = e & 63; const size_t idx = (size_t)(row0 + r) * DM + col0 + c; PLE[idx] = (bf16_t)f2bf(Cs[r * 65 + c]); }
        }
    }
}
__device__ __forceinline__ void phase4_naive(const Params& P, int bid, int nb, float* smem) {
    bid = sgpr_op(bid); nb = sgpr_op(nb);
    const int tid = tid_op();
    const bf16_t* HB = (const bf16_t*)(P.ws + WS_HB); const bf16_t* PLE = (const bf16_t*)(P.ws + WS_PLE); float* SSQF = (float*)(P.ws + WS_SSQF);
    float* Cs = smem + 16 * 129 + 16 * 65;
    constexpr int NRT = T / 128;
    for (int item = bid; item < 16 * NRT; item += nb) {
        const int ct = item % 16, rt = item / 16, row0 = rt * 128, col0 = ct * 64;
        ngemm_tile(HB, DM, row0, P.w_gate, DM, col0, 64, DM, nullptr, smem);
        _Pragma("unroll 1") for (int e = tid; e < 128 * 64; e += NT) { const int r = e >> 6, c = e & 63; const size_t idx = (size_t)(row0 + r) * DM + col0 + c;
            const float h2 = P.out[idx] + bf2f(PLE[idx]) * sigmoid_f(Cs[r * 65 + c]); P.out[idx] = h2; Cs[r * 65 + c] = h2; }
        __syncthreads();
        if (tid < 128) { float s = 0.f; _Pragma("unroll 4") for (int c = 0; c < 64; ++c) { const float v = Cs[tid * 65 + c]; s += v * v; } atomicAdd(SSQF + row0 + tid, s); }
    }
}
__device__ __forceinline__ void phase5(const Params& P, int bid, int nb) {
    bid = sgpr_op(bid); nb = sgpr_op(nb);
    const float* SSQF = (const float*)(P.ws + WS_SSQF);
    const int tid = tid_op(), lane = tid & 63, wave = tid >> 6;
    const int gw = bid * (NT / 64) + wave, ngw = nb * (NT / 64);
    for (int t = gw; t < T; t += ngw) {
        const float rstd = 1.0f / sqrtf(SSQF[t] * (1.f / DM) + RMS_EPS);
        float4* o = (float4*)(P.out + (size_t)t * DM);
#pragma unroll
        for (int j = 0; j < 4; ++j) { float4 v = o[lane + 64 * j]; const float4 g = ((const float4*)P.final_g)[lane + 64 * j];
            v.x *= rstd * g.x; v.y *= rstd * g.y; v.z *= rstd * g.z; v.w *= rstd * g.w; o[lane + 64 * j] = v; }
    }
}

namespace pg8 {
#define PG8_LAS __attribute__((address_space(3)))
typedef unsigned short bf16_t;
typedef short bf16x8 __attribute__((ext_vector_type(8)));
typedef float f32x4 __attribute__((ext_vector_type(4)));
typedef unsigned u32x4 __attribute__((ext_vector_type(4)));
constexpr int BM = 256, BK = 64, HALF = 128, HTB = HALF * BK * 2  , STAGE_BYTES = 8 * HTB, NXCD = 8, WGM = 8;

__host__ __device__ __forceinline__ int lds_byte(int r, int c) { const int st = (r >> 4) * 2 + (c >> 5), rr = r & 15, cc = c & 31, ob = rr * 64 + cc * 2; return st * 1024 + (ob ^ (((ob >> 9) & 1) << 5)); }
__host__ __device__ __forceinline__ void stage_rc(int b, int& R, int& C) { const int st = b / 1024, sb = b % 1024, swz = sb ^ (((sb >> 9) & 1) << 5); R = (st >> 1) * 16 + swz / 64; C = (st & 1) * 32 + (swz % 64) / 2; }
__host__ __device__ __forceinline__ int perm32(int rho) { const int n = rho >> 4, i = rho & 15; return 8 * (i >> 2) + 4 * n + (i & 3); }

struct Unit { int pm, pn; };
struct Gemm { const bf16_t* A; const bf16_t* Bt; int M, N, K, lda; };

struct StaticOrder {
    int nM, nN, nwg, G, c;
    __host__ __device__ void init(int M, int N, int G_, int c_) { nM = M / BM; nN = N / BM; nwg = nM * nN; G = G_; c = c_; }
    __host__ __device__ bool next(int i, Unit& u) const {
        const long L = (long)i * G + c; if (L >= nwg) return false;
        int wgid = (int)L; { const int q = nwg / NXCD, r = nwg % NXCD, xcd = wgid % NXCD, off = wgid / NXCD; wgid = (xcd < r ? xcd * (q + 1) : r * (q + 1) + (xcd - r) * q) + off; }
        const int nig = WGM * nN, gid = wgid / nig, fm = gid * WGM, gsz = (nM - fm) < WGM ? (nM - fm) : WGM;
        u.pm = fm + ((wgid % nig) % gsz); u.pn = (wgid % nig) / gsz; return true;
    }
    __device__ __forceinline__ void a_ready(const Unit&) const {}
    __device__ __forceinline__ void done(const Unit&) const {}
};

__device__ __forceinline__ unsigned cvt_pk_bf16(float lo, float hi) { unsigned r; asm volatile("v_cvt_pk_bf16_f32 %0, %1, %2" : "=v"(r) : "v"(lo), "v"(hi)); return r; }
template <class Epi, class Sched, bool ALIGN_EPI = false, bool SP2 = false>
__device__ __forceinline__ void gemm_phase(PG8_LAS unsigned char* lds, const Gemm g, const Sched& S, const Epi& E) {
    const int tid = tid_op(), wid = __builtin_amdgcn_readfirstlane(tid >> 6), lane = tid & 63, wr = wid >> 2, wc = wid & 3, fr = lane & 15, fq = lane >> 4;
    const int K = g.K, nt = K / BK;
    unsigned voffA[2], voffB[2];
#pragma unroll
    for (int i = 0; i < 2; ++i) { int R, C; stage_rc(tid * 16 + i * 8192, R, C); const int Rb = Epi::PERM ? ((R & ~31) + perm32(R & 31)) : R;
        voffA[i] = (unsigned)(R * g.lda + C) * 2u; voffB[i] = (unsigned)(Rb * K + C) * 2u; }
    const size_t kstep = (size_t)(BK * 2);
    const size_t hstepA = (size_t)HALF * g.lda * 2, hstepB = (size_t)HALF * K * 2;
    const size_t tstepA = 2 * hstepA, tstepB = 2 * hstepB;
    const unsigned ldsw = (unsigned)wid * 1024u;
    const int aoff = lds_byte(wr * 64 + fr, fq * 8), boff = lds_byte(wc * 32 + fr, fq * 8);
#define PG8_SA(b, h) (((b) * 2 + (h)) * HTB)
#define PG8_SB(b, h) ((4 + (b) * 2 + (h)) * HTB)
#define PG8_STAGE(bufoff, gbase, voff) do { _Pragma("unroll") for (int _i = 0; _i < 2; ++_i) \
        __builtin_amdgcn_global_load_lds((const unsigned*)((const char*)(gbase) + (voff)[_i]), (PG8_LAS unsigned*)(lds + (bufoff) + ldsw + _i * 8192), 16, 0, 0); } while (0)
#define PG8_LDA(dst, b, h) do { _Pragma("unroll") for (int m = 0; m < 4; ++m) _Pragma("unroll") for (int k = 0; k < 2; ++k) dst[m][k] = *(const PG8_LAS bf16x8*)(lds + PG8_SA(b, h) + aoff + m * 2048 + k * 1024); } while (0)
#define PG8_LDB(dst, b, h) do { _Pragma("unroll") for (int n = 0; n < 2; ++n) _Pragma("unroll") for (int k = 0; k < 2; ++k) dst[n][k] = *(const PG8_LAS bf16x8*)(lds + PG8_SB(b, h) + boff + n * 2048 + k * 1024); } while (0)
#define PG8_MMA(ai, bj, At, Bt) do { __builtin_amdgcn_s_setprio(1); _Pragma("unroll") for (int m = 0; m < 4; ++m) _Pragma("unroll") for (int n = 0; n < 2; ++n) _Pragma("unroll") for (int k = 0; k < 2; ++k) \
        acc[ai][bj][m][n] = __builtin_amdgcn_mfma_f32_16x16x32_bf16(Bt[n][k], At[m][k], acc[ai][bj][m][n], 0, 0, 0); __builtin_amdgcn_s_setprio(0); } while (0)
#define PG8_WAIT_V(n) asm volatile("s_waitcnt vmcnt(" #n ")" ::: "memory")
#define PG8_WAIT_L(n) asm volatile("s_waitcnt lgkmcnt(" #n ")" ::: "memory")
#define PG8_BAR __builtin_amdgcn_s_barrier()
#define PG8_SCHED __builtin_amdgcn_sched_barrier(0)
    Unit cur, nxt; int ui = 0;
    if (!S.next(0, cur)) return;
    f32x4 acc[2][2][4][2];
#pragma unroll
    for (int a = 0; a < 2; ++a)
#pragma unroll
        for (int b = 0; b < 2; ++b)
#pragma unroll
            for (int m = 0; m < 4; ++m)
#pragma unroll
                for (int n = 0; n < 2; ++n) acc[a][b][m][n] = (f32x4){0.f, 0.f, 0.f, 0.f};
    bf16x8 At[4][2], B0[2][2], B1[2][2];
    const char* cA = (const char*)g.A + (size_t)cur.pm * tstepA; const char* cB = (const char*)g.Bt + (size_t)cur.pn * tstepB;
    S.a_ready(cur);
    if constexpr (SP2) {
        PG8_STAGE(PG8_SB(0, 0), cB, voffB); PG8_STAGE(PG8_SB(0, 1), cB + hstepB, voffB); PG8_STAGE(PG8_SA(0, 0), cA, voffA); PG8_STAGE(PG8_SA(0, 1), cA + hstepA, voffA);
        if (wr == 1) PG8_BAR;
        PG8_WAIT_V(2); PG8_BAR;
        PG8_STAGE(PG8_SB(1, 0), cB + kstep, voffB); PG8_STAGE(PG8_SA(1, 0), cA + kstep, voffA); PG8_STAGE(PG8_SB(1, 1), cB + hstepB + kstep, voffB);
        PG8_WAIT_V(6); PG8_BAR;
    } else {
        PG8_STAGE(PG8_SB(0, 0), cB, voffB); PG8_STAGE(PG8_SA(0, 0), cA, voffA); PG8_STAGE(PG8_SB(0, 1), cB + hstepB, voffB); PG8_STAGE(PG8_SA(0, 1), cA + hstepA, voffA);
        if (wr == 1) PG8_BAR;
        PG8_WAIT_V(4); PG8_BAR;
        PG8_STAGE(PG8_SB(1, 0), cB + kstep, voffB); PG8_STAGE(PG8_SA(1, 0), cA + kstep, voffA); PG8_STAGE(PG8_SB(1, 1), cB + hstepB + kstep, voffB);
        PG8_WAIT_V(6); PG8_BAR;
    }
    for (;;) {
        const bool has_next = S.next(ui + 1, nxt);
        const char* nA = has_next ? (const char*)g.A + (size_t)nxt.pm * tstepA : cA; const char* nB = has_next ? (const char*)g.Bt + (size_t)nxt.pn * tstepB : cB;
#pragma unroll 1
        for (int t = 0; t < nt; t += 2) {
            const bool last = (t == nt - 2);
            const char* a1 = cA + (size_t)(t + 1) * kstep;
            const char* a2 = last ? nA : cA + (size_t)(t + 2) * kstep; const char* b2 = last ? nB : cB + (size_t)(t + 2) * kstep;
            const char* a3 = a2 + kstep; const char* b3 = b2 + kstep;
            if (last && has_next) S.a_ready(nxt);
            if constexpr (SP2) {
            PG8_LDB(B0, 0, 0); PG8_LDB(B1, 0, 1); PG8_SCHED; PG8_LDA(At, 0, 0); PG8_STAGE(PG8_SA(1, 1), a1 + hstepA, voffA);
            PG8_WAIT_V(8); PG8_WAIT_L(0); PG8_BAR; PG8_MMA(0, 0, At, B0); PG8_MMA(0, 1, At, B1); PG8_BAR; PG8_SCHED;
            PG8_LDA(At, 0, 1); PG8_STAGE(PG8_SB(0, 0), b2, voffB); PG8_STAGE(PG8_SB(0, 1), b2 + hstepB, voffB); PG8_STAGE(PG8_SA(0, 0), a2, voffA);
            PG8_WAIT_V(8); PG8_WAIT_L(0); PG8_BAR; PG8_MMA(1, 0, At, B0); PG8_MMA(1, 1, At, B1); PG8_BAR; PG8_SCHED;
            PG8_LDB(B0, 1, 0); PG8_LDB(B1, 1, 1); PG8_SCHED; PG8_LDA(At, 1, 0); PG8_STAGE(PG8_SA(0, 1), a2 + hstepA, voffA);
            PG8_WAIT_V(8); PG8_WAIT_L(0); PG8_BAR; PG8_MMA(0, 0, At, B0); PG8_MMA(0, 1, At, B1); PG8_BAR; PG8_SCHED;
            PG8_LDA(At, 1, 1); PG8_STAGE(PG8_SB(1, 0), b3, voffB); PG8_STAGE(PG8_SB(1, 1), b3 + hstepB, voffB); PG8_STAGE(PG8_SA(1, 0), a3, voffA);
            PG8_WAIT_V(8); PG8_WAIT_L(0); PG8_BAR; PG8_MMA(1, 0, At, B0); PG8_MMA(1, 1, At, B1); PG8_BAR; PG8_SCHED;
            } else {
            PG8_LDB(B0, 0, 0); PG8_SCHED; PG8_LDA(At, 0, 0); PG8_STAGE(PG8_SA(1, 1), a1 + hstepA, voffA);
            PG8_WAIT_L(8); PG8_BAR; PG8_WAIT_L(0); PG8_MMA(0, 0, At, B0); PG8_BAR; PG8_SCHED;
            PG8_LDB(B1, 0, 1); PG8_STAGE(PG8_SB(0, 0), b2, voffB);
            PG8_BAR; PG8_WAIT_L(0); PG8_MMA(0, 1, At, B1); PG8_BAR;
            PG8_LDA(At, 0, 1); PG8_STAGE(PG8_SA(0, 0), a2, voffA);
            PG8_BAR; PG8_WAIT_L(0); PG8_MMA(1, 0, At, B0); PG8_BAR; PG8_SCHED;
            PG8_STAGE(PG8_SB(0, 1), b2 + hstepB, voffB);
            PG8_WAIT_V(6); PG8_BAR; PG8_MMA(1, 1, At, B1); PG8_BAR;
            PG8_LDB(B0, 1, 0); PG8_SCHED; PG8_LDA(At, 1, 0); PG8_STAGE(PG8_SA(0, 1), a2 + hstepA, voffA);
            PG8_WAIT_L(8); PG8_BAR; PG8_WAIT_L(0); PG8_MMA(0, 0, At, B0); PG8_BAR; PG8_SCHED;
            PG8_LDB(B1, 1, 1); PG8_STAGE(PG8_SB(1, 0), b3, voffB);
            PG8_BAR; PG8_WAIT_L(0); PG8_MMA(0, 1, At, B1); PG8_BAR;
            PG8_LDA(At, 1, 1); PG8_STAGE(PG8_SA(1, 0), a3, voffA);
            PG8_BAR; PG8_WAIT_L(0); PG8_MMA(1, 0, At, B0); PG8_BAR; PG8_SCHED;
            PG8_STAGE(PG8_SB(1, 1), b3 + hstepB, voffB);
            PG8_WAIT_V(6); PG8_BAR; PG8_MMA(1, 1, At, B1); PG8_BAR;
            }
        }
        if constexpr (ALIGN_EPI) { if (wr == 0) PG8_BAR; }
        if constexpr (!Epi::AFTER_DRAIN) { E(acc, cur, wr, wc, fr, fq); S.done(cur); }
        if (!has_next) break;
#pragma unroll
        for (int a = 0; a < 2; ++a)
#pragma unroll
            for (int b = 0; b < 2; ++b)
#pragma unroll
                for (int m = 0; m < 4; ++m)
#pragma unroll
                    for (int n = 0; n < 2; ++n) acc[a][b][m][n] = (f32x4){0.f, 0.f, 0.f, 0.f};
        cur = nxt; cA = nA; cB = nB; ++ui;
        if constexpr (ALIGN_EPI) { if (wr == 1) PG8_BAR; }
    }
    PG8_WAIT_V(0);
    if constexpr (!ALIGN_EPI) { if (wr == 0) PG8_BAR; }
    PG8_BAR;
    if constexpr (Epi::AFTER_DRAIN) { E.fused(acc, cur, wr, wc, fr, fq, lds, wid, lane); S.done(cur); }
#undef PG8_SA
#undef PG8_SB
#undef PG8_STAGE
#undef PG8_LDA
#undef PG8_LDB
#undef PG8_MMA
#undef PG8_WAIT_V
#undef PG8_WAIT_L
#undef PG8_BAR
#undef PG8_SCHED
}
}

#define LAS __attribute__((address_space(3)))
typedef float f32x4 __attribute__((ext_vector_type(4)));
typedef unsigned u32x4 __attribute__((ext_vector_type(4)));
using pg8::cvt_pk_bf16;
__device__ __forceinline__ u32x4 pack8(const f32x4 a, const f32x4 b) { u32x4 w; w.x = cvt_pk_bf16(a[0], a[1]); w.y = cvt_pk_bf16(a[2], a[3]); w.z = cvt_pk_bf16(b[0], b[1]); w.w = cvt_pk_bf16(b[2], b[3]); return w; }

struct MapIn {
    __device__ __forceinline__ int operator()(int g) const { const int pn = g >> 8, cc = g & 255, bj = cc >> 7, w = cc & 127;
        if (pn < 2) return OFF_DQ + (4 * pn + (w >> 5)) * 64 + bj * 32 + (w & 31);
        if (pn < 4) return OFF_DK + (4 * (pn - 2) + (w >> 5)) * 64 + bj * 32 + (w & 31);
        if (pn < 6) return OFF_DV + (pn - 4) * 256 + cc;
        if (pn < 8) return OFF_DG + (pn - 6) * 256 + cc;
        if (pn == 8) return OFF_CQ + cc;
        if (pn == 9) return bj == 0 ? OFF_CQ + 256 + w : OFF_CKV + w;
        if (pn < 12) return OFF_MG + (pn - 10) * 256 + cc;
        return w < 16 ? OFF_KR + bj * 16 + w : -1; } };
struct MapUq {
    __device__ __forceinline__ int operator()(int g) const { const int pn = g >> 8, cc = g & 255;
        if (pn == 0) { const int bj = cc >> 7, w = cc & 127; return (w >> 4) * 96 + 64 + bj * 16 + (w & 15); }
        const int gp = g - 256; return (gp >> 6) * 96 + (gp & 63); } };
struct MapId { __device__ __forceinline__ int operator()(int g) const { return g; } };
template <class Map>
__device__ __forceinline__ void wconv(const float* W, int K, int ldw, const float* kscale, bf16_t* Wt, int ldwt, int kdst_off, int Ng, Map map, LAS float* scr, int gw, int ngw, int lane) {
    const int nblk = Ng / 32, items = (K / 64) * nblk;
    for (int it = gw; it < items; it += ngw) {
        const int kb = it / nblk, nbk = it % nblk, k0 = 64 * kb, n0 = 32 * nbk;
        const int src = map(n0 + (lane & 31));
#pragma unroll 8
        for (int i = 0; i < 32; ++i) { const int kk = 2 * i + (lane >> 5);
            float v = 0.f; if (src >= 0) { v = W[(size_t)(k0 + kk) * ldw + src]; if (kscale) v *= kscale[k0 + kk]; }
            scr[kk * 33 + (lane & 31)] = v; }
        asm volatile("s_waitcnt lgkmcnt(0)" ::: "memory");
        const int c = lane & 7;
#pragma unroll
        for (int j = 0; j < 4; ++j) { const int n = (lane >> 3) + 8 * j; const LAS float* sp = scr + (8 * c) * 33 + n;
            u32x4 o; o.x = f2bf(sp[0]) | (f2bf(sp[33]) << 16); o.y = f2bf(sp[2 * 33]) | (f2bf(sp[3 * 33]) << 16); o.z = f2bf(sp[4 * 33]) | (f2bf(sp[5 * 33]) << 16); o.w = f2bf(sp[6 * 33]) | (f2bf(sp[7 * 33]) << 16);
            *(u32x4*)(Wt + (size_t)(n0 + n) * ldwt + kdst_off + k0 + 8 * c) = o; }
        asm volatile("s_waitcnt lgkmcnt(0)" ::: "memory");
    }
}
constexpr int NIN = 13 * 256;
__device__ __forceinline__ void phase0_weights(const Params& P, LAS unsigned char* lds, int gw, int ngw) {
    const int tid = tid_op(), lane = tid & 63, wave = tid >> 6;
    LAS float* scr = (LAS float*)(lds + wave * 16384);
    wconv(P.w_in, DM, DIN, nullptr, (bf16_t*)(P.ws + WS_WIN), DM, 0, NIN, MapIn(), scr, gw, ngw, lane);
    wconv(P.w_ple, PLE_DIM, DM, nullptr, (bf16_t*)(P.ws + WS_WPLE), PLE_DIM, 0, DM, MapId(), scr, gw, ngw, lane);
    wconv(P.w_uq, QLORA, 768, P.qn_g, (bf16_t*)(P.ws + WS_WUQ), QLORA, 0, 768, MapUq(), scr, gw, ngw, lane);
    wconv(P.w_ukv, KVLORA, 1024, P.kvn_g, (bf16_t*)(P.ws + WS_WUKV), 256, 128, 1024, MapId(), scr, gw, ngw, lane);
    wconv(P.w_out, DM, DM, nullptr, (bf16_t*)(P.ws + WS_WOUT), DM, 0, DM, MapId(), scr, gw, ngw, lane);
    wconv(P.w_gate, DM, DM, nullptr, (bf16_t*)(P.ws + WS_WG), DM, 0, DM, MapId(), scr, gw, ngw, lane);
    u32x4* z = (u32x4*)(P.ws + WS_WUKV);
    for (int i = gw * 64 + lane; i < 1024 * 16; i += ngw * 64) { const int g = i >> 4, c = i & 15; z[g * 32 + c] = (u32x4){0u, 0u, 0u, 0u}; }
}

struct Epi1 {
    static constexpr bool PERM = true, AFTER_DRAIN = false;
    bf16_t *QD, *KD, *VD, *G, *CQ, *KM; float *SSQQ, *SSQKV; const float2 *CSA, *CSB;
    __device__ __forceinline__ void operator()(const f32x4 (&acc)[2][2][4][2], const pg8::Unit& u, int wr, int wc, int fr, int fq) const {
        const int pn = u.pn, b = u.pm >> 4, s0 = (u.pm & 15) * 256 + wr * 64 + fr, t0 = u.pm * 256 + wr * 64 + fr;
        if (pn < 4) {
            bf16_t* dst = pn < 2 ? QD : KD; const float sc = pn < 2 ? C2D : 1.f; const int mh = 4 * (pn & 1) + wc;
            f32x4 csb[2][4];
            { const f32x4* cs = (const f32x4*)(CSA + (size_t)t0 * 32 + 8 * fq);
#pragma unroll
              for (int k = 0; k < 4; ++k) csb[0][k] = cs[k]; }
#pragma unroll
            for (int g = 0; g < 8; ++g) { const int ai = g >> 2, m = g & 3, ro = ai * 128 + m * 16;
                if (g + 1 < 8) { const int ro2 = ((g + 1) >> 2) * 128 + ((g + 1) & 3) * 16; const f32x4* cs = (const f32x4*)(CSA + (size_t)(t0 + ro2) * 32 + 8 * fq);
#pragma unroll
                    for (int k = 0; k < 4; ++k) csb[(g + 1) & 1][k] = cs[k]; }
                asm volatile("" ::: "memory");
                f32x4 o1[2], o2[2];
#pragma unroll
                for (int n = 0; n < 2; ++n) { const f32x4 ca = csb[g & 1][2 * n], cb = csb[g & 1][2 * n + 1]; const f32x4 x1 = acc[ai][0][m][n], x2 = acc[ai][1][m][n];
                    o1[n] = (f32x4){x1[0] * ca[0] - x2[0] * ca[1], x1[1] * ca[2] - x2[1] * ca[3], x1[2] * cb[0] - x2[2] * cb[1], x1[3] * cb[2] - x2[3] * cb[3]} * sc;
                    o2[n] = (f32x4){x2[0] * ca[0] + x1[0] * ca[1], x2[1] * ca[2] + x1[1] * ca[3], x2[2] * cb[0] + x1[2] * cb[1], x2[3] * cb[2] + x1[3] * cb[3]} * sc; }
                bf16_t* rp = dst + ((size_t)(b * 8 + mh) * SEQ + s0 + ro) * 64 + 8 * fq;
                *(u32x4*)rp = pack8(o1[0], o1[1]); *(u32x4*)(rp + 32) = pack8(o2[0], o2[1]); asm volatile("" ::: "memory"); }
        } else if (pn < 6) {
#pragma unroll
            for (int ai = 0; ai < 2; ++ai)
#pragma unroll
                for (int m = 0; m < 4; ++m)
#pragma unroll
                    for (int bj = 0; bj < 2; ++bj) { const int ro = ai * 128 + m * 16, h = 2 * (pn - 4) + bj;
                        *(u32x4*)(VD + ((size_t)(b * 4 + h) * SEQ + s0 + ro) * 128 + 32 * wc + 8 * fq) = pack8(acc[ai][bj][m][0], acc[ai][bj][m][1]); }
        } else if (pn < 8 || pn == 10 || pn == 11) {
            const int cb = (pn < 8 ? (pn - 6) * 256 : 512 + (pn - 10) * 256) + 32 * wc + 8 * fq;
#pragma unroll
            for (int ai = 0; ai < 2; ++ai)
#pragma unroll
                for (int m = 0; m < 4; ++m)
#pragma unroll
                    for (int bj = 0; bj < 2; ++bj) { const int ro = ai * 128 + m * 16; f32x4 a = acc[ai][bj][m][0], c = acc[ai][bj][m][1];
#pragma unroll
                        for (int j = 0; j < 4; ++j) { a[j] = silu_f(a[j]); c[j] = silu_f(c[j]); }
                        *(u32x4*)(G + (size_t)(t0 + ro) * 1024 + cb + 128 * bj) = pack8(a, c); }
        } else if (pn < 10) {
#pragma unroll
            for (int ai = 0; ai < 2; ++ai)
#pragma unroll
                for (int m = 0; m < 4; ++m) { const int ro = ai * 128 + m * 16; float ss[2];
#pragma unroll
                    for (int bj = 0; bj < 2; ++bj) { const f32x4 a = acc[ai][bj][m][0], c = acc[ai][bj][m][1];
                        *(u32x4*)(CQ + (size_t)(t0 + ro) * CQP + (pn - 8) * 256 + 128 * bj + 32 * wc + 8 * fq) = pack8(a, c);
                        float q = (a[0] * a[0] + a[1] * a[1]) + (a[2] * a[2] + a[3] * a[3]) + (c[0] * c[0] + c[1] * c[1]) + (c[2] * c[2] + c[3] * c[3]);
                        q += __shfl_xor(q, 16); q += __shfl_xor(q, 32); ss[bj] = q; }
                    if (fq == 0) { if (pn == 8) atomicAdd(SSQQ + t0 + ro, ss[0] + ss[1]); else { atomicAdd(SSQQ + t0 + ro, ss[0]); atomicAdd(SSQKV + t0 + ro, ss[1]); } } }
        } else {
            if (wc == 0 && fq < 2) {
#pragma unroll
                for (int ai = 0; ai < 2; ++ai)
#pragma unroll
                    for (int m = 0; m < 4; ++m) { const int ro = ai * 128 + m * 16; const f32x4* cs = (const f32x4*)(CSB + (size_t)(t0 + ro) * 16 + 8 * fq);
                        f32x4 o1[2], o2[2];
#pragma unroll
                        for (int n = 0; n < 2; ++n) { const f32x4 ca = cs[2 * n], cb = cs[2 * n + 1]; const f32x4 x1 = acc[ai][0][m][n], x2 = acc[ai][1][m][n];
                            o1[n] = (f32x4){x1[0] * ca[0] - x2[0] * ca[1], x1[1] * ca[2] - x2[1] * ca[3], x1[2] * cb[0] - x2[2] * cb[1], x1[3] * cb[2] - x2[3] * cb[3]};
                            o2[n] = (f32x4){x2[0] * ca[0] + x1[0] * ca[1], x2[1] * ca[2] + x1[1] * ca[3], x2[2] * cb[0] + x1[2] * cb[1], x2[3] * cb[2] + x1[3] * cb[3]}; }
                        const u32x4 w1 = pack8(o1[0], o1[1]), w2 = pack8(o2[0], o2[1]);
#pragma unroll
                        for (int h = 0; h < 8; ++h) { bf16_t* rp = KM + ((size_t)(b * 8 + h) * SEQ + s0 + ro) * 96 + 64 + 8 * fq; *(u32x4*)rp = w1; *(u32x4*)(rp + 16) = w2; } }
            }
        }
    }
};
struct EpiStore {
    static constexpr bool PERM = true, AFTER_DRAIN = false;
    bf16_t* O; int ldc;
    __device__ __forceinline__ void operator()(const f32x4 (&acc)[2][2][4][2], const pg8::Unit& u, int wr, int wc, int fr, int fq) const {
        const int t0 = u.pm * 256 + wr * 64 + fr, c0 = u.pn * 256 + 32 * wc + 8 * fq;
#pragma unroll
        for (int ai = 0; ai < 2; ++ai)
#pragma unroll
            for (int m = 0; m < 4; ++m)
#pragma unroll
                for (int bj = 0; bj < 2; ++bj) *(u32x4*)(O + (size_t)(t0 + ai * 128 + m * 16) * ldc + c0 + 128 * bj) = pack8(acc[ai][bj][m][0], acc[ai][bj][m][1]);
    }
};
struct EpiQ {
    static constexpr bool PERM = true, AFTER_DRAIN = false;
    bf16_t* QM; const float* SSQQ; const float2* CSB;
    __device__ __forceinline__ void operator()(const f32x4 (&acc)[2][2][4][2], const pg8::Unit& u, int wr, int wc, int fr, int fq) const {
        const int pn = u.pn, b = u.pm >> 4, s0 = (u.pm & 15) * 256 + wr * 64 + fr, t0 = u.pm * 256 + wr * 64 + fr;
        float ssq[8];
#pragma unroll
        for (int g = 0; g < 8; ++g) ssq[g] = SSQQ[t0 + (g >> 2) * 128 + (g & 3) * 16];
        if (pn == 0) { const int h = 2 * wc + (fq >> 1), i0 = 8 * (fq & 1);
            f32x4 csb[2][4];
            { const f32x4* cs = (const f32x4*)(CSB + (size_t)t0 * 16 + i0);
#pragma unroll
              for (int k = 0; k < 4; ++k) csb[0][k] = cs[k]; }
#pragma unroll
            for (int g = 0; g < 8; ++g) { const int ai = g >> 2, m = g & 3, ro = ai * 128 + m * 16; const float sc = C2M * __builtin_amdgcn_rsqf(ssq[g] * (1.f / QLORA) + RMS_EPS);
                if (g + 1 < 8) { const int ro2 = ((g + 1) >> 2) * 128 + ((g + 1) & 3) * 16; const f32x4* cs = (const f32x4*)(CSB + (size_t)(t0 + ro2) * 16 + i0);
#pragma unroll
                    for (int k = 0; k < 4; ++k) csb[(g + 1) & 1][k] = cs[k]; }
                asm volatile("" ::: "memory");
                f32x4 o1[2], o2[2];
#pragma unroll
                for (int n = 0; n < 2; ++n) { const f32x4 ca = csb[g & 1][2 * n], cb = csb[g & 1][2 * n + 1]; const f32x4 x1 = acc[ai][0][m][n], x2 = acc[ai][1][m][n];
                    o1[n] = (f32x4){x1[0] * ca[0] - x2[0] * ca[1], x1[1] * ca[2] - x2[1] * ca[3], x1[2] * cb[0] - x2[2] * cb[1], x1[3] * cb[2] - x2[3] * cb[3]} * sc;
                    o2[n] = (f32x4){x2[0] * ca[0] + x1[0] * ca[1], x2[1] * ca[2] + x1[1] * ca[3], x2[2] * cb[0] + x1[2] * cb[1], x2[3] * cb[2] + x1[3] * cb[3]} * sc; }
                bf16_t* rp = QM + ((size_t)(b * 8 + h) * SEQ + s0 + ro) * 96 + 64 + i0;
                *(u32x4*)rp = pack8(o1[0], o1[1]); *(u32x4*)(rp + 16) = pack8(o2[0], o2[1]); asm volatile("" ::: "memory"); }
        } else {
#pragma unroll
            for (int g = 0; g < 8; ++g) { const int ai = g >> 2, m = g & 3, ro = ai * 128 + m * 16; const float sc = C2M * __builtin_amdgcn_rsqf(ssq[g] * (1.f / QLORA) + RMS_EPS);
#pragma unroll
                for (int bj = 0; bj < 2; ++bj) { const int h = 4 * (pn - 1) + 2 * bj + (wc >> 1), d = 32 * (wc & 1) + 8 * fq;
                    *(u32x4*)(QM + ((size_t)(b * 8 + h) * SEQ + s0 + ro) * 96 + d) = pack8(acc[ai][bj][m][0] * sc, acc[ai][bj][m][1] * sc); } }
        }
    }
};
struct EpiKV {
    static constexpr bool PERM = true, AFTER_DRAIN = false;
    bf16_t *KM, *VM; const float* SSQKV;
    __device__ __forceinline__ void operator()(const f32x4 (&acc)[2][2][4][2], const pg8::Unit& u, int wr, int wc, int fr, int fq) const {
        const int pn = u.pn, b = u.pm >> 4, s0 = (u.pm & 15) * 256 + wr * 64 + fr, t0 = u.pm * 256 + wr * 64 + fr;
        float ssq[8];
#pragma unroll
        for (int g = 0; g < 8; ++g) ssq[g] = SSQKV[t0 + (g >> 2) * 128 + (g & 3) * 16];
#pragma unroll
        for (int g = 0; g < 8; ++g) { const int ai = g >> 2, m = g & 3, ro = ai * 128 + m * 16; const float sc = __builtin_amdgcn_rsqf(ssq[g] * (1.f / KVLORA) + RMS_EPS);
#pragma unroll
            for (int bj = 0; bj < 2; ++bj) { const int h = 2 * pn + bj; const size_t rowi = (size_t)(b * 8 + h) * SEQ + s0 + ro;
                bf16_t* rp = (wc < 2) ? KM + rowi * 96 + 32 * wc + 8 * fq : VM + rowi * 64 + 32 * (wc - 2) + 8 * fq;
                *(u32x4*)rp = pack8(acc[ai][bj][m][0] * sc, acc[ai][bj][m][1] * sc); } }
    }
};
struct Epi3 {
    static constexpr bool PERM = true, AFTER_DRAIN = false;
    const float* x; bf16_t* HB;
    __device__ __forceinline__ void operator()(const f32x4 (&acc)[2][2][4][2], const pg8::Unit& u, int wr, int wc, int fr, int fq) const {
        const int t0 = u.pm * 256 + wr * 64 + fr, c0 = u.pn * 256 + 32 * wc + 8 * fq;
        f32x4 xb[2][4];
#pragma unroll
        for (int bj = 0; bj < 2; ++bj) { const size_t idx = (size_t)t0 * DM + c0 + 128 * bj; xb[0][2 * bj] = *(const f32x4*)(x + idx); xb[0][2 * bj + 1] = *(const f32x4*)(x + idx + 4); }
#pragma unroll
        for (int g = 0; g < 8; ++g) { const int ai = g >> 2, m = g & 3;
            if (g + 1 < 8) { const int r2 = ((g + 1) >> 2) * 128 + ((g + 1) & 3) * 16;
#pragma unroll
                for (int bj = 0; bj < 2; ++bj) { const size_t idx = (size_t)(t0 + r2) * DM + c0 + 128 * bj; xb[(g + 1) & 1][2 * bj] = *(const f32x4*)(x + idx); xb[(g + 1) & 1][2 * bj + 1] = *(const f32x4*)(x + idx + 4); } }
            asm volatile("" ::: "memory");
#pragma unroll
            for (int bj = 0; bj < 2; ++bj) { const size_t idx = (size_t)(t0 + ai * 128 + m * 16) * DM + c0 + 128 * bj;
                *(u32x4*)(HB + idx) = pack8(xb[g & 1][2 * bj] + acc[ai][bj][m][0], xb[g & 1][2 * bj + 1] + acc[ai][bj][m][1]); }
            asm volatile("" ::: "memory"); }
    }
};
struct Epi4 {
    static constexpr bool PERM = true, AFTER_DRAIN = false;
    float* out; const bf16_t* HB; const bf16_t* PLE; float* SSQF;
    __device__ __forceinline__ void operator()(const f32x4 (&acc)[2][2][4][2], const pg8::Unit& u, int wr, int wc, int fr, int fq) const {
        const int t0 = u.pm * 256 + wr * 64 + fr, c0 = u.pn * 256 + 32 * wc + 8 * fq;
        u32x4 hb[2][2], pb[2][2];
#pragma unroll
        for (int bj = 0; bj < 2; ++bj) { const size_t idx = (size_t)t0 * DM + c0 + 128 * bj; hb[0][bj] = *(const u32x4*)(HB + idx); pb[0][bj] = *(const u32x4*)(PLE + idx); }
#pragma unroll
        for (int g = 0; g < 8; ++g) { const int ai = g >> 2, m = g & 3;
            if (g + 1 < 8) { const int r2 = ((g + 1) >> 2) * 128 + ((g + 1) & 3) * 16;
#pragma unroll
                for (int bj = 0; bj < 2; ++bj) { const size_t idx = (size_t)(t0 + r2) * DM + c0 + 128 * bj; hb[(g + 1) & 1][bj] = *(const u32x4*)(HB + idx); pb[(g + 1) & 1][bj] = *(const u32x4*)(PLE + idx); } }
            asm volatile("" ::: "memory");
            float q = 0.f;
#pragma unroll
            for (int bj = 0; bj < 2; ++bj) { const size_t idx = (size_t)(t0 + ai * 128 + m * 16) * DM + c0 + 128 * bj;
                const u32x4 hw = hb[g & 1][bj], pw = pb[g & 1][bj]; const f32x4 a = acc[ai][bj][m][0], c = acc[ai][bj][m][1]; f32x4 h0, h1;
                h0[0] = __uint_as_float(hw.x << 16) + __uint_as_float(pw.x << 16) * sigmoid_f(a[0]); h0[1] = __uint_as_float(hw.x & 0xffff0000u) + __uint_as_float(pw.x & 0xffff0000u) * sigmoid_f(a[1]);
                h0[2] = __uint_as_float(hw.y << 16) + __uint_as_float(pw.y << 16) * sigmoid_f(a[2]); h0[3] = __uint_as_float(hw.y & 0xffff0000u) + __uint_as_float(pw.y & 0xffff0000u) * sigmoid_f(a[3]);
                h1[0] = __uint_as_float(hw.z << 16) + __uint_as_float(pw.z << 16) * sigmoid_f(c[0]); h1[1] = __uint_as_float(hw.z & 0xffff0000u) + __uint_as_float(pw.z & 0xffff0000u) * sigmoid_f(c[1]);
                h1[2] = __uint_as_float(hw.w << 16) + __uint_as_float(pw.w << 16) * sigmoid_f(c[2]); h1[3] = __uint_as_float(hw.w & 0xffff0000u) + __uint_as_float(pw.w & 0xffff0000u) * sigmoid_f(c[3]);
                *(f32x4*)(out + idx) = h0; *(f32x4*)(out + idx + 4) = h1;
                q += (h0[0] * h0[0] + h0[1] * h0[1]) + (h0[2] * h0[2] + h0[3] * h0[3]) + (h1[0] * h1[0] + h1[1] * h1[1]) + (h1[2] * h1[2] + h1[3] * h1[3]); }
            q += __shfl_xor(q, 16); q += __shfl_xor(q, 32);
            if (fq == 0) atomicAdd(SSQF + t0 + ai * 128 + m * 16, q);
            asm volatile("" ::: "memory"); }
    }
};

#ifndef PG8_SP2
#define PG8_SP2 true
#endif
#ifndef PG8_ALIGN
#define PG8_ALIGN true
#endif
__device__ __forceinline__ void phase1_gemm(const Params& P, LAS unsigned char* lds) {
    pg8::Gemm g{(const bf16_t*)(P.ws + WS_XN), (const bf16_t*)(P.ws + WS_WIN), T, NIN, DM, DM}; pg8::StaticOrder S; S.init(T, NIN, (int)gridDim.x, (int)blockIdx.x);
    Epi1 E{(bf16_t*)(P.ws + WS_QD), (bf16_t*)(P.ws + WS_KD), (bf16_t*)(P.ws + WS_VD), (bf16_t*)(P.ws + WS_G), (bf16_t*)(P.ws + WS_CQ), (bf16_t*)(P.ws + WS_KM),
           (float*)(P.ws + WS_SSQQ), (float*)(P.ws + WS_SSQKV), (const float2*)(P.ws + WS_CSA), (const float2*)(P.ws + WS_CSB)};
    pg8::gemm_phase<Epi1, pg8::StaticOrder, PG8_ALIGN, PG8_SP2>(lds, g, S, E);
}
__device__ __forceinline__ void phase15_gemm(const Params& P, LAS unsigned char* lds) {
    { pg8::Gemm g{(const bf16_t*)(P.ws + WS_CQ), (const bf16_t*)(P.ws + WS_WUQ), T, 768, QLORA, CQP}; pg8::StaticOrder S; S.init(T, 768, (int)gridDim.x, (int)blockIdx.x);
      EpiQ E{(bf16_t*)(P.ws + WS_QM), (const float*)(P.ws + WS_SSQQ), (const float2*)(P.ws + WS_CSB)};
      pg8::gemm_phase<EpiQ, pg8::StaticOrder, PG8_ALIGN, PG8_SP2>(lds, g, S, E); }
    { pg8::Gemm g{(const bf16_t*)(P.ws + WS_CQ) + 256, (const bf16_t*)(P.ws + WS_WUKV), T, 1024, 256, CQP}; pg8::StaticOrder S; S.init(T, 1024, (int)gridDim.x, (int)blockIdx.x);
      EpiKV E{(bf16_t*)(P.ws + WS_KM), (bf16_t*)(P.ws + WS_VM), (const float*)(P.ws + WS_SSQKV)};
      pg8::gemm_phase<EpiKV, pg8::StaticOrder, PG8_ALIGN, PG8_SP2>(lds, g, S, E); }
}
__device__ __forceinline__ void phase3_gemm(const Params& P, LAS unsigned char* lds) {
    { pg8::Gemm g{(const bf16_t*)(P.ws + WS_YCAT), (const bf16_t*)(P.ws + WS_WOUT), T, DM, DM, DM}; pg8::StaticOrder S; S.init(T, DM, (int)gridDim.x, (int)blockIdx.x);
      Epi3 E{P.x, (bf16_t*)(P.ws + WS_HB)};
      pg8::gemm_phase<Epi3, pg8::StaticOrder, PG8_ALIGN, PG8_SP2>(lds, g, S, E); }
    { pg8::Gemm g{(const bf16_t*)(P.ws + WS_PB), (const bf16_t*)(P.ws + WS_WPLE), T, DM, PLE_DIM, PLE_DIM}; pg8::StaticOrder S; S.init(T, DM, (int)gridDim.x, (int)blockIdx.x);
      EpiStore E{(bf16_t*)(P.ws + WS_PLE), DM};
      pg8::gemm_phase<EpiStore, pg8::StaticOrder, PG8_ALIGN, PG8_SP2>(lds, g, S, E); }
}
__device__ __forceinline__ void phase4_gemm(const Params& P, LAS unsigned char* lds) {
    pg8::Gemm g{(const bf16_t*)(P.ws + WS_HB), (const bf16_t*)(P.ws + WS_WG), T, DM, DM, DM}; pg8::StaticOrder S; S.init(T, DM, (int)gridDim.x, (int)blockIdx.x);
    Epi4 E{P.out, (const bf16_t*)(P.ws + WS_HB), (const bf16_t*)(P.ws + WS_PLE), (float*)(P.ws + WS_SSQF)};
    pg8::gemm_phase<Epi4, pg8::StaticOrder, PG8_ALIGN, PG8_SP2>(lds, g, S, E);
}

namespace att {
typedef short bf16x8 __attribute__((ext_vector_type(8)));
typedef short s16x4 __attribute__((ext_vector_type(4)));
typedef float f32x16 __attribute__((ext_vector_type(16)));
#define SBAR() __builtin_amdgcn_sched_barrier(0)
constexpr float THR = 8.f;
constexpr int BUF_BYTES = 32768, K_OFF = 0, V_OFF = 16384;
constexpr int WS_OFF = 2 * BUF_BYTES;
constexpr int ATT_LDS_BYTES = WS_OFF + 8 * 64 * 4;
__device__ __forceinline__ int crow(int r, int hi) { return (r & 3) + 8 * (r >> 2) + 4 * hi; }
__device__ __forceinline__ unsigned cvtpk(float lo, float hi) { unsigned r; asm volatile("v_cvt_pk_bf16_f32 %0, %1, %2" : "=v"(r) : "v"(lo), "v"(hi)); return r; }

__device__ __forceinline__ void partialSM(f32x16& p0, f32x16& p1, float& m_reg, float& alpha) {
    float pmax = p0[0];
#pragma unroll
    for (int r = 1; r < 16; ++r) pmax = fmaxf(pmax, p0[r]);
#pragma unroll
    for (int r = 0; r < 16; ++r) pmax = fmaxf(pmax, p1[r]);
    { auto rr = __builtin_amdgcn_permlane32_swap(__float_as_uint(pmax), __float_as_uint(pmax), false, false); pmax = fmaxf(__uint_as_float(rr[0]), __uint_as_float(rr[1])); }
    float mn;
    if (__builtin_expect(__all(pmax - m_reg <= THR), 1)) { mn = m_reg; alpha = 1.f; }
    else { mn = fmaxf(m_reg, pmax); alpha = __builtin_amdgcn_exp2f(m_reg - mn); m_reg = mn; }
#pragma unroll
    for (int r = 0; r < 16; ++r) { p0[r] -= mn; p1[r] -= mn; }
#pragma unroll
    for (int r = 0; r < 16; ++r) p0[r] = __builtin_amdgcn_exp2f(p0[r]);
}
__device__ __forceinline__ void finishSM(f32x16& p0, f32x16& p1, float alpha, float& l_reg, bf16x8& pa0, bf16x8& pa1, bf16x8& pa2, bf16x8& pa3) {
#pragma unroll
    for (int r = 0; r < 16; ++r) p1[r] = __builtin_amdgcn_exp2f(p1[r]);
    float ps = 0.f;
#pragma unroll
    for (int r = 0; r < 16; ++r) ps += p0[r];
#pragma unroll
    for (int r = 0; r < 16; ++r) ps += p1[r];
    { auto rr = __builtin_amdgcn_permlane32_swap(__float_as_uint(ps), __float_as_uint(ps), false, false); ps = __uint_as_float(rr[0]) + __uint_as_float(rr[1]); }
    l_reg = l_reg * alpha + ps;
#define PK4(P, BASE, OUT) do { unsigned a0 = cvtpk(P[BASE + 0], P[BASE + 1]), a1 = cvtpk(P[BASE + 2], P[BASE + 3]);   \
    unsigned b0 = cvtpk(P[BASE + 4], P[BASE + 5]), b1 = cvtpk(P[BASE + 6], P[BASE + 7]);                              \
    auto r0 = __builtin_amdgcn_permlane32_swap(a0, b0, false, false); auto r1 = __builtin_amdgcn_permlane32_swap(a1, b1, false, false); \
    u32x4 w = {r0[0], r1[0], r0[1], r1[1]}; OUT = __builtin_bit_cast(bf16x8, w); } while (0)
    PK4(p0, 0, pa0); PK4(p0, 8, pa1); PK4(p1, 0, pa2); PK4(p1, 8, pa3);
#undef PK4
}
__device__ __forceinline__ void cmask(f32x16& p0, f32x16& p1, int jb, int qrel, int hi) {
    const int kb = 64 * jb + 4 * hi;
#pragma unroll
    for (int r = 0; r < 16; ++r) { const int kv = kb + (r & 3) + 8 * (r >> 2); if (kv > qrel) p0[r] = -INFINITY; if (kv + 32 > qrel) p1[r] = -INFINITY; }
}
template <int DQK> __device__ __forceinline__ void qkt(f32x16& p0, f32x16& p1, LAS const unsigned char* kp  , const bf16x8* qr) {
    constexpr int PITCH = 2 * DQK + 16;
    p0 = f32x16{}; p1 = f32x16{};
#pragma unroll
    for (int d0 = 0; d0 < DQK / 16; ++d0) {
        const bf16x8 b0 = *(LAS const bf16x8*)(kp + d0 * 32), b1 = *(LAS const bf16x8*)(kp + 32 * PITCH + d0 * 32);
        p0 = __builtin_amdgcn_mfma_f32_32x32x16_bf16(b0, qr[d0], p0, 0, 0, 0);
        p1 = __builtin_amdgcn_mfma_f32_32x32x16_bf16(b1, qr[d0], p1, 0, 0, 0); }
}
template <int NCB> __device__ __forceinline__ int v_st(int k, int c) { const int kk = (k & ~0xC) | ((k & 4) << 1) | ((k & 8) >> 1); return ((kk >> 3) * NCB + (c >> 5)) * 512 + ((kk & 7) * 32 + (c & 31)) * 2; }
__device__ __forceinline__ int v_rd_base(int lane) { return ((lane & 3) << 3) | (((lane >> 2) & 3) << 6) | (((lane >> 4) & 1) << 5) | (((lane >> 5) & 1) << 8); }
template <int OFF> __device__ __forceinline__ s16x4 tr_read(int vb) { s16x4 r; asm volatile("ds_read_b64_tr_b16 %0, %1 offset:%2" : "=&v"(r) : "v"(vb), "i"(OFF) : "memory"); return r; }
template <int NCB, int D0> __device__ __forceinline__ void pv_one(f32x16& od, int vb, bf16x8 pa0, bf16x8 pa1, bf16x8 pa2, bf16x8 pa3) {
    constexpr int KS = 2 * NCB * 512, HF = NCB * 512, B0 = D0 * 512;
    const s16x4 l0 = tr_read<B0>(vb), h0 = tr_read<B0 + HF>(vb), l1 = tr_read<B0 + KS>(vb), h1 = tr_read<B0 + KS + HF>(vb);
    const s16x4 l2 = tr_read<B0 + 2 * KS>(vb), h2 = tr_read<B0 + 2 * KS + HF>(vb), l3 = tr_read<B0 + 3 * KS>(vb), h3 = tr_read<B0 + 3 * KS + HF>(vb);
    asm volatile("s_waitcnt lgkmcnt(0)" ::: "memory"); SBAR();
#define PK(L, H) (bf16x8){L[0], L[1], L[2], L[3], H[0], H[1], H[2], H[3]}
    od = __builtin_amdgcn_mfma_f32_32x32x16_bf16(pa0, PK(l0, h0), od, 0, 0, 0);
    od = __builtin_amdgcn_mfma_f32_32x32x16_bf16(pa1, PK(l1, h1), od, 0, 0, 0);
    od = __builtin_amdgcn_mfma_f32_32x32x16_bf16(pa2, PK(l2, h2), od, 0, 0, 0);
    od = __builtin_amdgcn_mfma_f32_32x32x16_bf16(pa3, PK(l3, h3), od, 0, 0, 0);
#undef PK
}
template <int NCB> __device__ __forceinline__ void pv_all(f32x16* o, int vb, bf16x8 pa0, bf16x8 pa1, bf16x8 pa2, bf16x8 pa3) {
    pv_one<NCB, 0>(o[0], vb, pa0, pa1, pa2, pa3); pv_one<NCB, 1>(o[1], vb, pa0, pa1, pa2, pa3);
    if constexpr (NCB == 4) { pv_one<NCB, 2>(o[2], vb, pa0, pa1, pa2, pa3); pv_one<NCB, 3>(o[3], vb, pa0, pa1, pa2, pa3); }
}

template <int DQK, int DV, int VP, int KIND>
__device__ __forceinline__ void attn_unit(const bf16_t* Qh, const bf16_t* Kh, const bf16_t* Vh, int qb, bf16_t* OUT, const bf16_t* GATE, LAS unsigned char* lds) {
    constexpr int NCB = DV / 32, NKS = DQK / 16, PITCH = 2 * DQK + 16, NKCH = DQK / 8, KCHUNKS = 64 * NKCH, NKI = (KCHUNKS + NT - 1) / NT, NVI = (64 * DV / 8) / NT;
    const int tid = tid_op(), lane = tid & 63, r32 = lane & 31, hi = lane >> 5; const int wid = __builtin_amdgcn_readfirstlane(tid >> 6);
    LAS float* wsf = (LAS float*)(lds + WS_OFF) + wid * 64; LAS float* li_l = wsf; LAS float* al_l = wsf + 32;
    const int q0 = qb * 256, NTL = (q0 + 256) / 64;
    float m_reg = -1e30f, l_reg = 0.f; f32x16 o[NCB]; bf16x8 qr[NKS];
#pragma unroll
    for (int d = 0; d < NCB; ++d) o[d] = f32x16{};
    { const bf16_t* Qw = Qh + (size_t)(q0 + wid * 32 + r32) * DQK + hi * 8;
#pragma unroll
      for (int d0 = 0; d0 < NKS; ++d0) qr[d0] = *(const bf16x8*)(Qw + d0 * 16); }
    int kgo[NKI], klo[NKI];
#pragma unroll
    for (int i = 0; i < NKI; ++i) { const int id = (tid + i * NT < KCHUNKS) ? tid + i * NT : tid; const int row = id / NKCH, ch = id % NKCH; kgo[i] = row * DQK + ch * 8; klo[i] = K_OFF + row * PITCH + ch * 16; }
    int vgo[NVI], vlo[NVI];
#pragma unroll
    for (int i = 0; i < NVI; ++i) { const int id = tid + i * NT; const int key = id / (DV / 8), c = (id % (DV / 8)) * 8; vgo[i] = key * VP + c; vlo[i] = V_OFF + v_st<NCB>(key, c); }
    bf16x8 ks[2][NKI], vs[2][NVI];
#define SLOAD(sl, t) do { const bf16_t* kt_ = Kh + (size_t)(t) * 64 * DQK; const bf16_t* vt_ = Vh + (size_t)(t) * 64 * VP; \
    _Pragma("unroll") for (int i_ = 0; i_ < NKI; ++i_) ks[sl][i_] = *(const bf16x8*)(kt_ + kgo[i_]); \
    _Pragma("unroll") for (int i_ = 0; i_ < NVI; ++i_) vs[sl][i_] = *(const bf16x8*)(vt_ + vgo[i_]); } while (0)
#define SWRITE(b, sl) do { LAS unsigned char* bb_ = lds + (b) * BUF_BYTES; \
    _Pragma("unroll") for (int i_ = 0; i_ < NKI; ++i_) *(LAS bf16x8*)(bb_ + klo[i_]) = ks[sl][i_]; \
    _Pragma("unroll") for (int i_ = 0; i_ < NVI; ++i_) *(LAS bf16x8*)(bb_ + vlo[i_]) = vs[sl][i_]; } while (0)
#define RESC(a) do { if (__any((a) < 1.f)) { if (hi == 0) al_l[r32] = (a); asm volatile("s_waitcnt lgkmcnt(0)" ::: "memory"); \
    _Pragma("unroll") for (int d_ = 0; d_ < NCB; ++d_) _Pragma("unroll") for (int r_ = 0; r_ < 16; ++r_) o[d_][r_] *= al_l[crow(r_, hi)]; } } while (0)
#define CMASK(P0, P1, t) do { const int jb_ = (t) - (NTL - 4); if (jb_ >= 0) cmask(P0, P1, jb_, qrel, hi); } while (0)
    LAS const unsigned char* kp0 = lds + K_OFF + r32 * PITCH + hi * 16; LAS const unsigned char* kp1 = kp0 + BUF_BYTES;
    const int vb0 = (int)(uintptr_t)(lds + V_OFF) + v_rd_base(lane), vb1 = vb0 + BUF_BYTES;
    const int qrel = wid * 32 + r32;
    f32x16 pA0, pA1, pB0, pB1; float alA, alB; bf16x8 pa0, pa1, pa2, pa3;
    SLOAD(0, 0); SWRITE(0, 0); __syncthreads();
    qkt<DQK>(pA0, pA1, kp0, qr); CMASK(pA0, pA1, 0); partialSM(pA0, pA1, m_reg, alA);
    SLOAD(1, 1); SLOAD(0, 2);
    SWRITE(1, 1); __syncthreads();
#pragma unroll 1
    for (int j = 1; j + 1 < NTL; j += 2) {
        SBAR(); qkt<DQK>(pB0, pB1, kp1, qr);
        finishSM(pA0, pA1, alA, l_reg, pa0, pa1, pa2, pa3); SBAR();
        SLOAD(1, j + 2); SBAR();
        pv_all<NCB>(o, vb0, pa0, pa1, pa2, pa3); CMASK(pB0, pB1, j); partialSM(pB0, pB1, m_reg, alB);
        __syncthreads(); SWRITE(0, 0);
        RESC(alB); __syncthreads();
        SBAR(); qkt<DQK>(pA0, pA1, kp0, qr);
        finishSM(pB0, pB1, alB, l_reg, pa0, pa1, pa2, pa3); SBAR();
        if (j + 3 < NTL) SLOAD(0, j + 3); SBAR();
        pv_all<NCB>(o, vb1, pa0, pa1, pa2, pa3); CMASK(pA0, pA1, j + 1); partialSM(pA0, pA1, m_reg, alA);
        __syncthreads(); SWRITE(1, 1);
        RESC(alA); __syncthreads();
    }
    SBAR(); qkt<DQK>(pB0, pB1, kp1, qr);
    finishSM(pA0, pA1, alA, l_reg, pa0, pa1, pa2, pa3); SBAR();
    pv_all<NCB>(o, vb0, pa0, pa1, pa2, pa3); CMASK(pB0, pB1, NTL - 1); partialSM(pB0, pB1, m_reg, alB);
    RESC(alB);
    finishSM(pB0, pB1, alB, l_reg, pa0, pa1, pa2, pa3); SBAR();
    pv_all<NCB>(o, vb1, pa0, pa1, pa2, pa3);
    if (hi == 0) li_l[r32] = l_reg; asm volatile("s_waitcnt lgkmcnt(0)" ::: "memory");
    float rli[16];
#pragma unroll
    for (int r = 0; r < 16; ++r) rli[r] = __builtin_amdgcn_rcpf(li_l[crow(r, hi)]);
    __syncthreads();
    LAS bf16_t* stg = (LAS bf16_t*)(lds + wid * 8192);
#pragma unroll
    for (int r = 0; r < 16; ++r) { const int orow = crow(r, hi);
#pragma unroll
        for (int d0 = 0; d0 < NCB; ++d0) stg[orow * DV + d0 * 32 + r32] = (bf16_t)f2bf(o[d0][r] * rli[r]); }
    asm volatile("s_waitcnt lgkmcnt(0)" ::: "memory");
    constexpr int CPR = DV / 8;
#pragma unroll
    for (int i = 0; i < (32 * CPR) / 64; ++i) { const int id = i * 64 + lane, row = id / CPR, ch = id % CPR; u32x4 v = *(LAS const u32x4*)(stg + row * DV + ch * 8);
        const size_t ro = (size_t)(q0 + wid * 32 + row);
        if constexpr (KIND == 0) { *(u32x4*)(OUT + ro * 128 + ch * 8) = v; }
        else { const u32x4 g = *(const u32x4*)(GATE + ro * 1024 + ch * 8); u32x4 w;
            w.x = cvtpk(__uint_as_float(v.x << 16) * __uint_as_float(g.x << 16), __uint_as_float(v.x & 0xffff0000u) * __uint_as_float(g.x & 0xffff0000u));
            w.y = cvtpk(__uint_as_float(v.y << 16) * __uint_as_float(g.y << 16), __uint_as_float(v.y & 0xffff0000u) * __uint_as_float(g.y & 0xffff0000u));
            w.z = cvtpk(__uint_as_float(v.z << 16) * __uint_as_float(g.z << 16), __uint_as_float(v.z & 0xffff0000u) * __uint_as_float(g.z & 0xffff0000u));
            w.w = cvtpk(__uint_as_float(v.w << 16) * __uint_as_float(g.w << 16), __uint_as_float(v.w & 0xffff0000u) * __uint_as_float(g.w & 0xffff0000u));
            *(u32x4*)(OUT + ro * 1024 + ch * 8) = w; } }
    asm volatile("s_waitcnt lgkmcnt(0)" ::: "memory");
    __syncthreads();
#undef SLOAD
#undef SWRITE
#undef RESC
#undef CMASK
}
#undef SBAR
}

namespace att2 {
using att::bf16x8; using att::s16x4; using att::f32x16; using att::crow; using att::cvtpk; using att::cmask; using att::tr_read;
#define SBAR() __builtin_amdgcn_sched_barrier(0)
#define WAIT_BAR(N) asm volatile("s_waitcnt vmcnt(" #N ") lgkmcnt(0)\n\ts_barrier" ::: "memory")
constexpr float THR = 8.f;
__device__ __forceinline__ void glds16(const void* gsrc, unsigned lds_dst) { unsigned keep;
    asm volatile("s_mov_b32 %0, m0\n\ts_mov_b32 m0, %2\n\ts_nop 0\n\tglobal_load_lds_dwordx4 %1, off\n\ts_mov_b32 m0, %0" : "=&s"(keep) : "v"(gsrc), "s"(lds_dst) : "memory"); }
__device__ __forceinline__ void partialSM(f32x16& p0, f32x16& p1, float& m_reg, float& alpha) {
    float pmax = p0[0];
#pragma unroll
    for (int r = 1; r < 16; ++r) pmax = fmaxf(pmax, p0[r]);
#pragma unroll
    for (int r = 0; r < 16; ++r) pmax = fmaxf(pmax, p1[r]);
    { auto rr = __builtin_amdgcn_permlane32_swap(__float_as_uint(pmax), __float_as_uint(pmax), false, false); pmax = fmaxf(__uint_as_float(rr[0]), __uint_as_float(rr[1])); }
    float mn;
    if (__builtin_expect(__all(pmax - m_reg <= THR), 1)) { mn = m_reg; alpha = 1.f; }
    else { mn = fmaxf(m_reg, pmax); alpha = __builtin_amdgcn_exp2f(m_reg - mn); m_reg = mn; }
#pragma unroll
    for (int r = 0; r < 16; ++r) { p0[r] -= mn; p1[r] -= mn; }
#pragma unroll
    for (int r = 0; r < 16; ++r) p0[r] = __builtin_amdgcn_exp2f(p0[r]);
}
__device__ __forceinline__ void finishSM(f32x16& p0, f32x16& p1, float alpha, float& l_reg, bf16x8& pa0, bf16x8& pa1, bf16x8& pa2, bf16x8& pa3) {
#pragma unroll
    for (int r = 0; r < 16; ++r) p1[r] = __builtin_amdgcn_exp2f(p1[r]);
    float ps = 0.f;
#pragma unroll
    for (int r = 0; r < 16; ++r) ps += p0[r];
#pragma unroll
    for (int r = 0; r < 16; ++r) ps += p1[r];
    { auto rr = __builtin_amdgcn_permlane32_swap(__float_as_uint(ps), __float_as_uint(ps), false, false); ps = __uint_as_float(rr[0]) + __uint_as_float(rr[1]); }
    l_reg = l_reg * alpha + ps;
#define PK8(P, B) __builtin_bit_cast(bf16x8, (u32x4){cvtpk(P[B], P[B + 1]), cvtpk(P[B + 2], P[B + 3]), cvtpk(P[B + 4], P[B + 5]), cvtpk(P[B + 6], P[B + 7])})
    pa0 = PK8(p0, 0); pa1 = PK8(p0, 8); pa2 = PK8(p1, 0); pa3 = PK8(p1, 8);
#undef PK8
}
template <int NKS> __device__ __forceinline__ void qkt(f32x16& p0, f32x16& p1, LAS const unsigned char* kp  , const bf16x8* qr) {
    p0 = f32x16{}; p1 = f32x16{};
#pragma unroll
    for (int d0 = 0; d0 < NKS; ++d0) {
        const bf16x8 b0 = *(LAS const bf16x8*)(kp + d0 * 2048), b1 = *(LAS const bf16x8*)(kp + d0 * 2048 + 512);
        p0 = __builtin_amdgcn_mfma_f32_32x32x16_bf16(b0, qr[d0], p0, 0, 0, 0);
        p1 = __builtin_amdgcn_mfma_f32_32x32x16_bf16(b1, qr[d0], p1, 0, 0, 0); }
}
template <int D0> __device__ __forceinline__ void pv_one(f32x16& od, int vb, bf16x8 pa0, bf16x8 pa1, bf16x8 pa2, bf16x8 pa3) {
    constexpr int B0 = D0 * 4096;
    const s16x4 l0 = tr_read<B0>(vb), h0 = tr_read<B0 + 512>(vb), l1 = tr_read<B0 + 1024>(vb), h1 = tr_read<B0 + 1536>(vb);
    const s16x4 l2 = tr_read<B0 + 2048>(vb), h2 = tr_read<B0 + 2560>(vb), l3 = tr_read<B0 + 3072>(vb), h3 = tr_read<B0 + 3584>(vb);
    asm volatile("s_waitcnt lgkmcnt(0)" ::: "memory"); SBAR();
#define PK(L, H) (bf16x8){L[0], L[1], L[2], L[3], H[0], H[1], H[2], H[3]}
    od = __builtin_amdgcn_mfma_f32_32x32x16_bf16(pa0, PK(l0, h0), od, 0, 0, 0);
    od = __builtin_amdgcn_mfma_f32_32x32x16_bf16(pa1, PK(l1, h1), od, 0, 0, 0);
    od = __builtin_amdgcn_mfma_f32_32x32x16_bf16(pa2, PK(l2, h2), od, 0, 0, 0);
    od = __builtin_amdgcn_mfma_f32_32x32x16_bf16(pa3, PK(l3, h3), od, 0, 0, 0);
#undef PK
}
template <int NCB> __device__ __forceinline__ void pv_all(f32x16* o, int vb, bf16x8 pa0, bf16x8 pa1, bf16x8 pa2, bf16x8 pa3) {
    pv_one<0>(o[0], vb, pa0, pa1, pa2, pa3); pv_one<1>(o[1], vb, pa0, pa1, pa2, pa3);
    if constexpr (NCB == 4) { pv_one<2>(o[2], vb, pa0, pa1, pa2, pa3); pv_one<3>(o[3], vb, pa0, pa1, pa2, pa3); }
}
template <int DQK, int DV> struct Geo {
    static constexpr int NCB = DV / 32, NKS = DQK / 16, NKCH = DQK / 8, KSLOT = NKCH * 1024, VSLOT = NCB * 4096, K_OFF = 0, V_OFF = 3 * KSLOT, WS_OFF = V_OFF + 3 * VSLOT, STG_OFF = WS_OFF + 2048;
    static constexpr int NKI = (NKCH + 7) / 8, NVI = (NCB * 4) / 8, NDMA = NKI + NVI;
};
template <int DQK, int DV, int VP>
__device__ __forceinline__ void attn_pass(const bf16_t* Qh, const bf16_t* Kh, const bf16_t* Vh, int qb, LAS unsigned char* lds, f32x16 (&o)[DV / 32], float (&rli)[16]) {
    typedef Geo<DQK, DV> Gm; constexpr int NCB = Gm::NCB, NKS = Gm::NKS, NKI = Gm::NKI, NVI = Gm::NVI, KSLOT = Gm::KSLOT, VSLOT = Gm::VSLOT;
    static_assert(Gm::NDMA == 3, "the ring waits below count 3 LDS-DMA pieces per wave and step (NVI of them V pieces)");
    const int tid = tid_op(), lane = tid & 63, r32 = lane & 31, hi = lane >> 5; const int wid = __builtin_amdgcn_readfirstlane(tid >> 6);
    LAS float* wsf = (LAS float*)(lds + Gm::WS_OFF) + wid * 64; LAS float* li_l = wsf; LAS float* al_l = wsf + 32;
    const unsigned lds0 = (unsigned)(uintptr_t)lds;
    const int q0 = qb * 256, NTL = (q0 + 256) / 64;
    const bf16_t* ksrc[NKI]; unsigned kdst[NKI]; const bf16_t* vsrc[NVI]; unsigned vdst[NVI];
#pragma unroll
    for (int i = 0; i < NKI; ++i) { const int c = (wid + 8 * i < Gm::NKCH) ? wid + 8 * i : wid; ksrc[i] = Kh + (size_t)lane * DQK + c * 8; kdst[i] = lds0 + Gm::K_OFF + c * 1024; }
#pragma unroll
    for (int i = 0; i < NVI; ++i) { const int pi = wid + 8 * i, dblk = pi >> 2, kq = pi & 3; vsrc[i] = Vh + (size_t)(16 * kq + (lane >> 2)) * VP + dblk * 32 + (lane & 3) * 8; vdst[i] = lds0 + Gm::V_OFF + pi * 1024; }
#define DMA_K(t, so) do { _Pragma("unroll") for (int i_ = 0; i_ < NKI; ++i_) glds16(ksrc[i_] + (size_t)(t) * 64 * DQK, (unsigned)__builtin_amdgcn_readfirstlane(kdst[i_] + (so) * KSLOT)); } while (0)
#define DMA_V(t, so) do { _Pragma("unroll") for (int i_ = 0; i_ < NVI; ++i_) glds16(vsrc[i_] + (size_t)(t) * 64 * VP, (unsigned)__builtin_amdgcn_readfirstlane(vdst[i_] + (so) * VSLOT)); } while (0)
    DMA_K(0, 0); DMA_V(0, 0); DMA_K(1, 1);
    float m_reg = -1e30f, l_reg = 0.f; bf16x8 qr[NKS];
#pragma unroll
    for (int d = 0; d < NCB; ++d) o[d] = f32x16{};
    { const bf16_t* Qw = Qh + (size_t)(q0 + wid * 32 + r32) * DQK + hi * 8;
#pragma unroll
      for (int d0 = 0; d0 < NKS; ++d0) qr[d0] = *(const bf16x8*)(Qw + d0 * 16); }
    LAS const unsigned char* kp0 = lds + Gm::K_OFF + hi * 1024 + r32 * 16;
    const int vb0 = (int)lds0 + Gm::V_OFF + ((lane >> 4) & 1) * 32 + (lane & 3) * 8 + (4 * hi + ((lane & 15) >> 2)) * 64;
    const int qrel = wid * 32 + r32;
#define RESC(a) do { if (__any((a) < 1.f)) { if (hi == 0) al_l[r32] = (a); asm volatile("s_waitcnt lgkmcnt(0)" ::: "memory"); \
    _Pragma("unroll") for (int d_ = 0; d_ < NCB; ++d_) _Pragma("unroll") for (int r_ = 0; r_ < 16; ++r_) o[d_][r_] *= al_l[crow(r_, hi)]; } } while (0)
#define CMASK(P0, P1, t) do { const int jb_ = (t) - (NTL - 4); if (jb_ >= 0) cmask(P0, P1, jb_, qrel, hi); } while (0)
    int sp = 2, sc = 0, sn = 1;
#define ROT() do { const int t_ = sp; sp = sc; sc = sn; sn = t_; } while (0)
    f32x16 pA0, pA1, pB0, pB1; float alA, alB; bf16x8 pa0, pa1, pa2, pa3;
    asm volatile("s_waitcnt vmcnt(0)" ::: "memory"); __builtin_amdgcn_s_barrier();
    DMA_K(2, sp); DMA_V(1, sn);
    qkt<NKS>(pA0, pA1, kp0 + sc * KSLOT, qr); CMASK(pA0, pA1, 0); partialSM(pA0, pA1, m_reg, alA);
    WAIT_BAR(3); ROT();
#define STEP(C0, C1, alC, P0, P1, alP, t) do { \
    if ((t) + 2 < NTL) DMA_K((t) + 2, sp); if ((t) + 1 < NTL) DMA_V((t) + 1, sn); \
    SBAR(); qkt<NKS>(C0, C1, kp0 + sc * KSLOT, qr); \
    finishSM(P0, P1, alP, l_reg, pa0, pa1, pa2, pa3); SBAR(); \
    pv_all<NCB>(o, vb0 + sp * VSLOT, pa0, pa1, pa2, pa3); CMASK(C0, C1, t); partialSM(C0, C1, m_reg, alC); \
    RESC(alC); \
    if ((t) + 2 < NTL) { WAIT_BAR(3); } else if ((t) + 1 < NTL) { if (NVI == 2) { WAIT_BAR(2); } else { WAIT_BAR(1); } } else { WAIT_BAR(0); } \
    ROT(); } while (0)
#pragma unroll 1
    for (int t = 1; t + 1 < NTL; t += 2) { STEP(pB0, pB1, alB, pA0, pA1, alA, t); STEP(pA0, pA1, alA, pB0, pB1, alB, t + 1); }
    STEP(pB0, pB1, alB, pA0, pA1, alA, NTL - 1);
    finishSM(pB0, pB1, alB, l_reg, pa0, pa1, pa2, pa3); SBAR();
    pv_all<NCB>(o, vb0 + sp * VSLOT, pa0, pa1, pa2, pa3);
    if (hi == 0) li_l[r32] = l_reg; asm volatile("s_waitcnt lgkmcnt(0)" ::: "memory");
#pragma unroll
    for (int r = 0; r < 16; ++r) rli[r] = __builtin_amdgcn_rcpf(li_l[crow(r, hi)]);
    WAIT_BAR(0);
#undef DMA_K
#undef DMA_V
#undef RESC
#undef CMASK
#undef ROT
#undef STEP
}
typedef short v4i16_t __attribute__((ext_vector_type(4)));
__device__ __forceinline__ s16x4 vtr(LAS const unsigned char* p) { return __builtin_bit_cast(s16x4, __builtin_amdgcn_ds_read_tr16_b64_v4i16((LAS v4i16_t*)p)); }
#define PIN(x) asm volatile("" : "+v"(x))
#define PEL(P0, P1, e) ((e) < 16 ? P0[(e) & 15] : P1[(e) & 15])
template <int NKS, int NCB>
__device__ __forceinline__ void step3(f32x16& C0, f32x16& C1, f32x16& P0, f32x16& P1, float alP, float& alC, float& m_reg, float& l_reg, f32x16 (&o)[NCB], const bf16x8 (&qr)[NKS],
                                      LAS const unsigned char* kp, LAS const unsigned char* vp, bool band, int jb, int qrel, int hi) {
    constexpr int NQK = 2 * NKS, NPV = 4 * NCB, A_PER = (32 + NQK - 1) / NQK, C_PER = (16 + NQK - 1) / NQK, E_PER = 32 / NPV;
    bf16x8 kfr[NQK]; s16x4 vlo[NPV], vhi[NPV]; u32x4 pw[4]; float sacc = 0.f;
    kfr[0] = *(LAS const bf16x8*)(kp); kfr[1] = *(LAS const bf16x8*)(kp + 512);
#pragma unroll
    for (int f = 0; f < NQK; ++f) {
        if (f + 2 < NQK) kfr[f + 2] = *(LAS const bf16x8*)(kp + ((f + 2) >> 1) * 2048 + ((f + 2) & 1) * 512);
        if (f < 8) { const int ks = f / NCB, d0 = f % NCB; vlo[f] = vtr(vp + d0 * 4096 + ks * 1024); vhi[f] = vtr(vp + d0 * 4096 + ks * 1024 + 512); }
        SBAR();
        if (f & 1) C1 = __builtin_amdgcn_mfma_f32_32x32x16_bf16(kfr[f], qr[f >> 1], f < 2 ? f32x16{} : C1, 0, 0, 0);
        else       C0 = __builtin_amdgcn_mfma_f32_32x32x16_bf16(kfr[f], qr[f >> 1], f < 2 ? f32x16{} : C0, 0, 0, 0);
#pragma unroll
        for (int k = 0; k < A_PER; ++k) { const int e = f * A_PER + k; if (e < 32) sacc += PEL(P0, P1, e); }
        PIN(sacc);
#pragma unroll
        for (int k = 0; k < C_PER; ++k) { const int i2 = f * C_PER + k; if (i2 < 16) { pw[i2 >> 2][i2 & 3] = cvtpk(PEL(P0, P1, 2 * i2), PEL(P0, P1, 2 * i2 + 1)); PIN(pw[i2 >> 2]); } }
        SBAR();
    }
    l_reg = l_reg * alP + sacc;
    if (band) { asm volatile("; band tile" ::: "memory"); cmask(C0, C1, jb, qrel, hi); }
    float pmax = fmaxf(fmaxf(C0[0], C0[1]), C1[0]);
#pragma unroll
    for (int r = 1; r < 16; ++r) { pmax = fmaxf(pmax, C1[r]); if (r > 1) pmax = fmaxf(pmax, C0[r]); }
    { auto rr = __builtin_amdgcn_permlane32_swap(__float_as_uint(pmax), __float_as_uint(pmax), false, false); pmax = fmaxf(__uint_as_float(rr[0]), __uint_as_float(rr[1])); }
    float mn;
    if (__builtin_expect(__all(pmax - m_reg <= THR), 1)) { mn = m_reg; alC = 1.f; }
    else { mn = fmaxf(m_reg, pmax); alC = __builtin_amdgcn_exp2f(m_reg - mn); m_reg = mn; }
    SBAR();
#pragma unroll
    for (int g = 0; g < NPV; ++g) {
        if (NPV == 16 && g < 8) { const int g2 = g + 8, ks = g2 / NCB, d0 = g2 % NCB; vlo[g2] = vtr(vp + d0 * 4096 + ks * 1024); vhi[g2] = vtr(vp + d0 * 4096 + ks * 1024 + 512); }
        SBAR();
        { const int ks = g / NCB, d0 = g % NCB;
          const bf16x8 vf = (bf16x8){vlo[g][0], vlo[g][1], vlo[g][2], vlo[g][3], vhi[g][0], vhi[g][1], vhi[g][2], vhi[g][3]};
          o[d0] = __builtin_amdgcn_mfma_f32_32x32x16_bf16(__builtin_bit_cast(bf16x8, pw[ks]), vf, o[d0], 0, 0, 0); }
#pragma unroll
        for (int k = 0; k < E_PER; ++k) { const int e = g * E_PER + k;
            if (e < 16) C0[e & 15] = __builtin_amdgcn_exp2f(C0[e & 15] - mn); else C1[e & 15] = __builtin_amdgcn_exp2f(C1[e & 15] - mn); }
        if (g * E_PER < 16) PIN(C0); else PIN(C1);
        SBAR();
    }
}
template <int DQK, int DV, int VP>
__device__ __forceinline__ void attn_pass3(const bf16_t* Qh, const bf16_t* Kh, const bf16_t* Vh, int qb, LAS unsigned char* lds, f32x16 (&o)[DV / 32], float (&rli)[16]) {
    typedef Geo<DQK, DV> Gm; constexpr int NCB = Gm::NCB, NKS = Gm::NKS, NKI = Gm::NKI, NVI = Gm::NVI, KSLOT = Gm::KSLOT, VSLOT = Gm::VSLOT;
    static_assert(Gm::NDMA == 3, "the ring waits below count 3 LDS-DMA pieces per wave and step (NVI of them V pieces)");
    const int tid = tid_op(), lane = tid & 63, r32 = lane & 31, hi = lane >> 5; const int wid = __builtin_amdgcn_readfirstlane(tid >> 6);
    LAS float* wsf = (LAS float*)(lds + Gm::WS_OFF) + wid * 64; LAS float* li_l = wsf; LAS float* al_l = wsf + 32;
    const unsigned lds0 = (unsigned)(uintptr_t)lds;
    const int q0 = qb * 256, NTL = (q0 + 256) / 64;
    const bf16_t* ksrc[NKI]; unsigned kdst[NKI]; const bf16_t* vsrc[NVI]; unsigned vdst[NVI];
#pragma unroll
    for (int i = 0; i < NKI; ++i) { const int c = (wid + 8 * i < Gm::NKCH) ? wid + 8 * i : wid; ksrc[i] = Kh + (size_t)lane * DQK + c * 8; kdst[i] = lds0 + Gm::K_OFF + c * 1024; }
#pragma unroll
    for (int i = 0; i < NVI; ++i) { const int pi = wid + 8 * i, dblk = pi >> 2, kq = pi & 3; vsrc[i] = Vh + (size_t)(16 * kq + (lane >> 2)) * VP + dblk * 32 + (lane & 3) * 8; vdst[i] = lds0 + Gm::V_OFF + pi * 1024; }
#define DMA_K(t, so) do { _Pragma("unroll") for (int i_ = 0; i_ < NKI; ++i_) glds16(ksrc[i_] + (size_t)(t) * 64 * DQK, (unsigned)__builtin_amdgcn_readfirstlane(kdst[i_] + (so) * KSLOT)); } while (0)
#define DMA_V(t, so) do { _Pragma("unroll") for (int i_ = 0; i_ < NVI; ++i_) glds16(vsrc[i_] + (size_t)(t) * 64 * VP, (unsigned)__builtin_amdgcn_readfirstlane(vdst[i_] + (so) * VSLOT)); } while (0)
    DMA_K(0, 0); DMA_V(0, 0); DMA_K(1, 1);
    float m_reg = -1e30f, l_reg = 0.f; bf16x8 qr[NKS];
#pragma unroll
    for (int d = 0; d < NCB; ++d) o[d] = f32x16{};
    { const bf16_t* Qw = Qh + (size_t)(q0 + wid * 32 + r32) * DQK + hi * 8;
#pragma unroll
      for (int d0 = 0; d0 < NKS; ++d0) qr[d0] = *(const bf16x8*)(Qw + d0 * 16); }
    LAS const unsigned char* kp0 = lds + Gm::K_OFF + hi * 1024 + r32 * 16;
    LAS const unsigned char* vp0 = lds + Gm::V_OFF + ((lane >> 4) & 1) * 32 + (lane & 3) * 8 + (4 * hi + ((lane & 15) >> 2)) * 64;
    const int qrel = wid * 32 + r32;
#define RESC(a) do { if (__any((a) < 1.f)) { if (hi == 0) al_l[r32] = (a); asm volatile("s_waitcnt lgkmcnt(0)" ::: "memory"); \
    _Pragma("unroll") for (int d_ = 0; d_ < NCB; ++d_) _Pragma("unroll") for (int r_ = 0; r_ < 16; ++r_) o[d_][r_] *= al_l[crow(r_, hi)]; } } while (0)
    int sp = 2, sc = 0, sn = 1;
#define ROT() do { const int t_ = sp; sp = sc; sc = sn; sn = t_; } while (0)
    f32x16 pA0, pA1, pB0, pB1; float alA, alB;
    asm volatile("s_waitcnt vmcnt(0)" ::: "memory"); __builtin_amdgcn_s_barrier();
    DMA_K(2, sp); DMA_V(1, sn);
    att2::qkt<NKS>(pA0, pA1, kp0 + sc * KSLOT, qr); if (NTL == 4) cmask(pA0, pA1, 0, qrel, hi);
    { float pmax = pA0[0];
#pragma unroll
      for (int r = 1; r < 16; ++r) pmax = fmaxf(pmax, pA0[r]);
#pragma unroll
      for (int r = 0; r < 16; ++r) pmax = fmaxf(pmax, pA1[r]);
      { auto rr = __builtin_amdgcn_permlane32_swap(__float_as_uint(pmax), __float_as_uint(pmax), false, false); pmax = fmaxf(__uint_as_float(rr[0]), __uint_as_float(rr[1])); }
      m_reg = pmax; alA = 0.f;
#pragma unroll
      for (int r = 0; r < 16; ++r) { pA0[r] = __builtin_amdgcn_exp2f(pA0[r] - pmax); pA1[r] = __builtin_amdgcn_exp2f(pA1[r] - pmax); } }
    WAIT_BAR(3); ROT();
#define STEP(C0, C1, alC, P0, P1, alP, t) do { \
    if ((t) + 2 < NTL) DMA_K((t) + 2, sp); if ((t) + 1 < NTL) DMA_V((t) + 1, sn); \
    SBAR(); step3<NKS, NCB>(C0, C1, P0, P1, alP, alC, m_reg, l_reg, o, qr, kp0 + sc * KSLOT, vp0 + sp * VSLOT, (t) >= NTL - 4, (t) - (NTL - 4), qrel, hi); \
    RESC(alC); \
    if ((t) + 2 < NTL) { WAIT_BAR(3); } else if ((t) + 1 < NTL) { if (NVI == 2) { WAIT_BAR(2); } else { WAIT_BAR(1); } } else { WAIT_BAR(0); } \
    ROT(); } while (0)
#pragma unroll 1
    for (int t = 1; t + 1 < NTL; t += 2) { STEP(pB0, pB1, alB, pA0, pA1, alA, t); STEP(pA0, pA1, alA, pB0, pB1, alB, t + 1); }
    STEP(pB0, pB1, alB, pA0, pA1, alA, NTL - 1);
    { float ps = 0.f;
#pragma unroll
      for (int r = 0; r < 16; ++r) ps += pB0[r] + pB1[r];
      l_reg = l_reg * alB + ps;
#define PK8(P, B) __builtin_bit_cast(bf16x8, (u32x4){cvtpk(P[B], P[B + 1]), cvtpk(P[B + 2], P[B + 3]), cvtpk(P[B + 4], P[B + 5]), cvtpk(P[B + 6], P[B + 7])})
      const bf16x8 pa0 = PK8(pB0, 0), pa1 = PK8(pB0, 8), pa2 = PK8(pB1, 0), pa3 = PK8(pB1, 8);
#undef PK8
      SBAR(); att2::pv_all<NCB>(o, (int)lds0 + Gm::V_OFF + ((lane >> 4) & 1) * 32 + (lane & 3) * 8 + (4 * hi + ((lane & 15) >> 2)) * 64 + sp * VSLOT, pa0, pa1, pa2, pa3); }
    { auto rr = __builtin_amdgcn_permlane32_swap(__float_as_uint(l_reg), __float_as_uint(l_reg), false, false); l_reg = __uint_as_float(rr[0]) + __uint_as_float(rr[1]); }
    if (hi == 0) li_l[r32] = l_reg; asm volatile("s_waitcnt lgkmcnt(0)" ::: "memory");
#pragma unroll
    for (int r = 0; r < 16; ++r) rli[r] = __builtin_amdgcn_rcpf(li_l[crow(r, hi)]);
    WAIT_BAR(0);
#undef DMA_K
#undef DMA_V
#undef RESC
#undef ROT
#undef STEP
}
#undef PIN
#undef PEL
template <int DV, bool GATED>
__device__ __forceinline__ void store_rows(LAS const bf16_t* stg, bf16_t* out, const bf16_t* gate, int pitch, int lane) {
    constexpr int CPR = DV / 8;
#pragma unroll
    for (int i = 0; i < (32 * CPR) / 64; ++i) { const int id = i * 64 + lane, row = id / CPR, ch = id % CPR; const u32x4 v = *(LAS const u32x4*)(stg + row * DV + ch * 8);
        if constexpr (!GATED) { *(u32x4*)(out + (size_t)row * pitch + ch * 8) = v; }
        else { const u32x4 g = *(const u32x4*)(gate + (size_t)row * pitch + ch * 8); u32x4 w;
            w.x = cvtpk(__uint_as_float(v.x << 16) * __uint_as_float(g.x << 16), __uint_as_float(v.x & 0xffff0000u) * __uint_as_float(g.x & 0xffff0000u));
            w.y = cvtpk(__uint_as_float(v.y << 16) * __uint_as_float(g.y << 16), __uint_as_float(v.y & 0xffff0000u) * __uint_as_float(g.y & 0xffff0000u));
            w.z = cvtpk(__uint_as_float(v.z << 16) * __uint_as_float(g.z << 16), __uint_as_float(v.z & 0xffff0000u) * __uint_as_float(g.z & 0xffff0000u));
            w.w = cvtpk(__uint_as_float(v.w << 16) * __uint_as_float(g.w << 16), __uint_as_float(v.w & 0xffff0000u) * __uint_as_float(g.w & 0xffff0000u));
            *(u32x4*)(out + (size_t)row * pitch + ch * 8) = w; } }
}
#ifndef ATTN_PASS
#define ATTN_PASS attn_pass3
#endif
__device__ __forceinline__ void mla_unit(const bf16_t* Qh, const bf16_t* Kh, const bf16_t* Vh, int qb, bf16_t* YC, const bf16_t* G, LAS unsigned char* lds) {
    typedef Geo<96, 64> Gm; f32x16 o[2]; float rli[16];
    ATTN_PASS<96, 64, 64>(Qh, Kh, Vh, qb, lds, o, rli);
    const int tid = tid_op(), lane = tid & 63, r32 = lane & 31, hi = lane >> 5; const int wid = __builtin_amdgcn_readfirstlane(tid >> 6);
    LAS bf16_t* stg = (LAS bf16_t*)(lds + Gm::STG_OFF + wid * 4096);
#pragma unroll
    for (int r = 0; r < 16; ++r) { const int orow = crow(r, hi);
#pragma unroll
        for (int d0 = 0; d0 < 2; ++d0) stg[orow * 64 + d0 * 32 + r32] = (bf16_t)f2bf(o[d0][r] * rli[r]); }
    asm volatile("s_waitcnt lgkmcnt(0)" ::: "memory");
    const size_t ro = (size_t)(qb * 256 + wid * 32) * 1024;
    store_rows<64, true>(stg, YC + ro, G + ro, 1024, lane);
    asm volatile("s_waitcnt lgkmcnt(0)" ::: "memory");
    __syncthreads();
}
__device__ __forceinline__ void diff_unit(const bf16_t* Q0, const bf16_t* K0, const bf16_t* Vh, int qb, bf16_t* YC, const bf16_t* G, const float* subln_g, float lam, LAS unsigned char* lds) {
    typedef Geo<64, 128> Gm; f32x16 o[4]; float rli[16];
    const int tid = tid_op(), lane = tid & 63, r32 = lane & 31, hi = lane >> 5; const int wid = __builtin_amdgcn_readfirstlane(tid >> 6);
    LAS unsigned* park = (LAS unsigned*)(lds + Gm::STG_OFF + wid * 8192);
    ATTN_PASS<64, 128, 128>(Q0, K0, Vh, qb, lds, o, rli);
#pragma unroll
    for (int r = 0; r < 16; r += 2)
#pragma unroll
        for (int d0 = 0; d0 < 4; ++d0) park[((r >> 1) * 4 + d0) * 64 + lane] = cvtpk(o[d0][r] * rli[r], o[d0][r + 1] * rli[r + 1]);
    ATTN_PASS<64, 128, 128>(Q0 + (size_t)SEQ * 64, K0 + (size_t)SEQ * 64, Vh, qb, lds, o, rli);
    asm volatile("s_waitcnt lgkmcnt(0)" ::: "memory");
    float ss[16];
#pragma unroll
    for (int r = 0; r < 16; r += 2) { float s0 = 0.f, s1 = 0.f;
#pragma unroll
        for (int d0 = 0; d0 < 4; ++d0) { const unsigned w = park[((r >> 1) * 4 + d0) * 64 + lane];
            const float a = __uint_as_float(w << 16) - lam * (o[d0][r] * rli[r]), b = __uint_as_float(w & 0xffff0000u) - lam * (o[d0][r + 1] * rli[r + 1]);
            o[d0][r] = a; o[d0][r + 1] = b; s0 += a * a; s1 += b * b; }
        ss[r] = s0; ss[r + 1] = s1; }
#pragma unroll
    for (int r = 0; r < 16; ++r) { float v = ss[r];
        v += __shfl_xor(v, 1); v += __shfl_xor(v, 2); v += __shfl_xor(v, 4); v += __shfl_xor(v, 8); v += __shfl_xor(v, 16);
        ss[r] = __builtin_amdgcn_rsqf(v * (1.f / 128.f) + RMS_EPS) * (1.f - LAM_INIT); }
    float gcol[4];
#pragma unroll
    for (int d0 = 0; d0 < 4; ++d0) gcol[d0] = subln_g[d0 * 32 + r32];
    asm volatile("s_waitcnt lgkmcnt(0)" ::: "memory");
    LAS bf16_t* stg = (LAS bf16_t*)park;
#pragma unroll
    for (int r = 0; r < 16; ++r) { const int orow = crow(r, hi);
#pragma unroll
        for (int d0 = 0; d0 < 4; ++d0) stg[orow * 128 + d0 * 32 + r32] = (bf16_t)f2bf(o[d0][r] * ss[r] * gcol[d0]); }
    asm volatile("s_waitcnt lgkmcnt(0)" ::: "memory");
    const size_t ro = (size_t)(qb * 256 + wid * 32) * 1024;
    store_rows<128, true>(stg, YC + ro, G + ro, 1024, lane);
    asm volatile("s_waitcnt lgkmcnt(0)" ::: "memory");
    __syncthreads();
}
#undef SBAR
#undef WAIT_BAR
}

__device__ __forceinline__ void phase2_v2(const Params& P, LAS unsigned char* lds) {
    const bf16_t* QD = (const bf16_t*)(P.ws + WS_QD); const bf16_t* KD = (const bf16_t*)(P.ws + WS_KD); const bf16_t* VD = (const bf16_t*)(P.ws + WS_VD);
    const bf16_t* QM = (const bf16_t*)(P.ws + WS_QM); const bf16_t* KM = (const bf16_t*)(P.ws + WS_KM); const bf16_t* VM = (const bf16_t*)(P.ws + WS_VM);
    const bf16_t* G = (const bf16_t*)(P.ws + WS_G); bf16_t* YC = (bf16_t*)(P.ws + WS_YCAT);
    const float lam = ((const float*)(P.ws + WS_MISC))[0];
    const int Gn = (int)gridDim.x, bx = (int)blockIdx.x, vcu = (Gn % 8 == 0) ? (bx % 8) * (Gn / 8) + bx / 8 : bx;
#pragma unroll 1
    for (int it = vcu; it < 256 + 512; it += Gn) {
        if (it < 256) {
            const int bh4 = it >> 3, sidx = it & 7, b = bh4 >> 2, h = bh4 & 3;
#pragma unroll 1
            for (int half = 0; half < 2; ++half) { const int qb = half == 0 ? 15 - sidx : sidx;
                att2::diff_unit(QD + (size_t)(b * 8 + 2 * h) * SEQ * 64, KD + (size_t)(b * 8 + 2 * h) * SEQ * 64, VD + (size_t)(b * 4 + h) * SEQ * 128, qb,
                                YC + (size_t)b * SEQ * 1024 + h * 128, G + (size_t)b * SEQ * 1024 + h * 128, P.subln_g, lam, lds); }
        } else {
            const int rem = it - 256, bh = rem >> 3, sidx = rem & 7, b = bh >> 3, hh = bh & 7;
#pragma unroll 1
            for (int half = 0; half < 2; ++half) { const int qb = half == 0 ? 15 - sidx : sidx;
                att2::mla_unit(QM + (size_t)bh * SEQ * 96, KM + (size_t)bh * SEQ * 96, VM + (size_t)bh * SEQ * 64, qb, YC + (size_t)b * SEQ * 1024 + 512 + hh * 64, G + (size_t)b * SEQ * 1024 + 512 + hh * 64, lds); }
        }
    }
    __syncthreads();
}

__device__ __forceinline__ void phase2_mfma(const Params& P, LAS unsigned char* lds) {
    const bf16_t* QD = (const bf16_t*)(P.ws + WS_QD); const bf16_t* KD = (const bf16_t*)(P.ws + WS_KD); const bf16_t* VD = (const bf16_t*)(P.ws + WS_VD);
    const bf16_t* QM = (const bf16_t*)(P.ws + WS_QM); const bf16_t* KM = (const bf16_t*)(P.ws + WS_KM); const bf16_t* VM = (const bf16_t*)(P.ws + WS_VM);
    const bf16_t* G = (const bf16_t*)(P.ws + WS_G); bf16_t* OD = (bf16_t*)(P.ws + WS_OD); bf16_t* YC = (bf16_t*)(P.ws + WS_YCAT);
    const int Gn = (int)gridDim.x, bx = (int)blockIdx.x, vcu = (Gn % 8 == 0) ? (bx % 8) * (Gn / 8) + bx / 8 : bx;
#pragma unroll 1
    for (int pr = vcu; pr < 1024; pr += Gn) {
        const int kind = pr >> 9, rem = pr & 511, bh = rem >> 3, sidx = rem & 7, b = bh >> 3, hh = bh & 7;
#pragma unroll 1
        for (int half = 0; half < 2; ++half) {
            const int qb = half == 0 ? 15 - sidx : sidx;
            if (kind == 0) att::attn_unit<64, 128, 128, 0>(QD + (size_t)bh * SEQ * 64, KD + (size_t)bh * SEQ * 64, VD + (size_t)(b * 4 + (hh >> 1)) * SEQ * 128, qb, OD + (size_t)bh * SEQ * 128, nullptr, lds);
            else att::attn_unit<96, 64, 64, 1>(QM + (size_t)bh * SEQ * 96, KM + (size_t)bh * SEQ * 96, VM + (size_t)bh * SEQ * 64, qb, YC + (size_t)b * SEQ * 1024 + 512 + hh * 64, G + (size_t)b * SEQ * 1024 + 512 + hh * 64, lds);
        }
    }
}

#define GAS __attribute__((address_space(1)))
constexpr int CW_BAR = 4096;
constexpr int LDSCTL_OFF = 162816, MISC_OFF = LDSCTL_OFF + 320;
#define XB_TMO      128
#define XB_XCNT(j)  (256  + 64 * (j))
#define XB_XSUB(j)  (1280 + 64 * (j))
#define XB_XGEN(j)  (2304 + 64 * (j))
#define XB_TOP      3328
#define XB_TOPGEN   3392
#define XCD_BAR_WORDS 3456
#define XB_SPIN_CAP (1u << 18)

__device__ __forceinline__ unsigned xb_ld(unsigned* p)              { return __hip_atomic_load(p, __ATOMIC_RELAXED, __HIP_MEMORY_SCOPE_AGENT); }
__device__ __forceinline__ unsigned xb_add(unsigned* p, unsigned v) { return __hip_atomic_fetch_add(p, v, __ATOMIC_RELAXED, __HIP_MEMORY_SCOPE_AGENT); }
__device__ __forceinline__ unsigned xb_xcc_id() { return (unsigned)__builtin_amdgcn_s_getreg((3 << 11) | 20) & 0xFu; }
#define XB_SPIN(cond, bar) do { unsigned _sp = 0; while (cond) { __builtin_amdgcn_s_sleep(1); \
    if ((++_sp & 255u) == 0u) { if (xb_ld(&(bar)[XB_TMO])) break; if (_sp > XB_SPIN_CAP) { atomicAdd(&(bar)[XB_TMO], 1u); break; } } } } while (0)

struct XcdBarrier {
    unsigned* bar; unsigned x;
    volatile LAS unsigned* st;
};

__device__ __forceinline__ XcdBarrier xcd_barrier_post(unsigned* bar, volatile LAS unsigned* st) {
    XcdBarrier b; b.bar = bar; b.x = xb_xcc_id(); b.st = st;
    if (threadIdx.x == 0) (void)xb_add(&bar[XB_XCNT(b.x)], 1u);
    return b;
}
__device__ __forceinline__ void xcd_barrier_complete(unsigned* bar, unsigned x, unsigned& nloc, unsigned& nx) {
    const unsigned G = gridDim.x * gridDim.y * gridDim.z;
    unsigned sum, cnt, mine, sp = 0u;
    for (;;) {
        sum = 0u; cnt = 0u; mine = 0u;
#pragma unroll
        for (unsigned j = 0; j < 16; ++j) { const unsigned c = xb_ld(&bar[XB_XCNT(j)]); sum += c; cnt += (c > 0u) ? 1u : 0u; mine = (j == x) ? c : mine; }
        if (sum == G) break;
        __builtin_amdgcn_s_sleep(1);
        if ((++sp & 255u) == 0u) { if (xb_ld(&bar[XB_TMO])) break; if (sp > XB_SPIN_CAP) { atomicAdd(&bar[XB_TMO], 1u); break; } }
    }
    nloc = mine > 0u ? mine : 1u; nx = cnt > 0u ? cnt : 1u;
}

__device__ __forceinline__ void xcd_barrier(const XcdBarrier& b) {
    asm volatile("s_waitcnt vmcnt(0)" ::: "memory");
    __syncthreads();
    if (threadIdx.x == 0) {
        unsigned* bar = b.bar;
        __builtin_amdgcn_s_waitcnt(0);
        unsigned nloc = b.st[0], nx = b.st[1];
        if (nloc == 0u) { xcd_barrier_complete(bar, b.x, nloc, nx); b.st[0] = nloc; b.st[1] = nx; }
        const unsigned old = xb_add(&bar[XB_XSUB(b.x)], 1u);
        const unsigned gen = old / nloc;
        if (old + 1u == (gen + 1u) * nloc) {
            __builtin_amdgcn_fence(__ATOMIC_RELEASE, "agent");
            asm volatile("s_waitcnt vmcnt(0)" ::: "memory");
            const unsigned og = xb_add(&bar[XB_TOP], 1u);
            const unsigned tg = og / nx;
            if (og + 1u == (tg + 1u) * nx) xb_add(&bar[XB_TOPGEN], 1u);
            else XB_SPIN(xb_ld(&bar[XB_TOPGEN]) == tg, bar);
            __builtin_amdgcn_fence(__ATOMIC_ACQUIRE, "agent");
            xb_add(&bar[XB_XGEN(b.x)], 1u);
            asm volatile("s_waitcnt vmcnt(0)" ::: "memory");
        } else {
            XB_SPIN(xb_ld(&bar[XB_XGEN(b.x)]) == gen, bar);
            __builtin_amdgcn_fence(__ATOMIC_ACQUIRE, "agent");
            asm volatile("s_waitcnt vmcnt(0)" ::: "memory");
        }
    }
    __syncthreads();
}

#ifndef OPT_P1
#define OPT_P1 1
#endif
#ifndef OPT_P2
#define OPT_P2 2
#endif
#ifndef OPT_P15
#define OPT_P15 1
#endif
#ifndef OPT_P3
#define OPT_P3 1
#endif
#ifndef OPT_P4
#define OPT_P4 1
#endif
constexpr int LDS_BYTES = 163840;
__global__ void __launch_bounds__(NT, 2) fwd_megakernel(Params P) {
    extern __shared__ __attribute__((aligned(16))) unsigned char lds_raw[];
    LAS unsigned char* lds = (LAS unsigned char*)lds_raw;
    float* smem = (float*)lds_raw;
    const int bid = blockIdx.x, nb = gridDim.x;
    for (int u = threadIdx.x; u < (LDS_BYTES - LDSCTL_OFF) / 4; u += NT) ((LAS unsigned*)(lds + LDSCTL_OFF))[u] = 0u;
    __syncthreads();
    const XcdBarrier bar = xcd_barrier_post((unsigned*)(P.ws + WS_CTL) + CW_BAR, (volatile LAS unsigned*)(lds + MISC_OFF) + 8);
    { const int wv = __builtin_amdgcn_readfirstlane((int)threadIdx.x >> 6);
      if (wv < 6) phase0(P, bid, nb, bid * 6 + wv, nb * 6); else phase0_weights(P, lds, bid * 2 + (wv - 6), nb * 2); }
    xcd_barrier(bar);
#if OPT_P1
    phase1_gemm(P, lds);
#else
    phase1_naive(P, bid, nb, smem);
#endif
    xcd_barrier(bar);
#if OPT_P15
    phase15_gemm(P, lds);
#else
    phase15_naive(P, bid, nb, smem);
#endif
    xcd_barrier(bar);
#if OPT_P2 == 2
    phase2_v2(P, lds);
    xcd_barrier(bar);
#elif OPT_P2
    phase2_mfma(P, lds);
    xcd_barrier(bar);
    phase25_naive(P, bid, nb);
    xcd_barrier(bar);
#else
    phase2_naive(P, bid, nb, smem);
    xcd_barrier(bar);
    phase25_naive(P, bid, nb);
    xcd_barrier(bar);
#endif
#if OPT_P3
    phase3_gemm(P, lds);
#else
    phase3_naive(P, bid, nb, smem);
#endif
    xcd_barrier(bar);
#if OPT_P4
    phase4_gemm(P, lds);
#else
    phase4_naive(P, bid, nb, smem);
#endif
    xcd_barrier(bar);
    phase5(P, bid, nb);
}

extern "C" void kernel_launch(void* const* d_in, const int* in_sizes, int n_in, void* d_out, int out_size, void* d_ws, size_t ws_size, hipStream_t stream) {
    if (n_in != 15 || out_size != T * DM || ws_size < WS_END) { fprintf(stderr, "kernel_launch: unexpected shapes (n_in %d out %d ws %zu)\n", n_in, out_size, ws_size); return; }
    static int grid_blocks = 0;
    if (!grid_blocks) {
        int dev = 0, cus = 0, per_cu = 0;
        (void)hipGetDevice(&dev);
        (void)hipDeviceGetAttribute(&cus, hipDeviceAttributeMultiprocessorCount, dev);
        if (hipFuncSetAttribute((const void*)fwd_megakernel, hipFuncAttributeMaxDynamicSharedMemorySize, LDS_BYTES) != hipSuccess) { fprintf(stderr, "kernel_launch: hipFuncSetAttribute failed\n"); return; }
        if (hipOccupancyMaxActiveBlocksPerMultiprocessor(&per_cu, (const void*)fwd_megakernel, NT, LDS_BYTES) != hipSuccess || per_cu < 1) { fprintf(stderr, "kernel_launch: occupancy query says %d blocks/CU\n", per_cu); return; }
        grid_blocks = cus;
    }
    Params P{};
    P.x = (const float*)d_in[0]; P.p = (const float*)d_in[1]; P.pos = (const int*)d_in[2]; P.norm_g = (const float*)d_in[3]; P.w_in = (const float*)d_in[4];
    P.diff_lambda = (const float*)d_in[5]; P.subln_g = (const float*)d_in[6]; P.qn_g = (const float*)d_in[7]; P.w_uq = (const float*)d_in[8]; P.kvn_g = (const float*)d_in[9];
    P.w_ukv = (const float*)d_in[10]; P.w_out = (const float*)d_in[11]; P.w_ple = (const float*)d_in[12]; P.w_gate = (const float*)d_in[13]; P.final_g = (const float*)d_in[14];
    P.out = (float*)d_out; P.ws = (unsigned char*)d_ws;
    if (hipMemsetAsync((char*)d_ws + WS_CTL, 0, 65536, stream) != hipSuccess) { fprintf(stderr, "kernel_launch: memset failed\n"); return; }
    hipLaunchKernelGGL(fwd_megakernel, dim3(grid_blocks), dim3(NT), LDS_BYTES, stream, P);
    const hipError_t e = hipPeekAtLastError();
    if (e != hipSuccess) fprintf(stderr, "launch failed: %s (grid %d)\n", hipGetErrorString(e), grid_blocks);
}
```
